# Optimizing an MI355X kernel written in HIP

```python
import jax
import jax.numpy as jnp
from jax import lax
import numpy as np

D_MODEL = 1024
BATCH = 32
SEQ = 2048
DEPTH = 4

GRID_W = 64
CTX_LEN = 256
EPS = 1e-6
NEG = -1e30
ROPE_THETA = 10000.0
Q_BLOCK = 128
CHUNK = 64

A_HEADS = 4
A_DK = 128
A_DV = 128
B_HEADS = 4
B_DQK = 64
B_DV = 128
B_CONV = 3
C_HEADS = 8
C_KV_HEADS = 2
C_DH = 64
D_HEADS = 4
D_Q_LORA = 256
D_KV_LORA = 128
D_NOPE = 128
D_ROPE = 64
D_DV = 128
N_BRANCH = 4
BRANCH_W = 512
D_FF = 4 * D_MODEL

KEY_COLS = (
    ('a_i', A_HEADS * A_DV),
    ('a_f_fwd', A_HEADS * A_DK),
    ('a_f_bwd', A_HEADS * A_DK),
    ('b_k', B_HEADS * B_DQK),
    ('b_v', B_HEADS * B_DV),
    ('b_gates', 4 * B_HEADS),
    ('c_k', C_KV_HEADS * C_DH),
    ('c_v', C_KV_HEADS * C_DH),
    ('d_ckv', D_KV_LORA),
    ('d_krope', D_ROPE),
)
QUERY_COLS = (
    ('a_q', A_HEADS * A_DK),
    ('a_g', A_HEADS * A_DV),
    ('b_q', B_HEADS * B_DQK),
    ('b_o', B_HEADS * B_DV),
    ('c_q', C_HEADS * C_DH),
    ('d_cq', D_Q_LORA),
    ('gates', N_BRANCH * D_MODEL),
)
KEY_WIDTH = sum(w for _, w in KEY_COLS)
IN_WIDTH = KEY_WIDTH + sum(w for _, w in QUERY_COLS)

kernel_name = 'hybrid_parallel_mixer_dit_trunk'


def rms_norm(x, g):
    xf = x.astype(jnp.float32)
    y = xf * lax.rsqrt(jnp.mean(xf * xf, axis=-1, keepdims=True) + EPS)
    return (y * g.astype(jnp.float32)).astype(x.dtype)


def modulate(h, shift, scale):
    return h * (1.0 + scale) + shift


def split_cols(p, layout):
    sizes = [w for _, w in layout]
    parts = jnp.split(p, np.cumsum(sizes)[:-1].tolist(), axis=-1)
    return {name: part for (name, _), part in zip(layout, parts)}


def split_heads(x, h):
    return x.reshape(x.shape[0], x.shape[1], h, -1)


def to_heads(x, h):
    return split_heads(x, h).transpose(0, 2, 1, 3)


def from_heads(x):
    b, h, n, d = x.shape
    return x.transpose(0, 2, 1, 3).reshape(b, n, h * d)


def flip_time(t, rev):
    return jnp.flip(t, axis=2) if rev else t


def to_chunks(x):
    b, h, n = x.shape[:3]
    x = x.reshape(b, h, n // CHUNK, CHUNK, *x.shape[3:])
    return jnp.moveaxis(x, 2, 0)


def from_chunks(x):
    x = jnp.moveaxis(x, 0, 2)
    b, h, nc, l = x.shape[:4]
    return x.reshape(b, h, nc * l, *x.shape[4:])


def axial_rope_tables(row, col, rot_dim):
    quarter = rot_dim // 4
    inv_freq = ROPE_THETA ** (-jnp.arange(quarter, dtype=jnp.float32) / quarter)
    ang_r = row.astype(jnp.float32)[:, None] * inv_freq
    ang_c = col.astype(jnp.float32)[:, None] * inv_freq
    return (jnp.cos(ang_r)[:, None], jnp.sin(ang_r)[:, None], jnp.cos(ang_c)[:, None], jnp.sin(ang_c)[:, None])


def rope_rotate(x, cos, sin):
    x1, x2 = jnp.split(x, 2, axis=-1)
    return jnp.concatenate([x1 * cos - x2 * sin, x2 * cos + x1 * sin], axis=-1)


def rope_2d(x, tabs):
    cr, sr, cc, sc = tabs
    xr, xc = jnp.split(x, 2, axis=-1)
    return jnp.concatenate([rope_rotate(xr, cr, sr), rope_rotate(xc, cc, sc)], axis=-1).astype(x.dtype)


def block_attention(q, k, v, scale):
    b, nq, hk, g, dk = q.shape
    nb = nq // Q_BLOCK
    qb = q.reshape(b, nb, Q_BLOCK, hk, g, dk).transpose(1, 0, 2, 3, 4, 5)

    def one_block(qi):
        s = jnp.einsum('bqhgd,bmhd->bhgqm', qi, k, preferred_element_type=jnp.float32) * scale
        p = jax.nn.softmax(s, axis=-1)
        return jnp.einsum('bhgqm,bmhd->bqhgd', p.astype(v.dtype), v)

    out = lax.map(one_block, qb)
    return out.transpose(1, 0, 2, 3, 4, 5).reshape(b, nq, hk, g, v.shape[-1])


def short_conv(x, w):
    return lax.conv_general_dilated(x, w[:, None, :].astype(x.dtype), window_strides=(1,), padding='SAME',
                                    dimension_numbers=('NWC', 'WIO', 'NWC'), feature_group_count=x.shape[-1])


def hgrn2_gates(f_pre, lb):
    log_f = jnp.logaddexp(jnp.log(lb), jnp.log1p(-lb) + jax.nn.log_sigmoid(f_pre.astype(jnp.float32)))
    return to_heads(-jnp.expm1(log_f), A_HEADS), to_heads(log_f, A_HEADS)


def hgrn2_scan(q, k, v, log_f, s0):
    causal = jnp.tril(jnp.ones((CHUNK, CHUNK), dtype=bool))

    def step(s, inp):
        qc, kc, vc, lfc = inp
        bcum = jnp.cumsum(lfc, axis=2)
        rel = bcum[:, :, :, None, :] - bcum[:, :, None, :, :]
        decay = jnp.exp(jnp.where(causal[:, :, None], rel, NEG))
        a = jnp.einsum('bhtk,bhsk,bhtsk->bhts', qc, kc, decay)
        o = jnp.einsum('bhtk,bhkv->bhtv', qc * jnp.exp(bcum), s) + jnp.einsum('bhts,bhsv->bhtv', a, vc)
        blast = bcum[:, :, -1:, :]
        s_new = jnp.exp(blast[:, :, 0, :])[..., None] * s + jnp.einsum('bhsk,bhsv->bhkv', kc * jnp.exp(blast - bcum), vc)
        return s_new, o

    s_fin, o = lax.scan(step, s0, (to_chunks(q), to_chunks(k), to_chunks(v), to_chunks(log_f)))
    return from_chunks(o), s_fin


def hgrn2_final_state(k, v, log_f):
    bcum = jnp.cumsum(log_f, axis=2)
    return jnp.einsum('bhnk,bhnv->bhkv', k * jnp.exp(bcum[:, :, -1:, :] - bcum), v)


def hgrn2_mixer(lat, ctx, lb, norm_g, need_ctx_out):
    f32 = jnp.float32
    q_l = to_heads(jax.nn.silu(lat['a_q'].astype(f32)), A_HEADS)
    v_l = to_heads(lat['a_i'].astype(f32), A_HEADS)
    v_c = to_heads(ctx['a_i'].astype(f32), A_HEADS)
    q_c = to_heads(jax.nn.silu(ctx['a_q'].astype(f32)), A_HEADS) if need_ctx_out else None
    o_l, o_c = 0.0, 0.0
    for d, name in enumerate(('a_f_fwd', 'a_f_bwd')):
        rev = d == 1
        k_l, lf_l = hgrn2_gates(lat[name], lb[d])
        k_c, lf_c = hgrn2_gates(ctx[name], lb[d])
        if need_ctx_out:
            zero = jnp.zeros((v_c.shape[0], A_HEADS, A_DK, A_DV), f32)
            oc, s_ctx = hgrn2_scan(flip_time(q_c, rev), flip_time(k_c, rev), flip_time(v_c, rev),
                                   flip_time(lf_c, rev), zero)
            o_c = o_c + flip_time(oc, rev)
        else:
            s_ctx = hgrn2_final_state(flip_time(k_c, rev), flip_time(v_c, rev), flip_time(lf_c, rev))
        ol, _ = hgrn2_scan(flip_time(q_l, rev), flip_time(k_l, rev), flip_time(v_l, rev),
                           flip_time(lf_l, rev), s_ctx)
        o_l = o_l + flip_time(ol, rev)

    def readout(o, g):
        return (from_heads(rms_norm(o, norm_g)) * jax.nn.silu(g.astype(f32))).astype(g.dtype)

    return readout(o_l, lat['a_g']), (readout(o_c, ctx['a_g']) if need_ctx_out else None)


def mlstm_scan(q, k, v, ig, lf, state):
    causal = jnp.tril(jnp.ones((CHUNK, CHUNK), dtype=bool))

    def step(carry, inp):
        cmat, nvec, m = carry
        qc, kc, vc, igc, lfc = inp
        b = jnp.cumsum(lfc, axis=-1)
        dmat = jnp.where(causal, b[..., :, None] - b[..., None, :] + igc[..., None, :], NEG)
        inter = b + m[..., None]
        m_t = jnp.maximum(inter, jnp.max(dmat, axis=-1))
        w_inter = jnp.exp(inter - m_t)
        s = jnp.einsum('bhtk,bhsk->bhts', qc, kc) * jnp.exp(dmat - m_t[..., None])
        num = w_inter[..., None] * jnp.einsum('bhtk,bhkv->bhtv', qc, cmat) + jnp.einsum('bhts,bhsv->bhtv', s, vc)
        den = w_inter * jnp.einsum('bhtk,bhk->bht', qc, nvec) + jnp.sum(s, axis=-1)
        h = num / jnp.maximum(jnp.abs(den), jnp.exp(-m_t))[..., None]
        m_new = m_t[..., -1]
        dec = jnp.exp(b[..., -1] + m - m_new)
        wk = jnp.exp(b[..., -1:] - b + igc - m_new[..., None])
        c_new = dec[..., None, None] * cmat + jnp.einsum('bhs,bhsk,bhsv->bhkv', wk, kc, vc)
        n_new = dec[..., None] * nvec + jnp.einsum('bhs,bhsk->bhk', wk, kc)
        return (c_new, n_new, m_new), h

    fin, h = lax.scan(step, state, (to_chunks(q), to_chunks(k), to_chunks(v), to_chunks(ig), to_chunks(lf)))
    return from_chunks(h), fin


def mlstm_final_state(k, v, ig, lf):
    b = jnp.cumsum(lf, axis=-1)
    logw = b[..., -1:] - b + ig
    m = jnp.max(logw, axis=-1)
    w = jnp.exp(logw - m[..., None])
    return (jnp.einsum('bhn,bhnk,bhnv->bhkv', w, k, v), jnp.einsum('bhn,bhnk->bhk', w, k), m)


def mlstm_mixer(lat, ctx, gate_bias, conv_w, norm_g, need_ctx_out):
    f32 = jnp.float32

    def prep(side, with_q):
        b, n = side['b_v'].shape[:2]
        k = to_heads((jax.nn.silu(short_conv(side['b_k'], conv_w[1])) * B_DQK ** -0.5).astype(f32), B_HEADS)
        v = to_heads(side['b_v'].astype(f32), B_HEADS)
        q = to_heads(jax.nn.silu(short_conv(side['b_q'], conv_w[0])).astype(f32), B_HEADS) if with_q else None
        g = (side['b_gates'] + gate_bias).astype(f32).reshape(b, n, 4, B_HEADS).transpose(2, 0, 3, 1)
        return q, k, v, g

    q_l, k_l, v_l, g_l = prep(lat, True)
    q_c, k_c, v_c, g_c = prep(ctx, need_ctx_out)
    h_l, h_c = 0.0, 0.0
    for d in range(2):
        rev = d == 1
        ig_c, lf_c = g_c[2 * d], jax.nn.log_sigmoid(g_c[2 * d + 1])
        ig_l, lf_l = g_l[2 * d], jax.nn.log_sigmoid(g_l[2 * d + 1])
        if need_ctx_out:
            bsz = v_c.shape[0]
            zero = (jnp.zeros((bsz, B_HEADS, B_DQK, B_DV), f32), jnp.zeros((bsz, B_HEADS, B_DQK), f32),
                    jnp.full((bsz, B_HEADS), NEG, f32))
            hc, st = mlstm_scan(flip_time(q_c, rev), flip_time(k_c, rev), flip_time(v_c, rev),
                                flip_time(ig_c, rev), flip_time(lf_c, rev), zero)
            h_c = h_c + flip_time(hc, rev)
        else:
            st = mlstm_final_state(flip_time(k_c, rev), flip_time(v_c, rev), flip_time(ig_c, rev), flip_time(lf_c, rev))
        hl, _ = mlstm_scan(flip_time(q_l, rev), flip_time(k_l, rev), flip_time(v_l, rev),
                           flip_time(ig_l, rev), flip_time(lf_l, rev), st)
        h_l = h_l + flip_time(hl, rev)

    def readout(h, o):
        return (from_heads(rms_norm(h, norm_g)) * jax.nn.sigmoid(o.astype(f32))).astype(o.dtype)

    return readout(h_l, lat['b_o']), (readout(h_c, ctx['b_o']) if need_ctx_out else None)


def gqa_mixer(lat, ctx, q_g, k_g, tabs, need_ctx_out):
    grp = C_HEADS // C_KV_HEADS
    scale = C_DH ** -0.5

    def keys(side, rope):
        k = rms_norm(split_heads(side['c_k'], C_KV_HEADS), k_g)
        if rope is not None:
            k = rope_2d(k, rope)
        return k, split_heads(side['c_v'], C_KV_HEADS)

    def queries(side, rope):
        q = rms_norm(split_heads(side['c_q'], C_HEADS), q_g)
        if rope is not None:
            q = rope_2d(q, rope)
        return q.reshape(q.shape[0], q.shape[1], C_KV_HEADS, grp, C_DH)

    k_c, v_c = keys(ctx, None)
    k_l, v_l = keys(lat, tabs)
    y_l = block_attention(queries(lat, tabs), jnp.concatenate([k_c, k_l], axis=1),
                          jnp.concatenate([v_c, v_l], axis=1), scale)
    y_l = y_l.reshape(y_l.shape[0], y_l.shape[1], -1)
    if not need_ctx_out:
        return y_l, None
    y_c = block_attention(queries(ctx, None), k_c, v_c, scale)
    return y_l, y_c.reshape(y_c.shape[0], y_c.shape[1], -1)


def mla_mixer(lat, ctx, q_g, kv_g, w_uq, w_uk, w_uv, tabs, need_ctx_out):
    scale = (D_NOPE + D_ROPE) ** -0.5

    def keys(side, rope):
        ckv = rms_norm(side['d_ckv'], kv_g)
        k_nope = split_heads(ckv @ w_uk, D_HEADS)
        v = split_heads(ckv @ w_uv, D_HEADS)
        k_rope = side['d_krope'][:, :, None, :]
        if rope is not None:
            k_rope = rope_2d(k_rope, rope)
        k_rope = jnp.broadcast_to(k_rope, k_nope.shape[:3] + (D_ROPE,))
        return jnp.concatenate([k_nope, k_rope], axis=-1), v

    def queries(side, rope):
        q = split_heads(rms_norm(side['d_cq'], q_g) @ w_uq, D_HEADS)
        q_nope, q_rope = q[..., :D_NOPE], q[..., D_NOPE:]
        if rope is not None:
            q_rope = rope_2d(q_rope, rope)
        return jnp.concatenate([q_nope, q_rope], axis=-1)[:, :, :, None, :]

    k_c, v_c = keys(ctx, None)
    k_l, v_l = keys(lat, tabs)
    y_l = block_attention(queries(lat, tabs), jnp.concatenate([k_c, k_l], axis=1),
                          jnp.concatenate([v_c, v_l], axis=1), scale)
    y_l = y_l.reshape(y_l.shape[0], y_l.shape[1], -1)
    if not need_ctx_out:
        return y_l, None
    y_c = block_attention(queries(ctx, None), k_c, v_c, scale)
    return y_l, y_c.reshape(y_c.shape[0], y_c.shape[1], -1)


def merge_branches(ys, gate_pre, w_branch_l):
    g = gate_pre.reshape(*gate_pre.shape[:-1], N_BRANCH, D_MODEL)
    out = 0.0
    for r, y in enumerate(ys):
        out = out + jax.nn.sigmoid(g[..., r, :]) * (y @ w_branch_l[r])
    return out


def squared_relu_mlp(h, w1, w2):
    return jnp.square(jax.nn.relu(h @ w1)) @ w2


def setup_inputs(seed: int = 0) -> dict:
    key = jax.random.key(seed)
    ks = iter(jax.random.split(key, 32))

    def nrm(shape, std):
        return std * jax.random.normal(next(ks), shape, jnp.float32)

    def gain(shape):
        return 1.0 + nrm(shape, 0.02)

    x = nrm((BATCH, SEQ, D_MODEL), 1.0)
    c = nrm((BATCH, D_MODEL), 1.0)
    ctx = nrm((BATCH, CTX_LEN, D_MODEL), 1.0)
    c_ctx = nrm((D_MODEL,), 1.0)
    w_ada = nrm((DEPTH, D_MODEL, 6 * D_MODEL), 0.5 * D_MODEL ** -0.5)
    b_ada = nrm((DEPTH, 6 * D_MODEL), 0.02)
    g_norm1 = gain((DEPTH, D_MODEL))
    g_norm2 = gain((DEPTH, D_MODEL))
    w_in = nrm((DEPTH, D_MODEL, IN_WIDTH), D_MODEL ** -0.5)
    i_bias = nrm((DEPTH, 2, B_HEADS), 0.1)
    f_bias = jnp.linspace(3.0, 6.0, B_HEADS, dtype=jnp.float32) + nrm((DEPTH, 2, B_HEADS), 0.1)
    b_mlstm_gates = jnp.stack([i_bias, f_bias], axis=2).reshape(DEPTH, 4 * B_HEADS)
    hgrn_lb_logits = nrm((DEPTH, 2, A_HEADS * A_DK), 0.5)
    hgrn_norm_g = gain((DEPTH, A_DV))
    mlstm_conv_w = nrm((DEPTH, 2, B_CONV, B_HEADS * B_DQK), B_CONV ** -0.5)
    mlstm_norm_g = gain((DEPTH, B_DV))
    gqa_q_norm_g = gain((DEPTH, C_DH))
    gqa_k_norm_g = gain((DEPTH, C_DH))
    mla_q_norm_g = gain((DEPTH, D_Q_LORA))
    mla_kv_norm_g = gain((DEPTH, D_KV_LORA))
    w_mla_uq = nrm((DEPTH, D_Q_LORA, D_HEADS * (D_NOPE + D_ROPE)), D_Q_LORA ** -0.5)
    w_mla_uk = nrm((DEPTH, D_KV_LORA, D_HEADS * D_NOPE), D_KV_LORA ** -0.5)
    w_mla_uv = nrm((DEPTH, D_KV_LORA, D_HEADS * D_DV), D_KV_LORA ** -0.5)
    w_branch = nrm((DEPTH, N_BRANCH, BRANCH_W, D_MODEL), BRANCH_W ** -0.5)
    w_out = nrm((DEPTH, D_MODEL, D_MODEL), D_MODEL ** -0.5)
    w_ff1 = nrm((DEPTH, D_MODEL, D_FF), D_MODEL ** -0.5)
    w_ff2 = nrm((DEPTH, D_FF, D_MODEL), D_FF ** -0.5)
    g_final = gain((D_MODEL,))
    return {'x': x, 'c': c, 'ctx': ctx, 'c_ctx': c_ctx, 'w_ada': w_ada, 'b_ada': b_ada,
            'g_norm1': g_norm1, 'g_norm2': g_norm2, 'w_in': w_in, 'b_mlstm_gates': b_mlstm_gates,
            'hgrn_lb_logits': hgrn_lb_logits, 'hgrn_norm_g': hgrn_norm_g, 'mlstm_conv_w': mlstm_conv_w,
            'mlstm_norm_g': mlstm_norm_g, 'gqa_q_norm_g': gqa_q_norm_g, 'gqa_k_norm_g': gqa_k_norm_g,
            'mla_q_norm_g': mla_q_norm_g, 'mla_kv_norm_g': mla_kv_norm_g, 'w_mla_uq': w_mla_uq,
            'w_mla_uk': w_mla_uk, 'w_mla_uv': w_mla_uv, 'w_branch': w_branch, 'w_out': w_out,
            'w_ff1': w_ff1, 'w_ff2': w_ff2, 'g_final': g_final}


def reference(x, c, ctx, c_ctx, w_ada, b_ada, g_norm1, g_norm2, w_in, b_mlstm_gates, hgrn_lb_logits,
              hgrn_norm_g, mlstm_conv_w, mlstm_norm_g, gqa_q_norm_g, gqa_k_norm_g, mla_q_norm_g,
              mla_kv_norm_g, w_mla_uq, w_mla_uk, w_mla_uv, w_branch, w_out, w_ff1, w_ff2, g_final):
    n_lat = x.shape[1]
    rows = n_lat // GRID_W
    row = jnp.repeat(jnp.arange(rows, dtype=jnp.int32), GRID_W)
    col = jnp.broadcast_to(jnp.arange(GRID_W, dtype=jnp.int32), (rows, GRID_W)).reshape(-1)
    rope_c = axial_rope_tables(row, col, C_DH)
    rope_d = axial_rope_tables(row, col, D_ROPE)

    lb_all = jnp.cumsum(jax.nn.softmax(hgrn_lb_logits.astype(jnp.float32), axis=0), axis=0)
    lb_all = lb_all - lb_all[0]

    s_c = jax.nn.silu(c)
    s_cc = jax.nn.silu(c_ctx)
    x_l, x_c = x, ctx
    for l in range(DEPTH):
        need_ctx = l < DEPTH - 1
        mod = jnp.split((s_c @ w_ada[l] + b_ada[l])[:, None, :], 6, axis=-1)
        n_cm = 6 if need_ctx else 2
        mod_c = jnp.split(s_cc @ w_ada[l][:, :n_cm * D_MODEL] + b_ada[l][:n_cm * D_MODEL], n_cm)

        h_l = modulate(rms_norm(x_l, g_norm1[l]), mod[0], mod[1])
        h_c = modulate(rms_norm(x_c, g_norm1[l]), mod_c[0], mod_c[1])
        p_l = h_l @ w_in[l]
        lat = split_cols(p_l[..., :KEY_WIDTH], KEY_COLS)
        lat.update(split_cols(p_l[..., KEY_WIDTH:], QUERY_COLS))
        p_c = h_c @ (w_in[l] if need_ctx else w_in[l][:, :KEY_WIDTH])
        ctxd = split_cols(p_c[..., :KEY_WIDTH], KEY_COLS)
        if need_ctx:
            ctxd.update(split_cols(p_c[..., KEY_WIDTH:], QUERY_COLS))

        ya_l, ya_c = hgrn2_mixer(lat, ctxd, lb_all[l], hgrn_norm_g[l], need_ctx)
        yb_l, yb_c = mlstm_mixer(lat, ctxd, b_mlstm_gates[l], mlstm_conv_w[l], mlstm_norm_g[l], need_ctx)
        yc_l, yc_c = gqa_mixer(lat, ctxd, gqa_q_norm_g[l], gqa_k_norm_g[l], rope_c, need_ctx)
        yd_l, yd_c = mla_mixer(lat, ctxd, mla_q_norm_g[l], mla_kv_norm_g[l], w_mla_uq[l], w_mla_uk[l],
                               w_mla_uv[l], rope_d, need_ctx)

        x_l = x_l + mod[2] * (merge_branches((ya_l, yb_l, yc_l, yd_l), lat['gates'], w_branch[l]) @ w_out[l])
        x_l = x_l + mod[5] * squared_relu_mlp(modulate(rms_norm(x_l, g_norm2[l]), mod[3], mod[4]), w_ff1[l], w_ff2[l])

        if need_ctx:
            x_c = x_c + mod_c[2] * (merge_branches((ya_c, yb_c, yc_c, yd_c), ctxd['gates'], w_branch[l]) @ w_out[l])
            x_c = x_c + mod_c[5] * squared_relu_mlp(modulate(rms_norm(x_c, g_norm2[l]), mod_c[3], mod_c[4]),
                                                    w_ff1[l], w_ff2[l])
    return rms_norm(x_l, g_final)
```

```cpp
#include <hip/hip_runtime.h>
#include <hip/hip_cooperative_groups.h>
#include <cstdio>
#include <cstdint>
namespace cg = cooperative_groups;

#ifndef PROBE
#define PROBE 0
#endif
#ifndef ONE_LAUNCH
#define ONE_LAUNCH 1
#endif

typedef unsigned short u16;
typedef short bf16x8 __attribute__((ext_vector_type(8)));
typedef short s16x4 __attribute__((ext_vector_type(4)));
typedef float f32x16 __attribute__((ext_vector_type(16)));
typedef float f32x2v __attribute__((ext_vector_type(2)));
typedef __bf16 bf16x2v __attribute__((ext_vector_type(2)));
#define DI __device__ __forceinline__
#define MFMA(a, b, c) __builtin_amdgcn_mfma_f32_32x32x16_bf16((a), (b), (c), 0, 0, 0)

constexpr int DM = 1024, NBATCH = 32, SEQ = 2048, CTXL = 256, DEPTH = 4, DFF = 4096;
constexpr int NG = 2, NB = 16, TPB = 2304, NTOK = NB * TPB;
constexpr int PS = 5376, NPC = 5328, INW = 9424;
constexpr int A_I = 0, A_FF = 512, A_FB = 1024, B_K = 1536, B_V = 1792, B_G = 2304, C_K = 2320, C_V = 2448,
              D_CKV = 2576, D_KR = 2704, A_Q = 2768, A_G = 3280, B_Q = 3792, B_O = 4048, C_Q = 4560, D_CQ = 5072;
constexpr float EPS = 1e-6f;
constexpr float LOG2E = 1.4426950408889634f;

constexpr size_t al256(size_t x) { return (x + 255) & ~(size_t)255; }
constexpr size_t OFF_WINT = 0;
constexpr size_t OFF_WGT = OFF_WINT + al256((size_t)PS * 1024 * 2);
constexpr size_t OFF_WBT = OFF_WGT + al256((size_t)4096 * 1024 * 2);
constexpr size_t OFF_WOT = OFF_WBT + al256((size_t)4 * 1024 * 512 * 2);
constexpr size_t OFF_W1T = OFF_WOT + al256((size_t)1024 * 1024 * 2);
constexpr size_t OFF_W2T = OFF_W1T + al256((size_t)4096 * 1024 * 2);
constexpr size_t OFF_WUQ = OFF_W2T + al256((size_t)1024 * 4096 * 2);
constexpr size_t OFF_WUK = OFF_WUQ + al256((size_t)768 * 256 * 2);
constexpr size_t OFF_WUV = OFF_WUK + al256((size_t)512 * 128 * 2);
constexpr size_t OFF_MOD = OFF_WUV + al256((size_t)512 * 128 * 2);
constexpr size_t OFF_LB = OFF_MOD + al256((size_t)4 * 33 * 6144 * 4);
constexpr size_t OFF_ROPE = OFF_LB + al256((size_t)4 * 2 * 512 * 4);
constexpr size_t OFF_CNT = OFF_ROPE + al256((size_t)2 * 64 * 16 * 4);
constexpr size_t OFF_BAR = OFF_CNT + 256;
constexpr size_t OFF_XC = OFF_BAR + al256(3456 * 4);
constexpr size_t OFF_XL = OFF_XC + al256((size_t)NBATCH * CTXL * DM * 2);
constexpr size_t OFF_P = OFF_XL + al256((size_t)NBATCH * SEQ * DM * 2);
constexpr size_t OFF_GB = OFF_P + al256((size_t)NTOK * PS * 2);
constexpr size_t OFF_KQ = OFF_GB + al256((size_t)NTOK * 16 * 4);
constexpr size_t OFF_H = OFF_KQ + al256((size_t)NTOK * 512 * 2);
constexpr size_t OFF_QD = OFF_H + al256((size_t)NTOK * 1024 * 2);
constexpr size_t OFF_KD = OFF_QD + al256((size_t)NTOK * 768 * 2);
constexpr size_t OFF_VD = OFF_KD + al256((size_t)NTOK * 768 * 2);
constexpr size_t OFF_OA = OFF_VD + al256((size_t)NTOK * 512 * 2);
constexpr size_t OFF_OB = OFF_OA + al256((size_t)2 * NTOK * 512 * 2);
constexpr size_t WS_NEED = OFF_OB + al256((size_t)2 * NTOK * 512 * 2);
constexpr int LDS_BYTES = 143360;
constexpr int LDSV = 69632;
constexpr int NTHR = 512;
constexpr size_t OFF_MF = OFF_QD;

struct Params {
  const float *x, *c, *ctx, *c_ctx, *w_ada, *b_ada, *g1, *g2, *w_in, *bgate, *lblog, *hnorm, *convw, *mnorm,
      *gqn, *gkn, *mqn, *mkvn, *wuq, *wuk, *wuv, *wbr, *wout, *wff1, *wff2, *gfin;
  float* out;
  char* ws;
};

DI int otid() { int t = threadIdx.x; asm volatile("" : "+v"(t)); return t; }
DI float bf2f(u16 v) { return __uint_as_float(((unsigned)v) << 16); }
DI unsigned pack2(float a, float b) {
  f32x2v v = {a, b};
  bf16x2v r = __builtin_convertvector(v, bf16x2v);
  return __builtin_bit_cast(unsigned, r);
}
DI u16 f2bf(float a) { return (u16)(pack2(a, 0.f) & 0xffffu); }
DI int crow(int reg, int h) { return (reg & 3) + 8 * (reg >> 2) + 4 * h; }
DI float sigmoidf_(float x) { return 1.f / (1.f + __expf(-x)); }
DI float siluf_(float x) { return x / (1.f + __expf(-x)); }
DI float ex2(float x) { return __builtin_amdgcn_exp2f(x); }
DI bf16x8 pack8(const f32x16& x, int s) {
  union { unsigned u[4]; bf16x8 v; } t;
  t.u[0] = pack2(x[8 * s + 0], x[8 * s + 1]);
  t.u[1] = pack2(x[8 * s + 2], x[8 * s + 3]);
  t.u[2] = pack2(x[8 * s + 4], x[8 * s + 5]);
  t.u[3] = pack2(x[8 * s + 6], x[8 * s + 7]);
  return t.v;
}
DI bf16x8 cat4(s16x4 lo, s16x4 hi) { return __builtin_shufflevector(lo, hi, 0, 1, 2, 3, 4, 5, 6, 7); }
DI float wave_sum(float v) {
#pragma unroll
  for (int d = 32; d >= 1; d >>= 1) v += __shfl_xor(v, d);
  return v;
}
DI void unpack8(const uint4& q, float* f) {
  f[0] = __uint_as_float(q.x << 16); f[1] = __uint_as_float(q.x & 0xffff0000u);
  f[2] = __uint_as_float(q.y << 16); f[3] = __uint_as_float(q.y & 0xffff0000u);
  f[4] = __uint_as_float(q.z << 16); f[5] = __uint_as_float(q.z & 0xffff0000u);
  f[6] = __uint_as_float(q.w << 16); f[7] = __uint_as_float(q.w & 0xffff0000u);
}
DI uint4 pack8f(const float* f) {
  uint4 q;
  q.x = pack2(f[0], f[1]); q.y = pack2(f[2], f[3]); q.z = pack2(f[4], f[5]); q.w = pack2(f[6], f[7]);
  return q;
}

DI u16* xrow_ptr(const Params& p, int g, int tok, int& modrow) {
  int bl = tok / TPB, pp = tok - bl * TPB, b = g * NB + bl;
  if (pp < CTXL) { modrow = 32; return (u16*)(p.ws + OFF_XC) + ((size_t)b * CTXL + pp) * DM; }
  modrow = b;
  return (u16*)(p.ws + OFF_XL) + ((size_t)b * SEQ + (pp - CTXL)) * DM;
}

#define LAS __attribute__((address_space(3)))
typedef float f32x4 __attribute__((ext_vector_type(4)));
namespace pg8 {
constexpr int BM = 256, BK = 64, HALF = 128, HTB = HALF * BK * 2, STAGE_BYTES = 8 * HTB, NXCD = 8, WGM = 8;
DI int lds_byte(int r, int c) { const int st = (r >> 4) * 2 + (c >> 5), rr = r & 15, cc = c & 31, ob = rr * 64 + cc * 2; return st * 1024 + (ob ^ (((ob >> 9) & 1) << 5)); }
DI void stage_rc(int b, int& R, int& C) { const int st = b / 1024, sb = b % 1024, swz = sb ^ (((sb >> 9) & 1) << 5); R = (st >> 1) * 16 + swz / 64; C = (st & 1) * 32 + (swz % 64) / 2; }
DI int perm32(int rho) { const int n = rho >> 4, i = rho & 15; return 8 * (i >> 2) + 4 * n + (i & 3); }
struct UDesc { const char* A; const char* B; unsigned lda2, ldb2; int nt, pm, pn, tag; };
DI bool tile_order(long L, int nM, int nN, int& pm, int& pn) {
  const int nwg = nM * nN; if (L >= nwg) return false;
  int wgid = (int)L; { const int q = nwg / NXCD, r = nwg % NXCD, xcd = wgid % NXCD, off = wgid / NXCD; wgid = (xcd < r ? xcd * (q + 1) : r * (q + 1) + (xcd - r) * q) + off; }
  const int nig = WGM * nN, gid = wgid / nig, fm = gid * WGM, gsz = (nM - fm) < WGM ? (nM - fm) : WGM;
  pm = fm + ((wgid % nig) % gsz); pn = (wgid % nig) / gsz; return true;
}
template <class Epi, class Sched>
DI void gemm_stream(LAS unsigned char* lds, const Sched& S, const Epi& E) {
  const int tid = otid(), wid = __builtin_amdgcn_readfirstlane(tid >> 6), lane = tid & 63, wr = wid >> 2, wc = wid & 3, fr = lane & 15, fq = lane >> 4;
  int RA[2], RB[2], CC[2];
#pragma unroll
  for (int i = 0; i < 2; ++i) { int R, C; stage_rc(tid * 16 + i * 8192, R, C); RA[i] = R; RB[i] = (R & ~31) + perm32(R & 31); CC[i] = C * 2; }
  const size_t kstep = (size_t)(BK * 2);
  const unsigned ldsw = (unsigned)wid * 1024u;
  const int aoff = lds_byte(wr * 64 + fr, fq * 8), boff = lds_byte(wc * 32 + fr, fq * 8);
#define PG8_SA(b, h) (((b) * 2 + (h)) * HTB)
#define PG8_SB(b, h) ((4 + (b) * 2 + (h)) * HTB)
#define PG8_STAGE(bufoff, gbase, voff) do { _Pragma("unroll") for (int _i = 0; _i < 2; ++_i) \
    __builtin_amdgcn_global_load_lds((const unsigned*)((const char*)(gbase) + (voff)[_i]), (LAS unsigned*)(lds + (bufoff) + ldsw + _i * 8192), 16, 0, 0); } while (0)
#define PG8_LDA(dst, b, h) do { _Pragma("unroll") for (int m = 0; m < 4; ++m) _Pragma("unroll") for (int k = 0; k < 2; ++k) dst[m][k] = *(const LAS bf16x8*)(lds + PG8_SA(b, h) + aoff + m * 2048 + k * 1024); } while (0)
#define PG8_LDB(dst, b, h) do { _Pragma("unroll") for (int n = 0; n < 2; ++n) _Pragma("unroll") for (int k = 0; k < 2; ++k) dst[n][k] = *(const LAS bf16x8*)(lds + PG8_SB(b, h) + boff + n * 2048 + k * 1024); } while (0)
#define PG8_MMA(ai, bj, At, Bt) do { __builtin_amdgcn_s_setprio(1); _Pragma("unroll") for (int m = 0; m < 4; ++m) _Pragma("unroll") for (int n = 0; n < 2; ++n) _Pragma("unroll") for (int k = 0; k < 2; ++k) \
    acc[ai][bj][m][n] = __builtin_amdgcn_mfma_f32_16x16x32_bf16(Bt[n][k], At[m][k], acc[ai][bj][m][n], 0, 0, 0); __builtin_amdgcn_s_setprio(0); } while (0)
#define PG8_WAIT_V(n) asm volatile("s_waitcnt vmcnt(" #n ")" ::: "memory")
#define PG8_WAIT_L(n) asm volatile("s_waitcnt lgkmcnt(" #n ")" ::: "memory")
#define PG8_BAR __builtin_amdgcn_s_barrier()
#define PG8_SCHED __builtin_amdgcn_sched_barrier(0)
  UDesc cur, nxt; int ui = 0;
  if (!S.next(0, cur)) return;
  f32x4 acc[2][2][4][2];
#pragma unroll
  for (int a = 0; a < 2; ++a)
#pragma unroll
    for (int b = 0; b < 2; ++b)
#pragma unroll
      for (int m = 0; m < 4; ++m)
#pragma unroll
        for (int n = 0; n < 2; ++n) acc[a][b][m][n] = (f32x4){0.f, 0.f, 0.f, 0.f};
  bf16x8 At[4][2], B0[2][2], B1[2][2];
  const char* cA = cur.A; const char* cB = cur.B;
  unsigned vA[2], vB[2];
#pragma unroll
  for (int i = 0; i < 2; ++i) { vA[i] = (unsigned)RA[i] * cur.lda2 + CC[i]; vB[i] = (unsigned)RB[i] * cur.ldb2 + CC[i]; }
  size_t hA = (size_t)HALF * cur.lda2, hB = (size_t)HALF * cur.ldb2;
  PG8_STAGE(PG8_SB(0, 0), cB, vB); PG8_STAGE(PG8_SA(0, 0), cA, vA); PG8_STAGE(PG8_SB(0, 1), cB + hB, vB); PG8_STAGE(PG8_SA(0, 1), cA + hA, vA);
  if (wr == 1) PG8_BAR;
  PG8_WAIT_V(4); PG8_BAR;
  PG8_STAGE(PG8_SB(1, 0), cB + kstep, vB); PG8_STAGE(PG8_SA(1, 0), cA + kstep, vA); PG8_STAGE(PG8_SB(1, 1), cB + hB + kstep, vB);
  PG8_WAIT_V(6); PG8_BAR;
  for (;;) {
    const bool has_next = S.next(ui + 1, nxt);
    const char* nA = has_next ? nxt.A : cA; const char* nB = has_next ? nxt.B : cB;
    const unsigned nlda = has_next ? nxt.lda2 : cur.lda2, nldb = has_next ? nxt.ldb2 : cur.ldb2;
    unsigned nvA[2], nvB[2];
#pragma unroll
    for (int i = 0; i < 2; ++i) { nvA[i] = (unsigned)RA[i] * nlda + CC[i]; nvB[i] = (unsigned)RB[i] * nldb + CC[i]; }
    const size_t nhA = (size_t)HALF * nlda, nhB = (size_t)HALF * nldb;
    const int nt = cur.nt;
    for (int t = 0; t < nt; t += 2) {
      const bool last = (t == nt - 2);
      const char* a1 = cA + (size_t)(t + 1) * kstep;
      const char* a2 = last ? nA : cA + (size_t)(t + 2) * kstep; const char* b2 = last ? nB : cB + (size_t)(t + 2) * kstep;
      const char* a3 = a2 + kstep; const char* b3 = b2 + kstep;
      unsigned v2A[2], v2B[2];
#pragma unroll
      for (int i = 0; i < 2; ++i) { v2A[i] = last ? nvA[i] : vA[i]; v2B[i] = last ? nvB[i] : vB[i]; }
      const size_t h2A = last ? nhA : hA, h2B = last ? nhB : hB;
      PG8_LDB(B0, 0, 0); PG8_SCHED; PG8_LDA(At, 0, 0); PG8_STAGE(PG8_SA(1, 1), a1 + hA, vA);
      PG8_WAIT_L(8); PG8_BAR; PG8_WAIT_L(0); PG8_MMA(0, 0, At, B0); PG8_BAR; PG8_SCHED;
      PG8_LDB(B1, 0, 1); PG8_STAGE(PG8_SB(0, 0), b2, v2B);
      PG8_BAR; PG8_WAIT_L(0); PG8_MMA(0, 1, At, B1); PG8_BAR;
      PG8_LDA(At, 0, 1); PG8_STAGE(PG8_SA(0, 0), a2, v2A);
      PG8_BAR; PG8_WAIT_L(0); PG8_MMA(1, 0, At, B0); PG8_BAR; PG8_SCHED;
      PG8_STAGE(PG8_SB(0, 1), b2 + h2B, v2B);
      PG8_WAIT_V(6); PG8_BAR; PG8_MMA(1, 1, At, B1); PG8_BAR;
      PG8_LDB(B0, 1, 0); PG8_SCHED; PG8_LDA(At, 1, 0); PG8_STAGE(PG8_SA(0, 1), a2 + h2A, v2A);
      PG8_WAIT_L(8); PG8_BAR; PG8_WAIT_L(0); PG8_MMA(0, 0, At, B0); PG8_BAR; PG8_SCHED;
      PG8_LDB(B1, 1, 1); PG8_STAGE(PG8_SB(1, 0), b3, v2B);
      PG8_BAR; PG8_WAIT_L(0); PG8_MMA(0, 1, At, B1); PG8_BAR;
      PG8_LDA(At, 1, 1); PG8_STAGE(PG8_SA(1, 0), a3, v2A);
      PG8_BAR; PG8_WAIT_L(0); PG8_MMA(1, 0, At, B0); PG8_BAR; PG8_SCHED;
      PG8_STAGE(PG8_SB(1, 1), b3 + h2B, v2B);
      PG8_WAIT_V(6); PG8_BAR; PG8_MMA(1, 1, At, B1); PG8_BAR;
    }
    const bool keep = E(acc, cur, wr, wc, fr, fq);
    if (!has_next) break;
    if (!keep) {
#pragma unroll
      for (int a = 0; a < 2; ++a)
#pragma unroll
        for (int b = 0; b < 2; ++b)
#pragma unroll
          for (int m = 0; m < 4; ++m)
#pragma unroll
            for (int n = 0; n < 2; ++n) acc[a][b][m][n] = (f32x4){0.f, 0.f, 0.f, 0.f};
    }
    cur = nxt; cA = nA; cB = nB; hA = nhA; hB = nhB;
#pragma unroll
    for (int i = 0; i < 2; ++i) { vA[i] = nvA[i]; vB[i] = nvB[i]; }
    ++ui;
  }
  PG8_WAIT_V(0);
  if (wr == 0) PG8_BAR;
  PG8_BAR;
#undef PG8_SA
#undef PG8_SB
#undef PG8_STAGE
#undef PG8_LDA
#undef PG8_LDB
#undef PG8_MMA
#undef PG8_WAIT_V
#undef PG8_WAIT_L
#undef PG8_BAR
#undef PG8_SCHED
}
struct PlainSched {
  const char* A; const char* B; unsigned lda2, ldb2; int nt, nM, nN, G, c; int lat_only = 0;
  DI bool next(int i, UDesc& u) const {
    int pm, pn; if (!tile_order((long)i * G + c, lat_only ? nM - NB : nM, nN, pm, pn)) return false;
    if (lat_only) pm = pm + (pm >> 3) + 1;
    u.A = A + (size_t)pm * 256 * lda2; u.B = B + (size_t)pn * 256 * ldb2; u.lda2 = lda2; u.ldb2 = ldb2; u.nt = nt; u.pm = pm; u.pn = pn; u.tag = 0; return true;
  }
};
}

DI uint4 pk8(const f32x4& a, const f32x4& b) {
  uint4 q; q.x = pack2(a[0], a[1]); q.y = pack2(a[2], a[3]); q.z = pack2(b[0], b[1]); q.w = pack2(b[2], b[3]); return q;
}

__device__ void phase_prep(const Params& p, char* lds) {
  const int tid = otid(), nthr = gridDim.x * NTHR, gt = blockIdx.x * NTHR + tid;
  {
    const float4* s = (const float4*)p.x; uint2* d = (uint2*)(p.ws + OFF_XL);
    const size_t n = (size_t)NBATCH * SEQ * DM / 4;
    for (size_t i = gt; i < n; i += nthr) { const float4 v = s[i]; uint2 o; o.x = pack2(v.x, v.y); o.y = pack2(v.z, v.w); d[i] = o; }
    const float4* s2 = (const float4*)p.ctx; uint2* d2 = (uint2*)(p.ws + OFF_XC);
    const size_t n2 = (size_t)NBATCH * CTXL * DM / 4;
    for (size_t i = gt; i < n2; i += nthr) { const float4 v = s2[i]; uint2 o; o.x = pack2(v.x, v.y); o.y = pack2(v.z, v.w); d2[i] = o; }
  }
  if (gt < 1024) {
    float v[DEPTH], mx = -1e30f;
    for (int l = 0; l < DEPTH; ++l) { v[l] = p.lblog[l * 1024 + gt]; mx = fmaxf(mx, v[l]); }
    float sum = 0.f;
    for (int l = 0; l < DEPTH; ++l) { v[l] = expf(v[l] - mx); sum += v[l]; }
    float* lb = (float*)(p.ws + OFF_LB);
    float run = 0.f;
    for (int l = 0; l < DEPTH; ++l) { lb[l * 1024 + gt] = run; if (l + 1 < DEPTH) run += v[l + 1] / sum; }
  }
  if (gt >= 1024 && gt < 2048) {
    int i = gt - 1024, pos = i >> 4, fi = i & 15;
    float inv = powf(10000.f, -(float)fi / 16.f);
    float ang = (float)pos * inv;
    float* rc = (float*)(p.ws + OFF_ROPE);
    rc[i] = cosf(ang); rc[1024 + i] = sinf(ang);
  }
  float* ssm = (float*)lds;
  float* red = (float*)lds + 2 * 33 * 32;
  for (int item = blockIdx.x; item < DEPTH * 24; item += gridDim.x) {
    const int l = item / 24, kh = tid >> 8, tl = tid & 255, j = (item % 24) * 256 + tl;
    float acc[33];
#pragma unroll
    for (int r = 0; r < 33; ++r) acc[r] = 0.f;
    const float* W = p.w_ada + (size_t)l * DM * 6144;
    for (int k0 = kh * 512; k0 < kh * 512 + 512; k0 += 32) {
      __syncthreads();
      for (int idx = tl; idx < 33 * 32; idx += 256) {
        int rr = idx >> 5, kk = idx & 31;
        float cv = rr < 32 ? p.c[rr * DM + k0 + kk] : p.c_ctx[k0 + kk];
        ssm[kh * 33 * 32 + idx] = cv / (1.f + expf(-cv));
      }
      __syncthreads();
#pragma unroll 4
      for (int kk = 0; kk < 32; ++kk) {
        float w = W[(size_t)(k0 + kk) * 6144 + j];
#pragma unroll
        for (int r = 0; r < 33; ++r) acc[r] += ssm[kh * 33 * 32 + r * 32 + kk] * w;
      }
    }
    __syncthreads();
    if (kh == 1) {
#pragma unroll
      for (int r = 0; r < 33; ++r) red[r * 256 + tl] = acc[r];
    }
    __syncthreads();
    if (kh == 0) {
      float bb = p.b_ada[l * 6144 + j];
      float* mod = (float*)(p.ws + OFF_MOD) + (size_t)l * 33 * 6144;
#pragma unroll
      for (int r = 0; r < 33; ++r) mod[r * 6144 + j] = acc[r] + red[r * 256 + tl] + bb;
    }
  }
  __syncthreads();
}

DI u16* wdst(const Params& p, int type, int sub, int n) {
  switch (type) {
    case 0: return n < NPC ? (u16*)(p.ws + OFF_WINT) + (size_t)n * 1024 : (u16*)(p.ws + OFF_WGT) + (size_t)(n - NPC) * 1024;
    case 1: return (u16*)(p.ws + OFF_WBT) + ((size_t)sub * 1024 + n) * 512;
    case 2: return (u16*)(p.ws + OFF_WOT) + (size_t)n * 1024;
    case 3: return (u16*)(p.ws + OFF_W1T) + (size_t)n * 1024;
    case 4: return (u16*)(p.ws + OFF_W2T) + (size_t)n * 4096;
    case 5: return (u16*)(p.ws + OFF_WUQ) + (size_t)n * 256;
    case 6: return (u16*)(p.ws + OFF_WUK) + (size_t)n * 128;
    default: return (u16*)(p.ws + OFF_WUV) + (size_t)n * 128;
  }
}
__device__ void phase_wconv(const Params& p, int l, char* lds) {
  float* tile = (float*)lds;
  const int tid = otid();
  {
    unsigned* z = (unsigned*)((u16*)(p.ws + OFF_WINT) + (size_t)NPC * 1024);
    for (int i = blockIdx.x * NTHR + tid; i < (PS - NPC) * 1024 / 2; i += gridDim.x * NTHR) z[i] = 0u;
  }
  constexpr int T0 = 16 * 148, T1 = T0 + 4 * 128, T2 = T1 + 256, T3 = T2 + 1024, T4 = T3 + 1024, T5 = T4 + 48, T6 = T5 + 16, T7 = T6 + 16;
  for (int it = blockIdx.x; it < T7; it += gridDim.x) {
    int type, sub = 0, K, N, kt, nt;
    const float* src;
    if (it < T0) { type = 0; K = 1024; N = INW; int q = it; kt = q / 148; nt = q % 148; src = p.w_in + (size_t)l * 1024 * INW; }
    else if (it < T1) { type = 1; K = 512; N = 1024; int q = it - T0; sub = q / 128; q %= 128; kt = q / 16; nt = q % 16; src = p.wbr + ((size_t)l * 4 + sub) * 512 * 1024; }
    else if (it < T2) { type = 2; K = 1024; N = 1024; int q = it - T1; kt = q / 16; nt = q % 16; src = p.wout + (size_t)l * 1024 * 1024; }
    else if (it < T3) { type = 3; K = 1024; N = 4096; int q = it - T2; kt = q / 64; nt = q % 64; src = p.wff1 + (size_t)l * 1024 * 4096; }
    else if (it < T4) { type = 4; K = 4096; N = 1024; int q = it - T3; kt = q / 16; nt = q % 16; src = p.wff2 + (size_t)l * 4096 * 1024; }
    else if (it < T5) { type = 5; K = 256; N = 768; int q = it - T4; kt = q / 12; nt = q % 12; src = p.wuq + (size_t)l * 256 * 768; }
    else if (it < T6) { type = 6; K = 128; N = 512; int q = it - T5; kt = q / 8; nt = q % 8; src = p.wuk + (size_t)l * 128 * 512; }
    else { type = 7; K = 128; N = 512; int q = it - T6; kt = q / 8; nt = q % 8; src = p.wuv + (size_t)l * 128 * 512; }
    (void)K;
    const int k0 = kt * 64, n0 = nt * 64;
    __syncthreads();
    {
      const int nn = tid & 63, ks = tid >> 6;
#pragma unroll 4
      for (int j = 0; j < 8; ++j) {
        int k = ks + 8 * j;
        tile[k * 65 + nn] = (n0 + nn < N) ? src[(size_t)(k0 + k) * N + n0 + nn] : 0.f;
      }
    }
    __syncthreads();
    {
      const int kp = tid & 31, nn = tid >> 5;
#pragma unroll 4
      for (int j = 0; j < 4; ++j) {
        int n = nn + 16 * j;
        if (n0 + n < N) {
          unsigned v = pack2(tile[(2 * kp) * 65 + n], tile[(2 * kp + 1) * 65 + n]);
          *(unsigned*)(wdst(p, type, sub, n0 + n) + k0 + 2 * kp) = v;
        }
      }
    }
  }
  __syncthreads();
}

DI void norm_token(const Params& p, int l, int g, int which, int tok, int lane, const float* gn, const float* mod, u16* H) {
  int mr; const u16* xr = xrow_ptr(p, g, tok, mr);
  const float* shift = mod + (size_t)mr * 6144 + (which == 0 ? 0 : 3) * DM;
  const float* scale = shift + DM;
  float4 v[4]; float ss = 0.f;
#pragma unroll
  for (int j = 0; j < 4; ++j) {
    const uint2 q = *(const uint2*)(xr + j * 256 + lane * 4);
    v[j].x = __uint_as_float(q.x << 16); v[j].y = __uint_as_float(q.x & 0xffff0000u); v[j].z = __uint_as_float(q.y << 16); v[j].w = __uint_as_float(q.y & 0xffff0000u);
    ss += v[j].x * v[j].x + v[j].y * v[j].y + v[j].z * v[j].z + v[j].w * v[j].w;
  }
  ss = wave_sum(ss);
  const float rstd = rsqrtf(ss * (1.f / DM) + EPS);
#pragma unroll
  for (int j = 0; j < 4; ++j) {
    int c = j * 256 + lane * 4;
    float4 gg = *(const float4*)(gn + c), sh = *(const float4*)(shift + c), sc = *(const float4*)(scale + c);
    float o0 = v[j].x * rstd * gg.x * (1.f + sc.x) + sh.x;
    float o1 = v[j].y * rstd * gg.y * (1.f + sc.y) + sh.y;
    float o2 = v[j].z * rstd * gg.z * (1.f + sc.z) + sh.z;
    float o3 = v[j].w * rstd * gg.w * (1.f + sc.w) + sh.w;
    uint2 o; o.x = pack2(o0, o1); o.y = pack2(o2, o3);
    *(uint2*)(H + (size_t)tok * DM + c) = o;
  }
}
__device__ void phase_norm(const Params& p, int l, int g, int which) {
  const int tid = otid(), lane = tid & 63, wid = tid >> 6;
  const float* gn = (which == 0 ? p.g1 : p.g2) + l * DM;
  const float* mod = (const float*)(p.ws + OFF_MOD) + (size_t)l * 33 * 6144;
  u16* H = (u16*)(p.ws + OFF_H);
  for (int tok = blockIdx.x * 8 + wid; tok < NTOK; tok += gridDim.x * 8) {
    if (which == 1 && l == DEPTH - 1 && (tok % TPB) < CTXL) continue;
    norm_token(p, l, g, which, tok, lane, gn, mod, H);
  }
}
__device__ void phase_norm_dyn(const Params& p, int l, int g, int* cnt) {
  const int tid = otid(), lane = tid & 63;
  const float* gn = p.g1 + l * DM;
  const float* mod = (const float*)(p.ws + OFF_MOD) + (size_t)l * 33 * 6144;
  u16* H = (u16*)(p.ws + OFF_H);
  for (;;) {
    int c = 0;
    if (lane == 0) c = atomicAdd(cnt, 1);
    c = __shfl(c, 0);
    if (c >= NTOK / 8) break;
    for (int t = 0; t < 8; ++t) norm_token(p, l, g, 0, c * 8 + t, lane, gn, mod, H);
  }
}

__device__ void phase_tokprep(const Params& p, int l) {
  const int tid = otid(), lane = tid & 63, wid = tid >> 6;
  u16* P = (u16*)(p.ws + OFF_P);
  u16* KQ = (u16*)(p.ws + OFF_KQ);
  u16* Kd = (u16*)(p.ws + OFF_KD);
  const float* rc = (const float*)(p.ws + OFF_ROPE);
  const float* rs = rc + 1024;
  const int c8 = lane & 7;
  for (int tok = blockIdx.x * 8 + wid; tok < NTOK; tok += gridDim.x * 8) {
    const int pp = tok % TPB;
    const bool lat = pp >= CTXL;
    const int pos = pp - CTXL, prow = pos >> 6, pcol = pos & 63;
    u16* row = P + (size_t)tok * PS;
    {
      const bool isk = lane < 32;
      const int cc = (isk ? lane : lane - 32) * 8;
      const int colb = (isk ? B_K : B_Q) + cc;
      const bool hasp = !(pp == 0 || pp == CTXL), hasn = !(pp == CTXL - 1 || pp == TPB - 1);
      float x0[8], x1[8], x2[8];
      uint4 q1 = *(const uint4*)(row + colb); unpack8(q1, x1);
      if (hasp) { uint4 q0 = *(const uint4*)(row - PS + colb); unpack8(q0, x0); } else { for (int e = 0; e < 8; ++e) x0[e] = 0.f; }
      if (hasn) { uint4 q2 = *(const uint4*)(row + PS + colb); unpack8(q2, x2); } else { for (int e = 0; e < 8; ++e) x2[e] = 0.f; }
      const float* cw = p.convw + ((size_t)l * 2 + (isk ? 1 : 0)) * 3 * 256 + cc;
      float o[8];
#pragma unroll
      for (int e = 0; e < 8; ++e) {
        float a = cw[e] * x0[e] + cw[256 + e] * x1[e] + cw[512 + e] * x2[e];
        a = siluf_(a);
        o[e] = isk ? a * 0.125f : a;
      }
      *(uint4*)(KQ + (size_t)tok * 512 + (isk ? 0 : 256) + cc) = pack8f(o);
    }
#pragma unroll
    for (int pass = 0; pass < 2; ++pass) {
      const bool act = pass == 0 || lane < 16;
      const int colb = (pass == 0 ? C_Q : C_K) + lane * 8;
      const float* gg = (pass == 0 ? p.gqn : p.gkn) + l * 64 + c8 * 8;
      float x[8];
      if (act) { uint4 q = *(const uint4*)(row + colb); unpack8(q, x); } else { for (int e = 0; e < 8; ++e) x[e] = 0.f; }
      float ss = 0.f;
#pragma unroll
      for (int e = 0; e < 8; ++e) ss += x[e] * x[e];
      ss += __shfl_xor(ss, 1); ss += __shfl_xor(ss, 2); ss += __shfl_xor(ss, 4);
      const float rstd = rsqrtf(ss * (1.f / 64.f) + EPS);
#pragma unroll
      for (int e = 0; e < 8; ++e) x[e] = x[e] * rstd * gg[e];
      float o[8];
#pragma unroll
      for (int e = 0; e < 8; ++e) {
        float other = __shfl_xor(x[e], 2);
        const int ppos = (c8 & 4) ? pcol : prow;
        const int fi = (c8 & 1) * 8 + e;
        float cs = 1.f, sn = 0.f;
        if (lat) { cs = rc[ppos * 16 + fi]; sn = rs[ppos * 16 + fi]; }
        o[e] = (c8 & 2) ? (x[e] * cs + other * sn) : (x[e] * cs - other * sn);
      }
      if (act) *(uint4*)(row + colb) = pack8f(o);
    }
    {
      const bool isckv = lane < 16, iscq = lane >= 32, iskr = lane >= 16 && lane < 24;
      int colb = isckv ? D_CKV + lane * 8 : (iscq ? D_CQ + (lane - 32) * 8 : D_KR + ((lane - 16) & 7) * 8);
      float x[8];
      { uint4 q = *(const uint4*)(row + colb); unpack8(q, x); }
      float ss = 0.f;
#pragma unroll
      for (int e = 0; e < 8; ++e) ss += x[e] * x[e];
      ss += __shfl_xor(ss, 1); ss += __shfl_xor(ss, 2); ss += __shfl_xor(ss, 4); ss += __shfl_xor(ss, 8);
      float ss32 = ss + __shfl_xor(ss, 16);
      float o[8];
      if (isckv) {
        const float rstd = rsqrtf(ss * (1.f / 128.f) + EPS);
        const float* gg = p.mkvn + l * 128 + lane * 8;
        for (int e = 0; e < 8; ++e) o[e] = x[e] * rstd * gg[e];
      } else if (iscq) {
        const float rstd = rsqrtf(ss32 * (1.f / 256.f) + EPS);
        const float* gg = p.mqn + l * 256 + (lane - 32) * 8;
        for (int e = 0; e < 8; ++e) o[e] = x[e] * rstd * gg[e];
      } else {
        for (int e = 0; e < 8; ++e) o[e] = x[e];
      }
      float orot[8];
#pragma unroll
      for (int e = 0; e < 8; ++e) {
        float other = __shfl_xor(x[e], 2);
        const int ck = lane & 7;
        const int ppos = (ck & 4) ? pcol : prow;
        const int fi = (ck & 1) * 8 + e;
        float cs = 1.f, sn = 0.f;
        if (lat) { cs = rc[ppos * 16 + fi]; sn = rs[ppos * 16 + fi]; }
        orot[e] = (ck & 2) ? (x[e] * cs + other * sn) : (x[e] * cs - other * sn);
      }
      if (isckv || iscq) *(uint4*)(row + colb) = pack8f(o);
      if (iskr) {
        uint4 q = pack8f(orot);
        const int ck = lane & 7;
#pragma unroll
        for (int hd = 0; hd < 4; ++hd) *(uint4*)(Kd + (size_t)tok * 768 + hd * 192 + 128 + ck * 8) = q;
      }
    }
  }
}

template <int DK, int DV, bool ROPEQ>
__device__ void attn_item(const u16* __restrict__ qrow, const u16* __restrict__ Kp, int kst, const u16* __restrict__ Vp, int vst,
                          u16* __restrict__ orow, int nkeys, float sc, int pos, const float* __restrict__ rc, char* lds) {
  constexpr int KLD = DK + 8, VLD = DV + 32;
  constexpr int KB = 64 * KLD, VB = 64 * VLD;
  u16* KS = (u16*)lds;
  u16* VS = KS + 2 * KB;
  const int tid = otid(), lane = tid & 63, r = lane & 31, h = lane >> 5;
  bf16x8 qf[DK / 16];
  {
#pragma unroll
    for (int s = 0; s < DK / 16; ++s) qf[s] = *(const bf16x8*)(qrow + h * 8 + s * 16);
    if (ROPEQ && pos >= 0) {
      const int prow = pos >> 6, pcol = pos & 63;
      const float* rs = rc + 1024;
      constexpr int s0 = (DK - 64) / 16;
#pragma unroll
      for (int part = 0; part < 2; ++part) {
        const int ppos = part ? pcol : prow;
#pragma unroll
        for (int j = 0; j < 8; ++j) {
          const int fi = 8 * h + j;
          float cs = rc[ppos * 16 + fi], sn = rs[ppos * 16 + fi];
          float x1 = bf2f((u16)qf[s0 + 2 * part][j]), x2 = bf2f((u16)qf[s0 + 2 * part + 1][j]);
          qf[s0 + 2 * part][j] = (short)f2bf(x1 * cs - x2 * sn);
          qf[s0 + 2 * part + 1][j] = (short)f2bf(x2 * cs + x1 * sn);
        }
      }
    }
  }
  f32x16 oT[DV / 32];
#pragma unroll
  for (int d = 0; d < DV / 32; ++d)
#pragma unroll
    for (int e = 0; e < 16; ++e) oT[d][e] = 0.f;
  float m = -1e30f, lsum = 0.f;
  const int ntile = nkeys >> 6;
  constexpr int NKP = KB * 2 / 1024, NVP = VB * 2 / 1024, NKJ = (NKP + 7) / 8, NVJ = (NVP + 7) / 8;
  const int wu = __builtin_amdgcn_readfirstlane(tid >> 6);
  unsigned ksrc[NKJ], vsrc[NVJ];
#pragma unroll
  for (int j = 0; j < NKJ; ++j) { const int o = (wu + 8 * j) * 1024 + lane * 16, row = o / (KLD * 2), col = (o % (KLD * 2)) / 2; ksrc[j] = (unsigned)(row * kst + (col < DK ? col : 0)) * 2u; }
#pragma unroll
  for (int j = 0; j < NVJ; ++j) { const int o = (wu + 8 * j) * 1024 + lane * 16, row = o / (VLD * 2), col = (o % (VLD * 2)) / 2; vsrc[j] = (unsigned)(row * vst + (col < DV ? col : 0)) * 2u; }
#define ATT_DMA(kt_, buf_) do { \
    const char* kg_ = (const char*)Kp + (size_t)(kt_) * 64 * kst * 2; const char* vg_ = (const char*)Vp + (size_t)(kt_) * 64 * vst * 2; \
    _Pragma("unroll") for (int j = 0; j < NKJ; ++j) if (wu + 8 * j < NKP) \
      __builtin_amdgcn_global_load_lds((const unsigned*)(kg_ + ksrc[j]), (LAS unsigned*)((char*)KS + (buf_) * KB * 2 + (wu + 8 * j) * 1024), 16, 0, 0); \
    _Pragma("unroll") for (int j = 0; j < NVJ; ++j) if (wu + 8 * j < NVP) \
      __builtin_amdgcn_global_load_lds((const unsigned*)(vg_ + vsrc[j]), (LAS unsigned*)((char*)VS + (buf_) * VB * 2 + (wu + 8 * j) * 1024), 16, 0, 0); \
  } while (0)
  __syncthreads();
  ATT_DMA(0, 0);
  asm volatile("s_waitcnt vmcnt(0)" ::: "memory");
  __syncthreads();
  const int troff = ((lane & 15) >> 2) * VLD + 16 * ((lane >> 4) & 1) + 4 * (lane & 3) + 4 * h * VLD;
#pragma unroll 1
  for (int kt = 0; kt < ntile; ++kt) {
    const int buf = kt & 1;
    if (kt + 1 < ntile) ATT_DMA(kt + 1, buf ^ 1);
    const u16* KSb = KS + buf * KB;
    const u16* VSb = VS + buf * VB;
    f32x16 sT[2];
#pragma unroll
    for (int kk = 0; kk < 2; ++kk) {
#pragma unroll
      for (int e = 0; e < 16; ++e) sT[kk][e] = 0.f;
#pragma unroll
      for (int s = 0; s < DK / 16; ++s) {
        bf16x8 a = *(const bf16x8*)(KSb + (kk * 32 + r) * KLD + s * 16 + h * 8);
        sT[kk] = MFMA(a, qf[s], sT[kk]);
      }
    }
    float mx = -1e30f;
#pragma unroll
    for (int kk = 0; kk < 2; ++kk)
#pragma unroll
      for (int e = 0; e < 16; ++e) mx = fmaxf(mx, sT[kk][e]);
    mx = fmaxf(mx, __shfl_xor(mx, 32));
    const float mn = fmaxf(m, mx * sc);
    const float alpha = ex2(m - mn);
    m = mn;
    lsum *= alpha;
#pragma unroll
    for (int kk = 0; kk < 2; ++kk)
#pragma unroll
      for (int e = 0; e < 16; ++e) { float pv = ex2(sT[kk][e] * sc - mn); sT[kk][e] = pv; lsum += pv; }
#pragma unroll
    for (int d = 0; d < DV / 32; ++d)
#pragma unroll
      for (int e = 0; e < 16; ++e) oT[d][e] *= alpha;
#pragma unroll
    for (int kk = 0; kk < 2; ++kk)
#pragma unroll
      for (int s2 = 0; s2 < 2; ++s2) {
        bf16x8 pb = pack8(sT[kk], s2);
#pragma unroll
        for (int d = 0; d < DV / 32; ++d) {
          const u16* vb = VSb + (kk * 32 + s2 * 16) * VLD + d * 32 + troff;
          s16x4 lo = __builtin_amdgcn_ds_read_tr16_b64_v4i16((LAS s16x4*)vb);
          s16x4 hi = __builtin_amdgcn_ds_read_tr16_b64_v4i16((LAS s16x4*)(vb + 8 * VLD));
          oT[d] = MFMA(cat4(lo, hi), pb, oT[d]);
        }
      }
    asm volatile("s_waitcnt vmcnt(0)" ::: "memory");
    __syncthreads();
  }
#undef ATT_DMA
  lsum += __shfl_xor(lsum, 32);
  const float inv = 1.f / lsum;
#pragma unroll
  for (int d = 0; d < DV / 32; ++d)
#pragma unroll
    for (int gq = 0; gq < 4; ++gq) {
      uint2 o;
      o.x = pack2(oT[d][4 * gq] * inv, oT[d][4 * gq + 1] * inv);
      o.y = pack2(oT[d][4 * gq + 2] * inv, oT[d][4 * gq + 3] * inv);
      *(uint2*)(orow + d * 32 + 8 * gq + 4 * h) = o;
    }
}

__device__ void scanA_unit(const Params& p, int l, int unit, char* lds) {
  const int tid = otid(), lane = tid & 63, wid = tid >> 6, r = lane & 31, h = lane >> 5;
  const int bl = unit >> 3, hd = (unit >> 1) & 3, dir = unit & 1;
  const u16* P = (const u16*)(p.ws + OFF_P);
  u16* Oa = (u16*)(p.ws + OFF_OA) + (size_t)dir * NTOK * 512;
  float* BC = (float*)lds;
  u16* Qs = (u16*)(lds + 33792);
  u16* KKs = (u16*)(lds + 51200);
  u16* AM = (u16*)(lds + 51200);
  u16* KT = (u16*)(lds + 68608);
  u16* VT = (u16*)(lds + 87040);
  u16* ST = (u16*)(lds + 105472);
  float* EL = (float*)(lds + 140288);
  float* QTOT = (float*)(lds + 140800);
  const int ch = tid & 15;
  float lbv[8];
  {
    const float* lb = (const float*)(p.ws + OFF_LB) + (size_t)l * 1024 + dir * 512 + hd * 128 + ch * 8;
#pragma unroll
    for (int e = 0; e < 8; ++e) lbv[e] = lb[e];
  }
  const int vt = wid & 3, th = wid >> 2;
  f32x16 S[2];
#pragma unroll
  for (int j = 0; j < 2; ++j)
#pragma unroll
    for (int e = 0; e < 16; ++e) S[j][e] = 0.f;
  __syncthreads();
  for (int i = tid; i < 128 * 136 / 2; i += NTHR) ((unsigned*)ST)[i] = 0u;
  uint4 pqr[2], pfr[2], pvr[2];
#define SCANA_TOK0(st_) (bl * TPB + ((st_) >= 4 ? CTXL : 0) + (dir ? ((st_) >= 4 ? 31 - ((st_) - 4) : 3 - (st_)) : ((st_) >= 4 ? (st_) - 4 : (st_))) * 64)
#define SCANA_PREFETCH(st_) do { const int t0_ = SCANA_TOK0(st_); \
    _Pragma("unroll") for (int j = 0; j < 2; ++j) { const int i = (tid >> 4) + 32 * j; \
      const u16* row = P + (size_t)(t0_ + (dir ? 63 - i : i)) * PS + hd * 128 + ch * 8; \
      pqr[j] = *(const uint4*)(row + A_Q); pfr[j] = *(const uint4*)(row + (dir ? A_FB : A_FF)); pvr[j] = *(const uint4*)(row + A_I); } } while (0)
  SCANA_PREFETCH(0);
#pragma unroll 1
  for (int step = 0; step < 36; ++step) {
    const int tok0 = SCANA_TOK0(step);
    __syncthreads();
#pragma unroll
    for (int j = 0; j < 2; ++j) {
      const int i = (tid >> 4) + 32 * j;
      uint4 qraw = pqr[j];
      uint4 fraw = pfr[j];
      uint4 vq = pvr[j];
      float qv[8], fv[8], kkv[8];
      unpack8(qraw, qv); unpack8(fraw, fv);
#pragma unroll
      for (int e = 0; e < 8; ++e) {
        qv[e] = siluf_(qv[e]);
        const float ex = __expf(-fv[e]);
        const float sg = 1.f / (1.f + ex);
        const float sgn = ex / (1.f + ex);
        const float f = lbv[e] + (1.f - lbv[e]) * sg;
        kkv[e] = (1.f - lbv[e]) * (fv[e] > 30.f ? 0.f : (fv[e] < -30.f ? 1.f : sgn));
        BC[i * 132 + ch * 8 + e] = __log2f(fmaxf(f, 1e-37f));
      }
      *(uint4*)(Qs + i * 136 + ch * 8) = pack8f(qv);
      *(uint4*)(KKs + i * 136 + ch * 8) = pack8f(kkv);
      u16* dv = VT + (ch * 8) * 72 + i;
      dv[0 * 72] = (u16)(vq.x & 0xffff); dv[1 * 72] = (u16)(vq.x >> 16); dv[2 * 72] = (u16)(vq.y & 0xffff); dv[3 * 72] = (u16)(vq.y >> 16);
      dv[4 * 72] = (u16)(vq.z & 0xffff); dv[5 * 72] = (u16)(vq.z >> 16); dv[6 * 72] = (u16)(vq.w & 0xffff); dv[7 * 72] = (u16)(vq.w >> 16);
    }
    __syncthreads();
    {
      const int k = tid & 127, qd = tid >> 7;
      float run = 0.f;
      for (int i = qd * 16; i < qd * 16 + 16; ++i) { run += BC[i * 132 + k]; BC[i * 132 + k] = run; }
      QTOT[qd * 128 + k] = run;
    }
    __syncthreads();
    {
      const int k = tid & 127, qd = tid >> 7;
      float off = 0.f;
      for (int q2 = 0; q2 < qd; ++q2) off += QTOT[q2 * 128 + k];
      if (qd > 0) for (int i = qd * 16; i < qd * 16 + 16; ++i) BC[i * 132 + k] += off;
    }
    __syncthreads();
    f32x4 cod[2];
#pragma unroll
    for (int jj = 0; jj < 2; ++jj) {
      cod[jj] = (f32x4){0.f, 0.f, 0.f, 0.f};
      const int job = wid + 8 * jj;
      if (job < 10) {
        const int bI = job < 1 ? 0 : (job < 3 ? 1 : (job < 6 ? 2 : 3));
        const int bJ = job - (bI * (bI + 1)) / 2;
        const int l16 = lane & 15, kg = lane >> 4;
        const int t = 16 * bI + l16, s = 16 * bJ + l16, rr = 16 * bI;
#pragma unroll
        for (int ks = 0; ks < 4; ++ks) {
          const int k0 = ks * 32 + kg * 8;
          float qv[8], kv[8];
          unpack8(*(const uint4*)(Qs + t * 136 + k0), qv);
          unpack8(*(const uint4*)(KKs + s * 136 + k0), kv);
#pragma unroll
          for (int e = 0; e < 8; ++e) {
            const float br = BC[rr * 132 + k0 + e];
            qv[e] *= ex2(BC[t * 132 + k0 + e] - br);
            kv[e] *= ex2(fminf(br - BC[s * 132 + k0 + e], 120.f));
          }
          union { uint4 u; bf16x8 v; } ua, ub;
          ua.u = pack8f(qv); ub.u = pack8f(kv);
          cod[jj] = __builtin_amdgcn_mfma_f32_16x16x32_bf16(ua.v, ub.v, cod[jj], 0, 0, 0);
        }
      }
    }
    if (tid < 128) EL[tid] = ex2(BC[63 * 132 + tid]);
#pragma unroll
    for (int j = 0; j < 2; ++j) {
      const int i = (tid >> 4) + 32 * j;
      float kv[8];
      unpack8(*(const uint4*)(KKs + i * 136 + ch * 8), kv);
      u16* dk = KT + (ch * 8) * 72 + i;
#pragma unroll
      for (int e = 0; e < 8; ++e) {
        const float b = BC[i * 132 + ch * 8 + e], bl_ = BC[63 * 132 + ch * 8 + e];
        dk[e * 72] = f2bf(kv[e] * ex2(bl_ - b));
      }
    }
    __syncthreads();
#pragma unroll
    for (int j = 0; j < 2; ++j) {
      const int i = (tid >> 4) + 32 * j;
      float qv[8];
      unpack8(*(const uint4*)(Qs + i * 136 + ch * 8), qv);
#pragma unroll
      for (int e = 0; e < 8; ++e) qv[e] *= ex2(BC[i * 132 + ch * 8 + e]);
      *(uint4*)(Qs + i * 136 + ch * 8) = pack8f(qv);
    }
    for (int i = tid; i < 64 * 72 / 2; i += NTHR) ((unsigned*)AM)[i] = 0u;
    __syncthreads();
#pragma unroll
    for (int jj = 0; jj < 2; ++jj) {
      const int job = wid + 8 * jj;
      if (job < 10) {
        const int bI = job < 1 ? 0 : (job < 3 ? 1 : (job < 6 ? 2 : 3));
        const int bJ = job - (bI * (bI + 1)) / 2;
        const int l16 = lane & 15, kg = lane >> 4;
#pragma unroll
        for (int e = 0; e < 4; ++e) {
          const int tp = 4 * kg + e;
          const float v = (bJ < bI || l16 <= tp) ? cod[jj][e] : 0.f;
          AM[(16 * bI + tp) * 72 + 16 * bJ + l16] = f2bf(v);
        }
      }
    }
    __syncthreads();
    if (step + 1 < 36) SCANA_PREFETCH(step + 1);
    f32x16 o;
#pragma unroll
    for (int e = 0; e < 16; ++e) o[e] = 0.f;
#pragma unroll
    for (int ks = 0; ks < 8; ++ks) {
      bf16x8 a = *(const bf16x8*)(Qs + (th * 32 + r) * 136 + ks * 16 + h * 8);
      bf16x8 b = *(const bf16x8*)(ST + (vt * 32 + r) * 136 + ks * 16 + h * 8);
      o = MFMA(a, b, o);
    }
    bf16x8 bv[4];
#pragma unroll
    for (int ks = 0; ks < 4; ++ks) bv[ks] = *(const bf16x8*)(VT + (vt * 32 + r) * 72 + ks * 16 + h * 8);
#pragma unroll
    for (int ks = 0; ks < 4; ++ks) {
      bf16x8 a = *(const bf16x8*)(AM + (th * 32 + r) * 72 + ks * 16 + h * 8);
      o = MFMA(a, bv[ks], o);
    }
    {
      u16* ob = Oa + (size_t)tok0 * 512 + hd * 128 + vt * 32 + r;
#pragma unroll
      for (int e = 0; e < 16; ++e) {
        const int i = th * 32 + crow(e, h);
        ob[(dir ? 63 - i : i) * 512] = f2bf(o[e]);
      }
    }
    __syncthreads();
#pragma unroll
    for (int j = 0; j < 2; ++j) {
      const int kt = 2 * th + j;
#pragma unroll
      for (int e = 0; e < 16; ++e) S[j][e] *= EL[kt * 32 + crow(e, h)];
#pragma unroll
      for (int ks = 0; ks < 4; ++ks) {
        bf16x8 a = *(const bf16x8*)(KT + (kt * 32 + r) * 72 + ks * 16 + h * 8);
        S[j] = MFMA(a, bv[ks], S[j]);
      }
#pragma unroll
      for (int gq = 0; gq < 4; ++gq) {
        uint2 w;
        w.x = pack2(S[j][4 * gq], S[j][4 * gq + 1]); w.y = pack2(S[j][4 * gq + 2], S[j][4 * gq + 3]);
        *(uint2*)(ST + (vt * 32 + r) * 136 + kt * 32 + 8 * gq + 4 * h) = w;
      }
    }
  }
#undef SCANA_PREFETCH
#undef SCANA_TOK0
}

__device__ void scanB_unit(const Params& p, int l, int unit2, char* lds) {
  const int tid0 = otid(), vb = tid0 >> 8, tid = tid0 & 255, lane = tid & 63, wid = tid >> 6, r = lane & 31, h = lane >> 5;
  const int unit = unit2 * 2 + vb;
  lds += vb * LDSV;
  const int bl = unit >> 3, hd = (unit >> 1) & 3, dir = unit & 1;
  const u16* P = (const u16*)(p.ws + OFF_P);
  const u16* KQ = (const u16*)(p.ws + OFF_KQ);
  const float* Gb = (const float*)(p.ws + OFF_GB);
  u16* Ob = (u16*)(p.ws + OFF_OB) + (size_t)dir * NTOK * 512;
  u16* QB = (u16*)lds;
  u16* KB = (u16*)(lds + 9216);
  u16* SM = (u16*)(lds + 18432);
  u16* KWT = (u16*)(lds + 27648);
  u16* VT = (u16*)(lds + 36864);
  float* vec = (float*)(lds + 55296);
  float *IG = vec, *LF = vec + 64, *BV = vec + 128, *UV = vec + 192, *MT = vec + 256, *WI = vec + 320, *WK = vec + 384,
        *DEN = vec + 448, *NV = vec + 512  , *SC = vec + 640, *BL2 = vec + 704, *UL2 = vec + 768, *EMT = vec + 832;
  const float bI = p.bgate[l * 16 + (2 * dir) * 4 + hd], bF = p.bgate[l * 16 + (2 * dir + 1) * 4 + hd];
  f32x16 C[2];
#pragma unroll
  for (int ft = 0; ft < 2; ++ft)
#pragma unroll
    for (int e = 0; e < 16; ++e) C[ft][e] = 0.f;
  float m = -1e30f;
  __syncthreads();
  if (tid < 128) NV[tid] = 0.f;
  int cur = 0;
  uint4 pk0, pk1, pq0, pq1, pv0, pv1, pv2, pv3; float pgI = 0.f, pgF = 0.f;
#define SCANB_TOK0(st_) (bl * TPB + ((st_) >= 4 ? CTXL : 0) + (dir ? ((st_) >= 4 ? 31 - ((st_) - 4) : 3 - (st_)) : ((st_) >= 4 ? (st_) - 4 : (st_))) * 64)
#define SCANB_LDKQ(j, K_, Q_) do { const int id = tid + 256 * (j), i = id >> 3, c8 = id & 7; \
      const u16* row = KQ + (size_t)(t0_ + (dir ? 63 - i : i)) * 512 + hd * 64 + c8 * 8; K_ = *(const uint4*)(row); Q_ = *(const uint4*)(row + 256); } while (0)
#define SCANB_LDV(j, V_) do { const int id = tid + 256 * (j), i = id >> 4, c16 = id & 15; \
      V_ = *(const uint4*)(P + (size_t)(t0_ + (dir ? 63 - i : i)) * PS + B_V + hd * 128 + c16 * 8); } while (0)
#define SCANB_PREFETCH(st_) do { const int t0_ = SCANB_TOK0(st_); \
    SCANB_LDKQ(0, pk0, pq0); SCANB_LDKQ(1, pk1, pq1); SCANB_LDV(0, pv0); SCANB_LDV(1, pv1); SCANB_LDV(2, pv2); SCANB_LDV(3, pv3); \
    if (tid < 64) { const int tok = t0_ + (dir ? 63 - tid : tid); pgI = Gb[(size_t)tok * 16 + (2 * dir) * 4 + hd]; pgF = Gb[(size_t)tok * 16 + (2 * dir + 1) * 4 + hd]; } } while (0)
#define SCANB_STKQ(j, K_, Q_) do { const int id = tid + 256 * (j), i = id >> 3, c8 = id & 7; \
      *(uint4*)(KB + i * 72 + c8 * 8) = K_; *(uint4*)(QB + i * 72 + c8 * 8) = Q_; } while (0)
#define SCANB_STV(j, V_) do { const int id = tid + 256 * (j), i = id >> 4, c16 = id & 15; const uint4 vq = V_; u16* dv = VT + (c16 * 8) * 72 + i; \
      dv[0 * 72] = (u16)(vq.x & 0xffff); dv[1 * 72] = (u16)(vq.x >> 16); dv[2 * 72] = (u16)(vq.y & 0xffff); dv[3 * 72] = (u16)(vq.y >> 16); \
      dv[4 * 72] = (u16)(vq.z & 0xffff); dv[5 * 72] = (u16)(vq.z >> 16); dv[6 * 72] = (u16)(vq.w & 0xffff); dv[7 * 72] = (u16)(vq.w >> 16); } while (0)
  SCANB_PREFETCH(0);
  if (vb == 1) { __syncthreads(); __syncthreads(); }
#pragma unroll 1
  for (int step = 0; step < 36; ++step) {
    const int tok0 = SCANB_TOK0(step);
    __syncthreads();
    SCANB_STKQ(0, pk0, pq0); SCANB_STKQ(1, pk1, pq1);
    SCANB_STV(0, pv0); SCANB_STV(1, pv1); SCANB_STV(2, pv2); SCANB_STV(3, pv3);
    if (tid < 64) {
      const int i = tid;
      const float gI = pgI + bI;
      const float gF = pgF + bF;
      const float lf = fminf(gF, 0.f) - log1pf(expf(-fabsf(gF)));
      float b = lf;
#pragma unroll
      for (int d = 1; d < 64; d <<= 1) { float t = __shfl_up(b, d); if (lane >= d) b += t; }
      const float u = gI - b;
      float pm = u;
#pragma unroll
      for (int d = 1; d < 64; d <<= 1) { float t = __shfl_up(pm, d); if (lane >= d) pm = fmaxf(pm, t); }
      const float mt = b + fmaxf(m, pm);
      const float wi = expf(b + m - mt);
      const float mnew = __shfl(mt, 63), b63 = __shfl(b, 63);
      const float dec = expf(b63 + m - mnew);
      const float wk = expf(b63 - b + gI - mnew);
      IG[i] = gI; LF[i] = lf; BV[i] = b; UV[i] = u; MT[i] = mt; WI[i] = wi; WK[i] = wk;
      BL2[i] = (b - mt) * LOG2E; UL2[i] = u * LOG2E; EMT[i] = expf(-mt);
      if (i == 0) { SC[0] = mnew; SC[1] = dec; }
    }
    __syncthreads();
    {
      const int tt = wid >> 1, st = wid & 1;
      f32x16 a16;
#pragma unroll
      for (int e = 0; e < 16; ++e) a16[e] = 0.f;
#pragma unroll
      for (int ks = 0; ks < 4; ++ks) {
        bf16x8 a = *(const bf16x8*)(QB + (tt * 32 + r) * 72 + ks * 16 + h * 8);
        bf16x8 b = *(const bf16x8*)(KB + (st * 32 + r) * 72 + ks * 16 + h * 8);
        a16 = MFMA(a, b, a16);
      }
      const int s = st * 32 + r;
      const float us = UL2[s];
#pragma unroll
      for (int e = 0; e < 16; ++e) {
        const int t = tt * 32 + crow(e, h);
        float v = 0.f;
        if (s <= t) v = a16[e] * ex2(BL2[t] + us);
        SM[t * 72 + s] = f2bf(v);
      }
    }
#pragma unroll
    for (int j = 0; j < 2; ++j) {
      const int id = tid + 256 * j, i = id >> 3, c8 = id & 7;
      float kv[8];
      unpack8(*(const uint4*)(KB + i * 72 + c8 * 8), kv);
      const float wk = WK[i];
#pragma unroll
      for (int e = 0; e < 8; ++e) KWT[(c8 * 8 + e) * 72 + i] = f2bf(kv[e] * wk);
    }
    __syncthreads();
    const float mnew = SC[0], dec = SC[1];
    if (tid < 64) {
      const int t = tid;
      float rsum = 0.f, qn = 0.f;
#pragma unroll
      for (int c8 = 0; c8 < 8; ++c8) {
        float sv[8], qv[8];
        unpack8(*(const uint4*)(SM + t * 72 + c8 * 8), sv);
        unpack8(*(const uint4*)(QB + t * 72 + c8 * 8), qv);
#pragma unroll
        for (int e = 0; e < 8; ++e) { rsum += sv[e]; qn += qv[e] * NV[cur * 64 + c8 * 8 + e]; }
      }
      DEN[t] = 1.f / fmaxf(fabsf(WI[t] * qn + rsum), EMT[t]);
    } else if (tid < 128) {
      const int f = tid - 64;
      float ns = 0.f;
#pragma unroll
      for (int c8 = 0; c8 < 8; ++c8) {
        float kv[8];
        unpack8(*(const uint4*)(KWT + f * 72 + c8 * 8), kv);
#pragma unroll
        for (int e = 0; e < 8; ++e) ns += kv[e];
      }
      NV[(cur ^ 1) * 64 + f] = dec * NV[cur * 64 + f] + ns;
    }
    __syncthreads();
    if (step + 1 < 36) SCANB_PREFETCH(step + 1);
    f32x16 num[2];
#pragma unroll
    for (int tt = 0; tt < 2; ++tt)
#pragma unroll
      for (int e = 0; e < 16; ++e) num[tt][e] = 0.f;
#pragma unroll
    for (int ft = 0; ft < 2; ++ft)
#pragma unroll
      for (int s = 0; s < 2; ++s) {
        bf16x8 pb = pack8(C[ft], s);
#pragma unroll
        for (int tt = 0; tt < 2; ++tt) {
          const u16* qb = QB + (tt * 32 + r) * 72 + ft * 32 + s * 16 + 4 * h;
          bf16x8 a = cat4(*(const s16x4*)qb, *(const s16x4*)(qb + 8));
          num[tt] = MFMA(a, pb, num[tt]);
        }
      }
#pragma unroll
    for (int tt = 0; tt < 2; ++tt)
#pragma unroll
      for (int e = 0; e < 16; ++e) num[tt][e] *= WI[tt * 32 + crow(e, h)];
    bf16x8 bv[4];
#pragma unroll
    for (int ks = 0; ks < 4; ++ks) bv[ks] = *(const bf16x8*)(VT + (wid * 32 + r) * 72 + ks * 16 + h * 8);
#pragma unroll
    for (int ks = 0; ks < 4; ++ks)
#pragma unroll
      for (int tt = 0; tt < 2; ++tt) {
        bf16x8 a = *(const bf16x8*)(SM + (tt * 32 + r) * 72 + ks * 16 + h * 8);
        num[tt] = MFMA(a, bv[ks], num[tt]);
      }
#pragma unroll
    for (int tt = 0; tt < 2; ++tt)
#pragma unroll
      for (int e = 0; e < 16; ++e) {
        const int i = tt * 32 + crow(e, h);
        const int tok = tok0 + (dir ? 63 - i : i);
        Ob[(size_t)tok * 512 + hd * 128 + wid * 32 + r] = f2bf(num[tt][e] * DEN[i]);
      }
#pragma unroll
    for (int ft = 0; ft < 2; ++ft) {
#pragma unroll
      for (int e = 0; e < 16; ++e) C[ft][e] *= dec;
#pragma unroll
      for (int ks = 0; ks < 4; ++ks) {
        bf16x8 a = *(const bf16x8*)(KWT + (ft * 32 + r) * 72 + ks * 16 + h * 8);
        C[ft] = MFMA(a, bv[ks], C[ft]);
      }
    }
    m = mnew;
    cur ^= 1;
  }
  if (vb == 0) { __syncthreads(); __syncthreads(); }
#undef SCANB_PREFETCH
#undef SCANB_LDKQ
#undef SCANB_LDV
#undef SCANB_STKQ
#undef SCANB_STV
#undef SCANB_TOK0
}

__device__ void phase_mixers(const Params& p, int l, int g, char* lds, int cbase = 0, bool scans_only = false, bool a_only = false) {
  int* s_item = (int*)(lds + LDS_BYTES - 16);
  int* cnt = (int*)(p.ws + OFF_CNT) + cbase + (l * NG + g);
  const u16* P = (const u16*)(p.ws + OFF_P);
  const u16* Qd = (const u16*)(p.ws + OFF_QD);
  const u16* Kd = (const u16*)(p.ws + OFF_KD);
  const u16* Vd = (const u16*)(p.ws + OFF_VD);
  u16* Y = (u16*)((char*)p.out);
  const float* rc = (const float*)(p.ws + OFF_ROPE);
  constexpr int NSA = NB * 8, NSB = NB * 4;
  constexpr int ND_L = NB * 4 * 8, NC_L = NB * 2 * 32, ND_C = NB * 4, NC_C = NB * 2 * 4;
  constexpr int I1 = NSA, I2 = I1 + NSB, I3 = I2 + ND_L, I4 = I3 + NC_L, I5 = I4 + ND_C, I6 = I5 + NC_C;
  const float scC = 0.125f * LOG2E, scD = 0.07216878364870322f * LOG2E;
  while (true) {
    __syncthreads();
    if (otid() == 0) *s_item = atomicAdd(cnt, 1);
    __syncthreads();
    const int it = *s_item;
    if (it >= (a_only ? I1 : (scans_only ? I2 : (l == DEPTH - 1 ? I4 : I6)))) break;
    if (it < I1) scanA_unit(p, l, it, lds);
    else if (it < I2) scanB_unit(p, l, it - I1, lds);
    else {
      bool isD, isLat; int q;
      if (it < I3) { isD = true; isLat = true; q = it - I2; }
      else if (it < I4) { isD = false; isLat = true; q = it - I3; }
      else if (it < I5) { isD = true; isLat = false; q = it - I4; }
      else { isD = false; isLat = false; q = it - I5; }
      const int tid = otid(), lane = tid & 63, wid = tid >> 6, r = lane & 31;
      const int nkeys = isLat ? TPB : CTXL;
      if (isD) {
        const int nqt = isLat ? 8 : 1;
        const int qt = q % nqt, hd = (q / nqt) % 4, bl = q / (nqt * 4);
        const int tokk = bl * TPB, ql = qt * 256 + wid * 32 + r;
        const int tokq = tokk + (isLat ? CTXL : 0) + ql;
        attn_item<192, 128, true>(Qd + (size_t)tokq * 768 + hd * 192, Kd + (size_t)tokk * 768 + hd * 192, 768,
                                  Vd + (size_t)tokk * 512 + hd * 128, 512, Y + (size_t)tokq * 2048 + 1536 + hd * 128,
                                  nkeys, scD, isLat ? ql : -1, rc, lds);
      } else {
        const int nqt = isLat ? 32 : 4;
        const int qt = q % nqt, kvh = (q / nqt) % 2, bl = q / (nqt * 2);
        const int hq = kvh * 4 + (wid >> 1);
        const int tokk = bl * TPB, ql = qt * 64 + (wid & 1) * 32 + r;
        const int tokq = tokk + (isLat ? CTXL : 0) + ql;
        attn_item<64, 64, false>(P + (size_t)tokq * PS + C_Q + hq * 64, P + (size_t)tokk * PS + C_K + kvh * 64, PS,
                                 P + (size_t)tokk * PS + C_V + kvh * 64, PS, Y + (size_t)tokq * 2048 + 1024 + hq * 64,
                                 nkeys, scC, -1, rc, lds);
      }
    }
  }
}

__device__ void phase_readout(const Params& p, int l) {
  const int tid = otid(), lane = tid & 63, wid = tid >> 6;
  const u16* P = (const u16*)(p.ws + OFF_P);
  const u16* Oa = (const u16*)(p.ws + OFF_OA);
  const u16* Ob = (const u16*)(p.ws + OFF_OB);
  u16* Y = (u16*)((char*)p.out);
  for (int tok = blockIdx.x * 8 + wid; tok < NTOK; tok += gridDim.x * 8) {
    if (l == DEPTH - 1 && (tok % TPB) < CTXL) continue;
#pragma unroll
    for (int mix = 0; mix < 2; ++mix) {
      const u16* O = mix == 0 ? Oa : Ob;
      const int col = lane * 8;
      float a[8], b[8], gt[8], o[8];
      unpack8(*(const uint4*)(O + (size_t)tok * 512 + col), a);
      unpack8(*(const uint4*)(O + ((size_t)NTOK + tok) * 512 + col), b);
      unpack8(*(const uint4*)(P + (size_t)tok * PS + (mix == 0 ? A_G : B_O) + col), gt);
      float ss = 0.f;
#pragma unroll
      for (int e = 0; e < 8; ++e) { a[e] += b[e]; ss += a[e] * a[e]; }
      ss += __shfl_xor(ss, 1); ss += __shfl_xor(ss, 2); ss += __shfl_xor(ss, 4); ss += __shfl_xor(ss, 8);
      const float rstd = rsqrtf(ss * (1.f / 128.f) + EPS);
      const float* gn = (mix == 0 ? p.hnorm : p.mnorm) + l * 128 + (col & 127);
#pragma unroll
      for (int e = 0; e < 8; ++e) {
        float y = a[e] * rstd * gn[e];
        o[e] = y * (mix == 0 ? siluf_(gt[e]) : sigmoidf_(gt[e]));
      }
      *(uint4*)(Y + (size_t)tok * 2048 + mix * 512 + col) = pack8f(o);
    }
  }
}

struct EpiInproj {
  u16* P; float* Gb;
  DI bool operator()(f32x4 (&acc)[2][2][4][2], const pg8::UDesc& u, int wr, int wc, int fr, int fq) const {
    const int row0 = u.pm * 256 + wr * 64 + fr, col0 = u.pn * 256 + wc * 32 + 8 * fq;
    const bool gate = (u.pn == 9) && (wc == 0) && (fq < 2);
#pragma unroll
    for (int ai = 0; ai < 2; ++ai)
#pragma unroll
      for (int m = 0; m < 4; ++m) {
        const size_t row = (size_t)(row0 + ai * 128 + m * 16);
#pragma unroll
        for (int bj = 0; bj < 2; ++bj) *(uint4*)(P + row * PS + col0 + bj * 128) = pk8(acc[ai][bj][m][0], acc[ai][bj][m][1]);
        if (gate) { *(f32x4*)(Gb + row * 16 + 8 * fq) = acc[ai][0][m][0]; *(f32x4*)(Gb + row * 16 + 8 * fq + 4) = acc[ai][0][m][1]; }
      }
    return false;
  }
};
__device__ void phase_inproj(const Params& p, char* lds) {
  pg8::PlainSched S{p.ws + OFF_H, p.ws + OFF_WINT, 2048u, 2048u, 16, NTOK / 256, PS / 256, (int)gridDim.x, (int)blockIdx.x};
  EpiInproj E{(u16*)(p.ws + OFF_P), (float*)(p.ws + OFF_GB)};
  pg8::gemm_stream(( LAS unsigned char*)lds, S, E);
}

struct MlaSched {
  const char* P; const char* Wq; const char* Wk; const char* Wv; int G, c;
  DI bool next(int i, pg8::UDesc& u) const {
    const long L = (long)i * G + c; if (L >= (NTOK / 256) * 7) return false;
    const int pm = (int)(L / 7), j = (int)(L % 7);
    u.pm = pm; u.lda2 = PS * 2;
    if (j < 3) { u.tag = 0; u.pn = j; u.A = P + (size_t)pm * 256 * PS * 2 + D_CQ * 2; u.B = Wq + (size_t)j * 256 * 512; u.ldb2 = 512; u.nt = 4; }
    else if (j < 5) { u.tag = 1; u.pn = j - 3; u.A = P + (size_t)pm * 256 * PS * 2 + D_CKV * 2; u.B = Wk + (size_t)(j - 3) * 256 * 256; u.ldb2 = 256; u.nt = 2; }
    else { u.tag = 2; u.pn = j - 5; u.A = P + (size_t)pm * 256 * PS * 2 + D_CKV * 2; u.B = Wv + (size_t)(j - 5) * 256 * 256; u.ldb2 = 256; u.nt = 2; }
    return true;
  }
};
struct EpiMla {
  u16 *Qd, *Kd, *Vd;
  DI bool operator()(f32x4 (&acc)[2][2][4][2], const pg8::UDesc& u, int wr, int wc, int fr, int fq) const {
    const int row0 = u.pm * 256 + wr * 64 + fr, col0 = u.pn * 256 + wc * 32 + 8 * fq;
#pragma unroll
    for (int ai = 0; ai < 2; ++ai)
#pragma unroll
      for (int m = 0; m < 4; ++m) {
        const size_t row = (size_t)(row0 + ai * 128 + m * 16);
#pragma unroll
        for (int bj = 0; bj < 2; ++bj) {
          const int col = col0 + bj * 128;
          u16* dst = u.tag == 0 ? Qd + row * 768 + col : (u.tag == 1 ? Kd + row * 768 + (col >> 7) * 192 + (col & 127) : Vd + row * 512 + col);
          *(uint4*)dst = pk8(acc[ai][bj][m][0], acc[ai][bj][m][1]);
        }
      }
    return false;
  }
};
__device__ void phase_mlaup(const Params& p, char* lds) {
  MlaSched S{p.ws + OFF_P, p.ws + OFF_WUQ, p.ws + OFF_WUK, p.ws + OFF_WUV, (int)gridDim.x, (int)blockIdx.x};
  EpiMla E{(u16*)(p.ws + OFF_QD), (u16*)(p.ws + OFF_KD), (u16*)(p.ws + OFF_VD)};
  pg8::gemm_stream((LAS unsigned char*)lds, S, E);
}

struct EpiGate {
  u16* Gt;
  DI bool operator()(f32x4 (&acc)[2][2][4][2], const pg8::UDesc& u, int wr, int wc, int fr, int fq) const {
    const int row0 = u.pm * 256 + wr * 64 + fr, col0 = u.pn * 256 + wc * 32 + 8 * fq;
#pragma unroll
    for (int ai = 0; ai < 2; ++ai)
#pragma unroll
      for (int m = 0; m < 4; ++m) {
        const size_t row = (size_t)(row0 + ai * 128 + m * 16);
#pragma unroll
        for (int bj = 0; bj < 2; ++bj) {
          f32x4 a = acc[ai][bj][m][0], b = acc[ai][bj][m][1];
#pragma unroll
          for (int e = 0; e < 4; ++e) { a[e] = fmaxf(sigmoidf_(a[e]), 1e-30f); b[e] = fmaxf(sigmoidf_(b[e]), 1e-30f); }
          *(uint4*)(Gt + row * 4096 + col0 + bj * 128) = pk8(a, b);
        }
      }
    return false;
  }
};
__device__ void phase_gate(const Params& p, char* lds, int lat_only) {
  pg8::PlainSched S{p.ws + OFF_H, p.ws + OFF_WGT, 2048u, 2048u, 16, NTOK / 256, 16, (int)gridDim.x, (int)blockIdx.x, lat_only};
  EpiGate E{(u16*)(p.ws + OFF_P)};
  pg8::gemm_stream((LAS unsigned char*)lds, S, E);
}

struct BranchSched {
  const char* Y; const char* Wb; int G, c, lat_only;
  DI bool next(int i, pg8::UDesc& u) const {
    int pm, pn; if (!pg8::tile_order((long)(i >> 2) * G + c, lat_only ? NTOK / 256 - NB : NTOK / 256, 4, pm, pn)) return false;
    if (lat_only) pm = pm + (pm >> 3) + 1;
    const int r = i & 3;
    u.pm = pm; u.pn = pn; u.tag = r; u.lda2 = 4096; u.ldb2 = 1024; u.nt = 8;
    u.A = Y + (size_t)pm * 256 * 4096 + r * 1024; u.B = Wb + ((size_t)r * 1024 + pn * 256) * 1024;
    return true;
  }
};
struct EpiBranch {
  const u16* Gt; u16* Mg;
  DI bool operator()(f32x4 (&acc)[2][2][4][2], const pg8::UDesc& u, int wr, int wc, int fr, int fq) const {
    const int row0 = u.pm * 256 + wr * 64 + fr, col0 = u.pn * 256 + wc * 32 + 8 * fq, r = u.tag;
#pragma unroll
    for (int ai = 0; ai < 2; ++ai)
#pragma unroll
      for (int m = 0; m < 4; ++m) {
        const size_t row = (size_t)(row0 + ai * 128 + m * 16);
#pragma unroll
        for (int bj = 0; bj < 2; ++bj) {
          const int col = col0 + bj * 128;
          float gv[8];
          unpack8(*(const uint4*)(Gt + row * 4096 + r * 1024 + col), gv);
          if (r < 3) {
            float gn[8];
            unpack8(*(const uint4*)(Gt + row * 4096 + (r + 1) * 1024 + col), gn);
#pragma unroll
            for (int e = 0; e < 4; ++e) {
              acc[ai][bj][m][0][e] *= gv[e] * __builtin_amdgcn_rcpf(gn[e]);
              acc[ai][bj][m][1][e] *= gv[4 + e] * __builtin_amdgcn_rcpf(gn[4 + e]);
            }
          } else {
            f32x4 a = acc[ai][bj][m][0], b = acc[ai][bj][m][1];
#pragma unroll
            for (int e = 0; e < 4; ++e) { a[e] *= gv[e]; b[e] *= gv[4 + e]; }
            *(uint4*)(Mg + row * 1024 + col) = pk8(a, b);
          }
        }
      }
    return r < 3;
  }
};
__device__ void phase_branch(const Params& p, char* lds, int lat_only) {
  BranchSched S{(const char*)p.out, p.ws + OFF_WBT, (int)gridDim.x, (int)blockIdx.x, lat_only};
  EpiBranch E{(const u16*)(p.ws + OFF_P), (u16*)(p.ws + OFF_OA)};
  pg8::gemm_stream((LAS unsigned char*)lds, S, E);
}

struct EpiResid {
  const Params* pp; const float* mod; int g, gidx; float* dummy;
  DI bool operator()(f32x4 (&acc)[2][2][4][2], const pg8::UDesc& u, int wr, int wc, int fr, int fq) const {
    int mr; u16* xb = xrow_ptr(*pp, g, u.pm * 256, mr);
    if (dummy) xb = (u16*)dummy + (size_t)u.pm * 256 * DM;
    const float* gate = mod + (size_t)mr * 6144 + gidx * DM;
    const int row0 = wr * 64 + fr, col0 = u.pn * 256 + wc * 32 + 8 * fq;
    f32x4 gv[2][2];
#pragma unroll
    for (int bj = 0; bj < 2; ++bj) { gv[bj][0] = *(const f32x4*)(gate + col0 + bj * 128); gv[bj][1] = *(const f32x4*)(gate + col0 + bj * 128 + 4); }
#pragma unroll
    for (int ai = 0; ai < 2; ++ai)
#pragma unroll
      for (int m = 0; m < 4; ++m) {
        u16* xr = xb + (size_t)(row0 + ai * 128 + m * 16) * DM + col0;
#pragma unroll
        for (int bj = 0; bj < 2; ++bj) {
          float xv[8];
          unpack8(*(const uint4*)(xr + bj * 128), xv);
          f32x4 x0 = {xv[0], xv[1], xv[2], xv[3]}, x1 = {xv[4], xv[5], xv[6], xv[7]};
          x0 += gv[bj][0] * acc[ai][bj][m][0]; x1 += gv[bj][1] * acc[ai][bj][m][1];
          *(uint4*)(xr + bj * 128) = pk8(x0, x1);
        }
      }
    return false;
  }
};
__device__ void phase_resid_gemm(const Params& p, int l, int g, const char* A, const char* W, int K, int gidx, char* lds, float* dummy = nullptr) {
  pg8::PlainSched S{A, W, (unsigned)K * 2u, (unsigned)K * 2u, K / 64, NTOK / 256, 4, (int)gridDim.x, (int)blockIdx.x, (l == DEPTH - 1) ? 1 : 0};
  EpiResid E{&p, (const float*)(p.ws + OFF_MOD) + (size_t)l * 33 * 6144, g, gidx, dummy};
  pg8::gemm_stream((LAS unsigned char*)lds, S, E);
}

struct EpiFF1 {
  u16* Hid;
  DI bool operator()(f32x4 (&acc)[2][2][4][2], const pg8::UDesc& u, int wr, int wc, int fr, int fq) const {
    const int row0 = u.pm * 256 + wr * 64 + fr, col0 = u.pn * 256 + wc * 32 + 8 * fq;
#pragma unroll
    for (int ai = 0; ai < 2; ++ai)
#pragma unroll
      for (int m = 0; m < 4; ++m) {
        const size_t row = (size_t)(row0 + ai * 128 + m * 16);
#pragma unroll
        for (int bj = 0; bj < 2; ++bj) {
          f32x4 a = acc[ai][bj][m][0], b = acc[ai][bj][m][1];
#pragma unroll
          for (int e = 0; e < 4; ++e) { float t = fmaxf(a[e], 0.f); a[e] = t * t; t = fmaxf(b[e], 0.f); b[e] = t * t; }
          *(uint4*)(Hid + row * DFF + col0 + bj * 128) = pk8(a, b);
        }
      }
    return false;
  }
};
__device__ void phase_ff1(const Params& p, char* lds, int lat_only) {
  pg8::PlainSched S{p.ws + OFF_H, p.ws + OFF_W1T, 2048u, 2048u, 16, NTOK / 256, 16, (int)gridDim.x, (int)blockIdx.x, lat_only};
  EpiFF1 E{(u16*)(p.ws + OFF_P)};
  pg8::gemm_stream((LAS unsigned char*)lds, S, E);
}

__device__ void phase_final(const Params& p) {
  const int tid = otid(), lane = tid & 63, wid = tid >> 6;
  for (int tok = blockIdx.x * 8 + wid; tok < NBATCH * SEQ; tok += gridDim.x * 8) {
    float* xr = p.out + (size_t)tok * DM;
    const u16* xs = (const u16*)(p.ws + OFF_XL) + (size_t)tok * DM;
    float4 v[4]; float ss = 0.f;
#pragma unroll
    for (int j = 0; j < 4; ++j) {
      const uint2 q = *(const uint2*)(xs + j * 256 + lane * 4);
      v[j].x = __uint_as_float(q.x << 16); v[j].y = __uint_as_float(q.x & 0xffff0000u); v[j].z = __uint_as_float(q.y << 16); v[j].w = __uint_as_float(q.y & 0xffff0000u);
      ss += v[j].x * v[j].x + v[j].y * v[j].y + v[j].z * v[j].z + v[j].w * v[j].w;
    }
    ss = wave_sum(ss);
    const float rstd = rsqrtf(ss * (1.f / DM) + EPS);
#pragma unroll
    for (int j = 0; j < 4; ++j) {
      int c = j * 256 + lane * 4;
      float4 gg = *(const float4*)(p.gfin + c);
      float4 o = {v[j].x * rstd * gg.x, v[j].y * rstd * gg.y, v[j].z * rstd * gg.z, v[j].w * rstd * gg.w};
      *(float4*)(xr + c) = o;
    }
  }
}

#define XB_TMO      128
#define XB_XCNT(j)  (256  + 64 * (j))
#define XB_XSUB(j)  (1280 + 64 * (j))
#define XB_XGEN(j)  (2304 + 64 * (j))
#define XB_TOP      3328
#define XB_TOPGEN   3392
#define XCD_BAR_WORDS 3456
#define XB_SPIN_CAP (1u << 18)
DI unsigned xb_ld(unsigned* p) { return __hip_atomic_load(p, __ATOMIC_RELAXED, __HIP_MEMORY_SCOPE_AGENT); }
DI unsigned xb_add(unsigned* p, unsigned v) { return __hip_atomic_fetch_add(p, v, __ATOMIC_RELAXED, __HIP_MEMORY_SCOPE_AGENT); }
DI unsigned xb_xcc_id() { return (unsigned)__builtin_amdgcn_s_getreg((3 << 11) | 20) & 0xFu; }
#define XB_SPIN(cond, bar) do { unsigned _sp = 0; while (cond) { __builtin_amdgcn_s_sleep(1); \
    if ((++_sp & 255u) == 0u) { if (xb_ld(&(bar)[XB_TMO])) break; if (_sp > XB_SPIN_CAP) { atomicAdd(&(bar)[XB_TMO], 1u); break; } } } } while (0)
struct XcdBarrier { unsigned* bar; unsigned x; volatile __attribute__((address_space(3))) unsigned* st; };
DI XcdBarrier xcd_barrier_post(unsigned* bar, volatile __attribute__((address_space(3))) unsigned* st) {
  XcdBarrier b; b.bar = bar; b.x = xb_xcc_id(); b.st = st;
  if (threadIdx.x == 0) (void)xb_add(&bar[XB_XCNT(b.x)], 1u);
  return b;
}
DI void xcd_barrier_complete(unsigned* bar, unsigned x, unsigned& nloc, unsigned& nx) {
  const unsigned G = gridDim.x * gridDim.y * gridDim.z;
  unsigned sum, cnt, mine, sp = 0u;
  for (;;) {
    sum = 0u; cnt = 0u; mine = 0u;
#pragma unroll
    for (unsigned j = 0; j < 16; ++j) { const unsigned c = xb_ld(&bar[XB_XCNT(j)]); sum += c; cnt += (c > 0u) ? 1u : 0u; mine = (j == x) ? c : mine; }
    if (sum == G) break;
    __builtin_amdgcn_s_sleep(1);
    if ((++sp & 255u) == 0u) { if (xb_ld(&bar[XB_TMO])) break; if (sp > XB_SPIN_CAP) { atomicAdd(&bar[XB_TMO], 1u); break; } }
  }
  nloc = mine > 0u ? mine : 1u; nx = cnt > 0u ? cnt : 1u;
}
DI void xcd_barrier(const XcdBarrier& b) {
  asm volatile("s_waitcnt vmcnt(0)" ::: "memory");
  __syncthreads();
  if (threadIdx.x == 0) {
    unsigned* bar = b.bar;
    __builtin_amdgcn_s_waitcnt(0);
    unsigned nloc = b.st[0], nx = b.st[1];
    if (nloc == 0u) { xcd_barrier_complete(bar, b.x, nloc, nx); b.st[0] = nloc; b.st[1] = nx; }
    const unsigned old = xb_add(&bar[XB_XSUB(b.x)], 1u);
    const unsigned gen = old / nloc;
    if (old + 1u == (gen + 1u) * nloc) {
      __builtin_amdgcn_fence(__ATOMIC_RELEASE, "agent");
      asm volatile("s_waitcnt vmcnt(0)" ::: "memory");
      const unsigned og = xb_add(&bar[XB_TOP], 1u);
      const unsigned tg = og / nx;
      if (og + 1u == (tg + 1u) * nx) xb_add(&bar[XB_TOPGEN], 1u);
      else XB_SPIN(xb_ld(&bar[XB_TOPGEN]) == tg, bar);
      __builtin_amdgcn_fence(__ATOMIC_ACQUIRE, "agent");
      xb_add(&bar[XB_XGEN(b.x)], 1u);
      asm volatile("s_waitcnt vmcnt(0)" ::: "memory");
    } else {
      XB_SPIN(xb_ld(&bar[XB_XGEN(b.x)]) == gen, bar);
      __builtin_amdgcn_fence(__ATOMIC_ACQUIRE, "agent");
      asm volatile("s_waitcnt vmcnt(0)" ::: "memory");
    }
  }
  __syncthreads();
}

constexpr int NSUB = 12;
constexpr int NPHASE = 1 + DEPTH * NG * NSUB + 1;

__global__ void __launch_bounds__(512) mega(Params p, int ph_lo, int ph_hi) {
  extern __shared__ __attribute__((aligned(16))) char lds[];
  volatile __attribute__((address_space(3))) unsigned* st = (volatile __attribute__((address_space(3))) unsigned*)(lds + LDS_BYTES - 32);
  if (threadIdx.x < 2) st[threadIdx.x] = 0u;
  __syncthreads();
  XcdBarrier xb{};
  if (ph_hi - ph_lo > 1) xb = xcd_barrier_post((unsigned*)(p.ws + OFF_BAR), st);
#define GSYNC() xcd_barrier(xb)
  for (int ph = ph_lo; ph < ph_hi; ++ph) {
    if (ph > 0 && ph < NPHASE - 1 && ((ph - 1) % NSUB) == 0 && (((ph - 1) / NSUB) % NG) != 0) continue;
    if (ph == 0) phase_prep(p, lds);
    else if (ph == NPHASE - 1) phase_final(p);
    else {
      const int q = ph - 1, lg = q / NSUB, sub = q % NSUB, l = lg / NG, g = lg % NG;
      switch (sub) {
        case 0: if (g == 0) for (int rep = 0; rep < ((PROBE & 128) ? 2 : 1); ++rep) phase_wconv(p, l, lds); if (lg == 0) phase_norm(p, l, g, 0); break;
        case 1: for (int rep = 0; rep < ((PROBE & 2) ? 2 : 1); ++rep) { if (rep) GSYNC(); phase_inproj(p, lds); } break;
        case 2: phase_tokprep(p, l); break;
        case 3: phase_mlaup(p, lds); break;
        case 4: phase_mixers(p, l, g, lds); if (PROBE & 1) { GSYNC(); phase_mixers(p, l, g, lds, 8); } if (PROBE & 4) { GSYNC(); phase_mixers(p, l, g, lds, 8, true); } if (PROBE & 16) { GSYNC(); phase_mixers(p, l, g, lds, 8, true, true); } break;
        case 5: for (int rep = 0; rep < ((PROBE & 8) ? 2 : 1); ++rep) { if (rep) GSYNC(); phase_readout(p, l); } break;
        case 6: for (int rep = 0; rep < ((PROBE & 2) ? 2 : 1); ++rep) { if (rep) GSYNC(); phase_gate(p, lds, l == DEPTH - 1); } break;
        case 7: for (int rep = 0; rep < ((PROBE & 32) ? 2 : 1); ++rep) { if (rep) GSYNC(); phase_branch(p, lds, l == DEPTH - 1); } break;
        case 8: for (int rep = 0; rep < ((PROBE & 64) ? 2 : 1); ++rep) { if (rep) GSYNC(); phase_resid_gemm(p, l, g, p.ws + OFF_OA, p.ws + OFF_WOT, DM, 2, lds, rep ? (float*)((char*)p.out) : nullptr); } break;
        case 9: for (int rep = 0; rep < ((PROBE & 8) ? 2 : 1); ++rep) { if (rep) GSYNC(); phase_norm(p, l, g, 1); } break;
        case 10: for (int rep = 0; rep < ((PROBE & 2) ? 2 : 1); ++rep) { if (rep) GSYNC(); phase_ff1(p, lds, l == DEPTH - 1); } break;
        default: for (int rep = 0; rep < ((PROBE & 64) ? 2 : 1); ++rep) { if (rep) GSYNC(); phase_resid_gemm(p, l, g, p.ws + OFF_P, p.ws + OFF_W2T, DFF, 5, lds, rep ? (float*)((char*)p.out) : nullptr); } if (lg + 1 < DEPTH * NG) phase_norm_dyn(p, (lg + 1) / NG, (lg + 1) % NG, (int*)(p.ws + OFF_CNT) + 16 + lg); break;
      }
    }
    if (ph + 1 < ph_hi) { if (ph == ph_lo) cg::this_grid().sync(); else GSYNC(); }
  }
}

extern "C" void kernel_launch(void* const* d_in, const int* in_sizes, int n_in, void* d_out, int out_size, void* d_ws,
                              size_t ws_size, hipStream_t stream) {
  static int grid_blocks = 0;
  if (!grid_blocks) {
    int dev = 0, cus = 0, per_cu = 0;
    (void)hipGetDevice(&dev);
    (void)hipDeviceGetAttribute(&cus, hipDeviceAttributeMultiprocessorCount, dev);
    (void)hipFuncSetAttribute((const void*)mega, hipFuncAttributeMaxDynamicSharedMemorySize, LDS_BYTES);
    (void)hipOccupancyMaxActiveBlocksPerMultiprocessor(&per_cu, mega, NTHR, LDS_BYTES);
    if (per_cu < 1) per_cu = 1;
    if (per_cu > 1) per_cu = 1;
    grid_blocks = cus * per_cu;
  }
  if (ws_size < WS_NEED) { fprintf(stderr, "workspace too small: %zu < %zu\n", ws_size, (size_t)WS_NEED); }
  Params p{};
  const float** pf = (const float**)&p;
  for (int i = 0; i < 26; ++i) pf[i] = (const float*)d_in[i];
  p.out = (float*)d_out;
  p.ws = (char*)d_ws;
  (void)hipMemsetAsync((char*)d_ws + OFF_CNT, 0, 256 + 3456 * 4, stream);
#if ONE_LAUNCH
  int lo = 0, hi = NPHASE;
  void* args[] = {&p, &lo, &hi};
  hipError_t e = hipLaunchCooperativeKernel((void*)mega, dim3(grid_blocks), dim3(NTHR), args, LDS_BYTES, stream);
  if (e != hipSuccess) fprintf(stderr, "cooperative launch failed: %s (grid %d)\n", hipGetErrorString(e), grid_blocks);
#else
  for (int ph = 0; ph < NPHASE; ++ph) mega<<<grid_blocks, NTHR, LDS_BYTES, stream>>>(p, ph, ph + 1);
#endif
}
```

```cpp
#include <hip/hip_runtime.h>
#include <hip/hip_cooperative_groups.h>
#include <cstdio>
#include <cstdint>
namespace cg = cooperative_groups;

#ifndef PROBE
#define PROBE 0
#endif
#ifndef ONE_LAUNCH
#define ONE_LAUNCH 1
#endif

typedef unsigned short u16;
typedef short bf16x8 __attribute__((ext_vector_type(8)));
typedef short s16x4 __attribute__((ext_vector_type(4)));
typedef float f32x16 __attribute__((ext_vector_type(16)));
typedef float f32x2v __attribute__((ext_vector_type(2)));
typedef __bf16 bf16x2v __attribute__((ext_vector_type(2)));
#define DI __device__ __forceinline__
#define MFMA(a, b, c) __builtin_amdgcn_mfma_f32_32x32x16_bf16((a), (b), (c), 0, 0, 0)

constexpr int DM = 1024, NBATCH = 32, SEQ = 2048, CTXL = 256, DEPTH = 4, DFF = 4096;
constexpr int NG = 2, NB = 16, TPB = 2304, NTOK = NB * TPB;
constexpr int PS = 5376, NPC = 5328, INW = 9424;
constexpr int A_I = 0, A_FF = 512, A_FB = 1024, B_K = 1536, B_V = 1792, B_G = 2304, C_K = 2320, C_V = 2448,
              D_CKV = 2576, D_KR = 2704, A_Q = 2768, A_G = 3280, B_Q = 3792, B_O = 4048, C_Q = 4560, D_CQ = 5072;
constexpr float EPS = 1e-6f;
constexpr float LOG2E = 1.4426950408889634f;

constexpr size_t al256(size_t x) { return (x + 255) & ~(size_t)255; }
constexpr size_t OFF_WINT = 0;
constexpr size_t OFF_WGT = OFF_WINT + al256((size_t)PS * 1024 * 2);
constexpr size_t OFF_WBT = OFF_WGT + al256((size_t)4096 * 1024 * 2);
constexpr size_t OFF_WOT = OFF_WBT + al256((size_t)4 * 1024 * 512 * 2);
constexpr size_t OFF_W1T = OFF_WOT + al256((size_t)1024 * 1024 * 2);
constexpr size_t OFF_W2T = OFF_W1T + al256((size_t)4096 * 1024 * 2);
constexpr size_t OFF_WUQ = OFF_W2T + al256((size_t)1024 * 4096 * 2);
constexpr size_t OFF_WUK = OFF_WUQ + al256((size_t)768 * 256 * 2);
constexpr size_t OFF_WUV = OFF_WUK + al256((size_t)512 * 128 * 2);
constexpr size_t OFF_MOD = OFF_WUV + al256((size_t)512 * 128 * 2);
constexpr size_t OFF_LB = OFF_MOD + al256((size_t)4 * 33 * 6144 * 4);
constexpr size_t OFF_ROPE = OFF_LB + al256((size_t)4 * 2 * 512 * 4);
constexpr size_t OFF_CNT = OFF_ROPE + al256((size_t)2 * 64 * 16 * 4);
constexpr size_t OFF_BAR = OFF_CNT + 256;
constexpr size_t OFF_XC = OFF_BAR + al256(3456 * 4);
constexpr size_t OFF_XL = OFF_XC + al256((size_t)NBATCH * CTXL * DM * 2);
constexpr size_t OFF_P = OFF_XL + al256((size_t)NBATCH * SEQ * DM * 2);
constexpr size_t OFF_GB = OFF_P + al256((size_t)NTOK * PS * 2);
constexpr size_t OFF_KQ = OFF_GB + al256((size_t)NTOK * 16 * 4);
constexpr size_t OFF_H = OFF_KQ + al256((size_t)NTOK * 512 * 2);
constexpr size_t OFF_QD = OFF_H + al256((size_t)NTOK * 1024 * 2);
constexpr size_t OFF_KD = OFF_QD + al256((size_t)NTOK * 768 * 2);
constexpr size_t OFF_VD = OFF_KD + al256((size_t)NTOK * 768 * 2);
constexpr size_t OFF_OA = OFF_VD + al256((size_t)NTOK * 512 * 2);
constexpr size_t OFF_OB = OFF_OA + al256((size_t)2 * NTOK * 512 * 2);
constexpr size_t OFF_W2ND = OFF_OB + al256((size_t)2 * NTOK * 512 * 2);
constexpr size_t WS_NEED = OFF_W2ND + (OFF_MOD - OFF_WINT);
constexpr int LDS_BYTES = 143360;
constexpr int LDSV = 69632;
constexpr int NTHR = 512;
constexpr size_t OFF_MF = OFF_QD;

struct Params {
  const float *x, *c, *ctx, *c_ctx, *w_ada, *b_ada, *g1, *g2, *w_in, *bgate, *lblog, *hnorm, *convw, *mnorm,
      *gqn, *gkn, *mqn, *mkvn, *wuq, *wuk, *wuv, *wbr, *wout, *wff1, *wff2, *gfin;
  float* out;
  char* ws;
};

DI int otid() { int t = threadIdx.x; asm volatile("" : "+v"(t)); return t; }
DI char* wsel(const Params& p, int l) { return p.ws + ((l & 1) ? OFF_W2ND : (size_t)0); }
DI float bf2f(u16 v) { return __uint_as_float(((unsigned)v) << 16); }
DI unsigned pack2(float a, float b) {
  f32x2v v = {a, b};
  bf16x2v r = __builtin_convertvector(v, bf16x2v);
  return __builtin_bit_cast(unsigned, r);
}
DI u16 f2bf(float a) { return (u16)(pack2(a, 0.f) & 0xffffu); }
DI int crow(int reg, int h) { return (reg & 3) + 8 * (reg >> 2) + 4 * h; }
DI float sigmoidf_(float x) { return 1.f / (1.f + __expf(-x)); }
DI float siluf_(float x) { return x / (1.f + __expf(-x)); }
DI float ex2(float x) { return __builtin_amdgcn_exp2f(x); }
DI bf16x8 pack8(const f32x16& x, int s) {
  union { unsigned u[4]; bf16x8 v; } t;
  t.u[0] = pack2(x[8 * s + 0], x[8 * s + 1]);
  t.u[1] = pack2(x[8 * s + 2], x[8 * s + 3]);
  t.u[2] = pack2(x[8 * s + 4], x[8 * s + 5]);
  t.u[3] = pack2(x[8 * s + 6], x[8 * s + 7]);
  return t.v;
}
DI bf16x8 cat4(s16x4 lo, s16x4 hi) { return __builtin_shufflevector(lo, hi, 0, 1, 2, 3, 4, 5, 6, 7); }
DI float wave_sum(float v) {
#pragma unroll
  for (int d = 32; d >= 1; d >>= 1) v += __shfl_xor(v, d);
  return v;
}
DI void unpack8(const uint4& q, float* f) {
  f[0] = __uint_as_float(q.x << 16); f[1] = __uint_as_float(q.x & 0xffff0000u);
  f[2] = __uint_as_float(q.y << 16); f[3] = __uint_as_float(q.y & 0xffff0000u);
  f[4] = __uint_as_float(q.z << 16); f[5] = __uint_as_float(q.z & 0xffff0000u);
  f[6] = __uint_as_float(q.w << 16); f[7] = __uint_as_float(q.w & 0xffff0000u);
}
DI uint4 pack8f(const float* f) {
  uint4 q;
  q.x = pack2(f[0], f[1]); q.y = pack2(f[2], f[3]); q.z = pack2(f[4], f[5]); q.w = pack2(f[6], f[7]);
  return q;
}

DI u16* xrow_ptr(const Params& p, int g, int tok, int& modrow) {
  int bl = tok / TPB, pp = tok - bl * TPB, b = g * NB + bl;
  if (pp < CTXL) { modrow = 32; return (u16*)(p.ws + OFF_XC) + ((size_t)b * CTXL + pp) * DM; }
  modrow = b;
  return (u16*)(p.ws + OFF_XL) + ((size_t)b * SEQ + (pp - CTXL)) * DM;
}

#define LAS __attribute__((address_space(3)))
typedef float f32x4 __attribute__((ext_vector_type(4)));
namespace pg8 {
constexpr int BM = 256, BK = 64, HALF = 128, HTB = HALF * BK * 2, STAGE_BYTES = 8 * HTB, NXCD = 8, WGM = 8;
DI int lds_byte(int r, int c) { const int st = (r >> 4) * 2 + (c >> 5), rr = r & 15, cc = c & 31, ob = rr * 64 + cc * 2; return st * 1024 + (ob ^ (((ob >> 9) & 1) << 5)); }
DI void stage_rc(int b, int& R, int& C) { const int st = b / 1024, sb = b % 1024, swz = sb ^ (((sb >> 9) & 1) << 5); R = (st >> 1) * 16 + swz / 64; C = (st & 1) * 32 + (swz % 64) / 2; }
DI int perm32(int rho) { const int n = rho >> 4, i = rho & 15; return 8 * (i >> 2) + 4 * n + (i & 3); }
struct UDesc { const char* A; const char* B; unsigned lda2, ldb2; int nt, pm, pn, tag; };
DI bool tile_order(long L, int nM, int nN, int& pm, int& pn) {
  const int nwg = nM * nN; if (L >= nwg) return false;
  int wgid = (int)L; { const int q = nwg / NXCD, r = nwg % NXCD, xcd = wgid % NXCD, off = wgid / NXCD; wgid = (xcd < r ? xcd * (q + 1) : r * (q + 1) + (xcd - r) * q) + off; }
  const int nig = WGM * nN, gid = wgid / nig, fm = gid * WGM, gsz = (nM - fm) < WGM ? (nM - fm) : WGM;
  pm = fm + ((wgid % nig) % gsz); pn = (wgid % nig) / gsz; return true;
}
template <class Epi, class Sched>
DI void gemm_stream(LAS unsigned char* lds, const Sched& S, const Epi& E) {
  const int tid = otid(), wid = __builtin_amdgcn_readfirstlane(tid >> 6), lane = tid & 63, wr = wid >> 2, wc = wid & 3, fr = lane & 15, fq = lane >> 4;
  int RA[2], RB[2], CC[2];
#pragma unroll
  for (int i = 0; i < 2; ++i) { int R, C; stage_rc(tid * 16 + i * 8192, R, C); RA[i] = R; RB[i] = (R & ~31) + perm32(R & 31); CC[i] = C * 2; }
  const size_t kstep = (size_t)(BK * 2);
  const unsigned ldsw = (unsigned)wid * 1024u;
  const int aoff = lds_byte(wr * 64 + fr, fq * 8), boff = lds_byte(wc * 32 + fr, fq * 8);
#define PG8_SA(b, h) (((b) * 2 + (h)) * HTB)
#define PG8_SB(b, h) ((4 + (b) * 2 + (h)) * HTB)
#define PG8_STAGE(bufoff, gbase, voff) do { _Pragma("unroll") for (int _i = 0; _i < 2; ++_i) \
    __builtin_amdgcn_global_load_lds((const unsigned*)((const char*)(gbase) + (voff)[_i]), (LAS unsigned*)(lds + (bufoff) + ldsw + _i * 8192), 16, 0, 0); } while (0)
#define PG8_LDA(dst, b, h) do { _Pragma("unroll") for (int m = 0; m < 4; ++m) _Pragma("unroll") for (int k = 0; k < 2; ++k) dst[m][k] = *(const LAS bf16x8*)(lds + PG8_SA(b, h) + aoff + m * 2048 + k * 1024); } while (0)
#define PG8_LDB(dst, b, h) do { _Pragma("unroll") for (int n = 0; n < 2; ++n) _Pragma("unroll") for (int k = 0; k < 2; ++k) dst[n][k] = *(const LAS bf16x8*)(lds + PG8_SB(b, h) + boff + n * 2048 + k * 1024); } while (0)
#define PG8_MMA(ai, bj, At, Bt) do { __builtin_amdgcn_s_setprio(1); _Pragma("unroll") for (int m = 0; m < 4; ++m) _Pragma("unroll") for (int n = 0; n < 2; ++n) _Pragma("unroll") for (int k = 0; k < 2; ++k) \
    acc[ai][bj][m][n] = __builtin_amdgcn_mfma_f32_16x16x32_bf16(Bt[n][k], At[m][k], acc[ai][bj][m][n], 0, 0, 0); __builtin_amdgcn_s_setprio(0); } while (0)
#define PG8_WAIT_V(n) asm volatile("s_waitcnt vmcnt(" #n ")" ::: "memory")
#define PG8_WAIT_L(n) asm volatile("s_waitcnt lgkmcnt(" #n ")" ::: "memory")
#define PG8_BAR __builtin_amdgcn_s_barrier()
#define PG8_SCHED __builtin_amdgcn_sched_barrier(0)
  UDesc cur, nxt; int ui = 0;
  if (!S.next(0, cur)) return;
  f32x4 acc[2][2][4][2];
#pragma unroll
  for (int a = 0; a < 2; ++a)
#pragma unroll
    for (int b = 0; b < 2; ++b)
#pragma unroll
      for (int m = 0; m < 4; ++m)
#pragma unroll
        for (int n = 0; n < 2; ++n) acc[a][b][m][n] = (f32x4){0.f, 0.f, 0.f, 0.f};
  bf16x8 At[4][2], B0[2][2], B1[2][2];
  const char* cA = cur.A; const char* cB = cur.B;
  unsigned vA[2], vB[2];
#pragma unroll
  for (int i = 0; i < 2; ++i) { vA[i] = (unsigned)RA[i] * cur.lda2 + CC[i]; vB[i] = (unsigned)RB[i] * cur.ldb2 + CC[i]; }
  size_t hA = (size_t)HALF * cur.lda2, hB = (size_t)HALF * cur.ldb2;
  PG8_STAGE(PG8_SB(0, 0), cB, vB); PG8_STAGE(PG8_SA(0, 0), cA, vA); PG8_STAGE(PG8_SB(0, 1), cB + hB, vB); PG8_STAGE(PG8_SA(0, 1), cA + hA, vA);
  if (wr == 1) PG8_BAR;
  PG8_WAIT_V(4); PG8_BAR;
  PG8_STAGE(PG8_SB(1, 0), cB + kstep, vB); PG8_STAGE(PG8_SA(1, 0), cA + kstep, vA); PG8_STAGE(PG8_SB(1, 1), cB + hB + kstep, vB);
  PG8_WAIT_V(6); PG8_BAR;
  for (;;) {
    const bool has_next = S.next(ui + 1, nxt);
    const char* nA = has_next ? nxt.A : cA; const char* nB = has_next ? nxt.B : cB;
    const unsigned nlda = has_next ? nxt.lda2 : cur.lda2, nldb = has_next ? nxt.ldb2 : cur.ldb2;
    unsigned nvA[2], nvB[2];
#pragma unroll
    for (int i = 0; i < 2; ++i) { nvA[i] = (unsigned)RA[i] * nlda + CC[i]; nvB[i] = (unsigned)RB[i] * nldb + CC[i]; }
    const size_t nhA = (size_t)HALF * nlda, nhB = (size_t)HALF * nldb;
    const int nt = cur.nt;
    for (int t = 0; t < nt; t += 2) {
      const bool last = (t == nt - 2);
      const char* a1 = cA + (size_t)(t + 1) * kstep;
      const char* a2 = last ? nA : cA + (size_t)(t + 2) * kstep; const char* b2 = last ? nB : cB + (size_t)(t + 2) * kstep;
      const char* a3 = a2 + kstep; const char* b3 = b2 + kstep;
      unsigned v2A[2], v2B[2];
#pragma unroll
      for (int i = 0; i < 2; ++i) { v2A[i] = last ? nvA[i] : vA[i]; v2B[i] = last ? nvB[i] : vB[i]; }
      const size_t h2A = last ? nhA : hA, h2B = last ? nhB : hB;
      PG8_LDB(B0, 0, 0); PG8_SCHED; PG8_LDA(At, 0, 0); PG8_STAGE(PG8_SA(1, 1), a1 + hA, vA);
      PG8_WAIT_L(8); PG8_BAR; PG8_WAIT_L(0); PG8_MMA(0, 0, At, B0); PG8_BAR; PG8_SCHED;
      PG8_LDB(B1, 0, 1); PG8_STAGE(PG8_SB(0, 0), b2, v2B);
      PG8_BAR; PG8_WAIT_L(0); PG8_MMA(0, 1, At, B1); PG8_BAR;
      PG8_LDA(At, 0, 1); PG8_STAGE(PG8_SA(0, 0), a2, v2A);
      PG8_BAR; PG8_WAIT_L(0); PG8_MMA(1, 0, At, B0); PG8_BAR; PG8_SCHED;
      PG8_STAGE(PG8_SB(0, 1), b2 + h2B, v2B);
      PG8_WAIT_V(6); PG8_BAR; PG8_MMA(1, 1, At, B1); PG8_BAR;
      PG8_LDB(B0, 1, 0); PG8_SCHED; PG8_LDA(At, 1, 0); PG8_STAGE(PG8_SA(0, 1), a2 + h2A, v2A);
      PG8_WAIT_L(8); PG8_BAR; PG8_WAIT_L(0); PG8_MMA(0, 0, At, B0); PG8_BAR; PG8_SCHED;
      PG8_LDB(B1, 1, 1); PG8_STAGE(PG8_SB(1, 0), b3, v2B);
      PG8_BAR; PG8_WAIT_L(0); PG8_MMA(0, 1, At, B1); PG8_BAR;
      PG8_LDA(At, 1, 1); PG8_STAGE(PG8_SA(1, 0), a3, v2A);
      PG8_BAR; PG8_WAIT_L(0); PG8_MMA(1, 0, At, B0); PG8_BAR; PG8_SCHED;
      PG8_STAGE(PG8_SB(1, 1), b3 + h2B, v2B);
      PG8_WAIT_V(6); PG8_BAR; PG8_MMA(1, 1, At, B1); PG8_BAR;
    }
    const bool keep = E(acc, cur, wr, wc, fr, fq);
    if (!has_next) break;
    if (!keep) {
#pragma unroll
      for (int a = 0; a < 2; ++a)
#pragma unroll
        for (int b = 0; b < 2; ++b)
#pragma unroll
          for (int m = 0; m < 4; ++m)
#pragma unroll
            for (int n = 0; n < 2; ++n) acc[a][b][m][n] = (f32x4){0.f, 0.f, 0.f, 0.f};
    }
    cur = nxt; cA = nA; cB = nB; hA = nhA; hB = nhB;
#pragma unroll
    for (int i = 0; i < 2; ++i) { vA[i] = nvA[i]; vB[i] = nvB[i]; }
    ++ui;
  }
  PG8_WAIT_V(0);
  if (wr == 0) PG8_BAR;
  PG8_BAR;
#undef PG8_SA
#undef PG8_SB
#undef PG8_STAGE
#undef PG8_LDA
#undef PG8_LDB
#undef PG8_MMA
#undef PG8_WAIT_V
#undef PG8_WAIT_L
#undef PG8_BAR
#undef PG8_SCHED
}
struct PlainSched {
  const char* A; const char* B; unsigned lda2, ldb2; int nt, nM, nN, G, c; int lat_only = 0;
  DI bool next(int i, UDesc& u) const {
    int pm, pn; if (!tile_order((long)i * G + c, lat_only ? nM - NB : nM, nN, pm, pn)) return false;
    if (lat_only) pm = pm + (pm >> 3) + 1;
    u.A = A + (size_t)pm * 256 * lda2; u.B = B + (size_t)pn * 256 * ldb2; u.lda2 = lda2; u.ldb2 = ldb2; u.nt = nt; u.pm = pm; u.pn = pn; u.tag = 0; return true;
  }
};
}

DI uint4 pk8(const f32x4& a, const f32x4& b) {
  uint4 q; q.x = pack2(a[0], a[1]); q.y = pack2(a[2], a[3]); q.z = pack2(b[0], b[1]); q.w = pack2(b[2], b[3]); return q;
}

__device__ void phase_prep(const Params& p, char* lds) {
  const int tid = otid(), nthr = gridDim.x * NTHR, gt = blockIdx.x * NTHR + tid;
  {
    const float4* s = (const float4*)p.x; uint2* d = (uint2*)(p.ws + OFF_XL);
    const size_t n = (size_t)NBATCH * SEQ * DM / 4;
    for (size_t i = gt; i < n; i += nthr) { const float4 v = s[i]; uint2 o; o.x = pack2(v.x, v.y); o.y = pack2(v.z, v.w); d[i] = o; }
    const float4* s2 = (const float4*)p.ctx; uint2* d2 = (uint2*)(p.ws + OFF_XC);
    const size_t n2 = (size_t)NBATCH * CTXL * DM / 4;
    for (size_t i = gt; i < n2; i += nthr) { const float4 v = s2[i]; uint2 o; o.x = pack2(v.x, v.y); o.y = pack2(v.z, v.w); d2[i] = o; }
  }
  if (gt < 1024) {
    float v[DEPTH], mx = -1e30f;
    for (int l = 0; l < DEPTH; ++l) { v[l] = p.lblog[l * 1024 + gt]; mx = fmaxf(mx, v[l]); }
    float sum = 0.f;
    for (int l = 0; l < DEPTH; ++l) { v[l] = expf(v[l] - mx); sum += v[l]; }
    float* lb = (float*)(p.ws + OFF_LB);
    float run = 0.f;
    for (int l = 0; l < DEPTH; ++l) { lb[l * 1024 + gt] = run; if (l + 1 < DEPTH) run += v[l + 1] / sum; }
  }
  if (gt >= 1024 && gt < 2048) {
    int i = gt - 1024, pos = i >> 4, fi = i & 15;
    float inv = powf(10000.f, -(float)fi / 16.f);
    float ang = (float)pos * inv;
    float* rc = (float*)(p.ws + OFF_ROPE);
    rc[i] = cosf(ang); rc[1024 + i] = sinf(ang);
  }
  float* ssm = (float*)lds;
  float* red = (float*)lds + 2 * 33 * 32;
  for (int item = blockIdx.x; item < DEPTH * 24; item += gridDim.x) {
    const int l = item / 24, kh = tid >> 8, tl = tid & 255, j = (item % 24) * 256 + tl;
    float acc[33];
#pragma unroll
    for (int r = 0; r < 33; ++r) acc[r] = 0.f;
    const float* W = p.w_ada + (size_t)l * DM * 6144;
    for (int k0 = kh * 512; k0 < kh * 512 + 512; k0 += 32) {
      __syncthreads();
      for (int idx = tl; idx < 33 * 32; idx += 256) {
        int rr = idx >> 5, kk = idx & 31;
        float cv = rr < 32 ? p.c[rr * DM + k0 + kk] : p.c_ctx[k0 + kk];
        ssm[kh * 33 * 32 + idx] = cv / (1.f + expf(-cv));
      }
      __syncthreads();
#pragma unroll 4
      for (int kk = 0; kk < 32; ++kk) {
        float w = W[(size_t)(k0 + kk) * 6144 + j];
#pragma unroll
        for (int r = 0; r < 33; ++r) acc[r] += ssm[kh * 33 * 32 + r * 32 + kk] * w;
      }
    }
    __syncthreads();
    if (kh == 1) {
#pragma unroll
      for (int r = 0; r < 33; ++r) red[r * 256 + tl] = acc[r];
    }
    __syncthreads();
    if (kh == 0) {
      float bb = p.b_ada[l * 6144 + j];
      float* mod = (float*)(p.ws + OFF_MOD) + (size_t)l * 33 * 6144;
#pragma unroll
      for (int r = 0; r < 33; ++r) mod[r * 6144 + j] = acc[r] + red[r * 256 + tl] + bb;
    }
  }
  __syncthreads();
}

DI u16* wdst(char* wb, int type, int sub, int n) {
  switch (type) {
    case 0: return n < NPC ? (u16*)(wb + OFF_WINT) + (size_t)n * 1024 : (u16*)(wb + OFF_WGT) + (size_t)(n - NPC) * 1024;
    case 1: return (u16*)(wb + OFF_WBT) + ((size_t)sub * 1024 + n) * 512;
    case 2: return (u16*)(wb + OFF_WOT) + (size_t)n * 1024;
    case 3: return (u16*)(wb + OFF_W1T) + (size_t)n * 1024;
    case 4: return (u16*)(wb + OFF_W2T) + (size_t)n * 4096;
    case 5: return (u16*)(wb + OFF_WUQ) + (size_t)n * 256;
    case 6: return (u16*)(wb + OFF_WUK) + (size_t)n * 128;
    default: return (u16*)(wb + OFF_WUV) + (size_t)n * 128;
  }
}
__device__ void phase_wconv(const Params& p, int l, char* lds, int* cnt = nullptr) {
  char* wb = wsel(p, l);
  int* s_item = (int*)(lds + LDS_BYTES - 16);
  float* tile = (float*)lds;
  const int tid = otid();
  {
    unsigned* z = (unsigned*)((u16*)(wb + OFF_WINT) + (size_t)NPC * 1024);
    for (int i = blockIdx.x * NTHR + tid; i < (PS - NPC) * 1024 / 2; i += gridDim.x * NTHR) z[i] = 0u;
  }
  constexpr int T0 = 16 * 148, T1 = T0 + 4 * 128, T2 = T1 + 256, T3 = T2 + 1024, T4 = T3 + 1024, T5 = T4 + 48, T6 = T5 + 16, T7 = T6 + 16;
  for (int itk = 0;; ++itk) {
    int it;
    if (cnt) { __syncthreads(); if (tid == 0) *s_item = atomicAdd(cnt, 1); __syncthreads(); it = *s_item; }
    else it = blockIdx.x + itk * gridDim.x;
    if (it >= T7) break;
    int type, sub = 0, K, N, kt, nt;
    const float* src;
    if (it < T0) { type = 0; K = 1024; N = INW; int q = it; kt = q / 148; nt = q % 148; src = p.w_in + (size_t)l * 1024 * INW; }
    else if (it < T1) { type = 1; K = 512; N = 1024; int q = it - T0; sub = q / 128; q %= 128; kt = q / 16; nt = q % 16; src = p.wbr + ((size_t)l * 4 + sub) * 512 * 1024; }
    else if (it < T2) { type = 2; K = 1024; N = 1024; int q = it - T1; kt = q / 16; nt = q % 16; src = p.wout + (size_t)l * 1024 * 1024; }
    else if (it < T3) { type = 3; K = 1024; N = 4096; int q = it - T2; kt = q / 64; nt = q % 64; src = p.wff1 + (size_t)l * 1024 * 4096; }
    else if (it < T4) { type = 4; K = 4096; N = 1024; int q = it - T3; kt = q / 16; nt = q % 16; src = p.wff2 + (size_t)l * 4096 * 1024; }
    else if (it < T5) { type = 5; K = 256; N = 768; int q = it - T4; kt = q / 12; nt = q % 12; src = p.wuq + (size_t)l * 256 * 768; }
    else if (it < T6) { type = 6; K = 128; N = 512; int q = it - T5; kt = q / 8; nt = q % 8; src = p.wuk + (size_t)l * 128 * 512; }
    else { type = 7; K = 128; N = 512; int q = it - T6; kt = q / 8; nt = q % 8; src = p.wuv + (size_t)l * 128 * 512; }
    (void)K;
    const int k0 = kt * 64, n0 = nt * 64;
    __syncthreads();
    {
      const int nn = tid & 63, ks = tid >> 6;
#pragma unroll 4
      for (int j = 0; j < 8; ++j) {
        int k = ks + 8 * j;
        tile[k * 65 + nn] = (n0 + nn < N) ? src[(size_t)(k0 + k) * N + n0 + nn] : 0.f;
      }
    }
    __syncthreads();
    {
      const int kp = tid & 31, nn = tid >> 5;
#pragma unroll 4
      for (int j = 0; j < 4; ++j) {
        int n = nn + 16 * j;
        if (n0 + n < N) {
          unsigned v = pack2(tile[(2 * kp) * 65 + n], tile[(2 * kp + 1) * 65 + n]);
          *(unsigned*)(wdst(wb, type, sub, n0 + n) + k0 + 2 * kp) = v;
        }
      }
    }
  }
  __syncthreads();
}

DI void norm_token(const Params& p, int l, int g, int which, int tok, int lane, const float* gn, const float* mod, u16* H) {
  int mr; const u16* xr = xrow_ptr(p, g, tok, mr);
  const float* shift = mod + (size_t)mr * 6144 + (which == 0 ? 0 : 3) * DM;
  const float* scale = shift + DM;
  float4 v[4]; float ss = 0.f;
#pragma unroll
  for (int j = 0; j < 4; ++j) {
    const uint2 q = *(const uint2*)(xr + j * 256 + lane * 4);
    v[j].x = __uint_as_float(q.x << 16); v[j].y = __uint_as_float(q.x & 0xffff0000u); v[j].z = __uint_as_float(q.y << 16); v[j].w = __uint_as_float(q.y & 0xffff0000u);
    ss += v[j].x * v[j].x + v[j].y * v[j].y + v[j].z * v[j].z + v[j].w * v[j].w;
  }
  ss = wave_sum(ss);
  const float rstd = rsqrtf(ss * (1.f / DM) + EPS);
#pragma unroll
  for (int j = 0; j < 4; ++j) {
    int c = j * 256 + lane * 4;
    float4 gg = *(const float4*)(gn + c), sh = *(const float4*)(shift + c), sc = *(const float4*)(scale + c);
    float o0 = v[j].x * rstd * gg.x * (1.f + sc.x) + sh.x;
    float o1 = v[j].y * rstd * gg.y * (1.f + sc.y) + sh.y;
    float o2 = v[j].z * rstd * gg.z * (1.f + sc.z) + sh.z;
    float o3 = v[j].w * rstd * gg.w * (1.f + sc.w) + sh.w;
    uint2 o; o.x = pack2(o0, o1); o.y = pack2(o2, o3);
    *(uint2*)(H + (size_t)tok * DM + c) = o;
  }
}
__device__ void phase_norm(const Params& p, int l, int g, int which) {
  const int tid = otid(), lane = tid & 63, wid = tid >> 6;
  const float* gn = (which == 0 ? p.g1 : p.g2) + l * DM;
  const float* mod = (const float*)(p.ws + OFF_MOD) + (size_t)l * 33 * 6144;
  u16* H = (u16*)(p.ws + OFF_H);
  for (int tok = blockIdx.x * 8 + wid; tok < NTOK; tok += gridDim.x * 8) {
    if (which == 1 && l == DEPTH - 1 && (tok % TPB) < CTXL) continue;
    norm_token(p, l, g, which, tok, lane, gn, mod, H);
  }
}
__device__ void phase_norm_dyn(const Params& p, int l, int g, int* cnt) {
  const int tid = otid(), lane = tid & 63;
  const float* gn = p.g1 + l * DM;
  const float* mod = (const float*)(p.ws + OFF_MOD) + (size_t)l * 33 * 6144;
  u16* H = (u16*)(p.ws + OFF_H);
  for (;;) {
    int c = 0;
    if (lane == 0) c = atomicAdd(cnt, 1);
    c = __shfl(c, 0);
    if (c >= NTOK / 8) break;
    for (int t = 0; t < 8; ++t) norm_token(p, l, g, 0, c * 8 + t, lane, gn, mod, H);
  }
}

__device__ void phase_tokprep(const Params& p, int l) {
  const int tid = otid(), lane = tid & 63, wid = tid >> 6;
  u16* P = (u16*)(p.ws + OFF_P);
  u16* KQ = (u16*)(p.ws + OFF_KQ);
  u16* Kd = (u16*)(p.ws + OFF_KD);
  const float* rc = (const float*)(p.ws + OFF_ROPE);
  const float* rs = rc + 1024;
  const int c8 = lane & 7;
  for (int tok = blockIdx.x * 8 + wid; tok < NTOK; tok += gridDim.x * 8) {
    const int pp = tok % TPB;
    const bool lat = pp >= CTXL;
    const int pos = pp - CTXL, prow = pos >> 6, pcol = pos & 63;
    u16* row = P + (size_t)tok * PS;
    {
      const bool isk = lane < 32;
      const int cc = (isk ? lane : lane - 32) * 8;
      const int colb = (isk ? B_K : B_Q) + cc;
      const bool hasp = !(pp == 0 || pp == CTXL), hasn = !(pp == CTXL - 1 || pp == TPB - 1);
      float x0[8], x1[8], x2[8];
      uint4 q1 = *(const uint4*)(row + colb); unpack8(q1, x1);
      if (hasp) { uint4 q0 = *(const uint4*)(row - PS + colb); unpack8(q0, x0); } else { for (int e = 0; e < 8; ++e) x0[e] = 0.f; }
      if (hasn) { uint4 q2 = *(const uint4*)(row + PS + colb); unpack8(q2, x2); } else { for (int e = 0; e < 8; ++e) x2[e] = 0.f; }
      const float* cw = p.convw + ((size_t)l * 2 + (isk ? 1 : 0)) * 3 * 256 + cc;
      float o[8];
#pragma unroll
      for (int e = 0; e < 8; ++e) {
        float a = cw[e] * x0[e] + cw[256 + e] * x1[e] + cw[512 + e] * x2[e];
        a = siluf_(a);
        o[e] = isk ? a * 0.125f : a;
      }
      *(uint4*)(KQ + (size_t)tok * 512 + (isk ? 0 : 256) + cc) = pack8f(o);
    }
#pragma unroll
    for (int pass = 0; pass < 2; ++pass) {
      const bool act = pass == 0 || lane < 16;
      const int colb = (pass == 0 ? C_Q : C_K) + lane * 8;
      const float* gg = (pass == 0 ? p.gqn : p.gkn) + l * 64 + c8 * 8;
      float x[8];
      if (act) { uint4 q = *(const uint4*)(row + colb); unpack8(q, x); } else { for (int e = 0; e < 8; ++e) x[e] = 0.f; }
      float ss = 0.f;
#pragma unroll
      for (int e = 0; e < 8; ++e) ss += x[e] * x[e];
      ss += __shfl_xor(ss, 1); ss += __shfl_xor(ss, 2); ss += __shfl_xor(ss, 4);
      const float rstd = rsqrtf(ss * (1.f / 64.f) + EPS);
#pragma unroll
      for (int e = 0; e < 8; ++e) x[e] = x[e] * rstd * gg[e];
      float o[8];
#pragma unroll
      for (int e = 0; e < 8; ++e) {
        float other = __shfl_xor(x[e], 2);
        const int ppos = (c8 & 4) ? pcol : prow;
        const int fi = (c8 & 1) * 8 + e;
        float cs = 1.f, sn = 0.f;
        if (lat) { cs = rc[ppos * 16 + fi]; sn = rs[ppos * 16 + fi]; }
        o[e] = (c8 & 2) ? (x[e] * cs + other * sn) : (x[e] * cs - other * sn);
      }
      if (act) *(uint4*)(row + colb) = pack8f(o);
    }
    {
      const bool isckv = lane < 16, iscq = lane >= 32, iskr = lane >= 16 && lane < 24;
      int colb = isckv ? D_CKV + lane * 8 : (iscq ? D_CQ + (lane - 32) * 8 : D_KR + ((lane - 16) & 7) * 8);
      float x[8];
      { uint4 q = *(const uint4*)(row + colb); unpack8(q, x); }
      float ss = 0.f;
#pragma unroll
      for (int e = 0; e < 8; ++e) ss += x[e] * x[e];
      ss += __shfl_xor(ss, 1); ss += __shfl_xor(ss, 2); ss += __shfl_xor(ss, 4); ss += __shfl_xor(ss, 8);
      float ss32 = ss + __shfl_xor(ss, 16);
      float o[8];
      if (isckv) {
        const float rstd = rsqrtf(ss * (1.f / 128.f) + EPS);
        const float* gg = p.mkvn + l * 128 + lane * 8;
        for (int e = 0; e < 8; ++e) o[e] = x[e] * rstd * gg[e];
      } else if (iscq) {
        const float rstd = rsqrtf(ss32 * (1.f / 256.f) + EPS);
        const float* gg = p.mqn + l * 256 + (lane - 32) * 8;
        for (int e = 0; e < 8; ++e) o[e] = x[e] * rstd * gg[e];
      } else {
        for (int e = 0; e < 8; ++e) o[e] = x[e];
      }
      float orot[8];
#pragma unroll
      for (int e = 0; e < 8; ++e) {
        float other = __shfl_xor(x[e], 2);
        const int ck = lane & 7;
        const int ppos = (ck & 4) ? pcol : prow;
        const int fi = (ck & 1) * 8 + e;
        float cs = 1.f, sn = 0.f;
        if (lat) { cs = rc[ppos * 16 + fi]; sn = rs[ppos * 16 + fi]; }
        orot[e] = (ck & 2) ? (x[e] * cs + other * sn) : (x[e] * cs - other * sn);
      }
      if (isckv || iscq) *(uint4*)(row + colb) = pack8f(o);
      if (iskr) {
        uint4 q = pack8f(orot);
        const int ck = lane & 7;
#pragma unroll
        for (int hd = 0; hd < 4; ++hd) *(uint4*)(Kd + (size_t)tok * 768 + hd * 192 + 128 + ck * 8) = q;
      }
    }
  }
}

template <int DK, int DV, bool ROPEQ>
__device__ void attn_item(const u16* __restrict__ qrow, const u16* __restrict__ Kp, int kst, const u16* __restrict__ Vp, int vst,
                          u16* __restrict__ orow, int nkeys, float sc, int pos, const float* __restrict__ rc, char* lds) {
  constexpr int KLD = DK + 8, VLD = DV + 32;
  constexpr int KB = 64 * KLD, VB = 64 * VLD;
  u16* KS = (u16*)lds;
  u16* VS = KS + 2 * KB;
  const int tid = otid(), lane = tid & 63, r = lane & 31, h = lane >> 5;
  bf16x8 qf[DK / 16];
  {
#pragma unroll
    for (int s = 0; s < DK / 16; ++s) qf[s] = *(const bf16x8*)(qrow + h * 8 + s * 16);
    if (ROPEQ && pos >= 0) {
      const int prow = pos >> 6, pcol = pos & 63;
      const float* rs = rc + 1024;
      constexpr int s0 = (DK - 64) / 16;
#pragma unroll
      for (int part = 0; part < 2; ++part) {
        const int ppos = part ? pcol : prow;
#pragma unroll
        for (int j = 0; j < 8; ++j) {
          const int fi = 8 * h + j;
          float cs = rc[ppos * 16 + fi], sn = rs[ppos * 16 + fi];
          float x1 = bf2f((u16)qf[s0 + 2 * part][j]), x2 = bf2f((u16)qf[s0 + 2 * part + 1][j]);
          qf[s0 + 2 * part][j] = (short)f2bf(x1 * cs - x2 * sn);
          qf[s0 + 2 * part + 1][j] = (short)f2bf(x2 * cs + x1 * sn);
        }
      }
    }
  }
  f32x16 oT[DV / 32];
#pragma unroll
  for (int d = 0; d < DV / 32; ++d)
#pragma unroll
    for (int e = 0; e < 16; ++e) oT[d][e] = 0.f;
  float m = -1e30f, lsum = 0.f;
  const int ntile = nkeys >> 6;
  constexpr int NKP = KB * 2 / 1024, NVP = VB * 2 / 1024, NKJ = (NKP + 7) / 8, NVJ = (NVP + 7) / 8;
  const int wu = __builtin_amdgcn_readfirstlane(tid >> 6);
  unsigned ksrc[NKJ], vsrc[NVJ];
#pragma unroll
  for (int j = 0; j < NKJ; ++j) { const int o = (wu + 8 * j) * 1024 + lane * 16, row = o / (KLD * 2), col = (o % (KLD * 2)) / 2; ksrc[j] = (unsigned)(row * kst + (col < DK ? col : 0)) * 2u; }
#pragma unroll
  for (int j = 0; j < NVJ; ++j) { const int o = (wu + 8 * j) * 1024 + lane * 16, row = o / (VLD * 2), col = (o % (VLD * 2)) / 2; vsrc[j] = (unsigned)(row * vst + (col < DV ? col : 0)) * 2u; }
#define ATT_DMA(kt_, buf_) do { \
    const char* kg_ = (const char*)Kp + (size_t)(kt_) * 64 * kst * 2; const char* vg_ = (const char*)Vp + (size_t)(kt_) * 64 * vst * 2; \
    _Pragma("unroll") for (int j = 0; j < NKJ; ++j) if (wu + 8 * j < NKP) \
      __builtin_amdgcn_global_load_lds((const unsigned*)(kg_ + ksrc[j]), (LAS unsigned*)((char*)KS + (buf_) * KB * 2 + (wu + 8 * j) * 1024), 16, 0, 0); \
    _Pragma("unroll") for (int j = 0; j < NVJ; ++j) if (wu + 8 * j < NVP) \
      __builtin_amdgcn_global_load_lds((const unsigned*)(vg_ + vsrc[j]), (LAS unsigned*)((char*)VS + (buf_) * VB * 2 + (wu + 8 * j) * 1024), 16, 0, 0); \
  } while (0)
  __syncthreads();
  ATT_DMA(0, 0);
  asm volatile("s_waitcnt vmcnt(0)" ::: "memory");
  __syncthreads();
  const int troff = ((lane & 15) >> 2) * VLD + 16 * ((lane >> 4) & 1) + 4 * (lane & 3) + 4 * h * VLD;
#pragma unroll 1
  for (int kt = 0; kt < ntile; ++kt) {
    const int buf = kt & 1;
    if (kt + 1 < ntile) ATT_DMA(kt + 1, buf ^ 1);
    const u16* KSb = KS + buf * KB;
    const u16* VSb = VS + buf * VB;
    f32x16 sT[2];
#pragma unroll
    for (int kk = 0; kk < 2; ++kk) {
#pragma unroll
      for (int e = 0; e < 16; ++e) sT[kk][e] = 0.f;
#pragma unroll
      for (int s = 0; s < DK / 16; ++s) {
        bf16x8 a = *(const bf16x8*)(KSb + (kk * 32 + r) * KLD + s * 16 + h * 8);
        sT[kk] = MFMA(a, qf[s], sT[kk]);
      }
    }
    float mx = -1e30f;
#pragma unroll
    for (int kk = 0; kk < 2; ++kk)
#pragma unroll
      for (int e = 0; e < 16; ++e) mx = fmaxf(mx, sT[kk][e]);
    mx = fmaxf(mx, __shfl_xor(mx, 32));
    const float mn = fmaxf(m, mx * sc);
    const float alpha = ex2(m - mn);
    m = mn;
    lsum *= alpha;
#pragma unroll
    for (int kk = 0; kk < 2; ++kk)
#pragma unroll
      for (int e = 0; e < 16; ++e) { float pv = ex2(sT[kk][e] * sc - mn); sT[kk][e] = pv; lsum += pv; }
#pragma unroll
    for (int d = 0; d < DV / 32; ++d)
#pragma unroll
      for (int e = 0; e < 16; ++e) oT[d][e] *= alpha;
#pragma unroll
    for (int kk = 0; kk < 2; ++kk)
#pragma unroll
      for (int s2 = 0; s2 < 2; ++s2) {
        bf16x8 pb = pack8(sT[kk], s2);
#pragma unroll
        for (int d = 0; d < DV / 32; ++d) {
          const u16* vb = VSb + (kk * 32 + s2 * 16) * VLD + d * 32 + troff;
          s16x4 lo = __builtin_amdgcn_ds_read_tr16_b64_v4i16((LAS s16x4*)vb);
          s16x4 hi = __builtin_amdgcn_ds_read_tr16_b64_v4i16((LAS s16x4*)(vb + 8 * VLD));
          oT[d] = MFMA(cat4(lo, hi), pb, oT[d]);
        }
      }
    asm volatile("s_waitcnt vmcnt(0)" ::: "memory");
    __syncthreads();
  }
#undef ATT_DMA
  lsum += __shfl_xor(lsum, 32);
  const float inv = 1.f / lsum;
#pragma unroll
  for (int d = 0; d < DV / 32; ++d)
#pragma unroll
    for (int gq = 0; gq < 4; ++gq) {
      uint2 o;
      o.x = pack2(oT[d][4 * gq] * inv, oT[d][4 * gq + 1] * inv);
      o.y = pack2(oT[d][4 * gq + 2] * inv, oT[d][4 * gq + 3] * inv);
      *(uint2*)(orow + d * 32 + 8 * gq + 4 * h) = o;
    }
}

__device__ void scanA_unit(const Params& p, int l, int unit, char* lds) {
  const int tid = otid(), lane = tid & 63, wid = tid >> 6, r = lane & 31, h = lane >> 5;
  const int bl = unit >> 3, hd = (unit >> 1) & 3, dir = unit & 1;
  const u16* P = (const u16*)(p.ws + OFF_P);
  u16* Oa = (u16*)(p.ws + OFF_OA) + (size_t)dir * NTOK * 512;
  float* BC = (float*)lds;
  u16* Qs = (u16*)(lds + 33792);
  u16* KKs = (u16*)(lds + 51200);
  u16* AM = (u16*)(lds + 51200);
  u16* KT = (u16*)(lds + 68608);
  u16* VT = (u16*)(lds + 87040);
  u16* ST = (u16*)(lds + 105472);
  float* EL = (float*)(lds + 140288);
  float* QTOT = (float*)(lds + 140800);
  const int ch = tid & 15;
  float lbv[8];
  {
    const float* lb = (const float*)(p.ws + OFF_LB) + (size_t)l * 1024 + dir * 512 + hd * 128 + ch * 8;
#pragma unroll
    for (int e = 0; e < 8; ++e) lbv[e] = lb[e];
  }
  const int vt = wid & 3, th = wid >> 2;
  f32x16 S[2];
#pragma unroll
  for (int j = 0; j < 2; ++j)
#pragma unroll
    for (int e = 0; e < 16; ++e) S[j][e] = 0.f;
  __syncthreads();
  for (int i = tid; i < 128 * 136 / 2; i += NTHR) ((unsigned*)ST)[i] = 0u;
  uint4 pqr[2], pfr[2], pvr[2];
#define SCANA_TOK0(st_) (bl * TPB + ((st_) >= 4 ? CTXL : 0) + (dir ? ((st_) >= 4 ? 31 - ((st_) - 4) : 3 - (st_)) : ((st_) >= 4 ? (st_) - 4 : (st_))) * 64)
#define SCANA_PREFETCH(st_) do { const int t0_ = SCANA_TOK0(st_); \
    _Pragma("unroll") for (int j = 0; j < 2; ++j) { const int i = (tid >> 4) + 32 * j; \
      const u16* row = P + (size_t)(t0_ + (dir ? 63 - i : i)) * PS + hd * 128 + ch * 8; \
      pqr[j] = *(const uint4*)(row + A_Q); pfr[j] = *(const uint4*)(row + (dir ? A_FB : A_FF)); pvr[j] = *(const uint4*)(row + A_I); } } while (0)
  SCANA_PREFETCH(0);
#pragma unroll 1
  for (int step = 0; step < 36; ++step) {
    const int tok0 = SCANA_TOK0(step);
    __syncthreads();
#pragma unroll
    for (int j = 0; j < 2; ++j) {
      const int i = (tid >> 4) + 32 * j;
      uint4 qraw = pqr[j];
      uint4 fraw = pfr[j];
      uint4 vq = pvr[j];
      float qv[8], fv[8], kkv[8];
      unpack8(qraw, qv); unpack8(fraw, fv);
#pragma unroll
      for (int e = 0; e < 8; ++e) {
        qv[e] = siluf_(qv[e]);
        const float ex = __expf(-fv[e]);
        const float sg = 1.f / (1.f + ex);
        const float sgn = ex / (1.f + ex);
        const float f = lbv[e] + (1.f - lbv[e]) * sg;
        kkv[e] = (1.f - lbv[e]) * (fv[e] > 30.f ? 0.f : (fv[e] < -30.f ? 1.f : sgn));
        BC[i * 132 + ch * 8 + e] = __log2f(fmaxf(f, 1e-37f));
      }
      *(uint4*)(Qs + i * 136 + ch * 8) = pack8f(qv);
      *(uint4*)(KKs + i * 136 + ch * 8) = pack8f(kkv);
      u16* dv = VT + (ch * 8) * 72 + i;
      dv[0 * 72] = (u16)(vq.x & 0xffff); dv[1 * 72] = (u16)(vq.x >> 16); dv[2 * 72] = (u16)(vq.y & 0xffff); dv[3 * 72] = (u16)(vq.y >> 16);
      dv[4 * 72] = (u16)(vq.z & 0xffff); dv[5 * 72] = (u16)(vq.z >> 16); dv[6 * 72] = (u16)(vq.w & 0xffff); dv[7 * 72] = (u16)(vq.w >> 16);
    }
    __syncthreads();
    {
      const int k = tid & 127, qd = tid >> 7;
      float run = 0.f;
      for (int i = qd * 16; i < qd * 16 + 16; ++i) { run += BC[i * 132 + k]; BC[i * 132 + k] = run; }
      QTOT[qd * 128 + k] = run;
    }
    __syncthreads();
    {
      const int k = tid & 127, qd = tid >> 7;
      float off = 0.f;
      for (int q2 = 0; q2 < qd; ++q2) off += QTOT[q2 * 128 + k];
      if (qd > 0) for (int i = qd * 16; i < qd * 16 + 16; ++i) BC[i * 132 + k] += off;
    }
    __syncthreads();
    f32x4 cod[2];
#pragma unroll
    for (int jj = 0; jj < 2; ++jj) {
      cod[jj] = (f32x4){0.f, 0.f, 0.f, 0.f};
      const int job = wid + 8 * jj;
      if (job < 10) {
        const int bI = job < 1 ? 0 : (job < 3 ? 1 : (job < 6 ? 2 : 3));
        const int bJ = job - (bI * (bI + 1)) / 2;
        const int l16 = lane & 15, kg = lane >> 4;
        const int t = 16 * bI + l16, s = 16 * bJ + l16, rr = 16 * bI;
#pragma unroll
        for (int ks = 0; ks < 4; ++ks) {
          const int k0 = ks * 32 + kg * 8;
          float qv[8], kv[8];
          unpack8(*(const uint4*)(Qs + t * 136 + k0), qv);
          unpack8(*(const uint4*)(KKs + s * 136 + k0), kv);
#pragma unroll
          for (int e = 0; e < 8; ++e) {
            const float br = BC[rr * 132 + k0 + e];
            qv[e] *= ex2(BC[t * 132 + k0 + e] - br);
            kv[e] *= ex2(fminf(br - BC[s * 132 + k0 + e], 120.f));
          }
          union { uint4 u; bf16x8 v; } ua, ub;
          ua.u = pack8f(qv); ub.u = pack8f(kv);
          cod[jj] = __builtin_amdgcn_mfma_f32_16x16x32_bf16(ua.v, ub.v, cod[jj], 0, 0, 0);
        }
      }
    }
    if (tid < 128) EL[tid] = ex2(BC[63 * 132 + tid]);
#pragma unroll
    for (int j = 0; j < 2; ++j) {
      const int i = (tid >> 4) + 32 * j;
      float kv[8];
      unpack8(*(const uint4*)(KKs + i * 136 + ch * 8), kv);
      u16* dk = KT + (ch * 8) * 72 + i;
#pragma unroll
      for (int e = 0; e < 8; ++e) {
        const float b = BC[i * 132 + ch * 8 + e], bl_ = BC[63 * 132 + ch * 8 + e];
        dk[e * 72] = f2bf(kv[e] * ex2(bl_ - b));
      }
    }
    __syncthreads();
#pragma unroll
    for (int j = 0; j < 2; ++j) {
      const int i = (tid >> 4) + 32 * j;
      float qv[8];
      unpack8(*(const uint4*)(Qs + i * 136 + ch * 8), qv);
#pragma unroll
      for (int e = 0; e < 8; ++e) qv[e] *= ex2(BC[i * 132 + ch * 8 + e]);
      *(uint4*)(Qs + i * 136 + ch * 8) = pack8f(qv);
    }
    for (int i = tid; i < 64 * 72 / 2; i += NTHR) ((unsigned*)AM)[i] = 0u;
    __syncthreads();
#pragma unroll
    for (int jj = 0; jj < 2; ++jj) {
      const int job = wid + 8 * jj;
      if (job < 10) {
        const int bI = job < 1 ? 0 : (job < 3 ? 1 : (job < 6 ? 2 : 3));
        const int bJ = job - (bI * (bI + 1)) / 2;
        const int l16 = lane & 15, kg = lane >> 4;
#pragma unroll
        for (int e = 0; e < 4; ++e) {
          const int tp = 4 * kg + e;
          const float v = (bJ < bI || l16 <= tp) ? cod[jj][e] : 0.f;
          AM[(16 * bI + tp) * 72 + 16 * bJ + l16] = f2bf(v);
        }
      }
    }
    __syncthreads();
    if (step + 1 < 36) SCANA_PREFETCH(step + 1);
    f32x16 o;
#pragma unroll
    for (int e = 0; e < 16; ++e) o[e] = 0.f;
#pragma unroll
    for (int ks = 0; ks < 8; ++ks) {
      bf16x8 a = *(const bf16x8*)(Qs + (th * 32 + r) * 136 + ks * 16 + h * 8);
      bf16x8 b = *(const bf16x8*)(ST + (vt * 32 + r) * 136 + ks * 16 + h * 8);
      o = MFMA(a, b, o);
    }
    bf16x8 bv[4];
#pragma unroll
    for (int ks = 0; ks < 4; ++ks) bv[ks] = *(const bf16x8*)(VT + (vt * 32 + r) * 72 + ks * 16 + h * 8);
#pragma unroll
    for (int ks = 0; ks < 4; ++ks) {
      bf16x8 a = *(const bf16x8*)(AM + (th * 32 + r) * 72 + ks * 16 + h * 8);
      o = MFMA(a, bv[ks], o);
    }
    {
      u16* ob = Oa + (size_t)tok0 * 512 + hd * 128 + vt * 32 + r;
#pragma unroll
      for (int e = 0; e < 16; ++e) {
        const int i = th * 32 + crow(e, h);
        ob[(dir ? 63 - i : i) * 512] = f2bf(o[e]);
      }
    }
    __syncthreads();
#pragma unroll
    for (int j = 0; j < 2; ++j) {
      const int kt = 2 * th + j;
#pragma unroll
      for (int e = 0; e < 16; ++e) S[j][e] *= EL[kt * 32 + crow(e, h)];
#pragma unroll
      for (int ks = 0; ks < 4; ++ks) {
        bf16x8 a = *(const bf16x8*)(KT + (kt * 32 + r) * 72 + ks * 16 + h * 8);
        S[j] = MFMA(a, bv[ks], S[j]);
      }
#pragma unroll
      for (int gq = 0; gq < 4; ++gq) {
        uint2 w;
        w.x = pack2(S[j][4 * gq], S[j][4 * gq + 1]); w.y = pack2(S[j][4 * gq + 2], S[j][4 * gq + 3]);
        *(uint2*)(ST + (vt * 32 + r) * 136 + kt * 32 + 8 * gq + 4 * h) = w;
      }
    }
  }
#undef SCANA_PREFETCH
#undef SCANA_TOK0
}

__device__ void scanB_unit(const Params& p, int l, int unit2, char* lds) {
  const int tid0 = otid(), vb = tid0 >> 8, tid = tid0 & 255, lane = tid & 63, wid = tid >> 6, r = lane & 31, h = lane >> 5;
  const int unit = unit2 * 2 + vb;
  lds += vb * LDSV;
  const int bl = unit >> 3, hd = (unit >> 1) & 3, dir = unit & 1;
  const u16* P = (const u16*)(p.ws + OFF_P);
  const u16* KQ = (const u16*)(p.ws + OFF_KQ);
  const float* Gb = (const float*)(p.ws + OFF_GB);
  u16* Ob = (u16*)(p.ws + OFF_OB) + (size_t)dir * NTOK * 512;
  u16* QB = (u16*)lds;
  u16* KB = (u16*)(lds + 9216);
  u16* SM = (u16*)(lds + 18432);
  u16* KWT = (u16*)(lds + 27648);
  u16* VT = (u16*)(lds + 36864);
  float* vec = (float*)(lds + 55296);
  float *IG = vec, *LF = vec + 64, *BV = vec + 128, *UV = vec + 192, *MT = vec + 256, *WI = vec + 320, *WK = vec + 384,
        *DEN = vec + 448, *NV = vec + 512  , *SC = vec + 640, *BL2 = vec + 704, *UL2 = vec + 768, *EMT = vec + 832;
  const float bI = p.bgate[l * 16 + (2 * dir) * 4 + hd], bF = p.bgate[l * 16 + (2 * dir + 1) * 4 + hd];
  f32x16 C[2];
#pragma unroll
  for (int ft = 0; ft < 2; ++ft)
#pragma unroll
    for (int e = 0; e < 16; ++e) C[ft][e] = 0.f;
  float m = -1e30f;
  __syncthreads();
  if (tid < 128) NV[tid] = 0.f;
  int cur = 0;
  uint4 pk0, pk1, pq0, pq1, pv0, pv1, pv2, pv3; float pgI = 0.f, pgF = 0.f;
#define SCANB_TOK0(st_) (bl * TPB + ((st_) >= 4 ? CTXL : 0) + (dir ? ((st_) >= 4 ? 31 - ((st_) - 4) : 3 - (st_)) : ((st_) >= 4 ? (st_) - 4 : (st_))) * 64)
#define SCANB_LDKQ(j, K_, Q_) do { const int id = tid + 256 * (j), i = id >> 3, c8 = id & 7; \
      const u16* row = KQ + (size_t)(t0_ + (dir ? 63 - i : i)) * 512 + hd * 64 + c8 * 8; K_ = *(const uint4*)(row); Q_ = *(const uint4*)(row + 256); } while (0)
#define SCANB_LDV(j, V_) do { const int id = tid + 256 * (j), i = id >> 4, c16 = id & 15; \
      V_ = *(const uint4*)(P + (size_t)(t0_ + (dir ? 63 - i : i)) * PS + B_V + hd * 128 + c16 * 8); } while (0)
#define SCANB_PREFETCH(st_) do { const int t0_ = SCANB_TOK0(st_); \
    SCANB_LDKQ(0, pk0, pq0); SCANB_LDKQ(1, pk1, pq1); SCANB_LDV(0, pv0); SCANB_LDV(1, pv1); SCANB_LDV(2, pv2); SCANB_LDV(3, pv3); \
    if (tid < 64) { const int tok = t0_ + (dir ? 63 - tid : tid); pgI = Gb[(size_t)tok * 16 + (2 * dir) * 4 + hd]; pgF = Gb[(size_t)tok * 16 + (2 * dir + 1) * 4 + hd]; } } while (0)
#define SCANB_STKQ(j, K_, Q_) do { const int id = tid + 256 * (j), i = id >> 3, c8 = id & 7; \
      *(uint4*)(KB + i * 72 + c8 * 8) = K_; *(uint4*)(QB + i * 72 + c8 * 8) = Q_; } while (0)
#define SCANB_STV(j, V_) do { const int id = tid + 256 * (j), i = id >> 4, c16 = id & 15; const uint4 vq = V_; u16* dv = VT + (c16 * 8) * 72 + i; \
      dv[0 * 72] = (u16)(vq.x & 0xffff); dv[1 * 72] = (u16)(vq.x >> 16); dv[2 * 72] = (u16)(vq.y & 0xffff); dv[3 * 72] = (u16)(vq.y >> 16); \
      dv[4 * 72] = (u16)(vq.z & 0xffff); dv[5 * 72] = (u16)(vq.z >> 16); dv[6 * 72] = (u16)(vq.w & 0xffff); dv[7 * 72] = (u16)(vq.w >> 16); } while (0)
  SCANB_PREFETCH(0);
#pragma unroll 1
  for (int step = 0; step < 36; ++step) {
    const int tok0 = SCANB_TOK0(step);
    __syncthreads();
    SCANB_STKQ(0, pk0, pq0); SCANB_STKQ(1, pk1, pq1);
    SCANB_STV(0, pv0); SCANB_STV(1, pv1); SCANB_STV(2, pv2); SCANB_STV(3, pv3);
    if (tid < 64) {
      const int i = tid;
      const float gI = pgI + bI;
      const float gF = pgF + bF;
      const float lf = fminf(gF, 0.f) - log1pf(expf(-fabsf(gF)));
      float b = lf;
#pragma unroll
      for (int d = 1; d < 64; d <<= 1) { float t = __shfl_up(b, d); if (lane >= d) b += t; }
      const float u = gI - b;
      float pm = u;
#pragma unroll
      for (int d = 1; d < 64; d <<= 1) { float t = __shfl_up(pm, d); if (lane >= d) pm = fmaxf(pm, t); }
      const float mt = b + fmaxf(m, pm);
      const float wi = expf(b + m - mt);
      const float mnew = __shfl(mt, 63), b63 = __shfl(b, 63);
      const float dec = expf(b63 + m - mnew);
      const float wk = expf(b63 - b + gI - mnew);
      IG[i] = gI; LF[i] = lf; BV[i] = b; UV[i] = u; MT[i] = mt; WI[i] = wi; WK[i] = wk;
      BL2[i] = (b - mt) * LOG2E; UL2[i] = u * LOG2E; EMT[i] = expf(-mt);
      if (i == 0) { SC[0] = mnew; SC[1] = dec; }
    }
    __syncthreads();
    {
      const int tt = wid >> 1, st = wid & 1;
      f32x16 a16;
#pragma unroll
      for (int e = 0; e < 16; ++e) a16[e] = 0.f;
#pragma unroll
      for (int ks = 0; ks < 4; ++ks) {
        bf16x8 a = *(const bf16x8*)(QB + (tt * 32 + r) * 72 + ks * 16 + h * 8);
        bf16x8 b = *(const bf16x8*)(KB + (st * 32 + r) * 72 + ks * 16 + h * 8);
        a16 = MFMA(a, b, a16);
      }
      const int s = st * 32 + r;
      const float us = UL2[s];
#pragma unroll
      for (int e = 0; e < 16; ++e) {
        const int t = tt * 32 + crow(e, h);
        float v = 0.f;
        if (s <= t) v = a16[e] * ex2(BL2[t] + us);
        SM[t * 72 + s] = f2bf(v);
      }
    }
#pragma unroll
    for (int j = 0; j < 2; ++j) {
      const int id = tid + 256 * j, i = id >> 3, c8 = id & 7;
      float kv[8];
      unpack8(*(const uint4*)(KB + i * 72 + c8 * 8), kv);
      const float wk = WK[i];
#pragma unroll
      for (int e = 0; e < 8; ++e) KWT[(c8 * 8 + e) * 72 + i] = f2bf(kv[e] * wk);
    }
    __syncthreads();
    const float mnew = SC[0], dec = SC[1];
    if (tid < 64) {
      const int t = tid;
      float rsum = 0.f, qn = 0.f;
#pragma unroll
      for (int c8 = 0; c8 < 8; ++c8) {
        float sv[8], qv[8];
        unpack8(*(const uint4*)(SM + t * 72 + c8 * 8), sv);
        unpack8(*(const uint4*)(QB + t * 72 + c8 * 8), qv);
#pragma unroll
        for (int e = 0; e < 8; ++e) { rsum += sv[e]; qn += qv[e] * NV[cur * 64 + c8 * 8 + e]; }
      }
      DEN[t] = 1.f / fmaxf(fabsf(WI[t] * qn + rsum), EMT[t]);
    } else if (tid < 128) {
      const int f = tid - 64;
      float ns = 0.f;
#pragma unroll
      for (int c8 = 0; c8 < 8; ++c8) {
        float kv[8];
        unpack8(*(const uint4*)(KWT + f * 72 + c8 * 8), kv);
#pragma unroll
        for (int e = 0; e < 8; ++e) ns += kv[e];
      }
      NV[(cur ^ 1) * 64 + f] = dec * NV[cur * 64 + f] + ns;
    }
    __syncthreads();
    if (step + 1 < 36) SCANB_PREFETCH(step + 1);
    f32x16 num[2];
#pragma unroll
    for (int tt = 0; tt < 2; ++tt)
#pragma unroll
      for (int e = 0; e < 16; ++e) num[tt][e] = 0.f;
#pragma unroll
    for (int ft = 0; ft < 2; ++ft)
#pragma unroll
      for (int s = 0; s < 2; ++s) {
        bf16x8 pb = pack8(C[ft], s);
#pragma unroll
        for (int tt = 0; tt < 2; ++tt) {
          const u16* qb = QB + (tt * 32 + r) * 72 + ft * 32 + s * 16 + 4 * h;
          bf16x8 a = cat4(*(const s16x4*)qb, *(const s16x4*)(qb + 8));
          num[tt] = MFMA(a, pb, num[tt]);
        }
      }
#pragma unroll
    for (int tt = 0; tt < 2; ++tt)
#pragma unroll
      for (int e = 0; e < 16; ++e) num[tt][e] *= WI[tt * 32 + crow(e, h)];
    bf16x8 bv[4];
#pragma unroll
    for (int ks = 0; ks < 4; ++ks) bv[ks] = *(const bf16x8*)(VT + (wid * 32 + r) * 72 + ks * 16 + h * 8);
#pragma unroll
    for (int ks = 0; ks < 4; ++ks)
#pragma unroll
      for (int tt = 0; tt < 2; ++tt) {
        bf16x8 a = *(const bf16x8*)(SM + (tt * 32 + r) * 72 + ks * 16 + h * 8);
        num[tt] = MFMA(a, bv[ks], num[tt]);
      }
#pragma unroll
    for (int tt = 0; tt < 2; ++tt)
#pragma unroll
      for (int e = 0; e < 16; ++e) {
        const int i = tt * 32 + crow(e, h);
        const int tok = tok0 + (dir ? 63 - i : i);
        Ob[(size_t)tok * 512 + hd * 128 + wid * 32 + r] = f2bf(num[tt][e] * DEN[i]);
      }
#pragma unroll
    for (int ft = 0; ft < 2; ++ft) {
#pragma unroll
      for (int e = 0; e < 16; ++e) C[ft][e] *= dec;
#pragma unroll
      for (int ks = 0; ks < 4; ++ks) {
        bf16x8 a = *(const bf16x8*)(KWT + (ft * 32 + r) * 72 + ks * 16 + h * 8);
        C[ft] = MFMA(a, bv[ks], C[ft]);
      }
    }
    m = mnew;
    cur ^= 1;
  }
#undef SCANB_PREFETCH
#undef SCANB_LDKQ
#undef SCANB_LDV
#undef SCANB_STKQ
#undef SCANB_STV
#undef SCANB_TOK0
}

__device__ void phase_mixers(const Params& p, int l, int g, char* lds, int cbase = 0, bool scans_only = false, bool a_only = false) {
  int* s_item = (int*)(lds + LDS_BYTES - 16);
  int* cnt = (int*)(p.ws + OFF_CNT) + cbase + (l * NG + g);
  const u16* P = (const u16*)(p.ws + OFF_P);
  const u16* Qd = (const u16*)(p.ws + OFF_QD);
  const u16* Kd = (const u16*)(p.ws + OFF_KD);
  const u16* Vd = (const u16*)(p.ws + OFF_VD);
  u16* Y = (u16*)((char*)p.out);
  const float* rc = (const float*)(p.ws + OFF_ROPE);
  constexpr int NSA = NB * 8, NSB = NB * 4;
  constexpr int ND_L = NB * 4 * 8, NC_L = NB * 2 * 32, ND_C = NB * 4, NC_C = NB * 2 * 4;
  constexpr int I1 = NSA, I2 = I1 + NSB, I3 = I2 + ND_L, I4 = I3 + NC_L, I5 = I4 + ND_C, I6 = I5 + NC_C;
  const float scC = 0.125f * LOG2E, scD = 0.07216878364870322f * LOG2E;
  while (true) {
    __syncthreads();
    if (otid() == 0) *s_item = atomicAdd(cnt, 1);
    __syncthreads();
    const int it = *s_item;
    if (it >= (a_only ? I1 : (scans_only ? I2 : (l == DEPTH - 1 ? I4 : I6)))) break;
    if (it < I1) scanA_unit(p, l, it, lds);
    else if (it < I2) scanB_unit(p, l, it - I1, lds);
    else {
      bool isD, isLat; int q;
      if (it < I3) { isD = true; isLat = true; q = it - I2; }
      else if (it < I4) { isD = false; isLat = true; q = it - I3; }
      else if (it < I5) { isD = true; isLat = false; q = it - I4; }
      else { isD = false; isLat = false; q = it - I5; }
      const int tid = otid(), lane = tid & 63, wid = tid >> 6, r = lane & 31;
      const int nkeys = isLat ? TPB : CTXL;
      if (isD) {
        const int nqt = isLat ? 8 : 1;
        const int qt = q % nqt, hd = (q / nqt) % 4, bl = q / (nqt * 4);
        const int tokk = bl * TPB, ql = qt * 256 + wid * 32 + r;
        const int tokq = tokk + (isLat ? CTXL : 0) + ql;
        attn_item<192, 128, true>(Qd + (size_t)tokq * 768 + hd * 192, Kd + (size_t)tokk * 768 + hd * 192, 768,
                                  Vd + (size_t)tokk * 512 + hd * 128, 512, Y + (size_t)tokq * 2048 + 1536 + hd * 128,
                                  nkeys, scD, isLat ? ql : -1, rc, lds);
      } else {
        const int nqt = isLat ? 32 : 4;
        const int qt = q % nqt, kvh = (q / nqt) % 2, bl = q / (nqt * 2);
        const int hq = kvh * 4 + (wid >> 1);
        const int tokk = bl * TPB, ql = qt * 64 + (wid & 1) * 32 + r;
        const int tokq = tokk + (isLat ? CTXL : 0) + ql;
        attn_item<64, 64, false>(P + (size_t)tokq * PS + C_Q + hq * 64, P + (size_t)tokk * PS + C_K + kvh * 64, PS,
                                 P + (size_t)tokk * PS + C_V + kvh * 64, PS, Y + (size_t)tokq * 2048 + 1024 + hq * 64,
                                 nkeys, scC, -1, rc, lds);
      }
    }
  }
}

__device__ void phase_readout(const Params& p, int l) {
  const int tid = otid(), lane = tid & 63, wid = tid >> 6;
  const u16* P = (const u16*)(p.ws + OFF_P);
  const u16* Oa = (const u16*)(p.ws + OFF_OA);
  const u16* Ob = (const u16*)(p.ws + OFF_OB);
  u16* Y = (u16*)((char*)p.out);
  for (int tok = blockIdx.x * 8 + wid; tok < NTOK; tok += gridDim.x * 8) {
    if (l == DEPTH - 1 && (tok % TPB) < CTXL) continue;
#pragma unroll
    for (int mix = 0; mix < 2; ++mix) {
      const u16* O = mix == 0 ? Oa : Ob;
      const int col = lane * 8;
      float a[8], b[8], gt[8], o[8];
      unpack8(*(const uint4*)(O + (size_t)tok * 512 + col), a);
      unpack8(*(const uint4*)(O + ((size_t)NTOK + tok) * 512 + col), b);
      unpack8(*(const uint4*)(P + (size_t)tok * PS + (mix == 0 ? A_G : B_O) + col), gt);
      float ss = 0.f;
#pragma unroll
      for (int e = 0; e < 8; ++e) { a[e] += b[e]; ss += a[e] * a[e]; }
      ss += __shfl_xor(ss, 1); ss += __shfl_xor(ss, 2); ss += __shfl_xor(ss, 4); ss += __shfl_xor(ss, 8);
      const float rstd = rsqrtf(ss * (1.f / 128.f) + EPS);
      const float* gn = (mix == 0 ? p.hnorm : p.mnorm) + l * 128 + (col & 127);
#pragma unroll
      for (int e = 0; e < 8; ++e) {
        float y = a[e] * rstd * gn[e];
        o[e] = y * (mix == 0 ? siluf_(gt[e]) : sigmoidf_(gt[e]));
      }
      *(uint4*)(Y + (size_t)tok * 2048 + mix * 512 + col) = pack8f(o);
    }
  }
}

struct EpiInproj {
  u16* P; float* Gb;
  DI bool operator()(f32x4 (&acc)[2][2][4][2], const pg8::UDesc& u, int wr, int wc, int fr, int fq) const {
    const int row0 = u.pm * 256 + wr * 64 + fr, col0 = u.pn * 256 + wc * 32 + 8 * fq;
    const bool gate = (u.pn == 9) && (wc == 0) && (fq < 2);
#pragma unroll
    for (int ai = 0; ai < 2; ++ai)
#pragma unroll
      for (int m = 0; m < 4; ++m) {
        const size_t row = (size_t)(row0 + ai * 128 + m * 16);
#pragma unroll
        for (int bj = 0; bj < 2; ++bj) *(uint4*)(P + row * PS + col0 + bj * 128) = pk8(acc[ai][bj][m][0], acc[ai][bj][m][1]);
        if (gate) { *(f32x4*)(Gb + row * 16 + 8 * fq) = acc[ai][0][m][0]; *(f32x4*)(Gb + row * 16 + 8 * fq + 4) = acc[ai][0][m][1]; }
      }
    return false;
  }
};
__device__ void phase_inproj(const Params& p, int l, char* lds) {
  pg8::PlainSched S{p.ws + OFF_H, wsel(p, l) + OFF_WINT, 2048u, 2048u, 16, NTOK / 256, PS / 256, (int)gridDim.x, (int)blockIdx.x};
  EpiInproj E{(u16*)(p.ws + OFF_P), (float*)(p.ws + OFF_GB)};
  pg8::gemm_stream(( LAS unsigned char*)lds, S, E);
}

struct MlaSched {
  const char* P; const char* Wq; const char* Wk; const char* Wv; int G, c;
  DI bool next(int i, pg8::UDesc& u) const {
    const long L = (long)i * G + c; if (L >= (NTOK / 256) * 7) return false;
    const int pm = (int)(L / 7), j = (int)(L % 7);
    u.pm = pm; u.lda2 = PS * 2;
    if (j < 3) { u.tag = 0; u.pn = j; u.A = P + (size_t)pm * 256 * PS * 2 + D_CQ * 2; u.B = Wq + (size_t)j * 256 * 512; u.ldb2 = 512; u.nt = 4; }
    else if (j < 5) { u.tag = 1; u.pn = j - 3; u.A = P + (size_t)pm * 256 * PS * 2 + D_CKV * 2; u.B = Wk + (size_t)(j - 3) * 256 * 256; u.ldb2 = 256; u.nt = 2; }
    else { u.tag = 2; u.pn = j - 5; u.A = P + (size_t)pm * 256 * PS * 2 + D_CKV * 2; u.B = Wv + (size_t)(j - 5) * 256 * 256; u.ldb2 = 256; u.nt = 2; }
    return true;
  }
};
struct EpiMla {
  u16 *Qd, *Kd, *Vd;
  DI bool operator()(f32x4 (&acc)[2][2][4][2], const pg8::UDesc& u, int wr, int wc, int fr, int fq) const {
    const int row0 = u.pm * 256 + wr * 64 + fr, col0 = u.pn * 256 + wc * 32 + 8 * fq;
#pragma unroll
    for (int ai = 0; ai < 2; ++ai)
#pragma unroll
      for (int m = 0; m < 4; ++m) {
        const size_t row = (size_t)(row0 + ai * 128 + m * 16);
#pragma unroll
        for (int bj = 0; bj < 2; ++bj) {
          const int col = col0 + bj * 128;
          u16* dst = u.tag == 0 ? Qd + row * 768 + col : (u.tag == 1 ? Kd + row * 768 + (col >> 7) * 192 + (col & 127) : Vd + row * 512 + col);
          *(uint4*)dst = pk8(acc[ai][bj][m][0], acc[ai][bj][m][1]);
        }
      }
    return false;
  }
};
__device__ void phase_mlaup(const Params& p, int l, char* lds) {
  MlaSched S{p.ws + OFF_P, wsel(p, l) + OFF_WUQ, wsel(p, l) + OFF_WUK, wsel(p, l) + OFF_WUV, (int)gridDim.x, (int)blockIdx.x};
  EpiMla E{(u16*)(p.ws + OFF_QD), (u16*)(p.ws + OFF_KD), (u16*)(p.ws + OFF_VD)};
  pg8::gemm_stream((LAS unsigned char*)lds, S, E);
}

struct EpiGate {
  u16* Gt;
  DI bool operator()(f32x4 (&acc)[2][2][4][2], const pg8::UDesc& u, int wr, int wc, int fr, int fq) const {
    const int row0 = u.pm * 256 + wr * 64 + fr, col0 = u.pn * 256 + wc * 32 + 8 * fq;
#pragma unroll
    for (int ai = 0; ai < 2; ++ai)
#pragma unroll
      for (int m = 0; m < 4; ++m) {
        const size_t row = (size_t)(row0 + ai * 128 + m * 16);
#pragma unroll
        for (int bj = 0; bj < 2; ++bj) {
          f32x4 a = acc[ai][bj][m][0], b = acc[ai][bj][m][1];
#pragma unroll
          for (int e = 0; e < 4; ++e) { a[e] = fmaxf(sigmoidf_(a[e]), 1e-30f); b[e] = fmaxf(sigmoidf_(b[e]), 1e-30f); }
          *(uint4*)(Gt + row * 4096 + col0 + bj * 128) = pk8(a, b);
        }
      }
    return false;
  }
};
__device__ void phase_gate(const Params& p, int l, char* lds, int lat_only) {
  pg8::PlainSched S{p.ws + OFF_H, wsel(p, l) + OFF_WGT, 2048u, 2048u, 16, NTOK / 256, 16, (int)gridDim.x, (int)blockIdx.x, lat_only};
  EpiGate E{(u16*)(p.ws + OFF_P)};
  pg8::gemm_stream((LAS unsigned char*)lds, S, E);
}

struct BranchSched {
  const char* Y; const char* Wb; int G, c, lat_only;
  DI bool next(int i, pg8::UDesc& u) const {
    int pm, pn; if (!pg8::tile_order((long)(i >> 2) * G + c, lat_only ? NTOK / 256 - NB : NTOK / 256, 4, pm, pn)) return false;
    if (lat_only) pm = pm + (pm >> 3) + 1;
    const int r = i & 3;
    u.pm = pm; u.pn = pn; u.tag = r; u.lda2 = 4096; u.ldb2 = 1024; u.nt = 8;
    u.A = Y + (size_t)pm * 256 * 4096 + r * 1024; u.B = Wb + ((size_t)r * 1024 + pn * 256) * 1024;
    return true;
  }
};
struct EpiBranch {
  const u16* Gt; u16* Mg;
  DI bool operator()(f32x4 (&acc)[2][2][4][2], const pg8::UDesc& u, int wr, int wc, int fr, int fq) const {
    const int row0 = u.pm * 256 + wr * 64 + fr, col0 = u.pn * 256 + wc * 32 + 8 * fq, r = u.tag;
#pragma unroll
    for (int ai = 0; ai < 2; ++ai)
#pragma unroll
      for (int m = 0; m < 4; ++m) {
        const size_t row = (size_t)(row0 + ai * 128 + m * 16);
#pragma unroll
        for (int bj = 0; bj < 2; ++bj) {
          const int col = col0 + bj * 128;
          float gv[8];
          unpack8(*(const uint4*)(Gt + row * 4096 + r * 1024 + col), gv);
          if (r < 3) {
            float gn[8];
            unpack8(*(const uint4*)(Gt + row * 4096 + (r + 1) * 1024 + col), gn);
#pragma unroll
            for (int e = 0; e < 4; ++e) {
              acc[ai][bj][m][0][e] *= gv[e] * __builtin_amdgcn_rcpf(gn[e]);
              acc[ai][bj][m][1][e] *= gv[4 + e] * __builtin_amdgcn_rcpf(gn[4 + e]);
            }
          } else {
            f32x4 a = acc[ai][bj][m][0], b = acc[ai][bj][m][1];
#pragma unroll
            for (int e = 0; e < 4; ++e) { a[e] *= gv[e]; b[e] *= gv[4 + e]; }
            *(uint4*)(Mg + row * 1024 + col) = pk8(a, b);
          }
        }
      }
    return r < 3;
  }
};
__device__ void phase_branch(const Params& p, int l, char* lds, int lat_only) {
  BranchSched S{(const char*)p.out, wsel(p, l) + OFF_WBT, (int)gridDim.x, (int)blockIdx.x, lat_only};
  EpiBranch E{(const u16*)(p.ws + OFF_P), (u16*)(p.ws + OFF_OA)};
  pg8::gemm_stream((LAS unsigned char*)lds, S, E);
}

struct EpiResid {
  const Params* pp; const float* mod; int g, gidx; float* dummy;
  DI bool operator()(f32x4 (&acc)[2][2][4][2], const pg8::UDesc& u, int wr, int wc, int fr, int fq) const {
    int mr; u16* xb = xrow_ptr(*pp, g, u.pm * 256, mr);
    if (dummy) xb = (u16*)dummy + (size_t)u.pm * 256 * DM;
    const float* gate = mod + (size_t)mr * 6144 + gidx * DM;
    const int row0 = wr * 64 + fr, col0 = u.pn * 256 + wc * 32 + 8 * fq;
    f32x4 gv[2][2];
#pragma unroll
    for (int bj = 0; bj < 2; ++bj) { gv[bj][0] = *(const f32x4*)(gate + col0 + bj * 128); gv[bj][1] = *(const f32x4*)(gate + col0 + bj * 128 + 4); }
#pragma unroll
    for (int ai = 0; ai < 2; ++ai)
#pragma unroll
      for (int m = 0; m < 4; ++m) {
        u16* xr = xb + (size_t)(row0 + ai * 128 + m * 16) * DM + col0;
#pragma unroll
        for (int bj = 0; bj < 2; ++bj) {
          float xv[8];
          unpack8(*(const uint4*)(xr + bj * 128), xv);
          f32x4 x0 = {xv[0], xv[1], xv[2], xv[3]}, x1 = {xv[4], xv[5], xv[6], xv[7]};
          x0 += gv[bj][0] * acc[ai][bj][m][0]; x1 += gv[bj][1] * acc[ai][bj][m][1];
          *(uint4*)(xr + bj * 128) = pk8(x0, x1);
        }
      }
    return false;
  }
};
__device__ void phase_resid_gemm(const Params& p, int l, int g, const char* A, const char* W, int K, int gidx, char* lds, float* dummy = nullptr) {
  pg8::PlainSched S{A, W, (unsigned)K * 2u, (unsigned)K * 2u, K / 64, NTOK / 256, 4, (int)gridDim.x, (int)blockIdx.x, (l == DEPTH - 1) ? 1 : 0};
  EpiResid E{&p, (const float*)(p.ws + OFF_MOD) + (size_t)l * 33 * 6144, g, gidx, dummy};
  pg8::gemm_stream((LAS unsigned char*)lds, S, E);
}

struct EpiFF1 {
  u16* Hid;
  DI bool operator()(f32x4 (&acc)[2][2][4][2], const pg8::UDesc& u, int wr, int wc, int fr, int fq) const {
    const int row0 = u.pm * 256 + wr * 64 + fr, col0 = u.pn * 256 + wc * 32 + 8 * fq;
#pragma unroll
    for (int ai = 0; ai < 2; ++ai)
#pragma unroll
      for (int m = 0; m < 4; ++m) {
        const size_t row = (size_t)(row0 + ai * 128 + m * 16);
#pragma unroll
        for (int bj = 0; bj < 2; ++bj) {
          f32x4 a = acc[ai][bj][m][0], b = acc[ai][bj][m][1];
#pragma unroll
          for (int e = 0; e < 4; ++e) { float t = fmaxf(a[e], 0.f); a[e] = t * t; t = fmaxf(b[e], 0.f); b[e] = t * t; }
          *(uint4*)(Hid + row * DFF + col0 + bj * 128) = pk8(a, b);
        }
      }
    return false;
  }
};
__device__ void phase_ff1(const Params& p, int l, char* lds, int lat_only) {
  pg8::PlainSched S{p.ws + OFF_H, wsel(p, l) + OFF_W1T, 2048u, 2048u, 16, NTOK / 256, 16, (int)gridDim.x, (int)blockIdx.x, lat_only};
  EpiFF1 E{(u16*)(p.ws + OFF_P)};
  pg8::gemm_stream((LAS unsigned char*)lds, S, E);
}

__device__ void phase_final(const Params& p) {
  const int tid = otid(), lane = tid & 63, wid = tid >> 6;
  for (int tok = blockIdx.x * 8 + wid; tok < NBATCH * SEQ; tok += gridDim.x * 8) {
    float* xr = p.out + (size_t)tok * DM;
    const u16* xs = (const u16*)(p.ws + OFF_XL) + (size_t)tok * DM;
    float4 v[4]; float ss = 0.f;
#pragma unroll
    for (int j = 0; j < 4; ++j) {
      const uint2 q = *(const uint2*)(xs + j * 256 + lane * 4);
      v[j].x = __uint_as_float(q.x << 16); v[j].y = __uint_as_float(q.x & 0xffff0000u); v[j].z = __uint_as_float(q.y << 16); v[j].w = __uint_as_float(q.y & 0xffff0000u);
      ss += v[j].x * v[j].x + v[j].y * v[j].y + v[j].z * v[j].z + v[j].w * v[j].w;
    }
    ss = wave_sum(ss);
    const float rstd = rsqrtf(ss * (1.f / DM) + EPS);
#pragma unroll
    for (int j = 0; j < 4; ++j) {
      int c = j * 256 + lane * 4;
      float4 gg = *(const float4*)(p.gfin + c);
      float4 o = {v[j].x * rstd * gg.x, v[j].y * rstd * gg.y, v[j].z * rstd * gg.z, v[j].w * rstd * gg.w};
      *(float4*)(xr + c) = o;
    }
  }
}

#define XB_TMO      128
#define XB_XCNT(j)  (256  + 64 * (j))
#define XB_XSUB(j)  (1280 + 64 * (j))
#define XB_XGEN(j)  (2304 + 64 * (j))
#define XB_TOP      3328
#define XB_TOPGEN   3392
#define XCD_BAR_WORDS 3456
#define XB_SPIN_CAP (1u << 18)
DI unsigned xb_ld(unsigned* p) { return __hip_atomic_load(p, __ATOMIC_RELAXED, __HIP_MEMORY_SCOPE_AGENT); }
DI unsigned xb_add(unsigned* p, unsigned v) { return __hip_atomic_fetch_add(p, v, __ATOMIC_RELAXED, __HIP_MEMORY_SCOPE_AGENT); }
DI unsigned xb_xcc_id() { return (unsigned)__builtin_amdgcn_s_getreg((3 << 11) | 20) & 0xFu; }
#define XB_SPIN(cond, bar) do { unsigned _sp = 0; while (cond) { __builtin_amdgcn_s_sleep(1); \
    if ((++_sp & 255u) == 0u) { if (xb_ld(&(bar)[XB_TMO])) break; if (_sp > XB_SPIN_CAP) { atomicAdd(&(bar)[XB_TMO], 1u); break; } } } } while (0)
struct XcdBarrier { unsigned* bar; unsigned x; volatile __attribute__((address_space(3))) unsigned* st; };
DI XcdBarrier xcd_barrier_post(unsigned* bar, volatile __attribute__((address_space(3))) unsigned* st) {
  XcdBarrier b; b.bar = bar; b.x = xb_xcc_id(); b.st = st;
  if (threadIdx.x == 0) (void)xb_add(&bar[XB_XCNT(b.x)], 1u);
  return b;
}
DI void xcd_barrier_complete(unsigned* bar, unsigned x, unsigned& nloc, unsigned& nx) {
  const unsigned G = gridDim.x * gridDim.y * gridDim.z;
  unsigned sum, cnt, mine, sp = 0u;
  for (;;) {
    sum = 0u; cnt = 0u; mine = 0u;
#pragma unroll
    for (unsigned j = 0; j < 16; ++j) { const unsigned c = xb_ld(&bar[XB_XCNT(j)]); sum += c; cnt += (c > 0u) ? 1u : 0u; mine = (j == x) ? c : mine; }
    if (sum == G) break;
    __builtin_amdgcn_s_sleep(1);
    if ((++sp & 255u) == 0u) { if (xb_ld(&bar[XB_TMO])) break; if (sp > XB_SPIN_CAP) { atomicAdd(&bar[XB_TMO], 1u); break; } }
  }
  nloc = mine > 0u ? mine : 1u; nx = cnt > 0u ? cnt : 1u;
}
DI void xcd_barrier(const XcdBarrier& b) {
  asm volatile("s_waitcnt vmcnt(0)" ::: "memory");
  __syncthreads();
  if (threadIdx.x == 0) {
    unsigned* bar = b.bar;
    __builtin_amdgcn_s_waitcnt(0);
    unsigned nloc = b.st[0], nx = b.st[1];
    if (nloc == 0u) { xcd_barrier_complete(bar, b.x, nloc, nx); b.st[0] = nloc; b.st[1] = nx; }
    const unsigned old = xb_add(&bar[XB_XSUB(b.x)], 1u);
    const unsigned gen = old / nloc;
    if (old + 1u == (gen + 1u) * nloc) {
      __builtin_amdgcn_fence(__ATOMIC_RELEASE, "agent");
      asm volatile("s_waitcnt vmcnt(0)" ::: "memory");
      const unsigned og = xb_add(&bar[XB_TOP], 1u);
      const unsigned tg = og / nx;
      if (og + 1u == (tg + 1u) * nx) xb_add(&bar[XB_TOPGEN], 1u);
      else XB_SPIN(xb_ld(&bar[XB_TOPGEN]) == tg, bar);
      __builtin_amdgcn_fence(__ATOMIC_ACQUIRE, "agent");
      xb_add(&bar[XB_XGEN(b.x)], 1u);
      asm volatile("s_waitcnt vmcnt(0)" ::: "memory");
    } else {
      XB_SPIN(xb_ld(&bar[XB_XGEN(b.x)]) == gen, bar);
      __builtin_amdgcn_fence(__ATOMIC_ACQUIRE, "agent");
      asm volatile("s_waitcnt vmcnt(0)" ::: "memory");
    }
  }
  __syncthreads();
}

constexpr int NSUB = 12;
constexpr int NPHASE = 1 + DEPTH * NG * NSUB + 1;

__global__ void __launch_bounds__(512) mega(Params p, int ph_lo, int ph_hi) {
  extern __shared__ __attribute__((aligned(16))) char lds[];
  volatile __attribute__((address_space(3))) unsigned* st = (volatile __attribute__((address_space(3))) unsigned*)(lds + LDS_BYTES - 32);
  if (threadIdx.x < 2) st[threadIdx.x] = 0u;
  __syncthreads();
  XcdBarrier xb{};
  if (ph_hi - ph_lo > 1) xb = xcd_barrier_post((unsigned*)(p.ws + OFF_BAR), st);
#define GSYNC() xcd_barrier(xb)
  for (int ph = ph_lo; ph < ph_hi; ++ph) {
    if (ph > 0 && ph < NPHASE - 1 && ((ph - 1) % NSUB) == 0 && ((ph - 1) / NSUB) != 0) continue;
    if (ph == 0) { phase_prep(p, lds); phase_wconv(p, 0, lds); }
    else if (ph == NPHASE - 1) phase_final(p);
    else {
      const int q = ph - 1, lg = q / NSUB, sub = q % NSUB, l = lg / NG, g = lg % NG;
      switch (sub) {
        case 0: if (lg == 0) phase_norm(p, l, g, 0); break;
        case 1: for (int rep = 0; rep < ((PROBE & 2) ? 2 : 1); ++rep) { if (rep) GSYNC(); phase_inproj(p, l, lds); } break;
        case 2: phase_tokprep(p, l); break;
        case 3: phase_mlaup(p, l, lds); break;
        case 4: phase_mixers(p, l, g, lds); if (PROBE & 1) { GSYNC(); phase_mixers(p, l, g, lds, 8); } if (PROBE & 4) { GSYNC(); phase_mixers(p, l, g, lds, 8, true); } if (PROBE & 16) { GSYNC(); phase_mixers(p, l, g, lds, 8, true, true); } break;
        case 5: for (int rep = 0; rep < ((PROBE & 8) ? 2 : 1); ++rep) { if (rep) GSYNC(); phase_readout(p, l); } break;
        case 6: for (int rep = 0; rep < ((PROBE & 2) ? 2 : 1); ++rep) { if (rep) GSYNC(); phase_gate(p, l, lds, l == DEPTH - 1); } break;
        case 7: for (int rep = 0; rep < ((PROBE & 32) ? 2 : 1); ++rep) { if (rep) GSYNC(); phase_branch(p, l, lds, l == DEPTH - 1); } if (g == 0 && l + 1 < DEPTH) phase_wconv(p, l + 1, lds, (int*)(p.ws + OFF_CNT) + 24 + l); break;
        case 8: for (int rep = 0; rep < ((PROBE & 64) ? 2 : 1); ++rep) { if (rep) GSYNC(); phase_resid_gemm(p, l, g, p.ws + OFF_OA, wsel(p, l) + OFF_WOT, DM, 2, lds, rep ? (float*)((char*)p.out) : nullptr); } break;
        case 9: for (int rep = 0; rep < ((PROBE & 8) ? 2 : 1); ++rep) { if (rep) GSYNC(); phase_norm(p, l, g, 1); } break;
        case 10: for (int rep = 0; rep < ((PROBE & 2) ? 2 : 1); ++rep) { if (rep) GSYNC(); phase_ff1(p, l, lds, l == DEPTH - 1); } break;
        default: for (int rep = 0; rep < ((PROBE & 64) ? 2 : 1); ++rep) { if (rep) GSYNC(); phase_resid_gemm(p, l, g, p.ws + OFF_P, wsel(p, l) + OFF_W2T, DFF, 5, lds, rep ? (float*)((char*)p.out) : nullptr); } if (lg + 1 < DEPTH * NG) phase_norm_dyn(p, (lg + 1) / NG, (lg + 1) % NG, (int*)(p.ws + OFF_CNT) + 16 + lg); break;
      }
    }
    if (ph + 1 < ph_hi) { if (ph == ph_lo) cg::this_grid().sync(); else GSYNC(); }
  }
}

extern "C" void kernel_launch(void* const* d_in, const int* in_sizes, int n_in, void* d_out, int out_size, void* d_ws,
                              size_t ws_size, hipStream_t stream) {
  static int grid_blocks = 0;
  if (!grid_blocks) {
    int dev = 0, cus = 0, per_cu = 0;
    (void)hipGetDevice(&dev);
    (void)hipDeviceGetAttribute(&cus, hipDeviceAttributeMultiprocessorCount, dev);
    (void)hipFuncSetAttribute((const void*)mega, hipFuncAttributeMaxDynamicSharedMemorySize, LDS_BYTES);
    (void)hipOccupancyMaxActiveBlocksPerMultiprocessor(&per_cu, mega, NTHR, LDS_BYTES);
    if (per_cu < 1) per_cu = 1;
    if (per_cu > 1) per_cu = 1;
    grid_blocks = cus * per_cu;
  }
  if (ws_size < WS_NEED) { fprintf(stderr, "workspace too small: %zu < %zu\n", ws_size, (size_t)WS_NEED); }
  Params p{};
  const float** pf = (const float**)&p;
  for (int i = 0; i < 26; ++i) pf[i] = (const float*)d_in[i];
  p.out = (float*)d_out;
  p.ws = (char*)d_ws;
  (void)hipMemsetAsync((char*)d_ws + OFF_CNT, 0, 256 + 3456 * 4, stream);
#if ONE_LAUNCH
  int lo = 0, hi = NPHASE;
  void* args[] = {&p, &lo, &hi};
  hipError_t e = hipLaunchCooperativeKernel((void*)mega, dim3(grid_blocks), dim3(NTHR), args, LDS_BYTES, stream);
  if (e != hipSuccess) fprintf(stderr, "cooperative launch failed: %s (grid %d)\n", hipGetErrorString(e), grid_blocks);
#else
  for (int ph = 0; ph < NPHASE; ++ph) mega<<<grid_blocks, NTHR, LDS_BYTES, stream>>>(p, ph, ph + 1);
#endif
}
```

```cpp
#include <hip/hip_runtime.h>
#include <hip/hip_cooperative_groups.h>
#include <cstdio>
#include <cstdint>
namespace cg = cooperative_groups;

#ifndef PROBE
#define PROBE 0
#endif
#ifndef ONE_LAUNCH
#define ONE_LAUNCH 1
#endif

typedef unsigned short u16;
typedef short bf16x8 __attribute__((ext_vector_type(8)));
typedef short s16x4 __attribute__((ext_vector_type(4)));
typedef float f32x16 __attribute__((ext_vector_type(16)));
typedef float f32x2v __attribute__((ext_vector_type(2)));
typedef __bf16 bf16x2v __attribute__((ext_vector_type(2)));
#define DI __device__ __forceinline__
#define MFMA(a, b, c) __builtin_amdgcn_mfma_f32_32x32x16_bf16((a), (b), (c), 0, 0, 0)

constexpr int DM = 1024, NBATCH = 32, SEQ = 2048, CTXL = 256, DEPTH = 4, DFF = 4096;
constexpr int NG = 2, NB = 16, TPB = 2304, NTOK = NB * TPB;
constexpr int PS = 5376, NPC = 5328, INW = 9424;
constexpr int A_I = 0, A_FF = 512, A_FB = 1024, B_K = 1536, B_V = 1792, B_G = 2304, C_K = 2320, C_V = 2448,
              D_CKV = 2576, D_KR = 2704, A_Q = 2768, A_G = 3280, B_Q = 3792, B_O = 4048, C_Q = 4560, D_CQ = 5072;
constexpr float EPS = 1e-6f;
constexpr float LOG2E = 1.4426950408889634f;

constexpr size_t al256(size_t x) { return (x + 255) & ~(size_t)255; }
constexpr size_t OFF_WINT = 0;
constexpr size_t OFF_WGT = OFF_WINT + al256((size_t)PS * 1024 * 2);
constexpr size_t OFF_WBT = OFF_WGT + al256((size_t)4096 * 1024 * 2);
constexpr size_t OFF_WOT = OFF_WBT + al256((size_t)4 * 1024 * 512 * 2);
constexpr size_t OFF_W1T = OFF_WOT + al256((size_t)1024 * 1024 * 2);
constexpr size_t OFF_W2T = OFF_W1T + al256((size_t)4096 * 1024 * 2);
constexpr size_t OFF_WUQ = OFF_W2T + al256((size_t)1024 * 4096 * 2);
constexpr size_t OFF_WUK = OFF_WUQ + al256((size_t)768 * 256 * 2);
constexpr size_t OFF_WUV = OFF_WUK + al256((size_t)512 * 128 * 2);
constexpr size_t OFF_MOD = OFF_WUV + al256((size_t)512 * 128 * 2);
constexpr size_t OFF_LB = OFF_MOD + al256((size_t)4 * 33 * 6144 * 4);
constexpr size_t OFF_ROPE = OFF_LB + al256((size_t)4 * 2 * 512 * 4);
constexpr size_t OFF_CNT = OFF_ROPE + al256((size_t)2 * 64 * 16 * 4);
constexpr size_t OFF_BAR = OFF_CNT + 256;
constexpr size_t OFF_XC = OFF_BAR + al256(3456 * 4);
constexpr size_t OFF_XL = OFF_XC + al256((size_t)NBATCH * CTXL * DM * 2);
constexpr size_t OFF_P = OFF_XL + al256((size_t)NBATCH * SEQ * DM * 2);
constexpr size_t OFF_GB = OFF_P + al256((size_t)NTOK * PS * 2);
constexpr size_t OFF_KQ = OFF_GB + al256((size_t)NTOK * 16 * 4);
constexpr size_t OFF_H = OFF_KQ + al256((size_t)NTOK * 512 * 2);
constexpr size_t OFF_QD = OFF_H + al256((size_t)NTOK * 1024 * 2);
constexpr size_t OFF_KD = OFF_QD + al256((size_t)NTOK * 768 * 2);
constexpr size_t OFF_VD = OFF_KD + al256((size_t)NTOK * 768 * 2);
constexpr size_t OFF_OA = OFF_VD + al256((size_t)NTOK * 512 * 2);
constexpr size_t OFF_OB = OFF_OA + al256((size_t)2 * NTOK * 512 * 2);
constexpr size_t OFF_W2ND = OFF_OB + al256((size_t)2 * NTOK * 512 * 2);
constexpr size_t WS_NEED = OFF_W2ND + (OFF_MOD - OFF_WINT);
constexpr int LDS_BYTES = 143360;
constexpr int LDSV = 69632;
constexpr int NTHR = 512;
constexpr size_t OFF_MF = OFF_QD;

struct Params {
  const float *x, *c, *ctx, *c_ctx, *w_ada, *b_ada, *g1, *g2, *w_in, *bgate, *lblog, *hnorm, *convw, *mnorm,
      *gqn, *gkn, *mqn, *mkvn, *wuq, *wuk, *wuv, *wbr, *wout, *wff1, *wff2, *gfin;
  float* out;
  char* ws;
};

DI int otid() { int t = threadIdx.x; asm volatile("" : "+v"(t)); return t; }
DI char* wsel(const Params& p, int l) { return p.ws + ((l & 1) ? OFF_W2ND : (size_t)0); }
DI float bf2f(u16 v) { return __uint_as_float(((unsigned)v) << 16); }
DI unsigned pack2(float a, float b) {
  f32x2v v = {a, b};
  bf16x2v r = __builtin_convertvector(v, bf16x2v);
  return __builtin_bit_cast(unsigned, r);
}
DI u16 f2bf(float a) { return (u16)(pack2(a, 0.f) & 0xffffu); }
DI int crow(int reg, int h) { return (reg & 3) + 8 * (reg >> 2) + 4 * h; }
DI float sigmoidf_(float x) { return 1.f / (1.f + __expf(-x)); }
DI float siluf_(float x) { return x / (1.f + __expf(-x)); }
DI float ex2(float x) { return __builtin_amdgcn_exp2f(x); }
DI bf16x8 pack8(const f32x16& x, int s) {
  union { unsigned u[4]; bf16x8 v; } t;
  t.u[0] = pack2(x[8 * s + 0], x[8 * s + 1]);
  t.u[1] = pack2(x[8 * s + 2], x[8 * s + 3]);
  t.u[2] = pack2(x[8 * s + 4], x[8 * s + 5]);
  t.u[3] = pack2(x[8 * s + 6], x[8 * s + 7]);
  return t.v;
}
DI bf16x8 cat4(s16x4 lo, s16x4 hi) { return __builtin_shufflevector(lo, hi, 0, 1, 2, 3, 4, 5, 6, 7); }
DI float wave_sum(float v) {
#pragma unroll
  for (int d = 32; d >= 1; d >>= 1) v += __shfl_xor(v, d);
  return v;
}
DI void unpack8(const uint4& q, float* f) {
  f[0] = __uint_as_float(q.x << 16); f[1] = __uint_as_float(q.x & 0xffff0000u);
  f[2] = __uint_as_float(q.y << 16); f[3] = __uint_as_float(q.y & 0xffff0000u);
  f[4] = __uint_as_float(q.z << 16); f[5] = __uint_as_float(q.z & 0xffff0000u);
  f[6] = __uint_as_float(q.w << 16); f[7] = __uint_as_float(q.w & 0xffff0000u);
}
DI uint4 pack8f(const float* f) {
  uint4 q;
  q.x = pack2(f[0], f[1]); q.y = pack2(f[2], f[3]); q.z = pack2(f[4], f[5]); q.w = pack2(f[6], f[7]);
  return q;
}

DI u16* xrow_ptr(const Params& p, int g, int tok, int& modrow) {
  int bl = tok / TPB, pp = tok - bl * TPB, b = g * NB + bl;
  if (pp < CTXL) { modrow = 32; return (u16*)(p.ws + OFF_XC) + ((size_t)b * CTXL + pp) * DM; }
  modrow = b;
  return (u16*)(p.ws + OFF_XL) + ((size_t)b * SEQ + (pp - CTXL)) * DM;
}

#define LAS __attribute__((address_space(3)))
typedef float f32x4 __attribute__((ext_vector_type(4)));
namespace pg8 {
constexpr int BM = 256, BK = 64, HALF = 128, HTB = HALF * BK * 2, STAGE_BYTES = 8 * HTB, NXCD = 8, WGM = 8;
DI int lds_byte(int r, int c) { const int st = (r >> 4) * 2 + (c >> 5), rr = r & 15, cc = c & 31, ob = rr * 64 + cc * 2; return st * 1024 + (ob ^ (((ob >> 9) & 1) << 5)); }
DI void stage_rc(int b, int& R, int& C) { const int st = b / 1024, sb = b % 1024, swz = sb ^ (((sb >> 9) & 1) << 5); R = (st >> 1) * 16 + swz / 64; C = (st & 1) * 32 + (swz % 64) / 2; }
DI int perm32(int rho) { const int n = rho >> 4, i = rho & 15; return 8 * (i >> 2) + 4 * n + (i & 3); }
struct UDesc { const char* A; const char* B; unsigned lda2, ldb2; int nt, pm, pn, tag; };
DI bool tile_order(long L, int nM, int nN, int& pm, int& pn) {
  const int nwg = nM * nN; if (L >= nwg) return false;
  int wgid = (int)L; { const int q = nwg / NXCD, r = nwg % NXCD, xcd = wgid % NXCD, off = wgid / NXCD; wgid = (xcd < r ? xcd * (q + 1) : r * (q + 1) + (xcd - r) * q) + off; }
  const int nig = WGM * nN, gid = wgid / nig, fm = gid * WGM, gsz = (nM - fm) < WGM ? (nM - fm) : WGM;
  pm = fm + ((wgid % nig) % gsz); pn = (wgid % nig) / gsz; return true;
}
template <class Epi, class Sched>
DI void gemm_stream(LAS unsigned char* lds, const Sched& S, const Epi& E) {
  const int tid = otid(), wid = __builtin_amdgcn_readfirstlane(tid >> 6), lane = tid & 63, wr = wid >> 2, wc = wid & 3, fr = lane & 15, fq = lane >> 4;
  int RA[2], RB[2], CC[2];
#pragma unroll
  for (int i = 0; i < 2; ++i) { int R, C; stage_rc(tid * 16 + i * 8192, R, C); RA[i] = R; RB[i] = (R & ~31) + perm32(R & 31); CC[i] = C * 2; }
  const size_t kstep = (size_t)(BK * 2);
  const unsigned ldsw = (unsigned)wid * 1024u;
  const int aoff = lds_byte(wr * 64 + fr, fq * 8), boff = lds_byte(wc * 32 + fr, fq * 8);
#define PG8_SA(b, h) (((b) * 2 + (h)) * HTB)
#define PG8_SB(b, h) ((4 + (b) * 2 + (h)) * HTB)
#define PG8_STAGE(bufoff, gbase, voff) do { _Pragma("unroll") for (int _i = 0; _i < 2; ++_i) \
    __builtin_amdgcn_global_load_lds((const unsigned*)((const char*)(gbase) + (voff)[_i]), (LAS unsigned*)(lds + (bufoff) + ldsw + _i * 8192), 16, 0, 0); } while (0)
#define PG8_LDA(dst, b, h) do { _Pragma("unroll") for (int m = 0; m < 4; ++m) _Pragma("unroll") for (int k = 0; k < 2; ++k) dst[m][k] = *(const LAS bf16x8*)(lds + PG8_SA(b, h) + aoff + m * 2048 + k * 1024); } while (0)
#define PG8_LDB(dst, b, h) do { _Pragma("unroll") for (int n = 0; n < 2; ++n) _Pragma("unroll") for (int k = 0; k < 2; ++k) dst[n][k] = *(const LAS bf16x8*)(lds + PG8_SB(b, h) + boff + n * 2048 + k * 1024); } while (0)
#define PG8_MMA(ai, bj, At, Bt) do { __builtin_amdgcn_s_setprio(1); _Pragma("unroll") for (int m = 0; m < 4; ++m) _Pragma("unroll") for (int n = 0; n < 2; ++n) _Pragma("unroll") for (int k = 0; k < 2; ++k) \
    acc[ai][bj][m][n] = __builtin_amdgcn_mfma_f32_16x16x32_bf16(Bt[n][k], At[m][k], acc[ai][bj][m][n], 0, 0, 0); __builtin_amdgcn_s_setprio(0); } while (0)
#define PG8_WAIT_V(n) asm volatile("s_waitcnt vmcnt(" #n ")" ::: "memory")
#define PG8_WAIT_L(n) asm volatile("s_waitcnt lgkmcnt(" #n ")" ::: "memory")
#define PG8_BAR __builtin_amdgcn_s_barrier()
#define PG8_SCHED __builtin_amdgcn_sched_barrier(0)
  UDesc cur, nxt; int ui = 0;
  if (!S.next(0, cur)) return;
  f32x4 acc[2][2][4][2];
#pragma unroll
  for (int a = 0; a < 2; ++a)
#pragma unroll
    for (int b = 0; b < 2; ++b)
#pragma unroll
      for (int m = 0; m < 4; ++m)
#pragma unroll
        for (int n = 0; n < 2; ++n) acc[a][b][m][n] = (f32x4){0.f, 0.f, 0.f, 0.f};
  bf16x8 At[4][2], B0[2][2], B1[2][2];
  const char* cA = cur.A; const char* cB = cur.B;
  unsigned vA[2], vB[2];
#pragma unroll
  for (int i = 0; i < 2; ++i) { vA[i] = (unsigned)RA[i] * cur.lda2 + CC[i]; vB[i] = (unsigned)RB[i] * cur.ldb2 + CC[i]; }
  size_t hA = (size_t)HALF * cur.lda2, hB = (size_t)HALF * cur.ldb2;
  PG8_STAGE(PG8_SB(0, 0), cB, vB); PG8_STAGE(PG8_SA(0, 0), cA, vA); PG8_STAGE(PG8_SB(0, 1), cB + hB, vB); PG8_STAGE(PG8_SA(0, 1), cA + hA, vA);
  if (wr == 1) PG8_BAR;
  PG8_WAIT_V(4); PG8_BAR;
  PG8_STAGE(PG8_SB(1, 0), cB + kstep, vB); PG8_STAGE(PG8_SA(1, 0), cA + kstep, vA); PG8_STAGE(PG8_SB(1, 1), cB + hB + kstep, vB);
  PG8_WAIT_V(6); PG8_BAR;
  for (;;) {
    const bool has_next = S.next(ui + 1, nxt);
    const char* nA = has_next ? nxt.A : cA; const char* nB = has_next ? nxt.B : cB;
    const unsigned nlda = has_next ? nxt.lda2 : cur.lda2, nldb = has_next ? nxt.ldb2 : cur.ldb2;
    unsigned nvA[2], nvB[2];
#pragma unroll
    for (int i = 0; i < 2; ++i) { nvA[i] = (unsigned)RA[i] * nlda + CC[i]; nvB[i] = (unsigned)RB[i] * nldb + CC[i]; }
    const size_t nhA = (size_t)HALF * nlda, nhB = (size_t)HALF * nldb;
    const int nt = cur.nt;
    for (int t = 0; t < nt; t += 2) {
      const bool last = (t == nt - 2);
      const char* a1 = cA + (size_t)(t + 1) * kstep;
      const char* a2 = last ? nA : cA + (size_t)(t + 2) * kstep; const char* b2 = last ? nB : cB + (size_t)(t + 2) * kstep;
      const char* a3 = a2 + kstep; const char* b3 = b2 + kstep;
      unsigned v2A[2], v2B[2];
#pragma unroll
      for (int i = 0; i < 2; ++i) { v2A[i] = last ? nvA[i] : vA[i]; v2B[i] = last ? nvB[i] : vB[i]; }
      const size_t h2A = last ? nhA : hA, h2B = last ? nhB : hB;
      PG8_LDB(B0, 0, 0); PG8_SCHED; PG8_LDA(At, 0, 0); PG8_STAGE(PG8_SA(1, 1), a1 + hA, vA);
      PG8_WAIT_L(8); PG8_BAR; PG8_WAIT_L(0); PG8_MMA(0, 0, At, B0); PG8_BAR; PG8_SCHED;
      PG8_LDB(B1, 0, 1); PG8_STAGE(PG8_SB(0, 0), b2, v2B);
      PG8_BAR; PG8_WAIT_L(0); PG8_MMA(0, 1, At, B1); PG8_BAR;
      PG8_LDA(At, 0, 1); PG8_STAGE(PG8_SA(0, 0), a2, v2A);
      PG8_BAR; PG8_WAIT_L(0); PG8_MMA(1, 0, At, B0); PG8_BAR; PG8_SCHED;
      PG8_STAGE(PG8_SB(0, 1), b2 + h2B, v2B);
      PG8_WAIT_V(6); PG8_BAR; PG8_MMA(1, 1, At, B1); PG8_BAR;
      PG8_LDB(B0, 1, 0); PG8_SCHED; PG8_LDA(At, 1, 0); PG8_STAGE(PG8_SA(0, 1), a2 + h2A, v2A);
      PG8_WAIT_L(8); PG8_BAR; PG8_WAIT_L(0); PG8_MMA(0, 0, At, B0); PG8_BAR; PG8_SCHED;
      PG8_LDB(B1, 1, 1); PG8_STAGE(PG8_SB(1, 0), b3, v2B);
      PG8_BAR; PG8_WAIT_L(0); PG8_MMA(0, 1, At, B1); PG8_BAR;
      PG8_LDA(At, 1, 1); PG8_STAGE(PG8_SA(1, 0), a3, v2A);
      PG8_BAR; PG8_WAIT_L(0); PG8_MMA(1, 0, At, B0); PG8_BAR; PG8_SCHED;
      PG8_STAGE(PG8_SB(1, 1), b3 + h2B, v2B);
      PG8_WAIT_V(6); PG8_BAR; PG8_MMA(1, 1, At, B1); PG8_BAR;
    }
    const bool keep = E(acc, cur, wr, wc, fr, fq);
    if (!has_next) break;
    if (!keep) {
#pragma unroll
      for (int a = 0; a < 2; ++a)
#pragma unroll
        for (int b = 0; b < 2; ++b)
#pragma unroll
          for (int m = 0; m < 4; ++m)
#pragma unroll
            for (int n = 0; n < 2; ++n) acc[a][b][m][n] = (f32x4){0.f, 0.f, 0.f, 0.f};
    }
    cur = nxt; cA = nA; cB = nB; hA = nhA; hB = nhB;
#pragma unroll
    for (int i = 0; i < 2; ++i) { vA[i] = nvA[i]; vB[i] = nvB[i]; }
    ++ui;
  }
  PG8_WAIT_V(0);
  if (wr == 0) PG8_BAR;
  PG8_BAR;
#undef PG8_SA
#undef PG8_SB
#undef PG8_STAGE
#undef PG8_LDA
#undef PG8_LDB
#undef PG8_MMA
#undef PG8_WAIT_V
#undef PG8_WAIT_L
#undef PG8_BAR
#undef PG8_SCHED
}
struct PlainSched {
  const char* A; const char* B; unsigned lda2, ldb2; int nt, nM, nN, G, c; int lat_only = 0;
  DI bool next(int i, UDesc& u) const {
    int pm, pn; if (!tile_order((long)i * G + c, lat_only ? nM - NB : nM, nN, pm, pn)) return false;
    if (lat_only) pm = pm + (pm >> 3) + 1;
    u.A = A + (size_t)pm * 256 * lda2; u.B = B + (size_t)pn * 256 * ldb2; u.lda2 = lda2; u.ldb2 = ldb2; u.nt = nt; u.pm = pm; u.pn = pn; u.tag = 0; return true;
  }
};
}

DI uint4 pk8(const f32x4& a, const f32x4& b) {
  uint4 q; q.x = pack2(a[0], a[1]); q.y = pack2(a[2], a[3]); q.z = pack2(b[0], b[1]); q.w = pack2(b[2], b[3]); return q;
}

__device__ void phase_prep(const Params& p, char* lds) {
  const int tid = otid(), nthr = gridDim.x * NTHR, gt = blockIdx.x * NTHR + tid;
  {
    const float4* s = (const float4*)p.x; uint2* d = (uint2*)(p.ws + OFF_XL);
    const size_t n = (size_t)NBATCH * SEQ * DM / 4;
    for (size_t i = gt; i < n; i += nthr) { const float4 v = s[i]; uint2 o; o.x = pack2(v.x, v.y); o.y = pack2(v.z, v.w); d[i] = o; }
    const float4* s2 = (const float4*)p.ctx; uint2* d2 = (uint2*)(p.ws + OFF_XC);
    const size_t n2 = (size_t)NBATCH * CTXL * DM / 4;
    for (size_t i = gt; i < n2; i += nthr) { const float4 v = s2[i]; uint2 o; o.x = pack2(v.x, v.y); o.y = pack2(v.z, v.w); d2[i] = o; }
  }
  if (gt < 1024) {
    float v[DEPTH], mx = -1e30f;
    for (int l = 0; l < DEPTH; ++l) { v[l] = p.lblog[l * 1024 + gt]; mx = fmaxf(mx, v[l]); }
    float sum = 0.f;
    for (int l = 0; l < DEPTH; ++l) { v[l] = expf(v[l] - mx); sum += v[l]; }
    float* lb = (float*)(p.ws + OFF_LB);
    float run = 0.f;
    for (int l = 0; l < DEPTH; ++l) { lb[l * 1024 + gt] = run; if (l + 1 < DEPTH) run += v[l + 1] / sum; }
  }
  if (gt >= 1024 && gt < 2048) {
    int i = gt - 1024, pos = i >> 4, fi = i & 15;
    float inv = powf(10000.f, -(float)fi / 16.f);
    float ang = (float)pos * inv;
    float* rc = (float*)(p.ws + OFF_ROPE);
    rc[i] = cosf(ang); rc[1024 + i] = sinf(ang);
  }
  float* ssm = (float*)lds;
  float* red = (float*)lds + 2 * 33 * 32;
  for (int item = blockIdx.x; item < DEPTH * 24; item += gridDim.x) {
    const int l = item / 24, kh = tid >> 8, tl = tid & 255, j = (item % 24) * 256 + tl;
    float acc[33];
#pragma unroll
    for (int r = 0; r < 33; ++r) acc[r] = 0.f;
    const float* W = p.w_ada + (size_t)l * DM * 6144;
    for (int k0 = kh * 512; k0 < kh * 512 + 512; k0 += 32) {
      __syncthreads();
      for (int idx = tl; idx < 33 * 32; idx += 256) {
        int rr = idx >> 5, kk = idx & 31;
        float cv = rr < 32 ? p.c[rr * DM + k0 + kk] : p.c_ctx[k0 + kk];
        ssm[kh * 33 * 32 + idx] = cv / (1.f + expf(-cv));
      }
      __syncthreads();
#pragma unroll 4
      for (int kk = 0; kk < 32; ++kk) {
        float w = W[(size_t)(k0 + kk) * 6144 + j];
#pragma unroll
        for (int r = 0; r < 33; ++r) acc[r] += ssm[kh * 33 * 32 + r * 32 + kk] * w;
      }
    }
    __syncthreads();
    if (kh == 1) {
#pragma unroll
      for (int r = 0; r < 33; ++r) red[r * 256 + tl] = acc[r];
    }
    __syncthreads();
    if (kh == 0) {
      float bb = p.b_ada[l * 6144 + j];
      float* mod = (float*)(p.ws + OFF_MOD) + (size_t)l * 33 * 6144;
#pragma unroll
      for (int r = 0; r < 33; ++r) mod[r * 6144 + j] = acc[r] + red[r * 256 + tl] + bb;
    }
  }
  __syncthreads();
}

DI u16* wdst(char* wb, int type, int sub, int n) {
  switch (type) {
    case 0: return n < NPC ? (u16*)(wb + OFF_WINT) + (size_t)n * 1024 : (u16*)(wb + OFF_WGT) + (size_t)(n - NPC) * 1024;
    case 1: return (u16*)(wb + OFF_WBT) + ((size_t)sub * 1024 + n) * 512;
    case 2: return (u16*)(wb + OFF_WOT) + (size_t)n * 1024;
    case 3: return (u16*)(wb + OFF_W1T) + (size_t)n * 1024;
    case 4: return (u16*)(wb + OFF_W2T) + (size_t)n * 4096;
    case 5: return (u16*)(wb + OFF_WUQ) + (size_t)n * 256;
    case 6: return (u16*)(wb + OFF_WUK) + (size_t)n * 128;
    default: return (u16*)(wb + OFF_WUV) + (size_t)n * 128;
  }
}
__device__ void phase_wconv(const Params& p, int l, char* lds, int* cnt = nullptr) {
  char* wb = wsel(p, l);
  int* s_item = (int*)(lds + LDS_BYTES - 16);
  float* tile = (float*)lds;
  const int tid = otid();
  {
    unsigned* z = (unsigned*)((u16*)(wb + OFF_WINT) + (size_t)NPC * 1024);
    for (int i = blockIdx.x * NTHR + tid; i < (PS - NPC) * 1024 / 2; i += gridDim.x * NTHR) z[i] = 0u;
  }
  constexpr int T0 = 16 * 148, T1 = T0 + 4 * 128, T2 = T1 + 256, T3 = T2 + 1024, T4 = T3 + 1024, T5 = T4 + 48, T6 = T5 + 16, T7 = T6 + 16;
  for (int itk = 0;; ++itk) {
    int it;
    if (cnt) { __syncthreads(); if (tid == 0) *s_item = atomicAdd(cnt, 1); __syncthreads(); it = *s_item; }
    else it = blockIdx.x + itk * gridDim.x;
    if (it >= T7) break;
    int type, sub = 0, K, N, kt, nt;
    const float* src;
    if (it < T0) { type = 0; K = 1024; N = INW; int q = it; kt = q / 148; nt = q % 148; src = p.w_in + (size_t)l * 1024 * INW; }
    else if (it < T1) { type = 1; K = 512; N = 1024; int q = it - T0; sub = q / 128; q %= 128; kt = q / 16; nt = q % 16; src = p.wbr + ((size_t)l * 4 + sub) * 512 * 1024; }
    else if (it < T2) { type = 2; K = 1024; N = 1024; int q = it - T1; kt = q / 16; nt = q % 16; src = p.wout + (size_t)l * 1024 * 1024; }
    else if (it < T3) { type = 3; K = 1024; N = 4096; int q = it - T2; kt = q / 64; nt = q % 64; src = p.wff1 + (size_t)l * 1024 * 4096; }
    else if (it < T4) { type = 4; K = 4096; N = 1024; int q = it - T3; kt = q / 16; nt = q % 16; src = p.wff2 + (size_t)l * 4096 * 1024; }
    else if (it < T5) { type = 5; K = 256; N = 768; int q = it - T4; kt = q / 12; nt = q % 12; src = p.wuq + (size_t)l * 256 * 768; }
    else if (it < T6) { type = 6; K = 128; N = 512; int q = it - T5; kt = q / 8; nt = q % 8; src = p.wuk + (size_t)l * 128 * 512; }
    else { type = 7; K = 128; N = 512; int q = it - T6; kt = q / 8; nt = q % 8; src = p.wuv + (size_t)l * 128 * 512; }
    (void)K;
    const int k0 = kt * 64, n0 = nt * 64;
    __syncthreads();
    {
      const int nn = tid & 63, ks = tid >> 6;
#pragma unroll 4
      for (int j = 0; j < 8; ++j) {
        int k = ks + 8 * j;
        tile[k * 65 + nn] = (n0 + nn < N) ? src[(size_t)(k0 + k) * N + n0 + nn] : 0.f;
      }
    }
    __syncthreads();
    {
      const int kp = tid & 31, nn = tid >> 5;
#pragma unroll 4
      for (int j = 0; j < 4; ++j) {
        int n = nn + 16 * j;
        if (n0 + n < N) {
          unsigned v = pack2(tile[(2 * kp) * 65 + n], tile[(2 * kp + 1) * 65 + n]);
          *(unsigned*)(wdst(wb, type, sub, n0 + n) + k0 + 2 * kp) = v;
        }
      }
    }
  }
  __syncthreads();
}

DI void norm_token(const Params& p, int l, int g, int which, int tok, int lane, const float* gn, const float* mod, u16* H) {
  int mr; const u16* xr = xrow_ptr(p, g, tok, mr);
  const float* shift = mod + (size_t)mr * 6144 + (which == 0 ? 0 : 3) * DM;
  const float* scale = shift + DM;
  float4 v[4]; float ss = 0.f;
#pragma unroll
  for (int j = 0; j < 4; ++j) {
    const uint2 q = *(const uint2*)(xr + j * 256 + lane * 4);
    v[j].x = __uint_as_float(q.x << 16); v[j].y = __uint_as_float(q.x & 0xffff0000u); v[j].z = __uint_as_float(q.y << 16); v[j].w = __uint_as_float(q.y & 0xffff0000u);
    ss += v[j].x * v[j].x + v[j].y * v[j].y + v[j].z * v[j].z + v[j].w * v[j].w;
  }
  ss = wave_sum(ss);
  const float rstd = rsqrtf(ss * (1.f / DM) + EPS);
#pragma unroll
  for (int j = 0; j < 4; ++j) {
    int c = j * 256 + lane * 4;
    float4 gg = *(const float4*)(gn + c), sh = *(const float4*)(shift + c), sc = *(const float4*)(scale + c);
    float o0 = v[j].x * rstd * gg.x * (1.f + sc.x) + sh.x;
    float o1 = v[j].y * rstd * gg.y * (1.f + sc.y) + sh.y;
    float o2 = v[j].z * rstd * gg.z * (1.f + sc.z) + sh.z;
    float o3 = v[j].w * rstd * gg.w * (1.f + sc.w) + sh.w;
    uint2 o; o.x = pack2(o0, o1); o.y = pack2(o2, o3);
    *(uint2*)(H + (size_t)tok * DM + c) = o;
  }
}
__device__ void phase_norm(const Params& p, int l, int g, int which) {
  const int tid = otid(), lane = tid & 63, wid = tid >> 6;
  const float* gn = (which == 0 ? p.g1 : p.g2) + l * DM;
  const float* mod = (const float*)(p.ws + OFF_MOD) + (size_t)l * 33 * 6144;
  u16* H = (u16*)(p.ws + OFF_H);
  for (int tok = blockIdx.x * 8 + wid; tok < NTOK; tok += gridDim.x * 8) {
    if (which == 1 && l == DEPTH - 1 && (tok % TPB) < CTXL) continue;
    norm_token(p, l, g, which, tok, lane, gn, mod, H);
  }
}
__device__ void phase_norm_dyn(const Params& p, int l, int g, int* cnt) {
  const int tid = otid(), lane = tid & 63;
  const float* gn = p.g1 + l * DM;
  const float* mod = (const float*)(p.ws + OFF_MOD) + (size_t)l * 33 * 6144;
  u16* H = (u16*)(p.ws + OFF_H);
  for (;;) {
    int c = 0;
    if (lane == 0) c = atomicAdd(cnt, 1);
    c = __shfl(c, 0);
    if (c >= NTOK / 8) break;
    for (int t = 0; t < 8; ++t) norm_token(p, l, g, 0, c * 8 + t, lane, gn, mod, H);
  }
}

__device__ void phase_tokprep(const Params& p, int l) {
  const int tid = otid(), lane = tid & 63, wid = tid >> 6;
  u16* P = (u16*)(p.ws + OFF_P);
  u16* KQ = (u16*)(p.ws + OFF_KQ);
  u16* Kd = (u16*)(p.ws + OFF_KD);
  const float* rc = (const float*)(p.ws + OFF_ROPE);
  const float* rs = rc + 1024;
  const int c8 = lane & 7;
  for (int tok = blockIdx.x * 8 + wid; tok < NTOK; tok += gridDim.x * 8) {
    const int pp = tok % TPB;
    const bool lat = pp >= CTXL;
    const int pos = pp - CTXL, prow = pos >> 6, pcol = pos & 63;
    u16* row = P + (size_t)tok * PS;
    {
      const bool isk = lane < 32;
      const int cc = (isk ? lane : lane - 32) * 8;
      const int colb = (isk ? B_K : B_Q) + cc;
      const bool hasp = !(pp == 0 || pp == CTXL), hasn = !(pp == CTXL - 1 || pp == TPB - 1);
      float x0[8], x1[8], x2[8];
      uint4 q1 = *(const uint4*)(row + colb); unpack8(q1, x1);
      if (hasp) { uint4 q0 = *(const uint4*)(row - PS + colb); unpack8(q0, x0); } else { for (int e = 0; e < 8; ++e) x0[e] = 0.f; }
      if (hasn) { uint4 q2 = *(const uint4*)(row + PS + colb); unpack8(q2, x2); } else { for (int e = 0; e < 8; ++e) x2[e] = 0.f; }
      const float* cw = p.convw + ((size_t)l * 2 + (isk ? 1 : 0)) * 3 * 256 + cc;
      float o[8];
#pragma unroll
      for (int e = 0; e < 8; ++e) {
        float a = cw[e] * x0[e] + cw[256 + e] * x1[e] + cw[512 + e] * x2[e];
        a = siluf_(a);
        o[e] = isk ? a * 0.125f : a;
      }
      *(uint4*)(KQ + (size_t)tok * 512 + (isk ? 0 : 256) + cc) = pack8f(o);
    }
#pragma unroll
    for (int pass = 0; pass < 2; ++pass) {
      const bool act = pass == 0 || lane < 16;
      const int colb = (pass == 0 ? C_Q : C_K) + lane * 8;
      const float* gg = (pass == 0 ? p.gqn : p.gkn) + l * 64 + c8 * 8;
      float x[8];
      if (act) { uint4 q = *(const uint4*)(row + colb); unpack8(q, x); } else { for (int e = 0; e < 8; ++e) x[e] = 0.f; }
      float ss = 0.f;
#pragma unroll
      for (int e = 0; e < 8; ++e) ss += x[e] * x[e];
      ss += __shfl_xor(ss, 1); ss += __shfl_xor(ss, 2); ss += __shfl_xor(ss, 4);
      const float rstd = rsqrtf(ss * (1.f / 64.f) + EPS);
#pragma unroll
      for (int e = 0; e < 8; ++e) x[e] = x[e] * rstd * gg[e];
      float o[8];
#pragma unroll
      for (int e = 0; e < 8; ++e) {
        float other = __shfl_xor(x[e], 2);
        const int ppos = (c8 & 4) ? pcol : prow;
        const int fi = (c8 & 1) * 8 + e;
        float cs = 1.f, sn = 0.f;
        if (lat) { cs = rc[ppos * 16 + fi]; sn = rs[ppos * 16 + fi]; }
        o[e] = (c8 & 2) ? (x[e] * cs + other * sn) : (x[e] * cs - other * sn);
      }
      if (act) *(uint4*)(row + colb) = pack8f(o);
    }
    {
      const bool isckv = lane < 16, iscq = lane >= 32, iskr = lane >= 16 && lane < 24;
      int colb = isckv ? D_CKV + lane * 8 : (iscq ? D_CQ + (lane - 32) * 8 : D_KR + ((lane - 16) & 7) * 8);
      float x[8];
      { uint4 q = *(const uint4*)(row + colb); unpack8(q, x); }
      float ss = 0.f;
#pragma unroll
      for (int e = 0; e < 8; ++e) ss += x[e] * x[e];
      ss += __shfl_xor(ss, 1); ss += __shfl_xor(ss, 2); ss += __shfl_xor(ss, 4); ss += __shfl_xor(ss, 8);
      float ss32 = ss + __shfl_xor(ss, 16);
      float o[8];
      if (isckv) {
        const float rstd = rsqrtf(ss * (1.f / 128.f) + EPS);
        const float* gg = p.mkvn + l * 128 + lane * 8;
        for (int e = 0; e < 8; ++e) o[e] = x[e] * rstd * gg[e];
      } else if (iscq) {
        const float rstd = rsqrtf(ss32 * (1.f / 256.f) + EPS);
        const float* gg = p.mqn + l * 256 + (lane - 32) * 8;
        for (int e = 0; e < 8; ++e) o[e] = x[e] * rstd * gg[e];
      } else {
        for (int e = 0; e < 8; ++e) o[e] = x[e];
      }
      float orot[8];
#pragma unroll
      for (int e = 0; e < 8; ++e) {
        float other = __shfl_xor(x[e], 2);
        const int ck = lane & 7;
        const int ppos = (ck & 4) ? pcol : prow;
        const int fi = (ck & 1) * 8 + e;
        float cs = 1.f, sn = 0.f;
        if (lat) { cs = rc[ppos * 16 + fi]; sn = rs[ppos * 16 + fi]; }
        orot[e] = (ck & 2) ? (x[e] * cs + other * sn) : (x[e] * cs - other * sn);
      }
      if (isckv || iscq) *(uint4*)(row + colb) = pack8f(o);
      if (iskr) {
        uint4 q = pack8f(orot);
        const int ck = lane & 7;
#pragma unroll
        for (int hd = 0; hd < 4; ++hd) *(uint4*)(Kd + (size_t)tok * 768 + hd * 192 + 128 + ck * 8) = q;
      }
    }
  }
}

template <int DK, int DV, bool ROPEQ>
__device__ void attn_item(const u16* __restrict__ qrow, const u16* __restrict__ Kp, int kst, const u16* __restrict__ Vp, int vst,
                          u16* __restrict__ orow, int nkeys, float sc, int pos, const float* __restrict__ rc, char* lds) {
  constexpr int KLD = DK + 8, VLD = DV + 32;
  constexpr int KB = 64 * KLD, VB = 64 * VLD;
  u16* KS = (u16*)lds;
  u16* VS = KS + 2 * KB;
  const int tid = otid(), lane = tid & 63, r = lane & 31, h = lane >> 5;
  bf16x8 qf[DK / 16];
  {
#pragma unroll
    for (int s = 0; s < DK / 16; ++s) qf[s] = *(const bf16x8*)(qrow + h * 8 + s * 16);
    if (ROPEQ && pos >= 0) {
      const int prow = pos >> 6, pcol = pos & 63;
      const float* rs = rc + 1024;
      constexpr int s0 = (DK - 64) / 16;
#pragma unroll
      for (int part = 0; part < 2; ++part) {
        const int ppos = part ? pcol : prow;
#pragma unroll
        for (int j = 0; j < 8; ++j) {
          const int fi = 8 * h + j;
          float cs = rc[ppos * 16 + fi], sn = rs[ppos * 16 + fi];
          float x1 = bf2f((u16)qf[s0 + 2 * part][j]), x2 = bf2f((u16)qf[s0 + 2 * part + 1][j]);
          qf[s0 + 2 * part][j] = (short)f2bf(x1 * cs - x2 * sn);
          qf[s0 + 2 * part + 1][j] = (short)f2bf(x2 * cs + x1 * sn);
        }
      }
    }
  }
  f32x16 oT[DV / 32];
#pragma unroll
  for (int d = 0; d < DV / 32; ++d)
#pragma unroll
    for (int e = 0; e < 16; ++e) oT[d][e] = 0.f;
  float m = -1e30f, lsum = 0.f;
  const int ntile = nkeys >> 6;
  constexpr int NKP = KB * 2 / 1024, NVP = VB * 2 / 1024, NKJ = (NKP + 7) / 8, NVJ = (NVP + 7) / 8;
  const int wu = __builtin_amdgcn_readfirstlane(tid >> 6);
  unsigned ksrc[NKJ], vsrc[NVJ];
#pragma unroll
  for (int j = 0; j < NKJ; ++j) { const int o = (wu + 8 * j) * 1024 + lane * 16, row = o / (KLD * 2), col = (o % (KLD * 2)) / 2; ksrc[j] = (unsigned)(row * kst + (col < DK ? col : 0)) * 2u; }
#pragma unroll
  for (int j = 0; j < NVJ; ++j) { const int o = (wu + 8 * j) * 1024 + lane * 16, row = o / (VLD * 2), col = (o % (VLD * 2)) / 2; vsrc[j] = (unsigned)(row * vst + (col < DV ? col : 0)) * 2u; }
#define ATT_DMA(kt_, buf_) do { \
    const char* kg_ = (const char*)Kp + (size_t)(kt_) * 64 * kst * 2; const char* vg_ = (const char*)Vp + (size_t)(kt_) * 64 * vst * 2; \
    _Pragma("unroll") for (int j = 0; j < NKJ; ++j) if (wu + 8 * j < NKP) \
      __builtin_amdgcn_global_load_lds((const unsigned*)(kg_ + ksrc[j]), (LAS unsigned*)((char*)KS + (buf_) * KB * 2 + (wu + 8 * j) * 1024), 16, 0, 0); \
    _Pragma("unroll") for (int j = 0; j < NVJ; ++j) if (wu + 8 * j < NVP) \
      __builtin_amdgcn_global_load_lds((const unsigned*)(vg_ + vsrc[j]), (LAS unsigned*)((char*)VS + (buf_) * VB * 2 + (wu + 8 * j) * 1024), 16, 0, 0); \
  } while (0)
  __syncthreads();
  ATT_DMA(0, 0);
  asm volatile("s_waitcnt vmcnt(0)" ::: "memory");
  __syncthreads();
  const int troff = ((lane & 15) >> 2) * VLD + 16 * ((lane >> 4) & 1) + 4 * (lane & 3) + 4 * h * VLD;
#pragma unroll 1
  for (int kt = 0; kt < ntile; ++kt) {
    const int buf = kt & 1;
    if (kt + 1 < ntile) ATT_DMA(kt + 1, buf ^ 1);
    const u16* KSb = KS + buf * KB;
    const u16* VSb = VS + buf * VB;
    f32x16 sT[2];
#pragma unroll
    for (int kk = 0; kk < 2; ++kk) {
#pragma unroll
      for (int e = 0; e < 16; ++e) sT[kk][e] = 0.f;
#pragma unroll
      for (int s = 0; s < DK / 16; ++s) {
        bf16x8 a = *(const bf16x8*)(KSb + (kk * 32 + r) * KLD + s * 16 + h * 8);
        sT[kk] = MFMA(a, qf[s], sT[kk]);
      }
    }
    float mx = -1e30f;
#pragma unroll
    for (int kk = 0; kk < 2; ++kk)
#pragma unroll
      for (int e = 0; e < 16; ++e) mx = fmaxf(mx, sT[kk][e]);
    mx = fmaxf(mx, __shfl_xor(mx, 32));
    const float mn = fmaxf(m, mx * sc);
    const float alpha = ex2(m - mn);
    m = mn;
    lsum *= alpha;
#pragma unroll
    for (int kk = 0; kk < 2; ++kk) {
      sT[kk] = sT[kk] * sc - mn;
#pragma unroll
      for (int e = 0; e < 16; ++e) sT[kk][e] = ex2(sT[kk][e]);
    }
    {
      f32x16 t16 = sT[0] + sT[1];
      typedef float f32x8v __attribute__((ext_vector_type(8)));
      typedef float f32x4v __attribute__((ext_vector_type(4)));
      f32x8v t8 = __builtin_shufflevector(t16, t16, 0, 1, 2, 3, 4, 5, 6, 7) + __builtin_shufflevector(t16, t16, 8, 9, 10, 11, 12, 13, 14, 15);
      f32x4v t4 = __builtin_shufflevector(t8, t8, 0, 1, 2, 3) + __builtin_shufflevector(t8, t8, 4, 5, 6, 7);
      lsum += (t4[0] + t4[1]) + (t4[2] + t4[3]);
    }
#pragma unroll
    for (int d = 0; d < DV / 32; ++d) oT[d] = oT[d] * alpha;
#pragma unroll
    for (int kk = 0; kk < 2; ++kk)
#pragma unroll
      for (int s2 = 0; s2 < 2; ++s2) {
        bf16x8 pb = pack8(sT[kk], s2);
#pragma unroll
        for (int d = 0; d < DV / 32; ++d) {
          const u16* vb = VSb + (kk * 32 + s2 * 16) * VLD + d * 32 + troff;
          s16x4 lo = __builtin_amdgcn_ds_read_tr16_b64_v4i16((LAS s16x4*)vb);
          s16x4 hi = __builtin_amdgcn_ds_read_tr16_b64_v4i16((LAS s16x4*)(vb + 8 * VLD));
          oT[d] = MFMA(cat4(lo, hi), pb, oT[d]);
        }
      }
    asm volatile("s_waitcnt vmcnt(0)" ::: "memory");
    __syncthreads();
  }
#undef ATT_DMA
  lsum += __shfl_xor(lsum, 32);
  const float inv = 1.f / lsum;
#pragma unroll
  for (int d = 0; d < DV / 32; ++d)
#pragma unroll
    for (int gq = 0; gq < 4; ++gq) {
      uint2 o;
      o.x = pack2(oT[d][4 * gq] * inv, oT[d][4 * gq + 1] * inv);
      o.y = pack2(oT[d][4 * gq + 2] * inv, oT[d][4 * gq + 3] * inv);
      *(uint2*)(orow + d * 32 + 8 * gq + 4 * h) = o;
    }
}

__device__ void scanA_unit(const Params& p, int l, int unit, char* lds) {
  const int tid = otid(), lane = tid & 63, wid = tid >> 6, r = lane & 31, h = lane >> 5;
  const int bl = unit >> 3, hd = (unit >> 1) & 3, dir = unit & 1;
  const u16* P = (const u16*)(p.ws + OFF_P);
  u16* Oa = (u16*)(p.ws + OFF_OA) + (size_t)dir * NTOK * 512;
  float* BC = (float*)lds;
  u16* Qs = (u16*)(lds + 33792);
  u16* KKs = (u16*)(lds + 51200);
  u16* AM = (u16*)(lds + 51200);
  u16* KT = (u16*)(lds + 68608);
  u16* VT = (u16*)(lds + 87040);
  u16* ST = (u16*)(lds + 105472);
  float* EL = (float*)(lds + 140288);
  float* QTOT = (float*)(lds + 140800);
  const int ch = tid & 15;
  float lbv[8];
  {
    const float* lb = (const float*)(p.ws + OFF_LB) + (size_t)l * 1024 + dir * 512 + hd * 128 + ch * 8;
#pragma unroll
    for (int e = 0; e < 8; ++e) lbv[e] = lb[e];
  }
  const int vt = wid & 3, th = wid >> 2;
  f32x16 S[2];
#pragma unroll
  for (int j = 0; j < 2; ++j)
#pragma unroll
    for (int e = 0; e < 16; ++e) S[j][e] = 0.f;
  __syncthreads();
  for (int i = tid; i < 128 * 136 / 2; i += NTHR) ((unsigned*)ST)[i] = 0u;
  uint4 pqr[2], pfr[2], pvr[2];
#define SCANA_TOK0(st_) (bl * TPB + ((st_) >= 4 ? CTXL : 0) + (dir ? ((st_) >= 4 ? 31 - ((st_) - 4) : 3 - (st_)) : ((st_) >= 4 ? (st_) - 4 : (st_))) * 64)
#define SCANA_PREFETCH(st_) do { const int t0_ = SCANA_TOK0(st_); \
    _Pragma("unroll") for (int j = 0; j < 2; ++j) { const int i = (tid >> 4) + 32 * j; \
      const u16* row = P + (size_t)(t0_ + (dir ? 63 - i : i)) * PS + hd * 128 + ch * 8; \
      pqr[j] = *(const uint4*)(row + A_Q); pfr[j] = *(const uint4*)(row + (dir ? A_FB : A_FF)); pvr[j] = *(const uint4*)(row + A_I); } } while (0)
  SCANA_PREFETCH(0);
#pragma unroll 1
  for (int step = 0; step < 36; ++step) {
    const int tok0 = SCANA_TOK0(step);
    __syncthreads();
#pragma unroll
    for (int j = 0; j < 2; ++j) {
      const int i = (tid >> 4) + 32 * j;
      uint4 qraw = pqr[j];
      uint4 fraw = pfr[j];
      uint4 vq = pvr[j];
      float qv[8], fv[8], kkv[8];
      unpack8(qraw, qv); unpack8(fraw, fv);
#pragma unroll
      for (int e = 0; e < 8; ++e) {
        qv[e] = siluf_(qv[e]);
        const float ex = __expf(-fv[e]);
        const float sg = 1.f / (1.f + ex);
        const float sgn = ex / (1.f + ex);
        const float f = lbv[e] + (1.f - lbv[e]) * sg;
        kkv[e] = (1.f - lbv[e]) * (fv[e] > 30.f ? 0.f : (fv[e] < -30.f ? 1.f : sgn));
        BC[i * 132 + ch * 8 + e] = __log2f(fmaxf(f, 1e-37f));
      }
      *(uint4*)(Qs + i * 136 + ch * 8) = pack8f(qv);
      *(uint4*)(KKs + i * 136 + ch * 8) = pack8f(kkv);
      u16* dv = VT + (ch * 8) * 72 + i;
      dv[0 * 72] = (u16)(vq.x & 0xffff); dv[1 * 72] = (u16)(vq.x >> 16); dv[2 * 72] = (u16)(vq.y & 0xffff); dv[3 * 72] = (u16)(vq.y >> 16);
      dv[4 * 72] = (u16)(vq.z & 0xffff); dv[5 * 72] = (u16)(vq.z >> 16); dv[6 * 72] = (u16)(vq.w & 0xffff); dv[7 * 72] = (u16)(vq.w >> 16);
    }
    __syncthreads();
    {
      const int k = tid & 127, qd = tid >> 7;
      float run = 0.f;
      for (int i = qd * 16; i < qd * 16 + 16; ++i) { run += BC[i * 132 + k]; BC[i * 132 + k] = run; }
      QTOT[qd * 128 + k] = run;
    }
    __syncthreads();
    {
      const int k = tid & 127, qd = tid >> 7;
      float off = 0.f;
      for (int q2 = 0; q2 < qd; ++q2) off += QTOT[q2 * 128 + k];
      if (qd > 0) for (int i = qd * 16; i < qd * 16 + 16; ++i) BC[i * 132 + k] += off;
    }
    __syncthreads();
    f32x4 cod[2];
#pragma unroll
    for (int jj = 0; jj < 2; ++jj) {
      cod[jj] = (f32x4){0.f, 0.f, 0.f, 0.f};
      const int job = wid + 8 * jj;
      if (job < 10) {
        const int bI = job < 1 ? 0 : (job < 3 ? 1 : (job < 6 ? 2 : 3));
        const int bJ = job - (bI * (bI + 1)) / 2;
        const int l16 = lane & 15, kg = lane >> 4;
        const int t = 16 * bI + l16, s = 16 * bJ + l16, rr = 16 * bI;
#pragma unroll
        for (int ks = 0; ks < 4; ++ks) {
          const int k0 = ks * 32 + kg * 8;
          float qv[8], kv[8];
          unpack8(*(const uint4*)(Qs + t * 136 + k0), qv);
          unpack8(*(const uint4*)(KKs + s * 136 + k0), kv);
#pragma unroll
          for (int e = 0; e < 8; ++e) {
            const float br = BC[rr * 132 + k0 + e];
            qv[e] *= ex2(BC[t * 132 + k0 + e] - br);
            kv[e] *= ex2(fminf(br - BC[s * 132 + k0 + e], 120.f));
          }
          union { uint4 u; bf16x8 v; } ua, ub;
          ua.u = pack8f(qv); ub.u = pack8f(kv);
          cod[jj] = __builtin_amdgcn_mfma_f32_16x16x32_bf16(ua.v, ub.v, cod[jj], 0, 0, 0);
        }
      }
    }
    if (tid < 128) EL[tid] = ex2(BC[63 * 132 + tid]);
#pragma unroll
    for (int j = 0; j < 2; ++j) {
      const int i = (tid >> 4) + 32 * j;
      float kv[8];
      unpack8(*(const uint4*)(KKs + i * 136 + ch * 8), kv);
      u16* dk = KT + (ch * 8) * 72 + i;
#pragma unroll
      for (int e = 0; e < 8; ++e) {
        const float b = BC[i * 132 + ch * 8 + e], bl_ = BC[63 * 132 + ch * 8 + e];
        dk[e * 72] = f2bf(kv[e] * ex2(bl_ - b));
      }
    }
    __syncthreads();
#pragma unroll
    for (int j = 0; j < 2; ++j) {
      const int i = (tid >> 4) + 32 * j;
      float qv[8];
      unpack8(*(const uint4*)(Qs + i * 136 + ch * 8), qv);
#pragma unroll
      for (int e = 0; e < 8; ++e) qv[e] *= ex2(BC[i * 132 + ch * 8 + e]);
      *(uint4*)(Qs + i * 136 + ch * 8) = pack8f(qv);
    }
    for (int i = tid; i < 64 * 72 / 2; i += NTHR) ((unsigned*)AM)[i] = 0u;
    __syncthreads();
#pragma unroll
    for (int jj = 0; jj < 2; ++jj) {
      const int job = wid + 8 * jj;
      if (job < 10) {
        const int bI = job < 1 ? 0 : (job < 3 ? 1 : (job < 6 ? 2 : 3));
        const int bJ = job - (bI * (bI + 1)) / 2;
        const int l16 = lane & 15, kg = lane >> 4;
#pragma unroll
        for (int e = 0; e < 4; ++e) {
          const int tp = 4 * kg + e;
          const float v = (bJ < bI || l16 <= tp) ? cod[jj][e] : 0.f;
          AM[(16 * bI + tp) * 72 + 16 * bJ + l16] = f2bf(v);
        }
      }
    }
    __syncthreads();
    if (step + 1 < 36) SCANA_PREFETCH(step + 1);
    f32x16 o;
#pragma unroll
    for (int e = 0; e < 16; ++e) o[e] = 0.f;
#pragma unroll
    for (int ks = 0; ks < 8; ++ks) {
      bf16x8 a = *(const bf16x8*)(Qs + (th * 32 + r) * 136 + ks * 16 + h * 8);
      bf16x8 b = *(const bf16x8*)(ST + (vt * 32 + r) * 136 + ks * 16 + h * 8);
      o = MFMA(a, b, o);
    }
    bf16x8 bv[4];
#pragma unroll
    for (int ks = 0; ks < 4; ++ks) bv[ks] = *(const bf16x8*)(VT + (vt * 32 + r) * 72 + ks * 16 + h * 8);
#pragma unroll
    for (int ks = 0; ks < 4; ++ks) {
      bf16x8 a = *(const bf16x8*)(AM + (th * 32 + r) * 72 + ks * 16 + h * 8);
      o = MFMA(a, bv[ks], o);
    }
    {
      u16* ob = Oa + (size_t)tok0 * 512 + hd * 128 + vt * 32 + r;
#pragma unroll
      for (int e = 0; e < 16; ++e) {
        const int i = th * 32 + crow(e, h);
        ob[(dir ? 63 - i : i) * 512] = f2bf(o[e]);
      }
    }
    __syncthreads();
#pragma unroll
    for (int j = 0; j < 2; ++j) {
      const int kt = 2 * th + j;
#pragma unroll
      for (int e = 0; e < 16; ++e) S[j][e] *= EL[kt * 32 + crow(e, h)];
#pragma unroll
      for (int ks = 0; ks < 4; ++ks) {
        bf16x8 a = *(const bf16x8*)(KT + (kt * 32 + r) * 72 + ks * 16 + h * 8);
        S[j] = MFMA(a, bv[ks], S[j]);
      }
#pragma unroll
      for (int gq = 0; gq < 4; ++gq) {
        uint2 w;
        w.x = pack2(S[j][4 * gq], S[j][4 * gq + 1]); w.y = pack2(S[j][4 * gq + 2], S[j][4 * gq + 3]);
        *(uint2*)(ST + (vt * 32 + r) * 136 + kt * 32 + 8 * gq + 4 * h) = w;
      }
    }
  }
#undef SCANA_PREFETCH
#undef SCANA_TOK0
}

__device__ void scanB_unit(const Params& p, int l, int unit2, char* lds) {
  const int tid0 = otid(), vb = tid0 >> 8, tid = tid0 & 255, lane = tid & 63, wid = tid >> 6, r = lane & 31, h = lane >> 5;
  const int unit = unit2 * 2 + vb;
  lds += vb * LDSV;
  const int bl = unit >> 3, hd = (unit >> 1) & 3, dir = unit & 1;
  const u16* P = (const u16*)(p.ws + OFF_P);
  const u16* KQ = (const u16*)(p.ws + OFF_KQ);
  const float* Gb = (const float*)(p.ws + OFF_GB);
  u16* Ob = (u16*)(p.ws + OFF_OB) + (size_t)dir * NTOK * 512;
  u16* QB = (u16*)lds;
  u16* KB = (u16*)(lds + 9216);
  u16* SM = (u16*)(lds + 18432);
  u16* KWT = (u16*)(lds + 27648);
  u16* VT = (u16*)(lds + 36864);
  float* vec = (float*)(lds + 55296);
  float *IG = vec, *LF = vec + 64, *BV = vec + 128, *UV = vec + 192, *MT = vec + 256, *WI = vec + 320, *WK = vec + 384,
        *DEN = vec + 448, *NV = vec + 512  , *SC = vec + 640, *BL2 = vec + 704, *UL2 = vec + 768, *EMT = vec + 832;
  const float bI = p.bgate[l * 16 + (2 * dir) * 4 + hd], bF = p.bgate[l * 16 + (2 * dir + 1) * 4 + hd];
  f32x16 C[2];
#pragma unroll
  for (int ft = 0; ft < 2; ++ft)
#pragma unroll
    for (int e = 0; e < 16; ++e) C[ft][e] = 0.f;
  float m = -1e30f;
  __syncthreads();
  if (tid < 128) NV[tid] = 0.f;
  int cur = 0;
  uint4 pk0, pk1, pq0, pq1, pv0, pv1, pv2, pv3; float pgI = 0.f, pgF = 0.f;
#define SCANB_TOK0(st_) (bl * TPB + ((st_) >= 4 ? CTXL : 0) + (dir ? ((st_) >= 4 ? 31 - ((st_) - 4) : 3 - (st_)) : ((st_) >= 4 ? (st_) - 4 : (st_))) * 64)
#define SCANB_LDKQ(j, K_, Q_) do { const int id = tid + 256 * (j), i = id >> 3, c8 = id & 7; \
      const u16* row = KQ + (size_t)(t0_ + (dir ? 63 - i : i)) * 512 + hd * 64 + c8 * 8; K_ = *(const uint4*)(row); Q_ = *(const uint4*)(row + 256); } while (0)
#define SCANB_LDV(j, V_) do { const int id = tid + 256 * (j), i = id >> 4, c16 = id & 15; \
      V_ = *(const uint4*)(P + (size_t)(t0_ + (dir ? 63 - i : i)) * PS + B_V + hd * 128 + c16 * 8); } while (0)
#define SCANB_PREFETCH(st_) do { const int t0_ = SCANB_TOK0(st_); \
    SCANB_LDKQ(0, pk0, pq0); SCANB_LDKQ(1, pk1, pq1); SCANB_LDV(0, pv0); SCANB_LDV(1, pv1); SCANB_LDV(2, pv2); SCANB_LDV(3, pv3); \
    if (tid < 64) { const int tok = t0_ + (dir ? 63 - tid : tid); pgI = Gb[(size_t)tok * 16 + (2 * dir) * 4 + hd]; pgF = Gb[(size_t)tok * 16 + (2 * dir + 1) * 4 + hd]; } } while (0)
#define SCANB_STKQ(j, K_, Q_) do { const int id = tid + 256 * (j), i = id >> 3, c8 = id & 7; \
      *(uint4*)(KB + i * 72 + c8 * 8) = K_; *(uint4*)(QB + i * 72 + c8 * 8) = Q_; } while (0)
#define SCANB_STV(j, V_) do { const int id = tid + 256 * (j), i = id >> 4, c16 = id & 15; const uint4 vq = V_; u16* dv = VT + (c16 * 8) * 72 + i; \
      dv[0 * 72] = (u16)(vq.x & 0xffff); dv[1 * 72] = (u16)(vq.x >> 16); dv[2 * 72] = (u16)(vq.y & 0xffff); dv[3 * 72] = (u16)(vq.y >> 16); \
      dv[4 * 72] = (u16)(vq.z & 0xffff); dv[5 * 72] = (u16)(vq.z >> 16); dv[6 * 72] = (u16)(vq.w & 0xffff); dv[7 * 72] = (u16)(vq.w >> 16); } while (0)
  SCANB_PREFETCH(0);
#pragma unroll 1
  for (int step = 0; step < 36; ++step) {
    const int tok0 = SCANB_TOK0(step);
    __syncthreads();
    SCANB_STKQ(0, pk0, pq0); SCANB_STKQ(1, pk1, pq1);
    SCANB_STV(0, pv0); SCANB_STV(1, pv1); SCANB_STV(2, pv2); SCANB_STV(3, pv3);
    if (tid < 64) {
      const int i = tid;
      const float gI = pgI + bI;
      const float gF = pgF + bF;
      const float lf = fminf(gF, 0.f) - log1pf(expf(-fabsf(gF)));
      float b = lf;
#pragma unroll
      for (int d = 1; d < 64; d <<= 1) { float t = __shfl_up(b, d); if (lane >= d) b += t; }
      const float u = gI - b;
      float pm = u;
#pragma unroll
      for (int d = 1; d < 64; d <<= 1) { float t = __shfl_up(pm, d); if (lane >= d) pm = fmaxf(pm, t); }
      const float mt = b + fmaxf(m, pm);
      const float wi = expf(b + m - mt);
      const float mnew = __shfl(mt, 63), b63 = __shfl(b, 63);
      const float dec = expf(b63 + m - mnew);
      const float wk = expf(b63 - b + gI - mnew);
      IG[i] = gI; LF[i] = lf; BV[i] = b; UV[i] = u; MT[i] = mt; WI[i] = wi; WK[i] = wk;
      BL2[i] = (b - mt) * LOG2E; UL2[i] = u * LOG2E; EMT[i] = expf(-mt);
      if (i == 0) { SC[0] = mnew; SC[1] = dec; }
    }
    __syncthreads();
    {
      const int tt = wid >> 1, st = wid & 1;
      f32x16 a16;
#pragma unroll
      for (int e = 0; e < 16; ++e) a16[e] = 0.f;
#pragma unroll
      for (int ks = 0; ks < 4; ++ks) {
        bf16x8 a = *(const bf16x8*)(QB + (tt * 32 + r) * 72 + ks * 16 + h * 8);
        bf16x8 b = *(const bf16x8*)(KB + (st * 32 + r) * 72 + ks * 16 + h * 8);
        a16 = MFMA(a, b, a16);
      }
      const int s = st * 32 + r;
      const float us = UL2[s];
#pragma unroll
      for (int e = 0; e < 16; ++e) {
        const int t = tt * 32 + crow(e, h);
        float v = 0.f;
        if (s <= t) v = a16[e] * ex2(BL2[t] + us);
        SM[t * 72 + s] = f2bf(v);
      }
    }
#pragma unroll
    for (int j = 0; j < 2; ++j) {
      const int id = tid + 256 * j, i = id >> 3, c8 = id & 7;
      float kv[8];
      unpack8(*(const uint4*)(KB + i * 72 + c8 * 8), kv);
      const float wk = WK[i];
#pragma unroll
      for (int e = 0; e < 8; ++e) KWT[(c8 * 8 + e) * 72 + i] = f2bf(kv[e] * wk);
    }
    __syncthreads();
    const float mnew = SC[0], dec = SC[1];
    if (tid < 64) {
      const int t = tid;
      float rsum = 0.f, qn = 0.f;
#pragma unroll
      for (int c8 = 0; c8 < 8; ++c8) {
        float sv[8], qv[8];
        unpack8(*(const uint4*)(SM + t * 72 + c8 * 8), sv);
        unpack8(*(const uint4*)(QB + t * 72 + c8 * 8), qv);
#pragma unroll
        for (int e = 0; e < 8; ++e) { rsum += sv[e]; qn += qv[e] * NV[cur * 64 + c8 * 8 + e]; }
      }
      DEN[t] = 1.f / fmaxf(fabsf(WI[t] * qn + rsum), EMT[t]);
    } else if (tid < 128) {
      const int f = tid - 64;
      float ns = 0.f;
#pragma unroll
      for (int c8 = 0; c8 < 8; ++c8) {
        float kv[8];
        unpack8(*(const uint4*)(KWT + f * 72 + c8 * 8), kv);
#pragma unroll
        for (int e = 0; e < 8; ++e) ns += kv[e];
      }
      NV[(cur ^ 1) * 64 + f] = dec * NV[cur * 64 + f] + ns;
    }
    __syncthreads();
    if (step + 1 < 36) SCANB_PREFETCH(step + 1);
    f32x16 num[2];
#pragma unroll
    for (int tt = 0; tt < 2; ++tt)
#pragma unroll
      for (int e = 0; e < 16; ++e) num[tt][e] = 0.f;
#pragma unroll
    for (int ft = 0; ft < 2; ++ft)
#pragma unroll
      for (int s = 0; s < 2; ++s) {
        bf16x8 pb = pack8(C[ft], s);
#pragma unroll
        for (int tt = 0; tt < 2; ++tt) {
          const u16* qb = QB + (tt * 32 + r) * 72 + ft * 32 + s * 16 + 4 * h;
          bf16x8 a = cat4(*(const s16x4*)qb, *(const s16x4*)(qb + 8));
          num[tt] = MFMA(a, pb, num[tt]);
        }
      }
#pragma unroll
    for (int tt = 0; tt < 2; ++tt)
#pragma unroll
      for (int e = 0; e < 16; ++e) num[tt][e] *= WI[tt * 32 + crow(e, h)];
    bf16x8 bv[4];
#pragma unroll
    for (int ks = 0; ks < 4; ++ks) bv[ks] = *(const bf16x8*)(VT + (wid * 32 + r) * 72 + ks * 16 + h * 8);
#pragma unroll
    for (int ks = 0; ks < 4; ++ks)
#pragma unroll
      for (int tt = 0; tt < 2; ++tt) {
        bf16x8 a = *(const bf16x8*)(SM + (tt * 32 + r) * 72 + ks * 16 + h * 8);
        num[tt] = MFMA(a, bv[ks], num[tt]);
      }
#pragma unroll
    for (int tt = 0; tt < 2; ++tt)
#pragma unroll
      for (int e = 0; e < 16; ++e) {
        const int i = tt * 32 + crow(e, h);
        const int tok = tok0 + (dir ? 63 - i : i);
        Ob[(size_t)tok * 512 + hd * 128 + wid * 32 + r] = f2bf(num[tt][e] * DEN[i]);
      }
#pragma unroll
    for (int ft = 0; ft < 2; ++ft) {
#pragma unroll
      for (int e = 0; e < 16; ++e) C[ft][e] *= dec;
#pragma unroll
      for (int ks = 0; ks < 4; ++ks) {
        bf16x8 a = *(const bf16x8*)(KWT + (ft * 32 + r) * 72 + ks * 16 + h * 8);
        C[ft] = MFMA(a, bv[ks], C[ft]);
      }
    }
    m = mnew;
    cur ^= 1;
  }
#undef SCANB_PREFETCH
#undef SCANB_LDKQ
#undef SCANB_LDV
#undef SCANB_STKQ
#undef SCANB_STV
#undef SCANB_TOK0
}

__device__ void phase_mixers(const Params& p, int l, int g, char* lds, int cbase = 0, bool scans_only = false, bool a_only = false) {
  int* s_item = (int*)(lds + LDS_BYTES - 16);
  int* cnt = (int*)(p.ws + OFF_CNT) + cbase + (l * NG + g);
  const u16* P = (const u16*)(p.ws + OFF_P);
  const u16* Qd = (const u16*)(p.ws + OFF_QD);
  const u16* Kd = (const u16*)(p.ws + OFF_KD);
  const u16* Vd = (const u16*)(p.ws + OFF_VD);
  u16* Y = (u16*)((char*)p.out);
  const float* rc = (const float*)(p.ws + OFF_ROPE);
  constexpr int NSA = NB * 8, NSB = NB * 4;
  constexpr int ND_L = NB * 4 * 8, NC_L = NB * 2 * 32, ND_C = NB * 4, NC_C = NB * 2 * 4;
  constexpr int I1 = NSA, I2 = I1 + NSB, I3 = I2 + ND_L, I4 = I3 + NC_L, I5 = I4 + ND_C, I6 = I5 + NC_C;
  const float scC = 0.125f * LOG2E, scD = 0.07216878364870322f * LOG2E;
  while (true) {
    __syncthreads();
    if (otid() == 0) *s_item = atomicAdd(cnt, 1);
    __syncthreads();
    const int it = *s_item;
    if (it >= (a_only ? I1 : (scans_only ? I2 : (l == DEPTH - 1 ? I4 : I6)))) break;
    if (it < I1) scanA_unit(p, l, it, lds);
    else if (it < I2) scanB_unit(p, l, it - I1, lds);
    else {
      bool isD, isLat; int q;
      if (it < I3) { isD = true; isLat = true; q = it - I2; }
      else if (it < I4) { isD = false; isLat = true; q = it - I3; }
      else if (it < I5) { isD = true; isLat = false; q = it - I4; }
      else { isD = false; isLat = false; q = it - I5; }
      const int tid = otid(), lane = tid & 63, wid = tid >> 6, r = lane & 31;
      const int nkeys = isLat ? TPB : CTXL;
      if (isD) {
        const int nqt = isLat ? 8 : 1;
        const int qt = q % nqt, hd = (q / nqt) % 4, bl = q / (nqt * 4);
        const int tokk = bl * TPB, ql = qt * 256 + wid * 32 + r;
        const int tokq = tokk + (isLat ? CTXL : 0) + ql;
        attn_item<192, 128, true>(Qd + (size_t)tokq * 768 + hd * 192, Kd + (size_t)tokk * 768 + hd * 192, 768,
                                  Vd + (size_t)tokk * 512 + hd * 128, 512, Y + (size_t)tokq * 2048 + 1536 + hd * 128,
                                  nkeys, scD, isLat ? ql : -1, rc, lds);
      } else {
        const int nqt = isLat ? 32 : 4;
        const int qt = q % nqt, kvh = (q / nqt) % 2, bl = q / (nqt * 2);
        const int hq = kvh * 4 + (wid >> 1);
        const int tokk = bl * TPB, ql = qt * 64 + (wid & 1) * 32 + r;
        const int tokq = tokk + (isLat ? CTXL : 0) + ql;
        attn_item<64, 64, false>(P + (size_t)tokq * PS + C_Q + hq * 64, P + (size_t)tokk * PS + C_K + kvh * 64, PS,
                                 P + (size_t)tokk * PS + C_V + kvh * 64, PS, Y + (size_t)tokq * 2048 + 1024 + hq * 64,
                                 nkeys, scC, -1, rc, lds);
      }
    }
  }
}

__device__ void phase_readout(const Params& p, int l) {
  const int tid = otid(), lane = tid & 63, wid = tid >> 6;
  const u16* P = (const u16*)(p.ws + OFF_P);
  const u16* Oa = (const u16*)(p.ws + OFF_OA);
  const u16* Ob = (const u16*)(p.ws + OFF_OB);
  u16* Y = (u16*)((char*)p.out);
  for (int tok = blockIdx.x * 8 + wid; tok < NTOK; tok += gridDim.x * 8) {
    if (l == DEPTH - 1 && (tok % TPB) < CTXL) continue;
#pragma unroll
    for (int mix = 0; mix < 2; ++mix) {
      const u16* O = mix == 0 ? Oa : Ob;
      const int col = lane * 8;
      float a[8], b[8], gt[8], o[8];
      unpack8(*(const uint4*)(O + (size_t)tok * 512 + col), a);
      unpack8(*(const uint4*)(O + ((size_t)NTOK + tok) * 512 + col), b);
      unpack8(*(const uint4*)(P + (size_t)tok * PS + (mix == 0 ? A_G : B_O) + col), gt);
      float ss = 0.f;
#pragma unroll
      for (int e = 0; e < 8; ++e) { a[e] += b[e]; ss += a[e] * a[e]; }
      ss += __shfl_xor(ss, 1); ss += __shfl_xor(ss, 2); ss += __shfl_xor(ss, 4); ss += __shfl_xor(ss, 8);
      const float rstd = rsqrtf(ss * (1.f / 128.f) + EPS);
      const float* gn = (mix == 0 ? p.hnorm : p.mnorm) + l * 128 + (col & 127);
#pragma unroll
      for (int e = 0; e < 8; ++e) {
        float y = a[e] * rstd * gn[e];
        o[e] = y * (mix == 0 ? siluf_(gt[e]) : sigmoidf_(gt[e]));
      }
      *(uint4*)(Y + (size_t)tok * 2048 + mix * 512 + col) = pack8f(o);
    }
  }
}

struct EpiInproj {
  u16* P; float* Gb;
  DI bool operator()(f32x4 (&acc)[2][2][4][2], const pg8::UDesc& u, int wr, int wc, int fr, int fq) const {
    const int row0 = u.pm * 256 + wr * 64 + fr, col0 = u.pn * 256 + wc * 32 + 8 * fq;
    const bool gate = (u.pn == 9) && (wc == 0) && (fq < 2);
#pragma unroll
    for (int ai = 0; ai < 2; ++ai)
#pragma unroll
      for (int m = 0; m < 4; ++m) {
        const size_t row = (size_t)(row0 + ai * 128 + m * 16);
#pragma unroll
        for (int bj = 0; bj < 2; ++bj) *(uint4*)(P + row * PS + col0 + bj * 128) = pk8(acc[ai][bj][m][0], acc[ai][bj][m][1]);
        if (gate) { *(f32x4*)(Gb + row * 16 + 8 * fq) = acc[ai][0][m][0]; *(f32x4*)(Gb + row * 16 + 8 * fq + 4) = acc[ai][0][m][1]; }
      }
    return false;
  }
};
__device__ void phase_inproj(const Params& p, int l, char* lds) {
  pg8::PlainSched S{p.ws + OFF_H, wsel(p, l) + OFF_WINT, 2048u, 2048u, 16, NTOK / 256, PS / 256, (int)gridDim.x, (int)blockIdx.x};
  EpiInproj E{(u16*)(p.ws + OFF_P), (float*)(p.ws + OFF_GB)};
  pg8::gemm_stream(( LAS unsigned char*)lds, S, E);
}

struct MlaSched {
  const char* P; const char* Wq; const char* Wk; const char* Wv; int G, c;
  DI bool next(int i, pg8::UDesc& u) const {
    const long L = (long)i * G + c; if (L >= (NTOK / 256) * 7) return false;
    const int pm = (int)(L / 7), j = (int)(L % 7);
    u.pm = pm; u.lda2 = PS * 2;
    if (j < 3) { u.tag = 0; u.pn = j; u.A = P + (size_t)pm * 256 * PS * 2 + D_CQ * 2; u.B = Wq + (size_t)j * 256 * 512; u.ldb2 = 512; u.nt = 4; }
    else if (j < 5) { u.tag = 1; u.pn = j - 3; u.A = P + (size_t)pm * 256 * PS * 2 + D_CKV * 2; u.B = Wk + (size_t)(j - 3) * 256 * 256; u.ldb2 = 256; u.nt = 2; }
    else { u.tag = 2; u.pn = j - 5; u.A = P + (size_t)pm * 256 * PS * 2 + D_CKV * 2; u.B = Wv + (size_t)(j - 5) * 256 * 256; u.ldb2 = 256; u.nt = 2; }
    return true;
  }
};
struct EpiMla {
  u16 *Qd, *Kd, *Vd;
  DI bool operator()(f32x4 (&acc)[2][2][4][2], const pg8::UDesc& u, int wr, int wc, int fr, int fq) const {
    const int row0 = u.pm * 256 + wr * 64 + fr, col0 = u.pn * 256 + wc * 32 + 8 * fq;
#pragma unroll
    for (int ai = 0; ai < 2; ++ai)
#pragma unroll
      for (int m = 0; m < 4; ++m) {
        const size_t row = (size_t)(row0 + ai * 128 + m * 16);
#pragma unroll
        for (int bj = 0; bj < 2; ++bj) {
          const int col = col0 + bj * 128;
          u16* dst = u.tag == 0 ? Qd + row * 768 + col : (u.tag == 1 ? Kd + row * 768 + (col >> 7) * 192 + (col & 127) : Vd + row * 512 + col);
          *(uint4*)dst = pk8(acc[ai][bj][m][0], acc[ai][bj][m][1]);
        }
      }
    return false;
  }
};
__device__ void phase_mlaup(const Params& p, int l, char* lds) {
  MlaSched S{p.ws + OFF_P, wsel(p, l) + OFF_WUQ, wsel(p, l) + OFF_WUK, wsel(p, l) + OFF_WUV, (int)gridDim.x, (int)blockIdx.x};
  EpiMla E{(u16*)(p.ws + OFF_QD), (u16*)(p.ws + OFF_KD), (u16*)(p.ws + OFF_VD)};
  pg8::gemm_stream((LAS unsigned char*)lds, S, E);
}

struct EpiGate {
  u16* Gt;
  DI bool operator()(f32x4 (&acc)[2][2][4][2], const pg8::UDesc& u, int wr, int wc, int fr, int fq) const {
    const int row0 = u.pm * 256 + wr * 64 + fr, col0 = u.pn * 256 + wc * 32 + 8 * fq;
#pragma unroll
    for (int ai = 0; ai < 2; ++ai)
#pragma unroll
      for (int m = 0; m < 4; ++m) {
        const size_t row = (size_t)(row0 + ai * 128 + m * 16);
#pragma unroll
        for (int bj = 0; bj < 2; ++bj) {
          f32x4 a = acc[ai][bj][m][0], b = acc[ai][bj][m][1];
#pragma unroll
          for (int e = 0; e < 4; ++e) { a[e] = fmaxf(sigmoidf_(a[e]), 1e-30f); b[e] = fmaxf(sigmoidf_(b[e]), 1e-30f); }
          *(uint4*)(Gt + row * 4096 + col0 + bj * 128) = pk8(a, b);
        }
      }
    return false;
  }
};
__device__ void phase_gate(const Params& p, int l, char* lds, int lat_only) {
  pg8::PlainSched S{p.ws + OFF_H, wsel(p, l) + OFF_WGT, 2048u, 2048u, 16, NTOK / 256, 16, (int)gridDim.x, (int)blockIdx.x, lat_only};
  EpiGate E{(u16*)(p.ws + OFF_P)};
  pg8::gemm_stream((LAS unsigned char*)lds, S, E);
}

struct BranchSched {
  const char* Y; const char* Wb; int G, c, lat_only;
  DI bool next(int i, pg8::UDesc& u) const {
    int pm, pn; if (!pg8::tile_order((long)(i >> 2) * G + c, lat_only ? NTOK / 256 - NB : NTOK / 256, 4, pm, pn)) return false;
    if (lat_only) pm = pm + (pm >> 3) + 1;
    const int r = i & 3;
    u.pm = pm; u.pn = pn; u.tag = r; u.lda2 = 4096; u.ldb2 = 1024; u.nt = 8;
    u.A = Y + (size_t)pm * 256 * 4096 + r * 1024; u.B = Wb + ((size_t)r * 1024 + pn * 256) * 1024;
    return true;
  }
};
struct EpiBranch {
  const u16* Gt; u16* Mg;
  DI bool operator()(f32x4 (&acc)[2][2][4][2], const pg8::UDesc& u, int wr, int wc, int fr, int fq) const {
    const int row0 = u.pm * 256 + wr * 64 + fr, col0 = u.pn * 256 + wc * 32 + 8 * fq, r = u.tag;
#pragma unroll
    for (int ai = 0; ai < 2; ++ai)
#pragma unroll
      for (int m = 0; m < 4; ++m) {
        const size_t row = (size_t)(row0 + ai * 128 + m * 16);
#pragma unroll
        for (int bj = 0; bj < 2; ++bj) {
          const int col = col0 + bj * 128;
          float gv[8];
          unpack8(*(const uint4*)(Gt + row * 4096 + r * 1024 + col), gv);
          if (r < 3) {
            float gn[8];
            unpack8(*(const uint4*)(Gt + row * 4096 + (r + 1) * 1024 + col), gn);
#pragma unroll
            for (int e = 0; e < 4; ++e) {
              acc[ai][bj][m][0][e] *= gv[e] * __builtin_amdgcn_rcpf(gn[e]);
              acc[ai][bj][m][1][e] *= gv[4 + e] * __builtin_amdgcn_rcpf(gn[4 + e]);
            }
          } else {
            f32x4 a = acc[ai][bj][m][0], b = acc[ai][bj][m][1];
#pragma unroll
            for (int e = 0; e < 4; ++e) { a[e] *= gv[e]; b[e] *= gv[4 + e]; }
            *(uint4*)(Mg + row * 1024 + col) = pk8(a, b);
          }
        }
      }
    return r < 3;
  }
};
__device__ void phase_branch(const Params& p, int l, char* lds, int lat_only) {
  BranchSched S{(const char*)p.out, wsel(p, l) + OFF_WBT, (int)gridDim.x, (int)blockIdx.x, lat_only};
  EpiBranch E{(const u16*)(p.ws + OFF_P), (u16*)(p.ws + OFF_OA)};
  pg8::gemm_stream((LAS unsigned char*)lds, S, E);
}

struct EpiResid {
  const Params* pp; const float* mod; int g, gidx; float* dummy;
  DI bool operator()(f32x4 (&acc)[2][2][4][2], const pg8::UDesc& u, int wr, int wc, int fr, int fq) const {
    int mr; u16* xb = xrow_ptr(*pp, g, u.pm * 256, mr);
    if (dummy) xb = (u16*)dummy + (size_t)u.pm * 256 * DM;
    const float* gate = mod + (size_t)mr * 6144 + gidx * DM;
    const int row0 = wr * 64 + fr, col0 = u.pn * 256 + wc * 32 + 8 * fq;
    f32x4 gv[2][2];
#pragma unroll
    for (int bj = 0; bj < 2; ++bj) { gv[bj][0] = *(const f32x4*)(gate + col0 + bj * 128); gv[bj][1] = *(const f32x4*)(gate + col0 + bj * 128 + 4); }
#pragma unroll
    for (int ai = 0; ai < 2; ++ai)
#pragma unroll
      for (int m = 0; m < 4; ++m) {
        u16* xr = xb + (size_t)(row0 + ai * 128 + m * 16) * DM + col0;
#pragma unroll
        for (int bj = 0; bj < 2; ++bj) {
          float xv[8];
          unpack8(*(const uint4*)(xr + bj * 128), xv);
          f32x4 x0 = {xv[0], xv[1], xv[2], xv[3]}, x1 = {xv[4], xv[5], xv[6], xv[7]};
          x0 += gv[bj][0] * acc[ai][bj][m][0]; x1 += gv[bj][1] * acc[ai][bj][m][1];
          *(uint4*)(xr + bj * 128) = pk8(x0, x1);
        }
      }
    return false;
  }
};
__device__ void phase_resid_gemm(const Params& p, int l, int g, const char* A, const char* W, int K, int gidx, char* lds, float* dummy = nullptr) {
  pg8::PlainSched S{A, W, (unsigned)K * 2u, (unsigned)K * 2u, K / 64, NTOK / 256, 4, (int)gridDim.x, (int)blockIdx.x, (l == DEPTH - 1) ? 1 : 0};
  EpiResid E{&p, (const float*)(p.ws + OFF_MOD) + (size_t)l * 33 * 6144, g, gidx, dummy};
  pg8::gemm_stream((LAS unsigned char*)lds, S, E);
}

struct EpiFF1 {
  u16* Hid;
  DI bool operator()(f32x4 (&acc)[2][2][4][2], const pg8::UDesc& u, int wr, int wc, int fr, int fq) const {
    const int row0 = u.pm * 256 + wr * 64 + fr, col0 = u.pn * 256 + wc * 32 + 8 * fq;
#pragma unroll
    for (int ai = 0; ai < 2; ++ai)
#pragma unroll
      for (int m = 0; m < 4; ++m) {
        const size_t row = (size_t)(row0 + ai * 128 + m * 16);
#pragma unroll
        for (int bj = 0; bj < 2; ++bj) {
          f32x4 a = acc[ai][bj][m][0], b = acc[ai][bj][m][1];
#pragma unroll
          for (int e = 0; e < 4; ++e) { float t = fmaxf(a[e], 0.f); a[e] = t * t; t = fmaxf(b[e], 0.f); b[e] = t * t; }
          *(uint4*)(Hid + row * DFF + col0 + bj * 128) = pk8(a, b);
        }
      }
    return false;
  }
};
__device__ void phase_ff1(const Params& p, int l, char* lds, int lat_only) {
  pg8::PlainSched S{p.ws + OFF_H, wsel(p, l) + OFF_W1T, 2048u, 2048u, 16, NTOK / 256, 16, (int)gridDim.x, (int)blockIdx.x, lat_only};
  EpiFF1 E{(u16*)(p.ws + OFF_P)};
  pg8::gemm_stream((LAS unsigned char*)lds, S, E);
}

__device__ void phase_final(const Params& p) {
  const int tid = otid(), lane = tid & 63, wid = tid >> 6;
  for (int tok = blockIdx.x * 8 + wid; tok < NBATCH * SEQ; tok += gridDim.x * 8) {
    float* xr = p.out + (size_t)tok * DM;
    const u16* xs = (const u16*)(p.ws + OFF_XL) + (size_t)tok * DM;
    float4 v[4]; float ss = 0.f;
#pragma unroll
    for (int j = 0; j < 4; ++j) {
      const uint2 q = *(const uint2*)(xs + j * 256 + lane * 4);
      v[j].x = __uint_as_float(q.x << 16); v[j].y = __uint_as_float(q.x & 0xffff0000u); v[j].z = __uint_as_float(q.y << 16); v[j].w = __uint_as_float(q.y & 0xffff0000u);
      ss += v[j].x * v[j].x + v[j].y * v[j].y + v[j].z * v[j].z + v[j].w * v[j].w;
    }
    ss = wave_sum(ss);
    const float rstd = rsqrtf(ss * (1.f / DM) + EPS);
#pragma unroll
    for (int j = 0; j < 4; ++j) {
      int c = j * 256 + lane * 4;
      float4 gg = *(const float4*)(p.gfin + c);
      float4 o = {v[j].x * rstd * gg.x, v[j].y * rstd * gg.y, v[j].z * rstd * gg.z, v[j].w * rstd * gg.w};
      *(float4*)(xr + c) = o;
    }
  }
}

#define XB_TMO      128
#define XB_XCNT(j)  (256  + 64 * (j))
#define XB_XSUB(j)  (1280 + 64 * (j))
#define XB_XGEN(j)  (2304 + 64 * (j))
#define XB_TOP      3328
#define XB_TOPGEN   3392
#define XCD_BAR_WORDS 3456
#define XB_SPIN_CAP (1u << 18)
DI unsigned xb_ld(unsigned* p) { return __hip_atomic_load(p, __ATOMIC_RELAXED, __HIP_MEMORY_SCOPE_AGENT); }
DI unsigned xb_add(unsigned* p, unsigned v) { return __hip_atomic_fetch_add(p, v, __ATOMIC_RELAXED, __HIP_MEMORY_SCOPE_AGENT); }
DI unsigned xb_xcc_id() { return (unsigned)__builtin_amdgcn_s_getreg((3 << 11) | 20) & 0xFu; }
#define XB_SPIN(cond, bar) do { unsigned _sp = 0; while (cond) { __builtin_amdgcn_s_sleep(1); \
    if ((++_sp & 255u) == 0u) { if (xb_ld(&(bar)[XB_TMO])) break; if (_sp > XB_SPIN_CAP) { atomicAdd(&(bar)[XB_TMO], 1u); break; } } } } while (0)
struct XcdBarrier { unsigned* bar; unsigned x; volatile __attribute__((address_space(3))) unsigned* st; };
DI XcdBarrier xcd_barrier_post(unsigned* bar, volatile __attribute__((address_space(3))) unsigned* st) {
  XcdBarrier b; b.bar = bar; b.x = xb_xcc_id(); b.st = st;
  if (threadIdx.x == 0) (void)xb_add(&bar[XB_XCNT(b.x)], 1u);
  return b;
}
DI void xcd_barrier_complete(unsigned* bar, unsigned x, unsigned& nloc, unsigned& nx) {
  const unsigned G = gridDim.x * gridDim.y * gridDim.z;
  unsigned sum, cnt, mine, sp = 0u;
  for (;;) {
    sum = 0u; cnt = 0u; mine = 0u;
#pragma unroll
    for (unsigned j = 0; j < 16; ++j) { const unsigned c = xb_ld(&bar[XB_XCNT(j)]); sum += c; cnt += (c > 0u) ? 1u : 0u; mine = (j == x) ? c : mine; }
    if (sum == G) break;
    __builtin_amdgcn_s_sleep(1);
    if ((++sp & 255u) == 0u) { if (xb_ld(&bar[XB_TMO])) break; if (sp > XB_SPIN_CAP) { atomicAdd(&bar[XB_TMO], 1u); break; } }
  }
  nloc = mine > 0u ? mine : 1u; nx = cnt > 0u ? cnt : 1u;
}
DI void xcd_barrier(const XcdBarrier& b) {
  asm volatile("s_waitcnt vmcnt(0)" ::: "memory");
  __syncthreads();
  if (threadIdx.x == 0) {
    unsigned* bar = b.bar;
    __builtin_amdgcn_s_waitcnt(0);
    unsigned nloc = b.st[0], nx = b.st[1];
    if (nloc == 0u) { xcd_barrier_complete(bar, b.x, nloc, nx); b.st[0] = nloc; b.st[1] = nx; }
    const unsigned old = xb_add(&bar[XB_XSUB(b.x)], 1u);
    const unsigned gen = old / nloc;
    if (old + 1u == (gen + 1u) * nloc) {
      __builtin_amdgcn_fence(__ATOMIC_RELEASE, "agent");
      asm volatile("s_waitcnt vmcnt(0)" ::: "memory");
      const unsigned og = xb_add(&bar[XB_TOP], 1u);
      const unsigned tg = og / nx;
      if (og + 1u == (tg + 1u) * nx) xb_add(&bar[XB_TOPGEN], 1u);
      else XB_SPIN(xb_ld(&bar[XB_TOPGEN]) == tg, bar);
      __builtin_amdgcn_fence(__ATOMIC_ACQUIRE, "agent");
      xb_add(&bar[XB_XGEN(b.x)], 1u);
      asm volatile("s_waitcnt vmcnt(0)" ::: "memory");
    } else {
      XB_SPIN(xb_ld(&bar[XB_XGEN(b.x)]) == gen, bar);
      __builtin_amdgcn_fence(__ATOMIC_ACQUIRE, "agent");
      asm volatile("s_waitcnt vmcnt(0)" ::: "memory");
    }
  }
  __syncthreads();
}

constexpr int NSUB = 12;
constexpr int NPHASE = 1 + DEPTH * NG * NSUB + 1;

__global__ void __launch_bounds__(512) mega(Params p, int ph_lo, int ph_hi) {
  extern __shared__ __attribute__((aligned(16))) char lds[];
  volatile __attribute__((address_space(3))) unsigned* st = (volatile __attribute__((address_space(3))) unsigned*)(lds + LDS_BYTES - 32);
  if (threadIdx.x < 2) st[threadIdx.x] = 0u;
  __syncthreads();
  XcdBarrier xb{};
  if (ph_hi - ph_lo > 1) xb = xcd_barrier_post((unsigned*)(p.ws + OFF_BAR), st);
#define GSYNC() xcd_barrier(xb)
  for (int ph = ph_lo; ph < ph_hi; ++ph) {
    if (ph > 0 && ph < NPHASE - 1 && ((ph - 1) % NSUB) == 0 && ((ph - 1) / NSUB) != 0) continue;
    if (ph == 0) { phase_prep(p, lds); phase_wconv(p, 0, lds); }
    else if (ph == NPHASE - 1) phase_final(p);
    else {
      const int q = ph - 1, lg = q / NSUB, sub = q % NSUB, l = lg / NG, g = lg % NG;
      switch (sub) {
        case 0: if (lg == 0) phase_norm(p, l, g, 0); break;
        case 1: for (int rep = 0; rep < ((PROBE & 2) ? 2 : 1); ++rep) { if (rep) GSYNC(); phase_inproj(p, l, lds); } break;
        case 2: phase_tokprep(p, l); break;
        case 3: phase_mlaup(p, l, lds); break;
        case 4: phase_mixers(p, l, g, lds); if (PROBE & 1) { GSYNC(); phase_mixers(p, l, g, lds, 8); } if (PROBE & 4) { GSYNC(); phase_mixers(p, l, g, lds, 8, true); } if (PROBE & 16) { GSYNC(); phase_mixers(p, l, g, lds, 8, true, true); } break;
        case 5: for (int rep = 0; rep < ((PROBE & 8) ? 2 : 1); ++rep) { if (rep) GSYNC(); phase_readout(p, l); } break;
        case 6: for (int rep = 0; rep < ((PROBE & 2) ? 2 : 1); ++rep) { if (rep) GSYNC(); phase_gate(p, l, lds, l == DEPTH - 1); } break;
        case 7: for (int rep = 0; rep < ((PROBE & 32) ? 2 : 1); ++rep) { if (rep) GSYNC(); phase_branch(p, l, lds, l == DEPTH - 1); } if (g == 0 && l + 1 < DEPTH) phase_wconv(p, l + 1, lds, (int*)(p.ws + OFF_CNT) + 24 + l); break;
        case 8: for (int rep = 0; rep < ((PROBE & 64) ? 2 : 1); ++rep) { if (rep) GSYNC(); phase_resid_gemm(p, l, g, p.ws + OFF_OA, wsel(p, l) + OFF_WOT, DM, 2, lds, rep ? (float*)((char*)p.out) : nullptr); } break;
        case 9: for (int rep = 0; rep < ((PROBE & 8) ? 2 : 1); ++rep) { if (rep) GSYNC(); phase_norm(p, l, g, 1); } break;
        case 10: for (int rep = 0; rep < ((PROBE & 2) ? 2 : 1); ++rep) { if (rep) GSYNC(); phase_ff1(p, l, lds, l == DEPTH - 1); } break;
        default: for (int rep = 0; rep < ((PROBE & 64) ? 2 : 1); ++rep) { if (rep) GSYNC(); phase_resid_gemm(p, l, g, p.ws + OFF_P, wsel(p, l) + OFF_W2T, DFF, 5, lds, rep ? (float*)((char*)p.out) : nullptr); } if (lg + 1 < DEPTH * NG) phase_norm_dyn(p, (lg + 1) / NG, (lg + 1) % NG, (int*)(p.ws + OFF_CNT) + 16 + lg); break;
      }
    }
    if (ph + 1 < ph_hi) { if (ph == ph_lo) cg::this_grid().sync(); else GSYNC(); }
  }
}

extern "C" void kernel_launch(void* const* d_in, const int* in_sizes, int n_in, void* d_out, int out_size, void* d_ws,
                              size_t ws_size, hipStream_t stream) {
  static int grid_blocks = 0;
  if (!grid_blocks) {
    int dev = 0, cus = 0, per_cu = 0;
    (void)hipGetDevice(&dev);
    (void)hipDeviceGetAttribute(&cus, hipDeviceAttributeMultiprocessorCount, dev);
    (void)hipFuncSetAttribute((const void*)mega, hipFuncAttributeMaxDynamicSharedMemorySize, LDS_BYTES);
    (void)hipOccupancyMaxActiveBlocksPerMultiprocessor(&per_cu, mega, NTHR, LDS_BYTES);
    if (per_cu < 1) per_cu = 1;
    if (per_cu > 1) per_cu = 1;
    grid_blocks = cus * per_cu;
  }
  if (ws_size < WS_NEED) { fprintf(stderr, "workspace too small: %zu < %zu\n", ws_size, (size_t)WS_NEED); }
  Params p{};
  const float** pf = (const float**)&p;
  for (int i = 0; i < 26; ++i) pf[i] = (const float*)d_in[i];
  p.out = (float*)d_out;
  p.ws = (char*)d_ws;
  (void)hipMemsetAsync((char*)d_ws + OFF_CNT, 0, 256 + 3456 * 4, stream);
#if ONE_LAUNCH
  int lo = 0, hi = NPHASE;
  void* args[] = {&p, &lo, &hi};
  hipError_t e = hipLaunchCooperativeKernel((void*)mega, dim3(grid_blocks), dim3(NTHR), args, LDS_BYTES, stream);
  if (e != hipSuccess) fprintf(stderr, "cooperative launch failed: %s (grid %d)\n", hipGetErrorString(e), grid_blocks);
#else
  for (int ph = 0; ph < NPHASE; ++ph) mega<<<grid_blocks, NTHR, LDS_BYTES, stream>>>(p, ph, ph + 1);
#endif
}
```

```cpp
#include <hip/hip_runtime.h>
#include <hip/hip_cooperative_groups.h>
#include <cstdio>
#include <cstdint>
namespace cg = cooperative_groups;

#ifndef PROBE
#define PROBE 0
#endif
#ifndef ONE_LAUNCH
#define ONE_LAUNCH 1
#endif

typedef unsigned short u16;
typedef short bf16x8 __attribute__((ext_vector_type(8)));
typedef short s16x4 __attribute__((ext_vector_type(4)));
typedef float f32x16 __attribute__((ext_vector_type(16)));
typedef float f32x2v __attribute__((ext_vector_type(2)));
typedef __bf16 bf16x2v __attribute__((ext_vector_type(2)));
#define DI __device__ __forceinline__
#define MFMA(a, b, c) __builtin_amdgcn_mfma_f32_32x32x16_bf16((a), (b), (c), 0, 0, 0)

constexpr int DM = 1024, NBATCH = 32, SEQ = 2048, CTXL = 256, DEPTH = 4, DFF = 4096;
constexpr int NG = 2, NB = 16, TPB = 2304, NTOK = NB * TPB;
constexpr int PS = 5376, NPC = 5328, INW = 9424;
constexpr int A_I = 0, A_FF = 512, A_FB = 1024, B_K = 1536, B_V = 1792, B_G = 2304, C_K = 2320, C_V = 2448,
              D_CKV = 2576, D_KR = 2704, A_Q = 2768, A_G = 3280, B_Q = 3792, B_O = 4048, C_Q = 4560, D_CQ = 5072;
constexpr float EPS = 1e-6f;
constexpr float LOG2E = 1.4426950408889634f;

constexpr size_t al256(size_t x) { return (x + 255) & ~(size_t)255; }
constexpr size_t OFF_WINT = 0;
constexpr size_t OFF_WGT = OFF_WINT + al256((size_t)PS * 1024 * 2);
constexpr size_t OFF_WBT = OFF_WGT + al256((size_t)4096 * 1024 * 2);
constexpr size_t OFF_WOT = OFF_WBT + al256((size_t)4 * 1024 * 512 * 2);
constexpr size_t OFF_W1T = OFF_WOT + al256((size_t)1024 * 1024 * 2);
constexpr size_t OFF_W2T = OFF_W1T + al256((size_t)4096 * 1024 * 2);
constexpr size_t OFF_WUQ = OFF_W2T + al256((size_t)1024 * 4096 * 2);
constexpr size_t OFF_WUK = OFF_WUQ + al256((size_t)768 * 256 * 2);
constexpr size_t OFF_WUV = OFF_WUK + al256((size_t)512 * 128 * 2);
constexpr size_t OFF_MOD = OFF_WUV + al256((size_t)512 * 128 * 2);
constexpr size_t OFF_LB = OFF_MOD + al256((size_t)4 * 33 * 6144 * 4);
constexpr size_t OFF_ROPE = OFF_LB + al256((size_t)4 * 2 * 512 * 4);
constexpr size_t OFF_CNT = OFF_ROPE + al256((size_t)2 * 64 * 16 * 4);
constexpr size_t OFF_BAR = OFF_CNT + 256;
constexpr size_t OFF_XC = OFF_BAR + al256(3456 * 4);
constexpr size_t OFF_XL = OFF_XC + al256((size_t)NBATCH * CTXL * DM * 2);
constexpr size_t OFF_P = OFF_XL + al256((size_t)NBATCH * SEQ * DM * 2);
constexpr size_t OFF_GB = OFF_P + al256((size_t)NTOK * PS * 2);
constexpr size_t OFF_KQ = OFF_GB + al256((size_t)NTOK * 16 * 4);
constexpr size_t OFF_H = OFF_KQ + al256((size_t)NTOK * 512 * 2);
constexpr size_t OFF_QD = OFF_H + al256((size_t)NTOK * 1024 * 2);
constexpr size_t OFF_KD = OFF_QD + al256((size_t)NTOK * 768 * 2);
constexpr size_t OFF_VD = OFF_KD + al256((size_t)NTOK * 768 * 2);
constexpr size_t OFF_OA = OFF_VD + al256((size_t)NTOK * 512 * 2);
constexpr size_t OFF_OB = OFF_OA + al256((size_t)2 * NTOK * 512 * 2);
constexpr size_t OFF_W2ND = OFF_OB + al256((size_t)2 * NTOK * 512 * 2);
constexpr size_t WS_NEED = OFF_W2ND + (OFF_MOD - OFF_WINT);
constexpr int LDS_BYTES = 143360;
constexpr int LDSV = 69632;
constexpr int NTHR = 512;
constexpr size_t OFF_MF = OFF_QD;

struct Params {
  const float *x, *c, *ctx, *c_ctx, *w_ada, *b_ada, *g1, *g2, *w_in, *bgate, *lblog, *hnorm, *convw, *mnorm,
      *gqn, *gkn, *mqn, *mkvn, *wuq, *wuk, *wuv, *wbr, *wout, *wff1, *wff2, *gfin;
  float* out;
  char* ws;
};

DI int otid() { int t = threadIdx.x; asm volatile("" : "+v"(t)); return t; }
DI char* wsel(const Params& p, int l) { return p.ws + ((l & 1) ? OFF_W2ND : (size_t)0); }
DI float bf2f(u16 v) { return __uint_as_float(((unsigned)v) << 16); }
DI unsigned pack2(float a, float b) {
  f32x2v v = {a, b};
  bf16x2v r = __builtin_convertvector(v, bf16x2v);
  return __builtin_bit_cast(unsigned, r);
}
DI u16 f2bf(float a) { return (u16)(pack2(a, 0.f) & 0xffffu); }
DI int crow(int reg, int h) { return (reg & 3) + 8 * (reg >> 2) + 4 * h; }
DI float sigmoidf_(float x) { return 1.f / (1.f + __expf(-x)); }
DI float siluf_(float x) { return x / (1.f + __expf(-x)); }
DI float ex2(float x) { return __builtin_amdgcn_exp2f(x); }
DI bf16x8 pack8(const f32x16& x, int s) {
  union { unsigned u[4]; bf16x8 v; } t;
  t.u[0] = pack2(x[8 * s + 0], x[8 * s + 1]);
  t.u[1] = pack2(x[8 * s + 2], x[8 * s + 3]);
  t.u[2] = pack2(x[8 * s + 4], x[8 * s + 5]);
  t.u[3] = pack2(x[8 * s + 6], x[8 * s + 7]);
  return t.v;
}
DI bf16x8 cat4(s16x4 lo, s16x4 hi) { return __builtin_shufflevector(lo, hi, 0, 1, 2, 3, 4, 5, 6, 7); }
DI float wave_sum(float v) {
#pragma unroll
  for (int d = 32; d >= 1; d >>= 1) v += __shfl_xor(v, d);
  return v;
}
DI void unpack8(const uint4& q, float* f) {
  f[0] = __uint_as_float(q.x << 16); f[1] = __uint_as_float(q.x & 0xffff0000u);
  f[2] = __uint_as_float(q.y << 16); f[3] = __uint_as_float(q.y & 0xffff0000u);
  f[4] = __uint_as_float(q.z << 16); f[5] = __uint_as_float(q.z & 0xffff0000u);
  f[6] = __uint_as_float(q.w << 16); f[7] = __uint_as_float(q.w & 0xffff0000u);
}
DI uint4 pack8f(const float* f) {
  uint4 q;
  q.x = pack2(f[0], f[1]); q.y = pack2(f[2], f[3]); q.z = pack2(f[4], f[5]); q.w = pack2(f[6], f[7]);
  return q;
}

DI u16* xrow_ptr(const Params& p, int g, int tok, int& modrow) {
  int bl = tok / TPB, pp = tok - bl * TPB, b = g * NB + bl;
  if (pp < CTXL) { modrow = 32; return (u16*)(p.ws + OFF_XC) + ((size_t)b * CTXL + pp) * DM; }
  modrow = b;
  return (u16*)(p.ws + OFF_XL) + ((size_t)b * SEQ + (pp - CTXL)) * DM;
}

#define LAS __attribute__((address_space(3)))
typedef float f32x4 __attribute__((ext_vector_type(4)));
namespace pg8 {
constexpr int BM = 256, BK = 64, HALF = 128, HTB = HALF * BK * 2, STAGE_BYTES = 8 * HTB, NXCD = 8, WGM = 8;
DI int lds_byte(int r, int c) { const int st = (r >> 4) * 2 + (c >> 5), rr = r & 15, cc = c & 31, ob = rr * 64 + cc * 2; return st * 1024 + (ob ^ (((ob >> 9) & 1) << 5)); }
DI void stage_rc(int b, int& R, int& C) { const int st = b / 1024, sb = b % 1024, swz = sb ^ (((sb >> 9) & 1) << 5); R = (st >> 1) * 16 + swz / 64; C = (st & 1) * 32 + (swz % 64) / 2; }
DI int perm32(int rho) { const int n = rho >> 4, i = rho & 15; return 8 * (i >> 2) + 4 * n + (i & 3); }
struct UDesc { const char* A; const char* B; unsigned lda2, ldb2; int nt, pm, pn, tag; };
DI bool tile_order(long L, int nM, int nN, int& pm, int& pn) {
  const int nwg = nM * nN; if (L >= nwg) return false;
  int wgid = (int)L; { const int q = nwg / NXCD, r = nwg % NXCD, xcd = wgid % NXCD, off = wgid / NXCD; wgid = (xcd < r ? xcd * (q + 1) : r * (q + 1) + (xcd - r) * q) + off; }
  const int nig = WGM * nN, gid = wgid / nig, fm = gid * WGM, gsz = (nM - fm) < WGM ? (nM - fm) : WGM;
  pm = fm + ((wgid % nig) % gsz); pn = (wgid % nig) / gsz; return true;
}
template <class Epi, class Sched>
DI void gemm_stream(LAS unsigned char* lds, const Sched& S, const Epi& E) {
  const int tid = otid(), wid = __builtin_amdgcn_readfirstlane(tid >> 6), lane = tid & 63, wr = wid >> 2, wc = wid & 3, fr = lane & 15, fq = lane >> 4;
  int RA[2], RB[2], CC[2];
#pragma unroll
  for (int i = 0; i < 2; ++i) { int R, C; stage_rc(tid * 16 + i * 8192, R, C); RA[i] = R; RB[i] = (R & ~31) + perm32(R & 31); CC[i] = C * 2; }
  const size_t kstep = (size_t)(BK * 2);
  const unsigned ldsw = (unsigned)wid * 1024u;
  const int aoff = lds_byte(wr * 64 + fr, fq * 8), boff = lds_byte(wc * 32 + fr, fq * 8);
#define PG8_SA(b, h) (((b) * 2 + (h)) * HTB)
#define PG8_SB(b, h) ((4 + (b) * 2 + (h)) * HTB)
#define PG8_STAGE(bufoff, gbase, voff) do { _Pragma("unroll") for (int _i = 0; _i < 2; ++_i) \
    __builtin_amdgcn_global_load_lds((const unsigned*)((const char*)(gbase) + (voff)[_i]), (LAS unsigned*)(lds + (bufoff) + ldsw + _i * 8192), 16, 0, 0); } while (0)
#define PG8_LDA(dst, b, h) do { _Pragma("unroll") for (int m = 0; m < 4; ++m) _Pragma("unroll") for (int k = 0; k < 2; ++k) dst[m][k] = *(const LAS bf16x8*)(lds + PG8_SA(b, h) + aoff + m * 2048 + k * 1024); } while (0)
#define PG8_LDB(dst, b, h) do { _Pragma("unroll") for (int n = 0; n < 2; ++n) _Pragma("unroll") for (int k = 0; k < 2; ++k) dst[n][k] = *(const LAS bf16x8*)(lds + PG8_SB(b, h) + boff + n * 2048 + k * 1024); } while (0)
#define PG8_MMA(ai, bj, At, Bt) do { __builtin_amdgcn_s_setprio(1); _Pragma("unroll") for (int m = 0; m < 4; ++m) _Pragma("unroll") for (int n = 0; n < 2; ++n) _Pragma("unroll") for (int k = 0; k < 2; ++k) \
    acc[ai][bj][m][n] = __builtin_amdgcn_mfma_f32_16x16x32_bf16(Bt[n][k], At[m][k], acc[ai][bj][m][n], 0, 0, 0); __builtin_amdgcn_s_setprio(0); } while (0)
#define PG8_WAIT_V(n) asm volatile("s_waitcnt vmcnt(" #n ")" ::: "memory")
#define PG8_WAIT_L(n) asm volatile("s_waitcnt lgkmcnt(" #n ")" ::: "memory")
#define PG8_BAR __builtin_amdgcn_s_barrier()
#define PG8_SCHED __builtin_amdgcn_sched_barrier(0)
  UDesc cur, nxt; int ui = 0;
  if (!S.next(0, cur)) return;
  f32x4 acc[2][2][4][2];
#pragma unroll
  for (int a = 0; a < 2; ++a)
#pragma unroll
    for (int b = 0; b < 2; ++b)
#pragma unroll
      for (int m = 0; m < 4; ++m)
#pragma unroll
        for (int n = 0; n < 2; ++n) acc[a][b][m][n] = (f32x4){0.f, 0.f, 0.f, 0.f};
  bf16x8 At[4][2], B0[2][2], B1[2][2];
  const char* cA = cur.A; const char* cB = cur.B;
  unsigned vA[2], vB[2];
#pragma unroll
  for (int i = 0; i < 2; ++i) { vA[i] = (unsigned)RA[i] * cur.lda2 + CC[i]; vB[i] = (unsigned)RB[i] * cur.ldb2 + CC[i]; }
  size_t hA = (size_t)HALF * cur.lda2, hB = (size_t)HALF * cur.ldb2;
  PG8_STAGE(PG8_SB(0, 0), cB, vB); PG8_STAGE(PG8_SA(0, 0), cA, vA); PG8_STAGE(PG8_SB(0, 1), cB + hB, vB); PG8_STAGE(PG8_SA(0, 1), cA + hA, vA);
  if (wr == 1) PG8_BAR;
  PG8_WAIT_V(4); PG8_BAR;
  PG8_STAGE(PG8_SB(1, 0), cB + kstep, vB); PG8_STAGE(PG8_SA(1, 0), cA + kstep, vA); PG8_STAGE(PG8_SB(1, 1), cB + hB + kstep, vB);
  PG8_WAIT_V(6); PG8_BAR;
  for (;;) {
    const bool has_next = S.next(ui + 1, nxt);
    const char* nA = has_next ? nxt.A : cA; const char* nB = has_next ? nxt.B : cB;
    const unsigned nlda = has_next ? nxt.lda2 : cur.lda2, nldb = has_next ? nxt.ldb2 : cur.ldb2;
    unsigned nvA[2], nvB[2];
#pragma unroll
    for (int i = 0; i < 2; ++i) { nvA[i] = (unsigned)RA[i] * nlda + CC[i]; nvB[i] = (unsigned)RB[i] * nldb + CC[i]; }
    const size_t nhA = (size_t)HALF * nlda, nhB = (size_t)HALF * nldb;
    const int nt = cur.nt;
    for (int t = 0; t < nt; t += 2) {
      const bool last = (t == nt - 2);
      const char* a1 = cA + (size_t)(t + 1) * kstep;
      const char* a2 = last ? nA : cA + (size_t)(t + 2) * kstep; const char* b2 = last ? nB : cB + (size_t)(t + 2) * kstep;
      const char* a3 = a2 + kstep; const char* b3 = b2 + kstep;
      unsigned v2A[2], v2B[2];
#pragma unroll
      for (int i = 0; i < 2; ++i) { v2A[i] = last ? nvA[i] : vA[i]; v2B[i] = last ? nvB[i] : vB[i]; }
      const size_t h2A = last ? nhA : hA, h2B = last ? nhB : hB;
      PG8_LDB(B0, 0, 0); PG8_SCHED; PG8_LDA(At, 0, 0); PG8_STAGE(PG8_SA(1, 1), a1 + hA, vA);
      PG8_WAIT_L(8); PG8_BAR; PG8_WAIT_L(0); PG8_MMA(0, 0, At, B0); PG8_BAR; PG8_SCHED;
      PG8_LDB(B1, 0, 1); PG8_STAGE(PG8_SB(0, 0), b2, v2B);
      PG8_BAR; PG8_WAIT_L(0); PG8_MMA(0, 1, At, B1); PG8_BAR;
      PG8_LDA(At, 0, 1); PG8_STAGE(PG8_SA(0, 0), a2, v2A);
      PG8_BAR; PG8_WAIT_L(0); PG8_MMA(1, 0, At, B0); PG8_BAR; PG8_SCHED;
      PG8_STAGE(PG8_SB(0, 1), b2 + h2B, v2B);
      PG8_WAIT_V(6); PG8_BAR; PG8_MMA(1, 1, At, B1); PG8_BAR;
      PG8_LDB(B0, 1, 0); PG8_SCHED; PG8_LDA(At, 1, 0); PG8_STAGE(PG8_SA(0, 1), a2 + h2A, v2A);
      PG8_WAIT_L(8); PG8_BAR; PG8_WAIT_L(0); PG8_MMA(0, 0, At, B0); PG8_BAR; PG8_SCHED;
      PG8_LDB(B1, 1, 1); PG8_STAGE(PG8_SB(1, 0), b3, v2B);
      PG8_BAR; PG8_WAIT_L(0); PG8_MMA(0, 1, At, B1); PG8_BAR;
      PG8_LDA(At, 1, 1); PG8_STAGE(PG8_SA(1, 0), a3, v2A);
      PG8_BAR; PG8_WAIT_L(0); PG8_MMA(1, 0, At, B0); PG8_BAR; PG8_SCHED;
      PG8_STAGE(PG8_SB(1, 1), b3 + h2B, v2B);
      PG8_WAIT_V(6); PG8_BAR; PG8_MMA(1, 1, At, B1); PG8_BAR;
    }
    const bool keep = E(acc, cur, wr, wc, fr, fq);
    if (!has_next) break;
    if (!keep) {
#pragma unroll
      for (int a = 0; a < 2; ++a)
#pragma unroll
        for (int b = 0; b < 2; ++b)
#pragma unroll
          for (int m = 0; m < 4; ++m)
#pragma unroll
            for (int n = 0; n < 2; ++n) acc[a][b][m][n] = (f32x4){0.f, 0.f, 0.f, 0.f};
    }
    cur = nxt; cA = nA; cB = nB; hA = nhA; hB = nhB;
#pragma unroll
    for (int i = 0; i < 2; ++i) { vA[i] = nvA[i]; vB[i] = nvB[i]; }
    ++ui;
  }
  PG8_WAIT_V(0);
  if (wr == 0) PG8_BAR;
  PG8_BAR;
#undef PG8_SA
#undef PG8_SB
#undef PG8_STAGE
#undef PG8_LDA
#undef PG8_LDB
#undef PG8_MMA
#undef PG8_WAIT_V
#undef PG8_WAIT_L
#undef PG8_BAR
#undef PG8_SCHED
}
struct PlainSched {
  const char* A; const char* B; unsigned lda2, ldb2; int nt, nM, nN, G, c; int lat_only = 0;
  DI bool next(int i, UDesc& u) const {
    int pm, pn; if (!tile_order((long)i * G + c, lat_only ? nM - NB : nM, nN, pm, pn)) return false;
    if (lat_only) pm = pm + (pm >> 3) + 1;
    u.A = A + (size_t)pm * 256 * lda2; u.B = B + (size_t)pn * 256 * ldb2; u.lda2 = lda2; u.ldb2 = ldb2; u.nt = nt; u.pm = pm; u.pn = pn; u.tag = 0; return true;
  }
};
}

DI uint4 pk8(const f32x4& a, const f32x4& b) {
  uint4 q; q.x = pack2(a[0], a[1]); q.y = pack2(a[2], a[3]); q.z = pack2(b[0], b[1]); q.w = pack2(b[2], b[3]); return q;
}

__device__ void phase_prep(const Params& p, char* lds) {
  const int tid = otid(), nthr = gridDim.x * NTHR, gt = blockIdx.x * NTHR + tid;
  {
    const float4* s = (const float4*)p.x; uint2* d = (uint2*)(p.ws + OFF_XL);
    const size_t n = (size_t)NBATCH * SEQ * DM / 4;
    for (size_t i = gt; i < n; i += nthr) { const float4 v = s[i]; uint2 o; o.x = pack2(v.x, v.y); o.y = pack2(v.z, v.w); d[i] = o; }
    const float4* s2 = (const float4*)p.ctx; uint2* d2 = (uint2*)(p.ws + OFF_XC);
    const size_t n2 = (size_t)NBATCH * CTXL * DM / 4;
    for (size_t i = gt; i < n2; i += nthr) { const float4 v = s2[i]; uint2 o; o.x = pack2(v.x, v.y); o.y = pack2(v.z, v.w); d2[i] = o; }
  }
  if (gt < 1024) {
    float v[DEPTH], mx = -1e30f;
    for (int l = 0; l < DEPTH; ++l) { v[l] = p.lblog[l * 1024 + gt]; mx = fmaxf(mx, v[l]); }
    float sum = 0.f;
    for (int l = 0; l < DEPTH; ++l) { v[l] = expf(v[l] - mx); sum += v[l]; }
    float* lb = (float*)(p.ws + OFF_LB);
    float run = 0.f;
    for (int l = 0; l < DEPTH; ++l) { lb[l * 1024 + gt] = run; if (l + 1 < DEPTH) run += v[l + 1] / sum; }
  }
  if (gt >= 1024 && gt < 2048) {
    int i = gt - 1024, pos = i >> 4, fi = i & 15;
    float inv = powf(10000.f, -(float)fi / 16.f);
    float ang = (float)pos * inv;
    float* rc = (float*)(p.ws + OFF_ROPE);
    rc[i] = cosf(ang); rc[1024 + i] = sinf(ang);
  }
  float* ssm = (float*)lds;
  float* red = (float*)lds + 2 * 33 * 32;
  for (int item = blockIdx.x; item < DEPTH * 24; item += gridDim.x) {
    const int l = item / 24, kh = tid >> 8, tl = tid & 255, j = (item % 24) * 256 + tl;
    float acc[33];
#pragma unroll
    for (int r = 0; r < 33; ++r) acc[r] = 0.f;
    const float* W = p.w_ada + (size_t)l * DM * 6144;
    for (int k0 = kh * 512; k0 < kh * 512 + 512; k0 += 32) {
      __syncthreads();
      for (int idx = tl; idx < 33 * 32; idx += 256) {
        int rr = idx >> 5, kk = idx & 31;
        float cv = rr < 32 ? p.c[rr * DM + k0 + kk] : p.c_ctx[k0 + kk];
        ssm[kh * 33 * 32 + idx] = cv / (1.f + expf(-cv));
      }
      __syncthreads();
#pragma unroll 4
      for (int kk = 0; kk < 32; ++kk) {
        float w = W[(size_t)(k0 + kk) * 6144 + j];
#pragma unroll
        for (int r = 0; r < 33; ++r) acc[r] += ssm[kh * 33 * 32 + r * 32 + kk] * w;
      }
    }
    __syncthreads();
    if (kh == 1) {
#pragma unroll
      for (int r = 0; r < 33; ++r) red[r * 256 + tl] = acc[r];
    }
    __syncthreads();
    if (kh == 0) {
      float bb = p.b_ada[l * 6144 + j];
      float* mod = (float*)(p.ws + OFF_MOD) + (size_t)l * 33 * 6144;
#pragma unroll
      for (int r = 0; r < 33; ++r) mod[r * 6144 + j] = acc[r] + red[r * 256 + tl] + bb;
    }
  }
  __syncthreads();
}

DI u16* wdst(char* wb, int type, int sub, int n) {
  switch (type) {
    case 0: return n < NPC ? (u16*)(wb + OFF_WINT) + (size_t)n * 1024 : (u16*)(wb + OFF_WGT) + (size_t)(n - NPC) * 1024;
    case 1: return (u16*)(wb + OFF_WBT) + ((size_t)sub * 1024 + n) * 512;
    case 2: return (u16*)(wb + OFF_WOT) + (size_t)n * 1024;
    case 3: return (u16*)(wb + OFF_W1T) + (size_t)n * 1024;
    case 4: return (u16*)(wb + OFF_W2T) + (size_t)n * 4096;
    case 5: return (u16*)(wb + OFF_WUQ) + (size_t)n * 256;
    case 6: return (u16*)(wb + OFF_WUK) + (size_t)n * 128;
    default: return (u16*)(wb + OFF_WUV) + (size_t)n * 128;
  }
}
__device__ void phase_wconv(const Params& p, int l, char* lds, int* cnt = nullptr) {
  char* wb = wsel(p, l);
  int* s_item = (int*)(lds + LDS_BYTES - 16);
  float* tile = (float*)lds;
  const int tid = otid();
  {
    unsigned* z = (unsigned*)((u16*)(wb + OFF_WINT) + (size_t)NPC * 1024);
    for (int i = blockIdx.x * NTHR + tid; i < (PS - NPC) * 1024 / 2; i += gridDim.x * NTHR) z[i] = 0u;
  }
  constexpr int T0 = 16 * 148, T1 = T0 + 4 * 128, T2 = T1 + 256, T3 = T2 + 1024, T4 = T3 + 1024, T5 = T4 + 48, T6 = T5 + 16, T7 = T6 + 16;
  for (int itk = 0;; ++itk) {
    int it;
    if (cnt) { __syncthreads(); if (tid == 0) *s_item = atomicAdd(cnt, 1); __syncthreads(); it = *s_item; }
    else it = blockIdx.x + itk * gridDim.x;
    if (it >= T7) break;
    int type, sub = 0, K, N, kt, nt;
    const float* src;
    if (it < T0) { type = 0; K = 1024; N = INW; int q = it; kt = q / 148; nt = q % 148; src = p.w_in + (size_t)l * 1024 * INW; }
    else if (it < T1) { type = 1; K = 512; N = 1024; int q = it - T0; sub = q / 128; q %= 128; kt = q / 16; nt = q % 16; src = p.wbr + ((size_t)l * 4 + sub) * 512 * 1024; }
    else if (it < T2) { type = 2; K = 1024; N = 1024; int q = it - T1; kt = q / 16; nt = q % 16; src = p.wout + (size_t)l * 1024 * 1024; }
    else if (it < T3) { type = 3; K = 1024; N = 4096; int q = it - T2; kt = q / 64; nt = q % 64; src = p.wff1 + (size_t)l * 1024 * 4096; }
    else if (it < T4) { type = 4; K = 4096; N = 1024; int q = it - T3; kt = q / 16; nt = q % 16; src = p.wff2 + (size_t)l * 4096 * 1024; }
    else if (it < T5) { type = 5; K = 256; N = 768; int q = it - T4; kt = q / 12; nt = q % 12; src = p.wuq + (size_t)l * 256 * 768; }
    else if (it < T6) { type = 6; K = 128; N = 512; int q = it - T5; kt = q / 8; nt = q % 8; src = p.wuk + (size_t)l * 128 * 512; }
    else { type = 7; K = 128; N = 512; int q = it - T6; kt = q / 8; nt = q % 8; src = p.wuv + (size_t)l * 128 * 512; }
    (void)K;
    const int k0 = kt * 64, n0 = nt * 64;
    __syncthreads();
    {
      const int nn = tid & 63, ks = tid >> 6;
#pragma unroll 4
      for (int j = 0; j < 8; ++j) {
        int k = ks + 8 * j;
        tile[k * 65 + nn] = (n0 + nn < N) ? src[(size_t)(k0 + k) * N + n0 + nn] : 0.f;
      }
    }
    __syncthreads();
    {
      const int kp = tid & 31, nn = tid >> 5;
#pragma unroll 4
      for (int j = 0; j < 4; ++j) {
        int n = nn + 16 * j;
        if (n0 + n < N) {
          unsigned v = pack2(tile[(2 * kp) * 65 + n], tile[(2 * kp + 1) * 65 + n]);
          *(unsigned*)(wdst(wb, type, sub, n0 + n) + k0 + 2 * kp) = v;
        }
      }
    }
  }
  __syncthreads();
}

DI void norm_token(const Params& p, int l, int g, int which, int tok, int lane, const float* gn, const float* mod, u16* H) {
  int mr; const u16* xr = xrow_ptr(p, g, tok, mr);
  const float* shift = mod + (size_t)mr * 6144 + (which == 0 ? 0 : 3) * DM;
  const float* scale = shift + DM;
  float4 v[4]; float ss = 0.f;
#pragma unroll
  for (int j = 0; j < 4; ++j) {
    const uint2 q = *(const uint2*)(xr + j * 256 + lane * 4);
    v[j].x = __uint_as_float(q.x << 16); v[j].y = __uint_as_float(q.x & 0xffff0000u); v[j].z = __uint_as_float(q.y << 16); v[j].w = __uint_as_float(q.y & 0xffff0000u);
    ss += v[j].x * v[j].x + v[j].y * v[j].y + v[j].z * v[j].z + v[j].w * v[j].w;
  }
  ss = wave_sum(ss);
  const float rstd = rsqrtf(ss * (1.f / DM) + EPS);
#pragma unroll
  for (int j = 0; j < 4; ++j) {
    int c = j * 256 + lane * 4;
    float4 gg = *(const float4*)(gn + c), sh = *(const float4*)(shift + c), sc = *(const float4*)(scale + c);
    float o0 = v[j].x * rstd * gg.x * (1.f + sc.x) + sh.x;
    float o1 = v[j].y * rstd * gg.y * (1.f + sc.y) + sh.y;
    float o2 = v[j].z * rstd * gg.z * (1.f + sc.z) + sh.z;
    float o3 = v[j].w * rstd * gg.w * (1.f + sc.w) + sh.w;
    uint2 o; o.x = pack2(o0, o1); o.y = pack2(o2, o3);
    *(uint2*)(H + (size_t)tok * DM + c) = o;
  }
}
DI void norm_load(const u16* xr, int lane, uint2 (&q)[4]) {
#pragma unroll
  for (int j = 0; j < 4; ++j) q[j] = *(const uint2*)(xr + j * 256 + lane * 4);
}
DI void norm_finish(const uint2 (&q)[4], int lane, const float* gn, const float* shift, u16* hrow) {
  const float* scale = shift + DM;
  float4 v[4]; float ss = 0.f;
#pragma unroll
  for (int j = 0; j < 4; ++j) {
    v[j].x = __uint_as_float(q[j].x << 16); v[j].y = __uint_as_float(q[j].x & 0xffff0000u); v[j].z = __uint_as_float(q[j].y << 16); v[j].w = __uint_as_float(q[j].y & 0xffff0000u);
    ss += v[j].x * v[j].x + v[j].y * v[j].y + v[j].z * v[j].z + v[j].w * v[j].w;
  }
  ss = wave_sum(ss);
  const float rstd = rsqrtf(ss * (1.f / DM) + EPS);
#pragma unroll
  for (int j = 0; j < 4; ++j) {
    int c = j * 256 + lane * 4;
    float4 gg = *(const float4*)(gn + c), sh = *(const float4*)(shift + c), sc = *(const float4*)(scale + c);
    float o0 = v[j].x * rstd * gg.x * (1.f + sc.x) + sh.x;
    float o1 = v[j].y * rstd * gg.y * (1.f + sc.y) + sh.y;
    float o2 = v[j].z * rstd * gg.z * (1.f + sc.z) + sh.z;
    float o3 = v[j].w * rstd * gg.w * (1.f + sc.w) + sh.w;
    uint2 o; o.x = pack2(o0, o1); o.y = pack2(o2, o3);
    *(uint2*)(hrow + c) = o;
  }
}
__device__ void phase_norm(const Params& p, int l, int g, int which) {
  const int tid = otid(), lane = tid & 63, wid = tid >> 6;
  const float* gn = (which == 0 ? p.g1 : p.g2) + l * DM;
  const float* mod = (const float*)(p.ws + OFF_MOD) + (size_t)l * 33 * 6144;
  u16* H = (u16*)(p.ws + OFF_H);
  const int stride = gridDim.x * 8;
  const bool skipc = which == 1 && l == DEPTH - 1;
  for (int tok = blockIdx.x * 8 + wid; tok < NTOK; tok += 2 * stride) {
    const int tokB = tok + stride;
    const bool doA = !(skipc && (tok % TPB) < CTXL), doB = tokB < NTOK && !(skipc && (tokB % TPB) < CTXL);
    int mrA = 0, mrB = 0;
    const u16* xa = xrow_ptr(p, g, tok, mrA);
    const u16* xb = xrow_ptr(p, g, doB ? tokB : tok, mrB);
    uint2 qa[4], qb[4];
    norm_load(xa, lane, qa);
    norm_load(xb, lane, qb);
    if (doA) norm_finish(qa, lane, gn, mod + (size_t)mrA * 6144 + (which == 0 ? 0 : 3) * DM, H + (size_t)tok * DM);
    if (doB) norm_finish(qb, lane, gn, mod + (size_t)mrB * 6144 + (which == 0 ? 0 : 3) * DM, H + (size_t)tokB * DM);
  }
}
__device__ void phase_norm_dyn(const Params& p, int l, int g, int* cnt) {
  const int tid = otid(), lane = tid & 63;
  const float* gn = p.g1 + l * DM;
  const float* mod = (const float*)(p.ws + OFF_MOD) + (size_t)l * 33 * 6144;
  u16* H = (u16*)(p.ws + OFF_H);
  for (;;) {
    int c = 0;
    if (lane == 0) c = atomicAdd(cnt, 1);
    c = __shfl(c, 0);
    if (c >= NTOK / 8) break;
    for (int t = 0; t < 8; ++t) norm_token(p, l, g, 0, c * 8 + t, lane, gn, mod, H);
  }
}

__device__ void phase_tokprep(const Params& p, int l) {
  const int tid = otid(), lane = tid & 63, wid = tid >> 6;
  u16* P = (u16*)(p.ws + OFF_P);
  u16* KQ = (u16*)(p.ws + OFF_KQ);
  u16* Kd = (u16*)(p.ws + OFF_KD);
  const float* rc = (const float*)(p.ws + OFF_ROPE);
  const float* rs = rc + 1024;
  const int c8 = lane & 7;
  for (int tok = blockIdx.x * 8 + wid; tok < NTOK; tok += gridDim.x * 8) {
    const int pp = tok % TPB;
    const bool lat = pp >= CTXL;
    const int pos = pp - CTXL, prow = pos >> 6, pcol = pos & 63;
    u16* row = P + (size_t)tok * PS;
    const uint4 zz = {0u, 0u, 0u, 0u};
    const uint4 pl_q = *(const uint4*)(row + C_Q + lane * 8);
    const uint4 pl_k = lane < 16 ? *(const uint4*)(row + C_K + lane * 8) : zz;
    const uint4 pl_m = *(const uint4*)(row + (lane < 16 ? D_CKV + lane * 8 : (lane >= 32 ? D_CQ + (lane - 32) * 8 : D_KR + ((lane - 16) & 7) * 8)));
    {
      const bool isk = lane < 32;
      const int cc = (isk ? lane : lane - 32) * 8;
      const int colb = (isk ? B_K : B_Q) + cc;
      const bool hasp = !(pp == 0 || pp == CTXL), hasn = !(pp == CTXL - 1 || pp == TPB - 1);
      float x0[8], x1[8], x2[8];
      uint4 q1 = *(const uint4*)(row + colb); unpack8(q1, x1);
      if (hasp) { uint4 q0 = *(const uint4*)(row - PS + colb); unpack8(q0, x0); } else { for (int e = 0; e < 8; ++e) x0[e] = 0.f; }
      if (hasn) { uint4 q2 = *(const uint4*)(row + PS + colb); unpack8(q2, x2); } else { for (int e = 0; e < 8; ++e) x2[e] = 0.f; }
      const float* cw = p.convw + ((size_t)l * 2 + (isk ? 1 : 0)) * 3 * 256 + cc;
      float o[8];
#pragma unroll
      for (int e = 0; e < 8; ++e) {
        float a = cw[e] * x0[e] + cw[256 + e] * x1[e] + cw[512 + e] * x2[e];
        a = siluf_(a);
        o[e] = isk ? a * 0.125f : a;
      }
      *(uint4*)(KQ + (size_t)tok * 512 + (isk ? 0 : 256) + cc) = pack8f(o);
    }
#pragma unroll
    for (int pass = 0; pass < 2; ++pass) {
      const bool act = pass == 0 || lane < 16;
      const int colb = (pass == 0 ? C_Q : C_K) + lane * 8;
      const float* gg = (pass == 0 ? p.gqn : p.gkn) + l * 64 + c8 * 8;
      float x[8];
      unpack8(pass == 0 ? pl_q : pl_k, x);
      float ss = 0.f;
#pragma unroll
      for (int e = 0; e < 8; ++e) ss += x[e] * x[e];
      ss += __shfl_xor(ss, 1); ss += __shfl_xor(ss, 2); ss += __shfl_xor(ss, 4);
      const float rstd = rsqrtf(ss * (1.f / 64.f) + EPS);
#pragma unroll
      for (int e = 0; e < 8; ++e) x[e] = x[e] * rstd * gg[e];
      float o[8];
#pragma unroll
      for (int e = 0; e < 8; ++e) {
        float other = __shfl_xor(x[e], 2);
        const int ppos = (c8 & 4) ? pcol : prow;
        const int fi = (c8 & 1) * 8 + e;
        float cs = 1.f, sn = 0.f;
        if (lat) { cs = rc[ppos * 16 + fi]; sn = rs[ppos * 16 + fi]; }
        o[e] = (c8 & 2) ? (x[e] * cs + other * sn) : (x[e] * cs - other * sn);
      }
      if (act) *(uint4*)(row + colb) = pack8f(o);
    }
    {
      const bool isckv = lane < 16, iscq = lane >= 32, iskr = lane >= 16 && lane < 24;
      int colb = isckv ? D_CKV + lane * 8 : (iscq ? D_CQ + (lane - 32) * 8 : D_KR + ((lane - 16) & 7) * 8);
      float x[8];
      unpack8(pl_m, x);
      float ss = 0.f;
#pragma unroll
      for (int e = 0; e < 8; ++e) ss += x[e] * x[e];
      ss += __shfl_xor(ss, 1); ss += __shfl_xor(ss, 2); ss += __shfl_xor(ss, 4); ss += __shfl_xor(ss, 8);
      float ss32 = ss + __shfl_xor(ss, 16);
      float o[8];
      if (isckv) {
        const float rstd = rsqrtf(ss * (1.f / 128.f) + EPS);
        const float* gg = p.mkvn + l * 128 + lane * 8;
        for (int e = 0; e < 8; ++e) o[e] = x[e] * rstd * gg[e];
      } else if (iscq) {
        const float rstd = rsqrtf(ss32 * (1.f / 256.f) + EPS);
        const float* gg = p.mqn + l * 256 + (lane - 32) * 8;
        for (int e = 0; e < 8; ++e) o[e] = x[e] * rstd * gg[e];
      } else {
        for (int e = 0; e < 8; ++e) o[e] = x[e];
      }
      float orot[8];
#pragma unroll
      for (int e = 0; e < 8; ++e) {
        float other = __shfl_xor(x[e], 2);
        const int ck = lane & 7;
        const int ppos = (ck & 4) ? pcol : prow;
        const int fi = (ck & 1) * 8 + e;
        float cs = 1.f, sn = 0.f;
        if (lat) { cs = rc[ppos * 16 + fi]; sn = rs[ppos * 16 + fi]; }
        orot[e] = (ck & 2) ? (x[e] * cs + other * sn) : (x[e] * cs - other * sn);
      }
      if (isckv || iscq) *(uint4*)(row + colb) = pack8f(o);
      if (iskr) {
        uint4 q = pack8f(orot);
        const int ck = lane & 7;
#pragma unroll
        for (int hd = 0; hd < 4; ++hd) *(uint4*)(Kd + (size_t)tok * 768 + hd * 192 + 128 + ck * 8) = q;
      }
    }
  }
}

template <int DK, int DV, bool ROPEQ>
__device__ void attn_item(const u16* __restrict__ qrow, const u16* __restrict__ Kp, int kst, const u16* __restrict__ Vp, int vst,
                          u16* __restrict__ orow, int nkeys, float sc, int pos, const float* __restrict__ rc, char* lds) {
  constexpr int KLD = DK + 8, VLD = DV + 32;
  constexpr int KB = 64 * KLD, VB = 64 * VLD;
  u16* KS = (u16*)lds;
  u16* VS = KS + 2 * KB;
  const int tid = otid(), lane = tid & 63, r = lane & 31, h = lane >> 5;
  bf16x8 qf[DK / 16];
  {
#pragma unroll
    for (int s = 0; s < DK / 16; ++s) qf[s] = *(const bf16x8*)(qrow + h * 8 + s * 16);
    if (ROPEQ && pos >= 0) {
      const int prow = pos >> 6, pcol = pos & 63;
      const float* rs = rc + 1024;
      constexpr int s0 = (DK - 64) / 16;
#pragma unroll
      for (int part = 0; part < 2; ++part) {
        const int ppos = part ? pcol : prow;
#pragma unroll
        for (int j = 0; j < 8; ++j) {
          const int fi = 8 * h + j;
          float cs = rc[ppos * 16 + fi], sn = rs[ppos * 16 + fi];
          float x1 = bf2f((u16)qf[s0 + 2 * part][j]), x2 = bf2f((u16)qf[s0 + 2 * part + 1][j]);
          qf[s0 + 2 * part][j] = (short)f2bf(x1 * cs - x2 * sn);
          qf[s0 + 2 * part + 1][j] = (short)f2bf(x2 * cs + x1 * sn);
        }
      }
    }
  }
  f32x16 oT[DV / 32];
#pragma unroll
  for (int d = 0; d < DV / 32; ++d)
#pragma unroll
    for (int e = 0; e < 16; ++e) oT[d][e] = 0.f;
  float m = -1e30f, lsum = 0.f;
  const int ntile = nkeys >> 6;
  constexpr int NKP = KB * 2 / 1024, NVP = VB * 2 / 1024, NKJ = (NKP + 7) / 8, NVJ = (NVP + 7) / 8;
  const int wu = __builtin_amdgcn_readfirstlane(tid >> 6);
  unsigned ksrc[NKJ], vsrc[NVJ];
#pragma unroll
  for (int j = 0; j < NKJ; ++j) { const int o = (wu + 8 * j) * 1024 + lane * 16, row = o / (KLD * 2), col = (o % (KLD * 2)) / 2; ksrc[j] = (unsigned)(row * kst + (col < DK ? col : 0)) * 2u; }
#pragma unroll
  for (int j = 0; j < NVJ; ++j) { const int o = (wu + 8 * j) * 1024 + lane * 16, row = o / (VLD * 2), col = (o % (VLD * 2)) / 2; vsrc[j] = (unsigned)(row * vst + (col < DV ? col : 0)) * 2u; }
#define ATT_DMA(kt_, buf_) do { \
    const char* kg_ = (const char*)Kp + (size_t)(kt_) * 64 * kst * 2; const char* vg_ = (const char*)Vp + (size_t)(kt_) * 64 * vst * 2; \
    _Pragma("unroll") for (int j = 0; j < NKJ; ++j) if (wu + 8 * j < NKP) \
      __builtin_amdgcn_global_load_lds((const unsigned*)(kg_ + ksrc[j]), (LAS unsigned*)((char*)KS + (buf_) * KB * 2 + (wu + 8 * j) * 1024), 16, 0, 0); \
    _Pragma("unroll") for (int j = 0; j < NVJ; ++j) if (wu + 8 * j < NVP) \
      __builtin_amdgcn_global_load_lds((const unsigned*)(vg_ + vsrc[j]), (LAS unsigned*)((char*)VS + (buf_) * VB * 2 + (wu + 8 * j) * 1024), 16, 0, 0); \
  } while (0)
  __syncthreads();
  ATT_DMA(0, 0);
  asm volatile("s_waitcnt vmcnt(0)" ::: "memory");
  __syncthreads();
  const int troff = ((lane & 15) >> 2) * VLD + 16 * ((lane >> 4) & 1) + 4 * (lane & 3) + 4 * h * VLD;
#pragma unroll 1
  for (int kt = 0; kt < ntile; ++kt) {
    const int buf = kt & 1;
    if (kt + 1 < ntile) ATT_DMA(kt + 1, buf ^ 1);
    const u16* KSb = KS + buf * KB;
    const u16* VSb = VS + buf * VB;
    f32x16 sT[2];
#pragma unroll
    for (int kk = 0; kk < 2; ++kk) {
#pragma unroll
      for (int e = 0; e < 16; ++e) sT[kk][e] = 0.f;
#pragma unroll
      for (int s = 0; s < DK / 16; ++s) {
        bf16x8 a = *(const bf16x8*)(KSb + (kk * 32 + r) * KLD + s * 16 + h * 8);
        sT[kk] = MFMA(a, qf[s], sT[kk]);
      }
    }
    float mx = -1e30f;
#pragma unroll
    for (int kk = 0; kk < 2; ++kk)
#pragma unroll
      for (int e = 0; e < 16; ++e) mx = fmaxf(mx, sT[kk][e]);
    mx = fmaxf(mx, __shfl_xor(mx, 32));
    const float mn = fmaxf(m, mx * sc);
    const float alpha = ex2(m - mn);
    m = mn;
    lsum *= alpha;
#pragma unroll
    for (int kk = 0; kk < 2; ++kk) {
      sT[kk] = sT[kk] * sc - mn;
#pragma unroll
      for (int e = 0; e < 16; ++e) sT[kk][e] = ex2(sT[kk][e]);
    }
    {
      f32x16 t16 = sT[0] + sT[1];
      typedef float f32x8v __attribute__((ext_vector_type(8)));
      typedef float f32x4v __attribute__((ext_vector_type(4)));
      f32x8v t8 = __builtin_shufflevector(t16, t16, 0, 1, 2, 3, 4, 5, 6, 7) + __builtin_shufflevector(t16, t16, 8, 9, 10, 11, 12, 13, 14, 15);
      f32x4v t4 = __builtin_shufflevector(t8, t8, 0, 1, 2, 3) + __builtin_shufflevector(t8, t8, 4, 5, 6, 7);
      lsum += (t4[0] + t4[1]) + (t4[2] + t4[3]);
    }
#pragma unroll
    for (int d = 0; d < DV / 32; ++d) oT[d] = oT[d] * alpha;
#pragma unroll
    for (int kk = 0; kk < 2; ++kk)
#pragma unroll
      for (int s2 = 0; s2 < 2; ++s2) {
        bf16x8 pb = pack8(sT[kk], s2);
#pragma unroll
        for (int d = 0; d < DV / 32; ++d) {
          const u16* vb = VSb + (kk * 32 + s2 * 16) * VLD + d * 32 + troff;
          s16x4 lo = __builtin_amdgcn_ds_read_tr16_b64_v4i16((LAS s16x4*)vb);
          s16x4 hi = __builtin_amdgcn_ds_read_tr16_b64_v4i16((LAS s16x4*)(vb + 8 * VLD));
          oT[d] = MFMA(cat4(lo, hi), pb, oT[d]);
        }
      }
    asm volatile("s_waitcnt vmcnt(0)" ::: "memory");
    __syncthreads();
  }
#undef ATT_DMA
  lsum += __shfl_xor(lsum, 32);
  const float inv = 1.f / lsum;
#pragma unroll
  for (int d = 0; d < DV / 32; ++d)
#pragma unroll
    for (int gq = 0; gq < 4; ++gq) {
      uint2 o;
      o.x = pack2(oT[d][4 * gq] * inv, oT[d][4 * gq + 1] * inv);
      o.y = pack2(oT[d][4 * gq + 2] * inv, oT[d][4 * gq + 3] * inv);
      *(uint2*)(orow + d * 32 + 8 * gq + 4 * h) = o;
    }
}

__device__ void scanA_unit(const Params& p, int l, int unit, char* lds) {
  const int tid = otid(), lane = tid & 63, wid = tid >> 6, r = lane & 31, h = lane >> 5;
  const int bl = unit >> 3, hd = (unit >> 1) & 3, dir = unit & 1;
  const u16* P = (const u16*)(p.ws + OFF_P);
  u16* Oa = (u16*)(p.ws + OFF_OA) + (size_t)dir * NTOK * 512;
  float* BC = (float*)lds;
  u16* Qs = (u16*)(lds + 33792);
  u16* KKs = (u16*)(lds + 51200);
  u16* AM = (u16*)(lds + 51200);
  u16* KT = (u16*)(lds + 68608);
  u16* VT = (u16*)(lds + 87040);
  u16* ST = (u16*)(lds + 105472);
  float* EL = (float*)(lds + 140288);
  float* QTOT = (float*)(lds + 140800);
  const int ch = tid & 15;
  float lbv[8];
  {
    const float* lb = (const float*)(p.ws + OFF_LB) + (size_t)l * 1024 + dir * 512 + hd * 128 + ch * 8;
#pragma unroll
    for (int e = 0; e < 8; ++e) lbv[e] = lb[e];
  }
  const int vt = wid & 3, th = wid >> 2;
  f32x16 S[2];
#pragma unroll
  for (int j = 0; j < 2; ++j)
#pragma unroll
    for (int e = 0; e < 16; ++e) S[j][e] = 0.f;
  __syncthreads();
  for (int i = tid; i < 128 * 136 / 2; i += NTHR) ((unsigned*)ST)[i] = 0u;
  uint4 pqr[2], pfr[2], pvr[2];
#define SCANA_TOK0(st_) (bl * TPB + ((st_) >= 4 ? CTXL : 0) + (dir ? ((st_) >= 4 ? 31 - ((st_) - 4) : 3 - (st_)) : ((st_) >= 4 ? (st_) - 4 : (st_))) * 64)
#define SCANA_PREFETCH(st_) do { const int t0_ = SCANA_TOK0(st_); \
    _Pragma("unroll") for (int j = 0; j < 2; ++j) { const int i = (tid >> 4) + 32 * j; \
      const u16* row = P + (size_t)(t0_ + (dir ? 63 - i : i)) * PS + hd * 128 + ch * 8; \
      pqr[j] = *(const uint4*)(row + A_Q); pfr[j] = *(const uint4*)(row + (dir ? A_FB : A_FF)); pvr[j] = *(const uint4*)(row + A_I); } } while (0)
  SCANA_PREFETCH(0);
#pragma unroll 1
  for (int step = 0; step < 36; ++step) {
    const int tok0 = SCANA_TOK0(step);
    __syncthreads();
#pragma unroll
    for (int j = 0; j < 2; ++j) {
      const int i = (tid >> 4) + 32 * j;
      uint4 qraw = pqr[j];
      uint4 fraw = pfr[j];
      uint4 vq = pvr[j];
      float qv[8], fv[8], kkv[8];
      unpack8(qraw, qv); unpack8(fraw, fv);
#pragma unroll
      for (int e = 0; e < 8; ++e) {
        qv[e] = siluf_(qv[e]);
        const float ex = __expf(-fv[e]);
        const float sg = 1.f / (1.f + ex);
        const float sgn = ex / (1.f + ex);
        const float f = lbv[e] + (1.f - lbv[e]) * sg;
        kkv[e] = (1.f - lbv[e]) * (fv[e] > 30.f ? 0.f : (fv[e] < -30.f ? 1.f : sgn));
        BC[i * 132 + ch * 8 + e] = __log2f(fmaxf(f, 1e-37f));
      }
      *(uint4*)(Qs + i * 136 + ch * 8) = pack8f(qv);
      *(uint4*)(KKs + i * 136 + ch * 8) = pack8f(kkv);
      u16* dv = VT + (ch * 8) * 72 + i;
      dv[0 * 72] = (u16)(vq.x & 0xffff); dv[1 * 72] = (u16)(vq.x >> 16); dv[2 * 72] = (u16)(vq.y & 0xffff); dv[3 * 72] = (u16)(vq.y >> 16);
      dv[4 * 72] = (u16)(vq.z & 0xffff); dv[5 * 72] = (u16)(vq.z >> 16); dv[6 * 72] = (u16)(vq.w & 0xffff); dv[7 * 72] = (u16)(vq.w >> 16);
    }
    __syncthreads();
    {
      const int k = tid & 127, qd = tid >> 7;
      float run = 0.f;
      for (int i = qd * 16; i < qd * 16 + 16; ++i) { run += BC[i * 132 + k]; BC[i * 132 + k] = run; }
      QTOT[qd * 128 + k] = run;
    }
    __syncthreads();
    {
      const int k = tid & 127, qd = tid >> 7;
      float off = 0.f;
      for (int q2 = 0; q2 < qd; ++q2) off += QTOT[q2 * 128 + k];
      if (qd > 0) for (int i = qd * 16; i < qd * 16 + 16; ++i) BC[i * 132 + k] += off;
    }
    __syncthreads();
    f32x4 cod[2];
#pragma unroll
    for (int jj = 0; jj < 2; ++jj) {
      cod[jj] = (f32x4){0.f, 0.f, 0.f, 0.f};
      const int job = wid + 8 * jj;
      if (job < 10) {
        const int bI = job < 1 ? 0 : (job < 3 ? 1 : (job < 6 ? 2 : 3));
        const int bJ = job - (bI * (bI + 1)) / 2;
        const int l16 = lane & 15, kg = lane >> 4;
        const int t = 16 * bI + l16, s = 16 * bJ + l16, rr = 16 * bI;
#pragma unroll
        for (int ks = 0; ks < 4; ++ks) {
          const int k0 = ks * 32 + kg * 8;
          float qv[8], kv[8];
          unpack8(*(const uint4*)(Qs + t * 136 + k0), qv);
          unpack8(*(const uint4*)(KKs + s * 136 + k0), kv);
#pragma unroll
          for (int e = 0; e < 8; ++e) {
            const float br = BC[rr * 132 + k0 + e];
            qv[e] *= ex2(BC[t * 132 + k0 + e] - br);
            kv[e] *= ex2(fminf(br - BC[s * 132 + k0 + e], 120.f));
          }
          union { uint4 u; bf16x8 v; } ua, ub;
          ua.u = pack8f(qv); ub.u = pack8f(kv);
          cod[jj] = __builtin_amdgcn_mfma_f32_16x16x32_bf16(ua.v, ub.v, cod[jj], 0, 0, 0);
        }
      }
    }
    if (tid < 128) EL[tid] = ex2(BC[63 * 132 + tid]);
#pragma unroll
    for (int j = 0; j < 2; ++j) {
      const int i = (tid >> 4) + 32 * j;
      float kv[8];
      unpack8(*(const uint4*)(KKs + i * 136 + ch * 8), kv);
      u16* dk = KT + (ch * 8) * 72 + i;
#pragma unroll
      for (int e = 0; e < 8; ++e) {
        const float b = BC[i * 132 + ch * 8 + e], bl_ = BC[63 * 132 + ch * 8 + e];
        dk[e * 72] = f2bf(kv[e] * ex2(bl_ - b));
      }
    }
    __syncthreads();
#pragma unroll
    for (int j = 0; j < 2; ++j) {
      const int i = (tid >> 4) + 32 * j;
      float qv[8];
      unpack8(*(const uint4*)(Qs + i * 136 + ch * 8), qv);
#pragma unroll
      for (int e = 0; e < 8; ++e) qv[e] *= ex2(BC[i * 132 + ch * 8 + e]);
      *(uint4*)(Qs + i * 136 + ch * 8) = pack8f(qv);
    }
    for (int i = tid; i < 64 * 72 / 2; i += NTHR) ((unsigned*)AM)[i] = 0u;
    __syncthreads();
#pragma unroll
    for (int jj = 0; jj < 2; ++jj) {
      const int job = wid + 8 * jj;
      if (job < 10) {
        const int bI = job < 1 ? 0 : (job < 3 ? 1 : (job < 6 ? 2 : 3));
        const int bJ = job - (bI * (bI + 1)) / 2;
        const int l16 = lane & 15, kg = lane >> 4;
#pragma unroll
        for (int e = 0; e < 4; ++e) {
          const int tp = 4 * kg + e;
          const float v = (bJ < bI || l16 <= tp) ? cod[jj][e] : 0.f;
          AM[(16 * bI + tp) * 72 + 16 * bJ + l16] = f2bf(v);
        }
      }
    }
    __syncthreads();
    if (step + 1 < 36) SCANA_PREFETCH(step + 1);
    f32x16 o;
#pragma unroll
    for (int e = 0; e < 16; ++e) o[e] = 0.f;
#pragma unroll
    for (int ks = 0; ks < 8; ++ks) {
      bf16x8 a = *(const bf16x8*)(Qs + (th * 32 + r) * 136 + ks * 16 + h * 8);
      bf16x8 b = *(const bf16x8*)(ST + (vt * 32 + r) * 136 + ks * 16 + h * 8);
      o = MFMA(a, b, o);
    }
    bf16x8 bv[4];
#pragma unroll
    for (int ks = 0; ks < 4; ++ks) bv[ks] = *(const bf16x8*)(VT + (vt * 32 + r) * 72 + ks * 16 + h * 8);
#pragma unroll
    for (int ks = 0; ks < 4; ++ks) {
      bf16x8 a = *(const bf16x8*)(AM + (th * 32 + r) * 72 + ks * 16 + h * 8);
      o = MFMA(a, bv[ks], o);
    }
    {
      u16* ob = Oa + (size_t)tok0 * 512 + hd * 128 + vt * 32 + r;
#pragma unroll
      for (int e = 0; e < 16; ++e) {
        const int i = th * 32 + crow(e, h);
        ob[(dir ? 63 - i : i) * 512] = f2bf(o[e]);
      }
    }
    __syncthreads();
#pragma unroll
    for (int j = 0; j < 2; ++j) {
      const int kt = 2 * th + j;
#pragma unroll
      for (int e = 0; e < 16; ++e) S[j][e] *= EL[kt * 32 + crow(e, h)];
#pragma unroll
      for (int ks = 0; ks < 4; ++ks) {
        bf16x8 a = *(const bf16x8*)(KT + (kt * 32 + r) * 72 + ks * 16 + h * 8);
        S[j] = MFMA(a, bv[ks], S[j]);
      }
#pragma unroll
      for (int gq = 0; gq < 4; ++gq) {
        uint2 w;
        w.x = pack2(S[j][4 * gq], S[j][4 * gq + 1]); w.y = pack2(S[j][4 * gq + 2], S[j][4 * gq + 3]);
        *(uint2*)(ST + (vt * 32 + r) * 136 + kt * 32 + 8 * gq + 4 * h) = w;
      }
    }
  }
#undef SCANA_PREFETCH
#undef SCANA_TOK0
}

__device__ void scanB_unit(const Params& p, int l, int unit2, char* lds) {
  const int tid0 = otid(), vb = tid0 >> 8, tid = tid0 & 255, lane = tid & 63, wid = tid >> 6, r = lane & 31, h = lane >> 5;
  const int unit = unit2 * 2 + vb;
  lds += vb * LDSV;
  const int bl = unit >> 3, hd = (unit >> 1) & 3, dir = unit & 1;
  const u16* P = (const u16*)(p.ws + OFF_P);
  const u16* KQ = (const u16*)(p.ws + OFF_KQ);
  const float* Gb = (const float*)(p.ws + OFF_GB);
  u16* Ob = (u16*)(p.ws + OFF_OB) + (size_t)dir * NTOK * 512;
  u16* QB = (u16*)lds;
  u16* KB = (u16*)(lds + 9216);
  u16* SM = (u16*)(lds + 18432);
  u16* KWT = (u16*)(lds + 27648);
  u16* VT = (u16*)(lds + 36864);
  float* vec = (float*)(lds + 55296);
  float *IG = vec, *LF = vec + 64, *BV = vec + 128, *UV = vec + 192, *MT = vec + 256, *WI = vec + 320, *WK = vec + 384,
        *DEN = vec + 448, *NV = vec + 512  , *SC = vec + 640, *BL2 = vec + 704, *UL2 = vec + 768, *EMT = vec + 832;
  const float bI = p.bgate[l * 16 + (2 * dir) * 4 + hd], bF = p.bgate[l * 16 + (2 * dir + 1) * 4 + hd];
  f32x16 C[2];
#pragma unroll
  for (int ft = 0; ft < 2; ++ft)
#pragma unroll
    for (int e = 0; e < 16; ++e) C[ft][e] = 0.f;
  float m = -1e30f;
  __syncthreads();
  if (tid < 128) NV[tid] = 0.f;
  int cur = 0;
  uint4 pk0, pk1, pq0, pq1, pv0, pv1, pv2, pv3; float pgI = 0.f, pgF = 0.f;
#define SCANB_TOK0(st_) (bl * TPB + ((st_) >= 4 ? CTXL : 0) + (dir ? ((st_) >= 4 ? 31 - ((st_) - 4) : 3 - (st_)) : ((st_) >= 4 ? (st_) - 4 : (st_))) * 64)
#define SCANB_LDKQ(j, K_, Q_) do { const int id = tid + 256 * (j), i = id >> 3, c8 = id & 7; \
      const u16* row = KQ + (size_t)(t0_ + (dir ? 63 - i : i)) * 512 + hd * 64 + c8 * 8; K_ = *(const uint4*)(row); Q_ = *(const uint4*)(row + 256); } while (0)
#define SCANB_LDV(j, V_) do { const int id = tid + 256 * (j), i = id >> 4, c16 = id & 15; \
      V_ = *(const uint4*)(P + (size_t)(t0_ + (dir ? 63 - i : i)) * PS + B_V + hd * 128 + c16 * 8); } while (0)
#define SCANB_PREFETCH(st_) do { const int t0_ = SCANB_TOK0(st_); \
    SCANB_LDKQ(0, pk0, pq0); SCANB_LDKQ(1, pk1, pq1); SCANB_LDV(0, pv0); SCANB_LDV(1, pv1); SCANB_LDV(2, pv2); SCANB_LDV(3, pv3); \
    if (tid < 64) { const int tok = t0_ + (dir ? 63 - tid : tid); pgI = Gb[(size_t)tok * 16 + (2 * dir) * 4 + hd]; pgF = Gb[(size_t)tok * 16 + (2 * dir + 1) * 4 + hd]; } } while (0)
#define SCANB_STKQ(j, K_, Q_) do { const int id = tid + 256 * (j), i = id >> 3, c8 = id & 7; \
      *(uint4*)(KB + i * 72 + c8 * 8) = K_; *(uint4*)(QB + i * 72 + c8 * 8) = Q_; } while (0)
#define SCANB_STV(j, V_) do { const int id = tid + 256 * (j), i = id >> 4, c16 = id & 15; const uint4 vq = V_; u16* dv = VT + (c16 * 8) * 72 + i; \
      dv[0 * 72] = (u16)(vq.x & 0xffff); dv[1 * 72] = (u16)(vq.x >> 16); dv[2 * 72] = (u16)(vq.y & 0xffff); dv[3 * 72] = (u16)(vq.y >> 16); \
      dv[4 * 72] = (u16)(vq.z & 0xffff); dv[5 * 72] = (u16)(vq.z >> 16); dv[6 * 72] = (u16)(vq.w & 0xffff); dv[7 * 72] = (u16)(vq.w >> 16); } while (0)
  SCANB_PREFETCH(0);
#pragma unroll 1
  for (int step = 0; step < 36; ++step) {
    const int tok0 = SCANB_TOK0(step);
    __syncthreads();
    SCANB_STKQ(0, pk0, pq0); SCANB_STKQ(1, pk1, pq1);
    SCANB_STV(0, pv0); SCANB_STV(1, pv1); SCANB_STV(2, pv2); SCANB_STV(3, pv3);
    if (tid < 64) {
      const int i = tid;
      const float gI = pgI + bI;
      const float gF = pgF + bF;
      const float lf = fminf(gF, 0.f) - log1pf(expf(-fabsf(gF)));
      float b = lf;
#pragma unroll
      for (int d = 1; d < 64; d <<= 1) { float t = __shfl_up(b, d); if (lane >= d) b += t; }
      const float u = gI - b;
      float pm = u;
#pragma unroll
      for (int d = 1; d < 64; d <<= 1) { float t = __shfl_up(pm, d); if (lane >= d) pm = fmaxf(pm, t); }
      const float mt = b + fmaxf(m, pm);
      const float wi = expf(b + m - mt);
      const float mnew = __shfl(mt, 63), b63 = __shfl(b, 63);
      const float dec = expf(b63 + m - mnew);
      const float wk = expf(b63 - b + gI - mnew);
      IG[i] = gI; LF[i] = lf; BV[i] = b; UV[i] = u; MT[i] = mt; WI[i] = wi; WK[i] = wk;
      BL2[i] = (b - mt) * LOG2E; UL2[i] = u * LOG2E; EMT[i] = expf(-mt);
      if (i == 0) { SC[0] = mnew; SC[1] = dec; }
    }
    __syncthreads();
    {
      const int tt = wid >> 1, st = wid & 1;
      f32x16 a16;
#pragma unroll
      for (int e = 0; e < 16; ++e) a16[e] = 0.f;
#pragma unroll
      for (int ks = 0; ks < 4; ++ks) {
        bf16x8 a = *(const bf16x8*)(QB + (tt * 32 + r) * 72 + ks * 16 + h * 8);
        bf16x8 b = *(const bf16x8*)(KB + (st * 32 + r) * 72 + ks * 16 + h * 8);
        a16 = MFMA(a, b, a16);
      }
      const int s = st * 32 + r;
      const float us = UL2[s];
#pragma unroll
      for (int e = 0; e < 16; ++e) {
        const int t = tt * 32 + crow(e, h);
        float v = 0.f;
        if (s <= t) v = a16[e] * ex2(BL2[t] + us);
        SM[t * 72 + s] = f2bf(v);
      }
    }
#pragma unroll
    for (int j = 0; j < 2; ++j) {
      const int id = tid + 256 * j, i = id >> 3, c8 = id & 7;
      float kv[8];
      unpack8(*(const uint4*)(KB + i * 72 + c8 * 8), kv);
      const float wk = WK[i];
#pragma unroll
      for (int e = 0; e < 8; ++e) KWT[(c8 * 8 + e) * 72 + i] = f2bf(kv[e] * wk);
    }
    __syncthreads();
    const float mnew = SC[0], dec = SC[1];
    if (tid < 64) {
      const int t = tid;
      float rsum = 0.f, qn = 0.f;
#pragma unroll
      for (int c8 = 0; c8 < 8; ++c8) {
        float sv[8], qv[8];
        unpack8(*(const uint4*)(SM + t * 72 + c8 * 8), sv);
        unpack8(*(const uint4*)(QB + t * 72 + c8 * 8), qv);
#pragma unroll
        for (int e = 0; e < 8; ++e) { rsum += sv[e]; qn += qv[e] * NV[cur * 64 + c8 * 8 + e]; }
      }
      DEN[t] = 1.f / fmaxf(fabsf(WI[t] * qn + rsum), EMT[t]);
    } else if (tid < 128) {
      const int f = tid - 64;
      float ns = 0.f;
#pragma unroll
      for (int c8 = 0; c8 < 8; ++c8) {
        float kv[8];
        unpack8(*(const uint4*)(KWT + f * 72 + c8 * 8), kv);
#pragma unroll
        for (int e = 0; e < 8; ++e) ns += kv[e];
      }
      NV[(cur ^ 1) * 64 + f] = dec * NV[cur * 64 + f] + ns;
    }
    __syncthreads();
    if (step + 1 < 36) SCANB_PREFETCH(step + 1);
    f32x16 num[2];
#pragma unroll
    for (int tt = 0; tt < 2; ++tt)
#pragma unroll
      for (int e = 0; e < 16; ++e) num[tt][e] = 0.f;
#pragma unroll
    for (int ft = 0; ft < 2; ++ft)
#pragma unroll
      for (int s = 0; s < 2; ++s) {
        bf16x8 pb = pack8(C[ft], s);
#pragma unroll
        for (int tt = 0; tt < 2; ++tt) {
          const u16* qb = QB + (tt * 32 + r) * 72 + ft * 32 + s * 16 + 4 * h;
          bf16x8 a = cat4(*(const s16x4*)qb, *(const s16x4*)(qb + 8));
          num[tt] = MFMA(a, pb, num[tt]);
        }
      }
#pragma unroll
    for (int tt = 0; tt < 2; ++tt)
#pragma unroll
      for (int e = 0; e < 16; ++e) num[tt][e] *= WI[tt * 32 + crow(e, h)];
    bf16x8 bv[4];
#pragma unroll
    for (int ks = 0; ks < 4; ++ks) bv[ks] = *(const bf16x8*)(VT + (wid * 32 + r) * 72 + ks * 16 + h * 8);
#pragma unroll
    for (int ks = 0; ks < 4; ++ks)
#pragma unroll
      for (int tt = 0; tt < 2; ++tt) {
        bf16x8 a = *(const bf16x8*)(SM + (tt * 32 + r) * 72 + ks * 16 + h * 8);
        num[tt] = MFMA(a, bv[ks], num[tt]);
      }
#pragma unroll
    for (int tt = 0; tt < 2; ++tt)
#pragma unroll
      for (int e = 0; e < 16; ++e) {
        const int i = tt * 32 + crow(e, h);
        const int tok = tok0 + (dir ? 63 - i : i);
        Ob[(size_t)tok * 512 + hd * 128 + wid * 32 + r] = f2bf(num[tt][e] * DEN[i]);
      }
#pragma unroll
    for (int ft = 0; ft < 2; ++ft) {
#pragma unroll
      for (int e = 0; e < 16; ++e) C[ft][e] *= dec;
#pragma unroll
      for (int ks = 0; ks < 4; ++ks) {
        bf16x8 a = *(const bf16x8*)(KWT + (ft * 32 + r) * 72 + ks * 16 + h * 8);
        C[ft] = MFMA(a, bv[ks], C[ft]);
      }
    }
    m = mnew;
    cur ^= 1;
  }
#undef SCANB_PREFETCH
#undef SCANB_LDKQ
#undef SCANB_LDV
#undef SCANB_STKQ
#undef SCANB_STV
#undef SCANB_TOK0
}

__device__ void phase_mixers(const Params& p, int l, int g, char* lds, int cbase = 0, bool scans_only = false, bool a_only = false) {
  int* s_item = (int*)(lds + LDS_BYTES - 16);
  int* cnt = (int*)(p.ws + OFF_CNT) + cbase + (l * NG + g);
  const u16* P = (const u16*)(p.ws + OFF_P);
  const u16* Qd = (const u16*)(p.ws + OFF_QD);
  const u16* Kd = (const u16*)(p.ws + OFF_KD);
  const u16* Vd = (const u16*)(p.ws + OFF_VD);
  u16* Y = (u16*)((char*)p.out);
  const float* rc = (const float*)(p.ws + OFF_ROPE);
  constexpr int NSA = NB * 8, NSB = NB * 4;
  constexpr int ND_L = NB * 4 * 8, NC_L = NB * 2 * 32, ND_C = NB * 4, NC_C = NB * 2 * 4;
  constexpr int I1 = NSA, I2 = I1 + NSB, I3 = I2 + ND_L, I4 = I3 + NC_L, I5 = I4 + ND_C, I6 = I5 + NC_C;
  const float scC = 0.125f * LOG2E, scD = 0.07216878364870322f * LOG2E;
  while (true) {
    __syncthreads();
    if (otid() == 0) *s_item = atomicAdd(cnt, 1);
    __syncthreads();
    const int it = *s_item;
    if (it >= (a_only ? I1 : (scans_only ? I2 : (l == DEPTH - 1 ? I4 : I6)))) break;
    if (it < I1) scanA_unit(p, l, it, lds);
    else if (it < I2) scanB_unit(p, l, it - I1, lds);
    else {
      bool isD, isLat; int q;
      if (it < I3) { isD = true; isLat = true; q = it - I2; }
      else if (it < I4) { isD = false; isLat = true; q = it - I3; }
      else if (it < I5) { isD = true; isLat = false; q = it - I4; }
      else { isD = false; isLat = false; q = it - I5; }
      const int tid = otid(), lane = tid & 63, wid = tid >> 6, r = lane & 31;
      const int nkeys = isLat ? TPB : CTXL;
      if (isD) {
        const int nqt = isLat ? 8 : 1;
        const int qt = q % nqt, hd = (q / nqt) % 4, bl = q / (nqt * 4);
        const int tokk = bl * TPB, ql = qt * 256 + wid * 32 + r;
        const int tokq = tokk + (isLat ? CTXL : 0) + ql;
        attn_item<192, 128, true>(Qd + (size_t)tokq * 768 + hd * 192, Kd + (size_t)tokk * 768 + hd * 192, 768,
                                  Vd + (size_t)tokk * 512 + hd * 128, 512, Y + (size_t)tokq * 2048 + 1536 + hd * 128,
                                  nkeys, scD, isLat ? ql : -1, rc, lds);
      } else {
        const int nqt = isLat ? 32 : 4;
        const int qt = q % nqt, kvh = (q / nqt) % 2, bl = q / (nqt * 2);
        const int hq = kvh * 4 + (wid >> 1);
        const int tokk = bl * TPB, ql = qt * 64 + (wid & 1) * 32 + r;
        const int tokq = tokk + (isLat ? CTXL : 0) + ql;
        attn_item<64, 64, false>(P + (size_t)tokq * PS + C_Q + hq * 64, P + (size_t)tokk * PS + C_K + kvh * 64, PS,
                                 P + (size_t)tokk * PS + C_V + kvh * 64, PS, Y + (size_t)tokq * 2048 + 1024 + hq * 64,
                                 nkeys, scC, -1, rc, lds);
      }
    }
  }
}

__device__ void phase_readout(const Params& p, int l) {
  const int tid = otid(), lane = tid & 63, wid = tid >> 6;
  const u16* P = (const u16*)(p.ws + OFF_P);
  const u16* Oa = (const u16*)(p.ws + OFF_OA);
  const u16* Ob = (const u16*)(p.ws + OFF_OB);
  u16* Y = (u16*)((char*)p.out);
  const int col = lane * 8;
  for (int tok = blockIdx.x * 8 + wid; tok < NTOK; tok += gridDim.x * 8) {
    if (l == DEPTH - 1 && (tok % TPB) < CTXL) continue;
    uint4 ra[2], rb[2], rg[2];
#pragma unroll
    for (int mix = 0; mix < 2; ++mix) {
      const u16* O = mix == 0 ? Oa : Ob;
      ra[mix] = *(const uint4*)(O + (size_t)tok * 512 + col);
      rb[mix] = *(const uint4*)(O + ((size_t)NTOK + tok) * 512 + col);
      rg[mix] = *(const uint4*)(P + (size_t)tok * PS + (mix == 0 ? A_G : B_O) + col);
    }
    uint4 outv[2];
#pragma unroll
    for (int mix = 0; mix < 2; ++mix) {
      float a[8], b[8], gt[8], o[8];
      unpack8(ra[mix], a); unpack8(rb[mix], b); unpack8(rg[mix], gt);
      float ss = 0.f;
#pragma unroll
      for (int e = 0; e < 8; ++e) { a[e] += b[e]; ss += a[e] * a[e]; }
      ss += __shfl_xor(ss, 1); ss += __shfl_xor(ss, 2); ss += __shfl_xor(ss, 4); ss += __shfl_xor(ss, 8);
      const float rstd = rsqrtf(ss * (1.f / 128.f) + EPS);
      const float* gn = (mix == 0 ? p.hnorm : p.mnorm) + l * 128 + (col & 127);
#pragma unroll
      for (int e = 0; e < 8; ++e) {
        float y = a[e] * rstd * gn[e];
        o[e] = y * (mix == 0 ? siluf_(gt[e]) : sigmoidf_(gt[e]));
      }
      outv[mix] = pack8f(o);
    }
    *(uint4*)(Y + (size_t)tok * 2048 + col) = outv[0];
    *(uint4*)(Y + (size_t)tok * 2048 + 512 + col) = outv[1];
  }
}

struct EpiInproj {
  u16* P; float* Gb;
  DI bool operator()(f32x4 (&acc)[2][2][4][2], const pg8::UDesc& u, int wr, int wc, int fr, int fq) const {
    const int row0 = u.pm * 256 + wr * 64 + fr, col0 = u.pn * 256 + wc * 32 + 8 * fq;
    const bool gate = (u.pn == 9) && (wc == 0) && (fq < 2);
#pragma unroll
    for (int ai = 0; ai < 2; ++ai)
#pragma unroll
      for (int m = 0; m < 4; ++m) {
        const size_t row = (size_t)(row0 + ai * 128 + m * 16);
#pragma unroll
        for (int bj = 0; bj < 2; ++bj) *(uint4*)(P + row * PS + col0 + bj * 128) = pk8(acc[ai][bj][m][0], acc[ai][bj][m][1]);
        if (gate) { *(f32x4*)(Gb + row * 16 + 8 * fq) = acc[ai][0][m][0]; *(f32x4*)(Gb + row * 16 + 8 * fq + 4) = acc[ai][0][m][1]; }
      }
    return false;
  }
};
__device__ void phase_inproj(const Params& p, int l, char* lds) {
  pg8::PlainSched S{p.ws + OFF_H, wsel(p, l) + OFF_WINT, 2048u, 2048u, 16, NTOK / 256, PS / 256, (int)gridDim.x, (int)blockIdx.x};
  EpiInproj E{(u16*)(p.ws + OFF_P), (float*)(p.ws + OFF_GB)};
  pg8::gemm_stream(( LAS unsigned char*)lds, S, E);
}

struct MlaSched {
  const char* P; const char* Wq; const char* Wk; const char* Wv; int G, c;
  DI bool next(int i, pg8::UDesc& u) const {
    const long L = (long)i * G + c; if (L >= (NTOK / 256) * 7) return false;
    const int pm = (int)(L / 7), j = (int)(L % 7);
    u.pm = pm; u.lda2 = PS * 2;
    if (j < 3) { u.tag = 0; u.pn = j; u.A = P + (size_t)pm * 256 * PS * 2 + D_CQ * 2; u.B = Wq + (size_t)j * 256 * 512; u.ldb2 = 512; u.nt = 4; }
    else if (j < 5) { u.tag = 1; u.pn = j - 3; u.A = P + (size_t)pm * 256 * PS * 2 + D_CKV * 2; u.B = Wk + (size_t)(j - 3) * 256 * 256; u.ldb2 = 256; u.nt = 2; }
    else { u.tag = 2; u.pn = j - 5; u.A = P + (size_t)pm * 256 * PS * 2 + D_CKV * 2; u.B = Wv + (size_t)(j - 5) * 256 * 256; u.ldb2 = 256; u.nt = 2; }
    return true;
  }
};
struct EpiMla {
  u16 *Qd, *Kd, *Vd;
  DI bool operator()(f32x4 (&acc)[2][2][4][2], const pg8::UDesc& u, int wr, int wc, int fr, int fq) const {
    const int row0 = u.pm * 256 + wr * 64 + fr, col0 = u.pn * 256 + wc * 32 + 8 * fq;
#pragma unroll
    for (int ai = 0; ai < 2; ++ai)
#pragma unroll
      for (int m = 0; m < 4; ++m) {
        const size_t row = (size_t)(row0 + ai * 128 + m * 16);
#pragma unroll
        for (int bj = 0; bj < 2; ++bj) {
          const int col = col0 + bj * 128;
          u16* dst = u.tag == 0 ? Qd + row * 768 + col : (u.tag == 1 ? Kd + row * 768 + (col >> 7) * 192 + (col & 127) : Vd + row * 512 + col);
          *(uint4*)dst = pk8(acc[ai][bj][m][0], acc[ai][bj][m][1]);
        }
      }
    return false;
  }
};
__device__ void phase_mlaup(const Params& p, int l, char* lds) {
  MlaSched S{p.ws + OFF_P, wsel(p, l) + OFF_WUQ, wsel(p, l) + OFF_WUK, wsel(p, l) + OFF_WUV, (int)gridDim.x, (int)blockIdx.x};
  EpiMla E{(u16*)(p.ws + OFF_QD), (u16*)(p.ws + OFF_KD), (u16*)(p.ws + OFF_VD)};
  pg8::gemm_stream((LAS unsigned char*)lds, S, E);
}

struct EpiGate {
  u16* Gt;
  DI bool operator()(f32x4 (&acc)[2][2][4][2], const pg8::UDesc& u, int wr, int wc, int fr, int fq) const {
    const int row0 = u.pm * 256 + wr * 64 + fr, col0 = u.pn * 256 + wc * 32 + 8 * fq;
#pragma unroll
    for (int ai = 0; ai < 2; ++ai)
#pragma unroll
      for (int m = 0; m < 4; ++m) {
        const size_t row = (size_t)(row0 + ai * 128 + m * 16);
#pragma unroll
        for (int bj = 0; bj < 2; ++bj) {
          f32x4 a = acc[ai][bj][m][0], b = acc[ai][bj][m][1];
#pragma unroll
          for (int e = 0; e < 4; ++e) { a[e] = fmaxf(sigmoidf_(a[e]), 1e-30f); b[e] = fmaxf(sigmoidf_(b[e]), 1e-30f); }
          *(uint4*)(Gt + row * 4096 + col0 + bj * 128) = pk8(a, b);
        }
      }
    return false;
  }
};
__device__ void phase_gate(const Params& p, int l, char* lds, int lat_only) {
  pg8::PlainSched S{p.ws + OFF_H, wsel(p, l) + OFF_WGT, 2048u, 2048u, 16, NTOK / 256, 16, (int)gridDim.x, (int)blockIdx.x, lat_only};
  EpiGate E{(u16*)(p.ws + OFF_P)};
  pg8::gemm_stream((LAS unsigned char*)lds, S, E);
}

struct BranchSched {
  const char* Y; const char* Wb; int G, c, lat_only;
  DI bool next(int i, pg8::UDesc& u) const {
    int pm, pn; if (!pg8::tile_order((long)(i >> 2) * G + c, lat_only ? NTOK / 256 - NB : NTOK / 256, 4, pm, pn)) return false;
    if (lat_only) pm = pm + (pm >> 3) + 1;
    const int r = i & 3;
    u.pm = pm; u.pn = pn; u.tag = r; u.lda2 = 4096; u.ldb2 = 1024; u.nt = 8;
    u.A = Y + (size_t)pm * 256 * 4096 + r * 1024; u.B = Wb + ((size_t)r * 1024 + pn * 256) * 1024;
    return true;
  }
};
struct EpiBranch {
  const u16* Gt; u16* Mg;
  DI bool operator()(f32x4 (&acc)[2][2][4][2], const pg8::UDesc& u, int wr, int wc, int fr, int fq) const {
    const int row0 = u.pm * 256 + wr * 64 + fr, col0 = u.pn * 256 + wc * 32 + 8 * fq, r = u.tag;
#pragma unroll
    for (int ai = 0; ai < 2; ++ai)
#pragma unroll
      for (int m = 0; m < 4; ++m) {
        const size_t row = (size_t)(row0 + ai * 128 + m * 16);
#pragma unroll
        for (int bj = 0; bj < 2; ++bj) {
          const int col = col0 + bj * 128;
          float gv[8];
          unpack8(*(const uint4*)(Gt + row * 4096 + r * 1024 + col), gv);
          if (r < 3) {
            float gn[8];
            unpack8(*(const uint4*)(Gt + row * 4096 + (r + 1) * 1024 + col), gn);
#pragma unroll
            for (int e = 0; e < 4; ++e) {
              acc[ai][bj][m][0][e] *= gv[e] * __builtin_amdgcn_rcpf(gn[e]);
              acc[ai][bj][m][1][e] *= gv[4 + e] * __builtin_amdgcn_rcpf(gn[4 + e]);
            }
          } else {
            f32x4 a = acc[ai][bj][m][0], b = acc[ai][bj][m][1];
#pragma unroll
            for (int e = 0; e < 4; ++e) { a[e] *= gv[e]; b[e] *= gv[4 + e]; }
            *(uint4*)(Mg + row * 1024 + col) = pk8(a, b);
          }
        }
      }
    return r < 3;
  }
};
__device__ void phase_branch(const Params& p, int l, char* lds, int lat_only) {
  BranchSched S{(const char*)p.out, wsel(p, l) + OFF_WBT, (int)gridDim.x, (int)blockIdx.x, lat_only};
  EpiBranch E{(const u16*)(p.ws + OFF_P), (u16*)(p.ws + OFF_OA)};
  pg8::gemm_stream((LAS unsigned char*)lds, S, E);
}

struct EpiResid {
  const Params* pp; const float* mod; int g, gidx; float* dummy;
  DI bool operator()(f32x4 (&acc)[2][2][4][2], const pg8::UDesc& u, int wr, int wc, int fr, int fq) const {
    int mr; u16* xb = xrow_ptr(*pp, g, u.pm * 256, mr);
    if (dummy) xb = (u16*)dummy + (size_t)u.pm * 256 * DM;
    const float* gate = mod + (size_t)mr * 6144 + gidx * DM;
    const int row0 = wr * 64 + fr, col0 = u.pn * 256 + wc * 32 + 8 * fq;
    f32x4 gv[2][2];
#pragma unroll
    for (int bj = 0; bj < 2; ++bj) { gv[bj][0] = *(const f32x4*)(gate + col0 + bj * 128); gv[bj][1] = *(const f32x4*)(gate + col0 + bj * 128 + 4); }
#pragma unroll
    for (int ai = 0; ai < 2; ++ai)
#pragma unroll
      for (int m = 0; m < 4; ++m) {
        u16* xr = xb + (size_t)(row0 + ai * 128 + m * 16) * DM + col0;
#pragma unroll
        for (int bj = 0; bj < 2; ++bj) {
          float xv[8];
          unpack8(*(const uint4*)(xr + bj * 128), xv);
          f32x4 x0 = {xv[0], xv[1], xv[2], xv[3]}, x1 = {xv[4], xv[5], xv[6], xv[7]};
          x0 += gv[bj][0] * acc[ai][bj][m][0]; x1 += gv[bj][1] * acc[ai][bj][m][1];
          *(uint4*)(xr + bj * 128) = pk8(x0, x1);
        }
      }
    return false;
  }
};
__device__ void phase_resid_gemm(const Params& p, int l, int g, const char* A, const char* W, int K, int gidx, char* lds, float* dummy = nullptr) {
  pg8::PlainSched S{A, W, (unsigned)K * 2u, (unsigned)K * 2u, K / 64, NTOK / 256, 4, (int)gridDim.x, (int)blockIdx.x, (l == DEPTH - 1) ? 1 : 0};
  EpiResid E{&p, (const float*)(p.ws + OFF_MOD) + (size_t)l * 33 * 6144, g, gidx, dummy};
  pg8::gemm_stream((LAS unsigned char*)lds, S, E);
}

struct EpiFF1 {
  u16* Hid;
  DI bool operator()(f32x4 (&acc)[2][2][4][2], const pg8::UDesc& u, int wr, int wc, int fr, int fq) const {
    const int row0 = u.pm * 256 + wr * 64 + fr, col0 = u.pn * 256 + wc * 32 + 8 * fq;
#pragma unroll
    for (int ai = 0; ai < 2; ++ai)
#pragma unroll
      for (int m = 0; m < 4; ++m) {
        const size_t row = (size_t)(row0 + ai * 128 + m * 16);
#pragma unroll
        for (int bj = 0; bj < 2; ++bj) {
          f32x4 a = acc[ai][bj][m][0], b = acc[ai][bj][m][1];
#pragma unroll
          for (int e = 0; e < 4; ++e) { float t = fmaxf(a[e], 0.f); a[e] = t * t; t = fmaxf(b[e], 0.f); b[e] = t * t; }
          *(uint4*)(Hid + row * DFF + col0 + bj * 128) = pk8(a, b);
        }
      }
    return false;
  }
};
__device__ void phase_ff1(const Params& p, int l, char* lds, int lat_only) {
  pg8::PlainSched S{p.ws + OFF_H, wsel(p, l) + OFF_W1T, 2048u, 2048u, 16, NTOK / 256, 16, (int)gridDim.x, (int)blockIdx.x, lat_only};
  EpiFF1 E{(u16*)(p.ws + OFF_P)};
  pg8::gemm_stream((LAS unsigned char*)lds, S, E);
}

__device__ void phase_final(const Params& p) {
  const int tid = otid(), lane = tid & 63, wid = tid >> 6;
  for (int tok = blockIdx.x * 8 + wid; tok < NBATCH * SEQ; tok += gridDim.x * 8) {
    float* xr = p.out + (size_t)tok * DM;
    const u16* xs = (const u16*)(p.ws + OFF_XL) + (size_t)tok * DM;
    float4 v[4]; float ss = 0.f;
#pragma unroll
    for (int j = 0; j < 4; ++j) {
      const uint2 q = *(const uint2*)(xs + j * 256 + lane * 4);
      v[j].x = __uint_as_float(q.x << 16); v[j].y = __uint_as_float(q.x & 0xffff0000u); v[j].z = __uint_as_float(q.y << 16); v[j].w = __uint_as_float(q.y & 0xffff0000u);
      ss += v[j].x * v[j].x + v[j].y * v[j].y + v[j].z * v[j].z + v[j].w * v[j].w;
    }
    ss = wave_sum(ss);
    const float rstd = rsqrtf(ss * (1.f / DM) + EPS);
#pragma unroll
    for (int j = 0; j < 4; ++j) {
      int c = j * 256 + lane * 4;
      float4 gg = *(const float4*)(p.gfin + c);
      float4 o = {v[j].x * rstd * gg.x, v[j].y * rstd * gg.y, v[j].z * rstd * gg.z, v[j].w * rstd * gg.w};
      *(float4*)(xr + c) = o;
    }
  }
}

#define XB_TMO      128
#define XB_XCNT(j)  (256  + 64 * (j))
#define XB_XSUB(j)  (1280 + 64 * (j))
#define XB_XGEN(j)  (2304 + 64 * (j))
#define XB_TOP      3328
#define XB_TOPGEN   3392
#define XCD_BAR_WORDS 3456
#define XB_SPIN_CAP (1u << 18)
DI unsigned xb_ld(unsigned* p) { return __hip_atomic_load(p, __ATOMIC_RELAXED, __HIP_MEMORY_SCOPE_AGENT); }
DI unsigned xb_add(unsigned* p, unsigned v) { return __hip_atomic_fetch_add(p, v, __ATOMIC_RELAXED, __HIP_MEMORY_SCOPE_AGENT); }
DI unsigned xb_xcc_id() { return (unsigned)__builtin_amdgcn_s_getreg((3 << 11) | 20) & 0xFu; }
#define XB_SPIN(cond, bar) do { unsigned _sp = 0; while (cond) { __builtin_amdgcn_s_sleep(1); \
    if ((++_sp & 255u) == 0u) { if (xb_ld(&(bar)[XB_TMO])) break; if (_sp > XB_SPIN_CAP) { atomicAdd(&(bar)[XB_TMO], 1u); break; } } } } while (0)
struct XcdBarrier { unsigned* bar; unsigned x; volatile __attribute__((address_space(3))) unsigned* st; };
DI XcdBarrier xcd_barrier_post(unsigned* bar, volatile __attribute__((address_space(3))) unsigned* st) {
  XcdBarrier b; b.bar = bar; b.x = xb_xcc_id(); b.st = st;
  if (threadIdx.x == 0) (void)xb_add(&bar[XB_XCNT(b.x)], 1u);
  return b;
}
DI void xcd_barrier_complete(unsigned* bar, unsigned x, unsigned& nloc, unsigned& nx) {
  const unsigned G = gridDim.x * gridDim.y * gridDim.z;
  unsigned sum, cnt, mine, sp = 0u;
  for (;;) {
    sum = 0u; cnt = 0u; mine = 0u;
#pragma unroll
    for (unsigned j = 0; j < 16; ++j) { const unsigned c = xb_ld(&bar[XB_XCNT(j)]); sum += c; cnt += (c > 0u) ? 1u : 0u; mine = (j == x) ? c : mine; }
    if (sum == G) break;
    __builtin_amdgcn_s_sleep(1);
    if ((++sp & 255u) == 0u) { if (xb_ld(&bar[XB_TMO])) break; if (sp > XB_SPIN_CAP) { atomicAdd(&bar[XB_TMO], 1u); break; } }
  }
  nloc = mine > 0u ? mine : 1u; nx = cnt > 0u ? cnt : 1u;
}
DI void xcd_barrier(const XcdBarrier& b) {
  asm volatile("s_waitcnt vmcnt(0)" ::: "memory");
  __syncthreads();
  if (threadIdx.x == 0) {
    unsigned* bar = b.bar;
    __builtin_amdgcn_s_waitcnt(0);
    unsigned nloc = b.st[0], nx = b.st[1];
    if (nloc == 0u) { xcd_barrier_complete(bar, b.x, nloc, nx); b.st[0] = nloc; b.st[1] = nx; }
    const unsigned old = xb_add(&bar[XB_XSUB(b.x)], 1u);
    const unsigned gen = old / nloc;
    if (old + 1u == (gen + 1u) * nloc) {
      __builtin_amdgcn_fence(__ATOMIC_RELEASE, "agent");
      asm volatile("s_waitcnt vmcnt(0)" ::: "memory");
      const unsigned og = xb_add(&bar[XB_TOP], 1u);
      const unsigned tg = og / nx;
      if (og + 1u == (tg + 1u) * nx) xb_add(&bar[XB_TOPGEN], 1u);
      else XB_SPIN(xb_ld(&bar[XB_TOPGEN]) == tg, bar);
      __builtin_amdgcn_fence(__ATOMIC_ACQUIRE, "agent");
      xb_add(&bar[XB_XGEN(b.x)], 1u);
      asm volatile("s_waitcnt vmcnt(0)" ::: "memory");
    } else {
      XB_SPIN(xb_ld(&bar[XB_XGEN(b.x)]) == gen, bar);
      __builtin_amdgcn_fence(__ATOMIC_ACQUIRE, "agent");
      asm volatile("s_waitcnt vmcnt(0)" ::: "memory");
    }
  }
  __syncthreads();
}

constexpr int NSUB = 12;
constexpr int NPHASE = 1 + DEPTH * NG * NSUB + 1;

__global__ void __launch_bounds__(512) mega(Params p, int ph_lo, int ph_hi) {
  extern __shared__ __attribute__((aligned(16))) char lds[];
  volatile __attribute__((address_space(3))) unsigned* st = (volatile __attribute__((address_space(3))) unsigned*)(lds + LDS_BYTES - 32);
  if (threadIdx.x < 2) st[threadIdx.x] = 0u;
  __syncthreads();
  XcdBarrier xb{};
  if (ph_hi - ph_lo > 1) xb = xcd_barrier_post((unsigned*)(p.ws + OFF_BAR), st);
#define GSYNC() xcd_barrier(xb)
  for (int ph = ph_lo; ph < ph_hi; ++ph) {
    if (ph > 0 && ph < NPHASE - 1 && ((ph - 1) % NSUB) == 0 && ((ph - 1) / NSUB) != 0) continue;
    if (ph == 0) { phase_prep(p, lds); phase_wconv(p, 0, lds); }
    else if (ph == NPHASE - 1) phase_final(p);
    else {
      const int q = ph - 1, lg = q / NSUB, sub = q % NSUB, l = lg / NG, g = lg % NG;
      switch (sub) {
        case 0: if (lg == 0) phase_norm(p, l, g, 0); break;
        case 1: for (int rep = 0; rep < ((PROBE & 2) ? 2 : 1); ++rep) { if (rep) GSYNC(); phase_inproj(p, l, lds); } break;
        case 2: phase_tokprep(p, l); break;
        case 3: phase_mlaup(p, l, lds); break;
        case 4: phase_mixers(p, l, g, lds); if (PROBE & 1) { GSYNC(); phase_mixers(p, l, g, lds, 8); } if (PROBE & 4) { GSYNC(); phase_mixers(p, l, g, lds, 8, true); } if (PROBE & 16) { GSYNC(); phase_mixers(p, l, g, lds, 8, true, true); } break;
        case 5: for (int rep = 0; rep < ((PROBE & 8) ? 2 : 1); ++rep) { if (rep) GSYNC(); phase_readout(p, l); } break;
        case 6: for (int rep = 0; rep < ((PROBE & 2) ? 2 : 1); ++rep) { if (rep) GSYNC(); phase_gate(p, l, lds, l == DEPTH - 1); } break;
        case 7: for (int rep = 0; rep < ((PROBE & 32) ? 2 : 1); ++rep) { if (rep) GSYNC(); phase_branch(p, l, lds, l == DEPTH - 1); } if (g == 0 && l + 1 < DEPTH) phase_wconv(p, l + 1, lds, (int*)(p.ws + OFF_CNT) + 24 + l); break;
        case 8: for (int rep = 0; rep < ((PROBE & 64) ? 2 : 1); ++rep) { if (rep) GSYNC(); phase_resid_gemm(p, l, g, p.ws + OFF_OA, wsel(p, l) + OFF_WOT, DM, 2, lds, rep ? (float*)((char*)p.out) : nullptr); } break;
        case 9: for (int rep = 0; rep < ((PROBE & 8) ? 2 : 1); ++rep) { if (rep) GSYNC(); phase_norm(p, l, g, 1); } break;
        case 10: for (int rep = 0; rep < ((PROBE & 2) ? 2 : 1); ++rep) { if (rep) GSYNC(); phase_ff1(p, l, lds, l == DEPTH - 1); } break;
        default: for (int rep = 0; rep < ((PROBE & 64) ? 2 : 1); ++rep) { if (rep) GSYNC(); phase_resid_gemm(p, l, g, p.ws + OFF_P, wsel(p, l) + OFF_W2T, DFF, 5, lds, rep ? (float*)((char*)p.out) : nullptr); } if (lg + 1 < DEPTH * NG) phase_norm_dyn(p, (lg + 1) / NG, (lg + 1) % NG, (int*)(p.ws + OFF_CNT) + 16 + lg); break;
      }
    }
    if (ph + 1 < ph_hi) { if (ph == ph_lo) cg::this_grid().sync(); else GSYNC(); }
  }
}

extern "C" void kernel_launch(void* const* d_in, const int* in_sizes, int n_in, void* d_out, int out_size, void* d_ws,
                              size_t ws_size, hipStream_t stream) {
  static int grid_blocks = 0;
  if (!grid_blocks) {
    int dev = 0, cus = 0, per_cu = 0;
    (void)hipGetDevice(&dev);
    (void)hipDeviceGetAttribute(&cus, hipDeviceAttributeMultiprocessorCount, dev);
    (void)hipFuncSetAttribute((const void*)mega, hipFuncAttributeMaxDynamicSharedMemorySize, LDS_BYTES);
    (void)hipOccupancyMaxActiveBlocksPerMultiprocessor(&per_cu, mega, NTHR, LDS_BYTES);
    if (per_cu < 1) per_cu = 1;
    if (per_cu > 1) per_cu = 1;
    grid_blocks = cus * per_cu;
  }
  if (ws_size < WS_NEED) { fprintf(stderr, "workspace too small: %zu < %zu\n", ws_size, (size_t)WS_NEED); }
  Params p{};
  const float** pf = (const float**)&p;
  for (int i = 0; i < 26; ++i) pf[i] = (const float*)d_in[i];
  p.out = (float*)d_out;
  p.ws = (char*)d_ws;
  (void)hipMemsetAsync((char*)d_ws + OFF_CNT, 0, 256 + 3456 * 4, stream);
#if ONE_LAUNCH
  int lo = 0, hi = NPHASE;
  void* args[] = {&p, &lo, &hi};
  hipError_t e = hipLaunchCooperativeKernel((void*)mega, dim3(grid_blocks), dim3(NTHR), args, LDS_BYTES, stream);
  if (e != hipSuccess) fprintf(stderr, "cooperative launch failed: %s (grid %d)\n", hipGetErrorString(e), grid_blocks);
#else
  for (int ph = 0; ph < NPHASE; ++ph) mega<<<grid_blocks, NTHR, LDS_BYTES, stream>>>(p, ph, ph + 1);
#endif
}
```

```cpp
#include <hip/hip_runtime.h>
#include <hip/hip_cooperative_groups.h>
#include <cstdio>
#include <cstdint>
namespace cg = cooperative_groups;

#ifndef PROBE
#define PROBE 0
#endif
#ifndef ONE_LAUNCH
#define ONE_LAUNCH 1
#endif

typedef unsigned short u16;
typedef short bf16x8 __attribute__((ext_vector_type(8)));
typedef short s16x4 __attribute__((ext_vector_type(4)));
typedef float f32x16 __attribute__((ext_vector_type(16)));
typedef float f32x2v __attribute__((ext_vector_type(2)));
typedef __bf16 bf16x2v __attribute__((ext_vector_type(2)));
#define DI __device__ __forceinline__
#define MFMA(a, b, c) __builtin_amdgcn_mfma_f32_32x32x16_bf16((a), (b), (c), 0, 0, 0)

constexpr int DM = 1024, NBATCH = 32, SEQ = 2048, CTXL = 256, DEPTH = 4, DFF = 4096;
constexpr int NG = 2, NB = 16, TPB = 2304, NTOK = NB * TPB;
constexpr int PS = 5376, NPC = 5328, INW = 9424;
constexpr int A_I = 0, A_FF = 512, A_FB = 1024, B_K = 1536, B_V = 1792, B_G = 2304, C_K = 2320, C_V = 2448,
              D_CKV = 2576, D_KR = 2704, A_Q = 2768, A_G = 3280, B_Q = 3792, B_O = 4048, C_Q = 4560, D_CQ = 5072;
constexpr float EPS = 1e-6f;
constexpr float LOG2E = 1.4426950408889634f;

constexpr size_t al256(size_t x) { return (x + 255) & ~(size_t)255; }
constexpr size_t OFF_WINT = 0;
constexpr size_t OFF_WGT = OFF_WINT + al256((size_t)PS * 1024 * 2);
constexpr size_t OFF_WBT = OFF_WGT + al256((size_t)4096 * 1024 * 2);
constexpr size_t OFF_WOT = OFF_WBT + al256((size_t)4 * 1024 * 512 * 2);
constexpr size_t OFF_W1T = OFF_WOT + al256((size_t)1024 * 1024 * 2);
constexpr size_t OFF_W2T = OFF_W1T + al256((size_t)4096 * 1024 * 2);
constexpr size_t OFF_WUQ = OFF_W2T + al256((size_t)1024 * 4096 * 2);
constexpr size_t OFF_WUK = OFF_WUQ + al256((size_t)768 * 256 * 2);
constexpr size_t OFF_WUV = OFF_WUK + al256((size_t)512 * 128 * 2);
constexpr size_t OFF_MOD = OFF_WUV + al256((size_t)512 * 128 * 2);
constexpr size_t OFF_LB = OFF_MOD + al256((size_t)4 * 33 * 6144 * 4);
constexpr size_t OFF_ROPE = OFF_LB + al256((size_t)4 * 2 * 512 * 4);
constexpr size_t OFF_CNT = OFF_ROPE + al256((size_t)2 * 64 * 16 * 4);
constexpr size_t OFF_BAR = OFF_CNT + 256;
constexpr size_t OFF_XC = OFF_BAR + al256(3456 * 4);
constexpr size_t OFF_XL = OFF_XC + al256((size_t)NBATCH * CTXL * DM * 2);
constexpr size_t OFF_P = OFF_XL + al256((size_t)NBATCH * SEQ * DM * 2);
constexpr size_t OFF_GB = OFF_P + al256((size_t)NTOK * PS * 2);
constexpr size_t OFF_KQ = OFF_GB + al256((size_t)NTOK * 16 * 4);
constexpr size_t OFF_H = OFF_KQ + al256((size_t)NTOK * 512 * 2);
constexpr size_t OFF_QD = OFF_H + al256((size_t)NTOK * 1024 * 2);
constexpr size_t OFF_KD = OFF_QD + al256((size_t)NTOK * 768 * 2);
constexpr size_t OFF_VD = OFF_KD + al256((size_t)NTOK * 768 * 2);
constexpr size_t OFF_OA = OFF_VD + al256((size_t)NTOK * 512 * 2);
constexpr size_t OFF_OB = OFF_OA + al256((size_t)2 * NTOK * 512 * 2);
constexpr size_t OFF_W2ND = OFF_OB + al256((size_t)2 * NTOK * 512 * 2);
constexpr size_t WS_NEED = OFF_W2ND + (OFF_MOD - OFF_WINT);
constexpr int LDS_BYTES = 143360;
constexpr int LDSV = 69632;
constexpr int NTHR = 512;
constexpr size_t OFF_MF = OFF_QD;

struct Params {
  const float *x, *c, *ctx, *c_ctx, *w_ada, *b_ada, *g1, *g2, *w_in, *bgate, *lblog, *hnorm, *convw, *mnorm,
      *gqn, *gkn, *mqn, *mkvn, *wuq, *wuk, *wuv, *wbr, *wout, *wff1, *wff2, *gfin;
  float* out;
  char* ws;
};

DI int otid() { int t = threadIdx.x; asm volatile("" : "+v"(t)); return t; }
DI char* wsel(const Params& p, int l) { return p.ws + ((l & 1) ? OFF_W2ND : (size_t)0); }
DI float bf2f(u16 v) { return __uint_as_float(((unsigned)v) << 16); }
DI unsigned pack2(float a, float b) {
  f32x2v v = {a, b};
  bf16x2v r = __builtin_convertvector(v, bf16x2v);
  return __builtin_bit_cast(unsigned, r);
}
DI u16 f2bf(float a) { return (u16)(pack2(a, 0.f) & 0xffffu); }
DI int crow(int reg, int h) { return (reg & 3) + 8 * (reg >> 2) + 4 * h; }
DI float sigmoidf_(float x) { return 1.f / (1.f + __expf(-x)); }
DI float siluf_(float x) { return x / (1.f + __expf(-x)); }
DI float ex2(float x) { return __builtin_amdgcn_exp2f(x); }
DI bf16x8 pack8(const f32x16& x, int s) {
  union { unsigned u[4]; bf16x8 v; } t;
  t.u[0] = pack2(x[8 * s + 0], x[8 * s + 1]);
  t.u[1] = pack2(x[8 * s + 2], x[8 * s + 3]);
  t.u[2] = pack2(x[8 * s + 4], x[8 * s + 5]);
  t.u[3] = pack2(x[8 * s + 6], x[8 * s + 7]);
  return t.v;
}
DI bf16x8 cat4(s16x4 lo, s16x4 hi) { return __builtin_shufflevector(lo, hi, 0, 1, 2, 3, 4, 5, 6, 7); }
DI float wave_sum(float v) {
#pragma unroll
  for (int d = 32; d >= 1; d >>= 1) v += __shfl_xor(v, d);
  return v;
}
DI void unpack8(const uint4& q, float* f) {
  f[0] = __uint_as_float(q.x << 16); f[1] = __uint_as_float(q.x & 0xffff0000u);
  f[2] = __uint_as_float(q.y << 16); f[3] = __uint_as_float(q.y & 0xffff0000u);
  f[4] = __uint_as_float(q.z << 16); f[5] = __uint_as_float(q.z & 0xffff0000u);
  f[6] = __uint_as_float(q.w << 16); f[7] = __uint_as_float(q.w & 0xffff0000u);
}
DI uint4 pack8f(const float* f) {
  uint4 q;
  q.x = pack2(f[0], f[1]); q.y = pack2(f[2], f[3]); q.z = pack2(f[4], f[5]); q.w = pack2(f[6], f[7]);
  return q;
}

DI u16* xrow_ptr(const Params& p, int g, int tok, int& modrow) {
  int bl = tok / TPB, pp = tok - bl * TPB, b = g * NB + bl;
  if (pp < CTXL) { modrow = 32; return (u16*)(p.ws + OFF_XC) + ((size_t)b * CTXL + pp) * DM; }
  modrow = b;
  return (u16*)(p.ws + OFF_XL) + ((size_t)b * SEQ + (pp - CTXL)) * DM;
}

#define LAS __attribute__((address_space(3)))
typedef float f32x4 __attribute__((ext_vector_type(4)));
namespace pg8 {
constexpr int BM = 256, BK = 64, HALF = 128, HTB = HALF * BK * 2, STAGE_BYTES = 8 * HTB, NXCD = 8, WGM = 8;
DI int lds_byte(int r, int c) { const int st = (r >> 4) * 2 + (c >> 5), rr = r & 15, cc = c & 31, ob = rr * 64 + cc * 2; return st * 1024 + (ob ^ (((ob >> 9) & 1) << 5)); }
DI void stage_rc(int b, int& R, int& C) { const int st = b / 1024, sb = b % 1024, swz = sb ^ (((sb >> 9) & 1) << 5); R = (st >> 1) * 16 + swz / 64; C = (st & 1) * 32 + (swz % 64) / 2; }
DI int perm32(int rho) { const int n = rho >> 4, i = rho & 15; return 8 * (i >> 2) + 4 * n + (i & 3); }
struct UDesc { const char* A; const char* B; unsigned lda2, ldb2; int nt, pm, pn, tag; };
DI bool tile_order(long L, int nM, int nN, int& pm, int& pn) {
  const int nwg = nM * nN; if (L >= nwg) return false;
  int wgid = (int)L; { const int q = nwg / NXCD, r = nwg % NXCD, xcd = wgid % NXCD, off = wgid / NXCD; wgid = (xcd < r ? xcd * (q + 1) : r * (q + 1) + (xcd - r) * q) + off; }
  const int nig = WGM * nN, gid = wgid / nig, fm = gid * WGM, gsz = (nM - fm) < WGM ? (nM - fm) : WGM;
  pm = fm + ((wgid % nig) % gsz); pn = (wgid % nig) / gsz; return true;
}
template <class Epi, class Sched>
DI void gemm_stream(LAS unsigned char* lds, const Sched& S, const Epi& E) {
  const int tid = otid(), wid = __builtin_amdgcn_readfirstlane(tid >> 6), lane = tid & 63, wr = wid >> 2, wc = wid & 3, fr = lane & 15, fq = lane >> 4;
  int RA[2], RB[2], CC[2];
#pragma unroll
  for (int i = 0; i < 2; ++i) { int R, C; stage_rc(tid * 16 + i * 8192, R, C); RA[i] = R; RB[i] = (R & ~31) + perm32(R & 31); CC[i] = C * 2; }
  const size_t kstep = (size_t)(BK * 2);
  const unsigned ldsw = (unsigned)wid * 1024u;
  const int aoff = lds_byte(wr * 64 + fr, fq * 8), boff = lds_byte(wc * 32 + fr, fq * 8);
#define PG8_SA(b, h) (((b) * 2 + (h)) * HTB)
#define PG8_SB(b, h) ((4 + (b) * 2 + (h)) * HTB)
#define PG8_STAGE(bufoff, gbase, voff) do { _Pragma("unroll") for (int _i = 0; _i < 2; ++_i) \
    __builtin_amdgcn_global_load_lds((const unsigned*)((const char*)(gbase) + (voff)[_i]), (LAS unsigned*)(lds + (bufoff) + ldsw + _i * 8192), 16, 0, 0); } while (0)
#define PG8_LDA(dst, b, h) do { _Pragma("unroll") for (int m = 0; m < 4; ++m) _Pragma("unroll") for (int k = 0; k < 2; ++k) dst[m][k] = *(const LAS bf16x8*)(lds + PG8_SA(b, h) + aoff + m * 2048 + k * 1024); } while (0)
#define PG8_LDB(dst, b, h) do { _Pragma("unroll") for (int n = 0; n < 2; ++n) _Pragma("unroll") for (int k = 0; k < 2; ++k) dst[n][k] = *(const LAS bf16x8*)(lds + PG8_SB(b, h) + boff + n * 2048 + k * 1024); } while (0)
#define PG8_MMA(ai, bj, At, Bt) do { __builtin_amdgcn_s_setprio(1); _Pragma("unroll") for (int m = 0; m < 4; ++m) _Pragma("unroll") for (int n = 0; n < 2; ++n) _Pragma("unroll") for (int k = 0; k < 2; ++k) \
    acc[ai][bj][m][n] = __builtin_amdgcn_mfma_f32_16x16x32_bf16(Bt[n][k], At[m][k], acc[ai][bj][m][n], 0, 0, 0); __builtin_amdgcn_s_setprio(0); } while (0)
#define PG8_WAIT_V(n) asm volatile("s_waitcnt vmcnt(" #n ")" ::: "memory")
#define PG8_WAIT_L(n) asm volatile("s_waitcnt lgkmcnt(" #n ")" ::: "memory")
#define PG8_BAR __builtin_amdgcn_s_barrier()
#define PG8_SCHED __builtin_amdgcn_sched_barrier(0)
  UDesc cur, nxt; int ui = 0;
  if (!S.next(0, cur)) return;
  f32x4 acc[2][2][4][2];
#pragma unroll
  for (int a = 0; a < 2; ++a)
#pragma unroll
    for (int b = 0; b < 2; ++b)
#pragma unroll
      for (int m = 0; m < 4; ++m)
#pragma unroll
        for (int n = 0; n < 2; ++n) acc[a][b][m][n] = (f32x4){0.f, 0.f, 0.f, 0.f};
  bf16x8 At[4][2], B0[2][2], B1[2][2];
  const char* cA = cur.A; const char* cB = cur.B;
  unsigned vA[2], vB[2];
#pragma unroll
  for (int i = 0; i < 2; ++i) { vA[i] = (unsigned)RA[i] * cur.lda2 + CC[i]; vB[i] = (unsigned)RB[i] * cur.ldb2 + CC[i]; }
  size_t hA = (size_t)HALF * cur.lda2, hB = (size_t)HALF * cur.ldb2;
  PG8_STAGE(PG8_SB(0, 0), cB, vB); PG8_STAGE(PG8_SA(0, 0), cA, vA); PG8_STAGE(PG8_SB(0, 1), cB + hB, vB); PG8_STAGE(PG8_SA(0, 1), cA + hA, vA);
  if (wr == 1) PG8_BAR;
  PG8_WAIT_V(4); PG8_BAR;
  PG8_STAGE(PG8_SB(1, 0), cB + kstep, vB); PG8_STAGE(PG8_SA(1, 0), cA + kstep, vA); PG8_STAGE(PG8_SB(1, 1), cB + hB + kstep, vB);
  PG8_WAIT_V(6); PG8_BAR;
  for (;;) {
    const bool has_next = S.next(ui + 1, nxt);
    const char* nA = has_next ? nxt.A : cA; const char* nB = has_next ? nxt.B : cB;
    const unsigned nlda = has_next ? nxt.lda2 : cur.lda2, nldb = has_next ? nxt.ldb2 : cur.ldb2;
    unsigned nvA[2], nvB[2];
#pragma unroll
    for (int i = 0; i < 2; ++i) { nvA[i] = (unsigned)RA[i] * nlda + CC[i]; nvB[i] = (unsigned)RB[i] * nldb + CC[i]; }
    const size_t nhA = (size_t)HALF * nlda, nhB = (size_t)HALF * nldb;
    const int nt = cur.nt;
    for (int t = 0; t < nt; t += 2) {
      const bool last = (t == nt - 2);
      const char* a1 = cA + (size_t)(t + 1) * kstep;
      const char* a2 = last ? nA : cA + (size_t)(t + 2) * kstep; const char* b2 = last ? nB : cB + (size_t)(t + 2) * kstep;
      const char* a3 = a2 + kstep; const char* b3 = b2 + kstep;
      unsigned v2A[2], v2B[2];
#pragma unroll
      for (int i = 0; i < 2; ++i) { v2A[i] = last ? nvA[i] : vA[i]; v2B[i] = last ? nvB[i] : vB[i]; }
      const size_t h2A = last ? nhA : hA, h2B = last ? nhB : hB;
      PG8_LDB(B0, 0, 0); PG8_SCHED; PG8_LDA(At, 0, 0); PG8_STAGE(PG8_SA(1, 1), a1 + hA, vA);
      PG8_WAIT_L(8); PG8_BAR; PG8_WAIT_L(0); PG8_MMA(0, 0, At, B0); PG8_BAR; PG8_SCHED;
      PG8_LDB(B1, 0, 1); PG8_STAGE(PG8_SB(0, 0), b2, v2B);
      PG8_BAR; PG8_WAIT_L(0); PG8_MMA(0, 1, At, B1); PG8_BAR;
      PG8_LDA(At, 0, 1); PG8_STAGE(PG8_SA(0, 0), a2, v2A);
      PG8_BAR; PG8_WAIT_L(0); PG8_MMA(1, 0, At, B0); PG8_BAR; PG8_SCHED;
      PG8_STAGE(PG8_SB(0, 1), b2 + h2B, v2B);
      PG8_WAIT_V(6); PG8_BAR; PG8_MMA(1, 1, At, B1); PG8_BAR;
      PG8_LDB(B0, 1, 0); PG8_SCHED; PG8_LDA(At, 1, 0); PG8_STAGE(PG8_SA(0, 1), a2 + h2A, v2A);
      PG8_WAIT_L(8); PG8_BAR; PG8_WAIT_L(0); PG8_MMA(0, 0, At, B0); PG8_BAR; PG8_SCHED;
      PG8_LDB(B1, 1, 1); PG8_STAGE(PG8_SB(1, 0), b3, v2B);
      PG8_BAR; PG8_WAIT_L(0); PG8_MMA(0, 1, At, B1); PG8_BAR;
      PG8_LDA(At, 1, 1); PG8_STAGE(PG8_SA(1, 0), a3, v2A);
      PG8_BAR; PG8_WAIT_L(0); PG8_MMA(1, 0, At, B0); PG8_BAR; PG8_SCHED;
      PG8_STAGE(PG8_SB(1, 1), b3 + h2B, v2B);
      PG8_WAIT_V(6); PG8_BAR; PG8_MMA(1, 1, At, B1); PG8_BAR;
    }
    const bool keep = E(acc, cur, wr, wc, fr, fq);
    if (!has_next) break;
    if (!keep) {
#pragma unroll
      for (int a = 0; a < 2; ++a)
#pragma unroll
        for (int b = 0; b < 2; ++b)
#pragma unroll
          for (int m = 0; m < 4; ++m)
#pragma unroll
            for (int n = 0; n < 2; ++n) acc[a][b][m][n] = (f32x4){0.f, 0.f, 0.f, 0.f};
    }
    cur = nxt; cA = nA; cB = nB; hA = nhA; hB = nhB;
#pragma unroll
    for (int i = 0; i < 2; ++i) { vA[i] = nvA[i]; vB[i] = nvB[i]; }
    ++ui;
  }
  PG8_WAIT_V(0);
  if (wr == 0) PG8_BAR;
  PG8_BAR;
#undef PG8_SA
#undef PG8_SB
#undef PG8_STAGE
#undef PG8_LDA
#undef PG8_LDB
#undef PG8_MMA
#undef PG8_WAIT_V
#undef PG8_WAIT_L
#undef PG8_BAR
#undef PG8_SCHED
}
struct PlainSched {
  const char* A; const char* B; unsigned lda2, ldb2; int nt, nM, nN, G, c; int lat_only = 0;
  DI bool next(int i, UDesc& u) const {
    int pm, pn; if (!tile_order((long)i * G + c, lat_only ? nM - NB : nM, nN, pm, pn)) return false;
    if (lat_only) pm = pm + (pm >> 3) + 1;
    u.A = A + (size_t)pm * 256 * lda2; u.B = B + (size_t)pn * 256 * ldb2; u.lda2 = lda2; u.ldb2 = ldb2; u.nt = nt; u.pm = pm; u.pn = pn; u.tag = 0; return true;
  }
};
}

DI uint4 pk8(const f32x4& a, const f32x4& b) {
  uint4 q; q.x = pack2(a[0], a[1]); q.y = pack2(a[2], a[3]); q.z = pack2(b[0], b[1]); q.w = pack2(b[2], b[3]); return q;
}

__device__ void phase_prep(const Params& p, char* lds) {
  const int tid = otid(), nthr = gridDim.x * NTHR, gt = blockIdx.x * NTHR + tid;
  {
    const float4* s = (const float4*)p.x; uint2* d = (uint2*)(p.ws + OFF_XL);
    const size_t n = (size_t)NBATCH * SEQ * DM / 4;
    for (size_t i = gt; i < n; i += nthr) { const float4 v = s[i]; uint2 o; o.x = pack2(v.x, v.y); o.y = pack2(v.z, v.w); d[i] = o; }
    const float4* s2 = (const float4*)p.ctx; uint2* d2 = (uint2*)(p.ws + OFF_XC);
    const size_t n2 = (size_t)NBATCH * CTXL * DM / 4;
    for (size_t i = gt; i < n2; i += nthr) { const float4 v = s2[i]; uint2 o; o.x = pack2(v.x, v.y); o.y = pack2(v.z, v.w); d2[i] = o; }
  }
  if (gt < 1024) {
    float v[DEPTH], mx = -1e30f;
    for (int l = 0; l < DEPTH; ++l) { v[l] = p.lblog[l * 1024 + gt]; mx = fmaxf(mx, v[l]); }
    float sum = 0.f;
    for (int l = 0; l < DEPTH; ++l) { v[l] = expf(v[l] - mx); sum += v[l]; }
    float* lb = (float*)(p.ws + OFF_LB);
    float run = 0.f;
    for (int l = 0; l < DEPTH; ++l) { lb[l * 1024 + gt] = run; if (l + 1 < DEPTH) run += v[l + 1] / sum; }
  }
  if (gt >= 1024 && gt < 2048) {
    int i = gt - 1024, pos = i >> 4, fi = i & 15;
    float inv = powf(10000.f, -(float)fi / 16.f);
    float ang = (float)pos * inv;
    float* rc = (float*)(p.ws + OFF_ROPE);
    rc[i] = cosf(ang); rc[1024 + i] = sinf(ang);
  }
  float* ssm = (float*)lds;
  float* red = (float*)lds + 2 * 33 * 32;
  for (int item = blockIdx.x; item < DEPTH * 24; item += gridDim.x) {
    const int l = item / 24, kh = tid >> 8, tl = tid & 255, j = (item % 24) * 256 + tl;
    float acc[33];
#pragma unroll
    for (int r = 0; r < 33; ++r) acc[r] = 0.f;
    const float* W = p.w_ada + (size_t)l * DM * 6144;
    for (int k0 = kh * 512; k0 < kh * 512 + 512; k0 += 32) {
      __syncthreads();
      for (int idx = tl; idx < 33 * 32; idx += 256) {
        int rr = idx >> 5, kk = idx & 31;
        float cv = rr < 32 ? p.c[rr * DM + k0 + kk] : p.c_ctx[k0 + kk];
        ssm[kh * 33 * 32 + idx] = cv / (1.f + expf(-cv));
      }
      __syncthreads();
#pragma unroll 4
      for (int kk = 0; kk < 32; ++kk) {
        float w = W[(size_t)(k0 + kk) * 6144 + j];
#pragma unroll
        for (int r = 0; r < 33; ++r) acc[r] += ssm[kh * 33 * 32 + r * 32 + kk] * w;
      }
    }
    __syncthreads();
    if (kh == 1) {
#pragma unroll
      for (int r = 0; r < 33; ++r) red[r * 256 + tl] = acc[r];
    }
    __syncthreads();
    if (kh == 0) {
      float bb = p.b_ada[l * 6144 + j];
      float* mod = (float*)(p.ws + OFF_MOD) + (size_t)l * 33 * 6144;
#pragma unroll
      for (int r = 0; r < 33; ++r) mod[r * 6144 + j] = acc[r] + red[r * 256 + tl] + bb;
    }
  }
  __syncthreads();
}

DI u16* wdst(char* wb, int type, int sub, int n) {
  switch (type) {
    case 0: return n < NPC ? (u16*)(wb + OFF_WINT) + (size_t)n * 1024 : (u16*)(wb + OFF_WGT) + (size_t)(n - NPC) * 1024;
    case 1: return (u16*)(wb + OFF_WBT) + ((size_t)sub * 1024 + n) * 512;
    case 2: return (u16*)(wb + OFF_WOT) + (size_t)n * 1024;
    case 3: return (u16*)(wb + OFF_W1T) + (size_t)n * 1024;
    case 4: return (u16*)(wb + OFF_W2T) + (size_t)n * 4096;
    case 5: return (u16*)(wb + OFF_WUQ) + (size_t)n * 256;
    case 6: return (u16*)(wb + OFF_WUK) + (size_t)n * 128;
    default: return (u16*)(wb + OFF_WUV) + (size_t)n * 128;
  }
}
__device__ void phase_wconv(const Params& p, int l, char* lds, int* cnt = nullptr) {
  char* wb = wsel(p, l);
  int* s_item = (int*)(lds + LDS_BYTES - 16);
  float* tile = (float*)lds;
  const int tid = otid();
  {
    unsigned* z = (unsigned*)((u16*)(wb + OFF_WINT) + (size_t)NPC * 1024);
    for (int i = blockIdx.x * NTHR + tid; i < (PS - NPC) * 1024 / 2; i += gridDim.x * NTHR) z[i] = 0u;
  }
  constexpr int T0 = 16 * 148, T1 = T0 + 4 * 128, T2 = T1 + 256, T3 = T2 + 1024, T4 = T3 + 1024, T5 = T4 + 48, T6 = T5 + 16, T7 = T6 + 16;
  for (int itk = 0;; ++itk) {
    int it;
    if (cnt) { __syncthreads(); if (tid == 0) *s_item = atomicAdd(cnt, 1); __syncthreads(); it = *s_item; }
    else it = blockIdx.x + itk * gridDim.x;
    if (it >= T7) break;
    int type, sub = 0, K, N, kt, nt;
    const float* src;
    if (it < T0) { type = 0; K = 1024; N = INW; int q = it; kt = q / 148; nt = q % 148; src = p.w_in + (size_t)l * 1024 * INW; }
    else if (it < T1) { type = 1; K = 512; N = 1024; int q = it - T0; sub = q / 128; q %= 128; kt = q / 16; nt = q % 16; src = p.wbr + ((size_t)l * 4 + sub) * 512 * 1024; }
    else if (it < T2) { type = 2; K = 1024; N = 1024; int q = it - T1; kt = q / 16; nt = q % 16; src = p.wout + (size_t)l * 1024 * 1024; }
    else if (it < T3) { type = 3; K = 1024; N = 4096; int q = it - T2; kt = q / 64; nt = q % 64; src = p.wff1 + (size_t)l * 1024 * 4096; }
    else if (it < T4) { type = 4; K = 4096; N = 1024; int q = it - T3; kt = q / 16; nt = q % 16; src = p.wff2 + (size_t)l * 4096 * 1024; }
    else if (it < T5) { type = 5; K = 256; N = 768; int q = it - T4; kt = q / 12; nt = q % 12; src = p.wuq + (size_t)l * 256 * 768; }
    else if (it < T6) { type = 6; K = 128; N = 512; int q = it - T5; kt = q / 8; nt = q % 8; src = p.wuk + (size_t)l * 128 * 512; }
    else { type = 7; K = 128; N = 512; int q = it - T6; kt = q / 8; nt = q % 8; src = p.wuv + (size_t)l * 128 * 512; }
    (void)K;
    const int k0 = kt * 64, n0 = nt * 64;
    __syncthreads();
    {
      const int nn = tid & 63, ks = tid >> 6;
#pragma unroll 4
      for (int j = 0; j < 8; ++j) {
        int k = ks + 8 * j;
        tile[k * 65 + nn] = (n0 + nn < N) ? src[(size_t)(k0 + k) * N + n0 + nn] : 0.f;
      }
    }
    __syncthreads();
    {
      const int kp = tid & 31, nn = tid >> 5;
#pragma unroll 4
      for (int j = 0; j < 4; ++j) {
        int n = nn + 16 * j;
        if (n0 + n < N) {
          unsigned v = pack2(tile[(2 * kp) * 65 + n], tile[(2 * kp + 1) * 65 + n]);
          *(unsigned*)(wdst(wb, type, sub, n0 + n) + k0 + 2 * kp) = v;
        }
      }
    }
  }
  __syncthreads();
}

DI void norm_token(const Params& p, int l, int g, int which, int tok, int lane, const float* gn, const float* mod, u16* H) {
  int mr; const u16* xr = xrow_ptr(p, g, tok, mr);
  const float* shift = mod + (size_t)mr * 6144 + (which == 0 ? 0 : 3) * DM;
  const float* scale = shift + DM;
  float4 v[4]; float ss = 0.f;
#pragma unroll
  for (int j = 0; j < 4; ++j) {
    const uint2 q = *(const uint2*)(xr + j * 256 + lane * 4);
    v[j].x = __uint_as_float(q.x << 16); v[j].y = __uint_as_float(q.x & 0xffff0000u); v[j].z = __uint_as_float(q.y << 16); v[j].w = __uint_as_float(q.y & 0xffff0000u);
    ss += v[j].x * v[j].x + v[j].y * v[j].y + v[j].z * v[j].z + v[j].w * v[j].w;
  }
  ss = wave_sum(ss);
  const float rstd = rsqrtf(ss * (1.f / DM) + EPS);
#pragma unroll
  for (int j = 0; j < 4; ++j) {
    int c = j * 256 + lane * 4;
    float4 gg = *(const float4*)(gn + c), sh = *(const float4*)(shift + c), sc = *(const float4*)(scale + c);
    float o0 = v[j].x * rstd * gg.x * (1.f + sc.x) + sh.x;
    float o1 = v[j].y * rstd * gg.y * (1.f + sc.y) + sh.y;
    float o2 = v[j].z * rstd * gg.z * (1.f + sc.z) + sh.z;
    float o3 = v[j].w * rstd * gg.w * (1.f + sc.w) + sh.w;
    uint2 o; o.x = pack2(o0, o1); o.y = pack2(o2, o3);
    *(uint2*)(H + (size_t)tok * DM + c) = o;
  }
}
DI void norm_load(const u16* xr, int lane, uint2 (&q)[4]) {
#pragma unroll
  for (int j = 0; j < 4; ++j) q[j] = *(const uint2*)(xr + j * 256 + lane * 4);
}
DI void norm_finish(const uint2 (&q)[4], int lane, const float* gn, const float* shift, u16* hrow) {
  const float* scale = shift + DM;
  float4 v[4]; float ss = 0.f;
#pragma unroll
  for (int j = 0; j < 4; ++j) {
    v[j].x = __uint_as_float(q[j].x << 16); v[j].y = __uint_as_float(q[j].x & 0xffff0000u); v[j].z = __uint_as_float(q[j].y << 16); v[j].w = __uint_as_float(q[j].y & 0xffff0000u);
    ss += v[j].x * v[j].x + v[j].y * v[j].y + v[j].z * v[j].z + v[j].w * v[j].w;
  }
  ss = wave_sum(ss);
  const float rstd = rsqrtf(ss * (1.f / DM) + EPS);
#pragma unroll
  for (int j = 0; j < 4; ++j) {
    int c = j * 256 + lane * 4;
    float4 gg = *(const float4*)(gn + c), sh = *(const float4*)(shift + c), sc = *(const float4*)(scale + c);
    float o0 = v[j].x * rstd * gg.x * (1.f + sc.x) + sh.x;
    float o1 = v[j].y * rstd * gg.y * (1.f + sc.y) + sh.y;
    float o2 = v[j].z * rstd * gg.z * (1.f + sc.z) + sh.z;
    float o3 = v[j].w * rstd * gg.w * (1.f + sc.w) + sh.w;
    uint2 o; o.x = pack2(o0, o1); o.y = pack2(o2, o3);
    *(uint2*)(hrow + c) = o;
  }
}
__device__ void phase_norm(const Params& p, int l, int g, int which) {
  const int tid = otid(), lane = tid & 63, wid = tid >> 6;
  const float* gn = (which == 0 ? p.g1 : p.g2) + l * DM;
  const float* mod = (const float*)(p.ws + OFF_MOD) + (size_t)l * 33 * 6144;
  u16* H = (u16*)(p.ws + OFF_H);
  const int stride = gridDim.x * 8;
  const bool skipc = which == 1 && l == DEPTH - 1;
  for (int tok = blockIdx.x * 8 + wid; tok < NTOK; tok += 2 * stride) {
    const int tokB = tok + stride;
    const bool doA = !(skipc && (tok % TPB) < CTXL), doB = tokB < NTOK && !(skipc && (tokB % TPB) < CTXL);
    int mrA = 0, mrB = 0;
    const u16* xa = xrow_ptr(p, g, tok, mrA);
    const u16* xb = xrow_ptr(p, g, doB ? tokB : tok, mrB);
    uint2 qa[4], qb[4];
    norm_load(xa, lane, qa);
    norm_load(xb, lane, qb);
    if (doA) norm_finish(qa, lane, gn, mod + (size_t)mrA * 6144 + (which == 0 ? 0 : 3) * DM, H + (size_t)tok * DM);
    if (doB) norm_finish(qb, lane, gn, mod + (size_t)mrB * 6144 + (which == 0 ? 0 : 3) * DM, H + (size_t)tokB * DM);
  }
}
__device__ void phase_norm_dyn(const Params& p, int l, int g, int* cnt) {
  const int tid = otid(), lane = tid & 63;
  const float* gn = p.g1 + l * DM;
  const float* mod = (const float*)(p.ws + OFF_MOD) + (size_t)l * 33 * 6144;
  u16* H = (u16*)(p.ws + OFF_H);
  for (;;) {
    int c = 0;
    if (lane == 0) c = atomicAdd(cnt, 1);
    c = __shfl(c, 0);
    if (c >= NTOK / 8) break;
    for (int t = 0; t < 8; ++t) norm_token(p, l, g, 0, c * 8 + t, lane, gn, mod, H);
  }
}

__device__ void phase_tokprep(const Params& p, int l) {
  const int tid = otid(), lane = tid & 63, wid = tid >> 6;
  u16* P = (u16*)(p.ws + OFF_P);
  u16* KQ = (u16*)(p.ws + OFF_KQ);
  u16* Kd = (u16*)(p.ws + OFF_KD);
  const float* rc = (const float*)(p.ws + OFF_ROPE);
  const float* rs = rc + 1024;
  const int c8 = lane & 7;
  for (int tok = blockIdx.x * 8 + wid; tok < NTOK; tok += gridDim.x * 8) {
    const int pp = tok % TPB;
    const bool lat = pp >= CTXL;
    const int pos = pp - CTXL, prow = pos >> 6, pcol = pos & 63;
    u16* row = P + (size_t)tok * PS;
    const uint4 zz = {0u, 0u, 0u, 0u};
    const uint4 pl_q = *(const uint4*)(row + C_Q + lane * 8);
    const uint4 pl_k = lane < 16 ? *(const uint4*)(row + C_K + lane * 8) : zz;
    const uint4 pl_m = *(const uint4*)(row + (lane < 16 ? D_CKV + lane * 8 : (lane >= 32 ? D_CQ + (lane - 32) * 8 : D_KR + ((lane - 16) & 7) * 8)));
    {
      const bool isk = lane < 32;
      const int cc = (isk ? lane : lane - 32) * 8;
      const int colb = (isk ? B_K : B_Q) + cc;
      const bool hasp = !(pp == 0 || pp == CTXL), hasn = !(pp == CTXL - 1 || pp == TPB - 1);
      float x0[8], x1[8], x2[8];
      uint4 q1 = *(const uint4*)(row + colb); unpack8(q1, x1);
      if (hasp) { uint4 q0 = *(const uint4*)(row - PS + colb); unpack8(q0, x0); } else { for (int e = 0; e < 8; ++e) x0[e] = 0.f; }
      if (hasn) { uint4 q2 = *(const uint4*)(row + PS + colb); unpack8(q2, x2); } else { for (int e = 0; e < 8; ++e) x2[e] = 0.f; }
      const float* cw = p.convw + ((size_t)l * 2 + (isk ? 1 : 0)) * 3 * 256 + cc;
      float o[8];
#pragma unroll
      for (int e = 0; e < 8; ++e) {
        float a = cw[e] * x0[e] + cw[256 + e] * x1[e] + cw[512 + e] * x2[e];
        a = siluf_(a);
        o[e] = isk ? a * 0.125f : a;
      }
      *(uint4*)(KQ + (size_t)tok * 512 + (isk ? 0 : 256) + cc) = pack8f(o);
    }
#pragma unroll
    for (int pass = 0; pass < 2; ++pass) {
      const bool act = pass == 0 || lane < 16;
      const int colb = (pass == 0 ? C_Q : C_K) + lane * 8;
      const float* gg = (pass == 0 ? p.gqn : p.gkn) + l * 64 + c8 * 8;
      float x[8];
      unpack8(pass == 0 ? pl_q : pl_k, x);
      float ss = 0.f;
#pragma unroll
      for (int e = 0; e < 8; ++e) ss += x[e] * x[e];
      ss += __shfl_xor(ss, 1); ss += __shfl_xor(ss, 2); ss += __shfl_xor(ss, 4);
      const float rstd = rsqrtf(ss * (1.f / 64.f) + EPS);
#pragma unroll
      for (int e = 0; e < 8; ++e) x[e] = x[e] * rstd * gg[e];
      float o[8];
#pragma unroll
      for (int e = 0; e < 8; ++e) {
        float other = __shfl_xor(x[e], 2);
        const int ppos = (c8 & 4) ? pcol : prow;
        const int fi = (c8 & 1) * 8 + e;
        float cs = 1.f, sn = 0.f;
        if (lat) { cs = rc[ppos * 16 + fi]; sn = rs[ppos * 16 + fi]; }
        o[e] = (c8 & 2) ? (x[e] * cs + other * sn) : (x[e] * cs - other * sn);
      }
      if (act) *(uint4*)(row + colb) = pack8f(o);
    }
    {
      const bool isckv = lane < 16, iscq = lane >= 32, iskr = lane >= 16 && lane < 24;
      int colb = isckv ? D_CKV + lane * 8 : (iscq ? D_CQ + (lane - 32) * 8 : D_KR + ((lane - 16) & 7) * 8);
      float x[8];
      unpack8(pl_m, x);
      float ss = 0.f;
#pragma unroll
      for (int e = 0; e < 8; ++e) ss += x[e] * x[e];
      ss += __shfl_xor(ss, 1); ss += __shfl_xor(ss, 2); ss += __shfl_xor(ss, 4); ss += __shfl_xor(ss, 8);
      float ss32 = ss + __shfl_xor(ss, 16);
      float o[8];
      if (isckv) {
        const float rstd = rsqrtf(ss * (1.f / 128.f) + EPS);
        const float* gg = p.mkvn + l * 128 + lane * 8;
        for (int e = 0; e < 8; ++e) o[e] = x[e] * rstd * gg[e];
      } else if (iscq) {
        const float rstd = rsqrtf(ss32 * (1.f / 256.f) + EPS);
        const float* gg = p.mqn + l * 256 + (lane - 32) * 8;
        for (int e = 0; e < 8; ++e) o[e] = x[e] * rstd * gg[e];
      } else {
        for (int e = 0; e < 8; ++e) o[e] = x[e];
      }
      float orot[8];
#pragma unroll
      for (int e = 0; e < 8; ++e) {
        float other = __shfl_xor(x[e], 2);
        const int ck = lane & 7;
        const int ppos = (ck & 4) ? pcol : prow;
        const int fi = (ck & 1) * 8 + e;
        float cs = 1.f, sn = 0.f;
        if (lat) { cs = rc[ppos * 16 + fi]; sn = rs[ppos * 16 + fi]; }
        orot[e] = (ck & 2) ? (x[e] * cs + other * sn) : (x[e] * cs - other * sn);
      }
      if (isckv || iscq) *(uint4*)(row + colb) = pack8f(o);
      if (iskr) {
        uint4 q = pack8f(orot);
        const int ck = lane & 7;
#pragma unroll
        for (int hd = 0; hd < 4; ++hd) *(uint4*)(Kd + (size_t)tok * 768 + hd * 192 + 128 + ck * 8) = q;
      }
    }
  }
}

template <int DK, int DV, bool ROPEQ>
__device__ void attn_item(const u16* __restrict__ qrow, const u16* __restrict__ Kp, int kst, const u16* __restrict__ Vp, int vst,
                          u16* __restrict__ orow, int nkeys, float sc, int pos, const float* __restrict__ rc, char* lds) {
  constexpr int KLD = DK + 8, VLD = DV + 32;
  constexpr int KB = 64 * KLD, VB = 64 * VLD;
  u16* KS = (u16*)lds;
  u16* VS = KS + 2 * KB;
  const int tid = otid(), lane = tid & 63, r = lane & 31, h = lane >> 5;
  bf16x8 qf[DK / 16];
  {
#pragma unroll
    for (int s = 0; s < DK / 16; ++s) qf[s] = *(const bf16x8*)(qrow + h * 8 + s * 16);
    if (ROPEQ && pos >= 0) {
      const int prow = pos >> 6, pcol = pos & 63;
      const float* rs = rc + 1024;
      constexpr int s0 = (DK - 64) / 16;
#pragma unroll
      for (int part = 0; part < 2; ++part) {
        const int ppos = part ? pcol : prow;
#pragma unroll
        for (int j = 0; j < 8; ++j) {
          const int fi = 8 * h + j;
          float cs = rc[ppos * 16 + fi], sn = rs[ppos * 16 + fi];
          float x1 = bf2f((u16)qf[s0 + 2 * part][j]), x2 = bf2f((u16)qf[s0 + 2 * part + 1][j]);
          qf[s0 + 2 * part][j] = (short)f2bf(x1 * cs - x2 * sn);
          qf[s0 + 2 * part + 1][j] = (short)f2bf(x2 * cs + x1 * sn);
        }
      }
    }
  }
  f32x16 oT[DV / 32];
#pragma unroll
  for (int d = 0; d < DV / 32; ++d)
#pragma unroll
    for (int e = 0; e < 16; ++e) oT[d][e] = 0.f;
  float m = -1e30f, lsum = 0.f;
  const int ntile = nkeys >> 6;
  constexpr int NKP = KB * 2 / 1024, NVP = VB * 2 / 1024, NKJ = (NKP + 7) / 8, NVJ = (NVP + 7) / 8;
  const int wu = __builtin_amdgcn_readfirstlane(tid >> 6);
  unsigned ksrc[NKJ], vsrc[NVJ];
#pragma unroll
  for (int j = 0; j < NKJ; ++j) { const int o = (wu + 8 * j) * 1024 + lane * 16, row = o / (KLD * 2), col = (o % (KLD * 2)) / 2; ksrc[j] = (unsigned)(row * kst + (col < DK ? col : 0)) * 2u; }
#pragma unroll
  for (int j = 0; j < NVJ; ++j) { const int o = (wu + 8 * j) * 1024 + lane * 16, row = o / (VLD * 2), col = (o % (VLD * 2)) / 2; vsrc[j] = (unsigned)(row * vst + (col < DV ? col : 0)) * 2u; }
#define ATT_DMA(kt_, buf_) do { \
    const char* kg_ = (const char*)Kp + (size_t)(kt_) * 64 * kst * 2; const char* vg_ = (const char*)Vp + (size_t)(kt_) * 64 * vst * 2; \
    _Pragma("unroll") for (int j = 0; j < NKJ; ++j) if (wu + 8 * j < NKP) \
      __builtin_amdgcn_global_load_lds((const unsigned*)(kg_ + ksrc[j]), (LAS unsigned*)((char*)KS + (buf_) * KB * 2 + (wu + 8 * j) * 1024), 16, 0, 0); \
    _Pragma("unroll") for (int j = 0; j < NVJ; ++j) if (wu + 8 * j < NVP) \
      __builtin_amdgcn_global_load_lds((const unsigned*)(vg_ + vsrc[j]), (LAS unsigned*)((char*)VS + (buf_) * VB * 2 + (wu + 8 * j) * 1024), 16, 0, 0); \
  } while (0)
  __syncthreads();
  ATT_DMA(0, 0);
  asm volatile("s_waitcnt vmcnt(0)" ::: "memory");
  __syncthreads();
  const int troff = ((lane & 15) >> 2) * VLD + 16 * ((lane >> 4) & 1) + 4 * (lane & 3) + 4 * h * VLD;
#pragma unroll 1
  for (int kt = 0; kt < ntile; ++kt) {
    const int buf = kt & 1;
    if (kt + 1 < ntile) ATT_DMA(kt + 1, buf ^ 1);
    const u16* KSb = KS + buf * KB;
    const u16* VSb = VS + buf * VB;
    f32x16 sT[2];
#pragma unroll
    for (int kk = 0; kk < 2; ++kk) {
#pragma unroll
      for (int e = 0; e < 16; ++e) sT[kk][e] = 0.f;
#pragma unroll
      for (int s = 0; s < DK / 16; ++s) {
        bf16x8 a = *(const bf16x8*)(KSb + (kk * 32 + r) * KLD + s * 16 + h * 8);
        sT[kk] = MFMA(a, qf[s], sT[kk]);
      }
    }
    float mx = -1e30f;
#pragma unroll
    for (int kk = 0; kk < 2; ++kk)
#pragma unroll
      for (int e = 0; e < 16; ++e) mx = fmaxf(mx, sT[kk][e]);
    mx = fmaxf(mx, __shfl_xor(mx, 32));
    const float mn = fmaxf(m, mx * sc);
    const float alpha = ex2(m - mn);
    m = mn;
    lsum *= alpha;
#pragma unroll
    for (int kk = 0; kk < 2; ++kk) {
      sT[kk] = sT[kk] * sc - mn;
#pragma unroll
      for (int e = 0; e < 16; ++e) sT[kk][e] = ex2(sT[kk][e]);
    }
    {
      f32x16 t16 = sT[0] + sT[1];
      typedef float f32x8v __attribute__((ext_vector_type(8)));
      typedef float f32x4v __attribute__((ext_vector_type(4)));
      f32x8v t8 = __builtin_shufflevector(t16, t16, 0, 1, 2, 3, 4, 5, 6, 7) + __builtin_shufflevector(t16, t16, 8, 9, 10, 11, 12, 13, 14, 15);
      f32x4v t4 = __builtin_shufflevector(t8, t8, 0, 1, 2, 3) + __builtin_shufflevector(t8, t8, 4, 5, 6, 7);
      lsum += (t4[0] + t4[1]) + (t4[2] + t4[3]);
    }
#pragma unroll
    for (int d = 0; d < DV / 32; ++d) oT[d] = oT[d] * alpha;
#pragma unroll
    for (int kk = 0; kk < 2; ++kk)
#pragma unroll
      for (int s2 = 0; s2 < 2; ++s2) {
        bf16x8 pb = pack8(sT[kk], s2);
#pragma unroll
        for (int d = 0; d < DV / 32; ++d) {
          const u16* vb = VSb + (kk * 32 + s2 * 16) * VLD + d * 32 + troff;
          s16x4 lo = __builtin_amdgcn_ds_read_tr16_b64_v4i16((LAS s16x4*)vb);
          s16x4 hi = __builtin_amdgcn_ds_read_tr16_b64_v4i16((LAS s16x4*)(vb + 8 * VLD));
          oT[d] = MFMA(cat4(lo, hi), pb, oT[d]);
        }
      }
    asm volatile("s_waitcnt vmcnt(0)" ::: "memory");
    __syncthreads();
  }
#undef ATT_DMA
  lsum += __shfl_xor(lsum, 32);
  const float inv = 1.f / lsum;
#pragma unroll
  for (int d = 0; d < DV / 32; ++d)
#pragma unroll
    for (int gq = 0; gq < 4; ++gq) {
      uint2 o;
      o.x = pack2(oT[d][4 * gq] * inv, oT[d][4 * gq + 1] * inv);
      o.y = pack2(oT[d][4 * gq + 2] * inv, oT[d][4 * gq + 3] * inv);
      *(uint2*)(orow + d * 32 + 8 * gq + 4 * h) = o;
    }
}

__device__ void scanA_unit(const Params& p, int l, int unit, char* lds) {
  const int tid = otid(), lane = tid & 63, wid = tid >> 6, r = lane & 31, h = lane >> 5;
  const int bl = unit >> 3, hd = (unit >> 1) & 3, dir = unit & 1;
  const u16* P = (const u16*)(p.ws + OFF_P);
  u16* Oa = (u16*)(p.ws + OFF_OA) + (size_t)dir * NTOK * 512;
  float* BC = (float*)lds;
  u16* Qs = (u16*)(lds + 33792);
  u16* KKs = (u16*)(lds + 51200);
  u16* AM = (u16*)(lds + 51200);
  u16* KT = (u16*)(lds + 68608);
  u16* VT = (u16*)(lds + 87040);
  u16* ST = (u16*)(lds + 105472);
  float* EL = (float*)(lds + 140288);
  float* QTOT = (float*)(lds + 140800);
  const int ch = tid & 15;
  float lbv[8];
  {
    const float* lb = (const float*)(p.ws + OFF_LB) + (size_t)l * 1024 + dir * 512 + hd * 128 + ch * 8;
#pragma unroll
    for (int e = 0; e < 8; ++e) lbv[e] = lb[e];
  }
  const int vt = wid & 3, th = wid >> 2;
  f32x16 S[2];
#pragma unroll
  for (int j = 0; j < 2; ++j)
#pragma unroll
    for (int e = 0; e < 16; ++e) S[j][e] = 0.f;
  __syncthreads();
  for (int i = tid; i < 128 * 136 / 2; i += NTHR) ((unsigned*)ST)[i] = 0u;
  uint4 pqr[2], pfr[2], pvr[2];
#define SCANA_TOK0(st_) (bl * TPB + ((st_) >= 4 ? CTXL : 0) + (dir ? ((st_) >= 4 ? 31 - ((st_) - 4) : 3 - (st_)) : ((st_) >= 4 ? (st_) - 4 : (st_))) * 64)
#define SCANA_PREFETCH(st_) do { const int t0_ = SCANA_TOK0(st_); \
    _Pragma("unroll") for (int j = 0; j < 2; ++j) { const int i = (tid >> 4) + 32 * j; \
      const u16* row = P + (size_t)(t0_ + (dir ? 63 - i : i)) * PS + hd * 128 + ch * 8; \
      pqr[j] = *(const uint4*)(row + A_Q); pfr[j] = *(const uint4*)(row + (dir ? A_FB : A_FF)); pvr[j] = *(const uint4*)(row + A_I); } } while (0)
  SCANA_PREFETCH(0);
#pragma unroll 1
  for (int step = 0; step < 36; ++step) {
    const int tok0 = SCANA_TOK0(step);
    __syncthreads();
#pragma unroll
    for (int j = 0; j < 2; ++j) {
      const int i = (tid >> 4) + 32 * j;
      uint4 qraw = pqr[j];
      uint4 fraw = pfr[j];
      uint4 vq = pvr[j];
      float qv[8], fv[8], kkv[8];
      unpack8(qraw, qv); unpack8(fraw, fv);
#pragma unroll
      for (int e = 0; e < 8; ++e) {
        qv[e] = siluf_(qv[e]);
        const float ex = __expf(-fv[e]);
        const float sg = 1.f / (1.f + ex);
        const float sgn = ex / (1.f + ex);
        const float f = lbv[e] + (1.f - lbv[e]) * sg;
        kkv[e] = (1.f - lbv[e]) * (fv[e] > 30.f ? 0.f : (fv[e] < -30.f ? 1.f : sgn));
        BC[i * 132 + ch * 8 + e] = __log2f(fmaxf(f, 1e-37f));
      }
      *(uint4*)(Qs + i * 136 + ch * 8) = pack8f(qv);
      *(uint4*)(KKs + i * 136 + ch * 8) = pack8f(kkv);
      u16* dv = VT + (ch * 8) * 72 + i;
      dv[0 * 72] = (u16)(vq.x & 0xffff); dv[1 * 72] = (u16)(vq.x >> 16); dv[2 * 72] = (u16)(vq.y & 0xffff); dv[3 * 72] = (u16)(vq.y >> 16);
      dv[4 * 72] = (u16)(vq.z & 0xffff); dv[5 * 72] = (u16)(vq.z >> 16); dv[6 * 72] = (u16)(vq.w & 0xffff); dv[7 * 72] = (u16)(vq.w >> 16);
    }
    __syncthreads();
    {
      const int k = tid & 127, qd = tid >> 7;
      float run = 0.f;
      for (int i = qd * 16; i < qd * 16 + 16; ++i) { run += BC[i * 132 + k]; BC[i * 132 + k] = run; }
      QTOT[qd * 128 + k] = run;
    }
    __syncthreads();
    {
      const int k = tid & 127, qd = tid >> 7;
      float off = 0.f;
      for (int q2 = 0; q2 < qd; ++q2) off += QTOT[q2 * 128 + k];
      if (qd > 0) for (int i = qd * 16; i < qd * 16 + 16; ++i) BC[i * 132 + k] += off;
    }
    __syncthreads();
    f32x4 cod[2];
#pragma unroll
    for (int jj = 0; jj < 2; ++jj) {
      cod[jj] = (f32x4){0.f, 0.f, 0.f, 0.f};
      const int job = wid + 8 * jj;
      if (job < 10) {
        const int bI = job < 1 ? 0 : (job < 3 ? 1 : (job < 6 ? 2 : 3));
        const int bJ = job - (bI * (bI + 1)) / 2;
        const int l16 = lane & 15, kg = lane >> 4;
        const int t = 16 * bI + l16, s = 16 * bJ + l16, rr = 16 * bI;
#pragma unroll
        for (int ks = 0; ks < 4; ++ks) {
          const int k0 = ks * 32 + kg * 8;
          float qv[8], kv[8];
          unpack8(*(const uint4*)(Qs + t * 136 + k0), qv);
          unpack8(*(const uint4*)(KKs + s * 136 + k0), kv);
#pragma unroll
          for (int e = 0; e < 8; ++e) {
            const float br = BC[rr * 132 + k0 + e];
            qv[e] *= ex2(BC[t * 132 + k0 + e] - br);
            kv[e] *= ex2(fminf(br - BC[s * 132 + k0 + e], 120.f));
          }
          union { uint4 u; bf16x8 v; } ua, ub;
          ua.u = pack8f(qv); ub.u = pack8f(kv);
          cod[jj] = __builtin_amdgcn_mfma_f32_16x16x32_bf16(ua.v, ub.v, cod[jj], 0, 0, 0);
        }
      }
    }
    if (tid < 128) EL[tid] = ex2(BC[63 * 132 + tid]);
#pragma unroll
    for (int j = 0; j < 2; ++j) {
      const int i = (tid >> 4) + 32 * j;
      float kv[8];
      unpack8(*(const uint4*)(KKs + i * 136 + ch * 8), kv);
      u16* dk = KT + (ch * 8) * 72 + i;
#pragma unroll
      for (int e = 0; e < 8; ++e) {
        const float b = BC[i * 132 + ch * 8 + e], bl_ = BC[63 * 132 + ch * 8 + e];
        dk[e * 72] = f2bf(kv[e] * ex2(bl_ - b));
      }
    }
    __syncthreads();
#pragma unroll
    for (int j = 0; j < 2; ++j) {
      const int i = (tid >> 4) + 32 * j;
      float qv[8];
      unpack8(*(const uint4*)(Qs + i * 136 + ch * 8), qv);
#pragma unroll
      for (int e = 0; e < 8; ++e) qv[e] *= ex2(BC[i * 132 + ch * 8 + e]);
      *(uint4*)(Qs + i * 136 + ch * 8) = pack8f(qv);
    }
    for (int i = tid; i < 64 * 72 / 2; i += NTHR) ((unsigned*)AM)[i] = 0u;
    __syncthreads();
#pragma unroll
    for (int jj = 0; jj < 2; ++jj) {
      const int job = wid + 8 * jj;
      if (job < 10) {
        const int bI = job < 1 ? 0 : (job < 3 ? 1 : (job < 6 ? 2 : 3));
        const int bJ = job - (bI * (bI + 1)) / 2;
        const int l16 = lane & 15, kg = lane >> 4;
#pragma unroll
        for (int e = 0; e < 4; ++e) {
          const int tp = 4 * kg + e;
          const float v = (bJ < bI || l16 <= tp) ? cod[jj][e] : 0.f;
          AM[(16 * bI + tp) * 72 + 16 * bJ + l16] = f2bf(v);
        }
      }
    }
    __syncthreads();
    if (step + 1 < 36) SCANA_PREFETCH(step + 1);
    f32x16 o;
#pragma unroll
    for (int e = 0; e < 16; ++e) o[e] = 0.f;
#pragma unroll
    for (int ks = 0; ks < 8; ++ks) {
      bf16x8 a = *(const bf16x8*)(Qs + (th * 32 + r) * 136 + ks * 16 + h * 8);
      bf16x8 b = *(const bf16x8*)(ST + (vt * 32 + r) * 136 + ks * 16 + h * 8);
      o = MFMA(a, b, o);
    }
    bf16x8 bv[4];
#pragma unroll
    for (int ks = 0; ks < 4; ++ks) bv[ks] = *(const bf16x8*)(VT + (vt * 32 + r) * 72 + ks * 16 + h * 8);
#pragma unroll
    for (int ks = 0; ks < 4; ++ks) {
      bf16x8 a = *(const bf16x8*)(AM + (th * 32 + r) * 72 + ks * 16 + h * 8);
      o = MFMA(a, bv[ks], o);
    }
    {
      u16* ob = Oa + (size_t)tok0 * 512 + hd * 128 + vt * 32 + r;
#pragma unroll
      for (int e = 0; e < 16; ++e) {
        const int i = th * 32 + crow(e, h);
        ob[(dir ? 63 - i : i) * 512] = f2bf(o[e]);
      }
    }
    __syncthreads();
#pragma unroll
    for (int j = 0; j < 2; ++j) {
      const int kt = 2 * th + j;
#pragma unroll
      for (int e = 0; e < 16; ++e) S[j][e] *= EL[kt * 32 + crow(e, h)];
#pragma unroll
      for (int ks = 0; ks < 4; ++ks) {
        bf16x8 a = *(const bf16x8*)(KT + (kt * 32 + r) * 72 + ks * 16 + h * 8);
        S[j] = MFMA(a, bv[ks], S[j]);
      }
#pragma unroll
      for (int gq = 0; gq < 4; ++gq) {
        uint2 w;
        w.x = pack2(S[j][4 * gq], S[j][4 * gq + 1]); w.y = pack2(S[j][4 * gq + 2], S[j][4 * gq + 3]);
        *(uint2*)(ST + (vt * 32 + r) * 136 + kt * 32 + 8 * gq + 4 * h) = w;
      }
    }
  }
#undef SCANA_PREFETCH
#undef SCANA_TOK0
}

__device__ void scanB_unit(const Params& p, int l, int unit2, char* lds) {
  const int tid0 = otid(), vb = tid0 >> 8, tid = tid0 & 255, lane = tid & 63, wid = tid >> 6, r = lane & 31, h = lane >> 5;
  const int unit = unit2 * 2 + vb;
  lds += vb * LDSV;
  const int bl = unit >> 3, hd = (unit >> 1) & 3, dir = unit & 1;
  const u16* P = (const u16*)(p.ws + OFF_P);
  const u16* KQ = (const u16*)(p.ws + OFF_KQ);
  const float* Gb = (const float*)(p.ws + OFF_GB);
  u16* Ob = (u16*)(p.ws + OFF_OB) + (size_t)dir * NTOK * 512;
  u16* QB = (u16*)lds;
  u16* KB = (u16*)(lds + 9216);
  u16* SM = (u16*)(lds + 18432);
  u16* KWT = (u16*)(lds + 27648);
  u16* VT = (u16*)(lds + 36864);
  float* vec = (float*)(lds + 55296);
  float *IG = vec, *LF = vec + 64, *BV = vec + 128, *UV = vec + 192, *MT = vec + 256, *WI = vec + 320, *WK = vec + 384,
        *DEN = vec + 448, *NV = vec + 512  , *SC = vec + 640, *BL2 = vec + 704, *UL2 = vec + 768, *EMT = vec + 832;
  const float bI = p.bgate[l * 16 + (2 * dir) * 4 + hd], bF = p.bgate[l * 16 + (2 * dir + 1) * 4 + hd];
  f32x16 C[2];
#pragma unroll
  for (int ft = 0; ft < 2; ++ft)
#pragma unroll
    for (int e = 0; e < 16; ++e) C[ft][e] = 0.f;
  float m = -1e30f;
  __syncthreads();
  if (tid < 128) NV[tid] = 0.f;
  int cur = 0;
  uint4 pk0, pk1, pq0, pq1, pv0, pv1, pv2, pv3; float pgI = 0.f, pgF = 0.f;
#define SCANB_TOK0(st_) (bl * TPB + ((st_) >= 4 ? CTXL : 0) + (dir ? ((st_) >= 4 ? 31 - ((st_) - 4) : 3 - (st_)) : ((st_) >= 4 ? (st_) - 4 : (st_))) * 64)
#define SCANB_LDKQ(j, K_, Q_) do { const int id = tid + 256 * (j), i = id >> 3, c8 = id & 7; \
      const u16* row = KQ + (size_t)(t0_ + (dir ? 63 - i : i)) * 512 + hd * 64 + c8 * 8; K_ = *(const uint4*)(row); Q_ = *(const uint4*)(row + 256); } while (0)
#define SCANB_LDV(j, V_) do { const int id = tid + 256 * (j), i = id >> 4, c16 = id & 15; \
      V_ = *(const uint4*)(P + (size_t)(t0_ + (dir ? 63 - i : i)) * PS + B_V + hd * 128 + c16 * 8); } while (0)
#define SCANB_PREFETCH(st_) do { const int t0_ = SCANB_TOK0(st_); \
    SCANB_LDKQ(0, pk0, pq0); SCANB_LDKQ(1, pk1, pq1); SCANB_LDV(0, pv0); SCANB_LDV(1, pv1); SCANB_LDV(2, pv2); SCANB_LDV(3, pv3); \
    if (tid < 64) { const int tok = t0_ + (dir ? 63 - tid : tid); pgI = Gb[(size_t)tok * 16 + (2 * dir) * 4 + hd]; pgF = Gb[(size_t)tok * 16 + (2 * dir + 1) * 4 + hd]; } } while (0)
#define SCANB_STKQ(j, K_, Q_) do { const int id = tid + 256 * (j), i = id >> 3, c8 = id & 7; \
      *(uint4*)(KB + i * 72 + c8 * 8) = K_; *(uint4*)(QB + i * 72 + c8 * 8) = Q_; } while (0)
#define SCANB_STV(j, V_) do { const int id = tid + 256 * (j), i = id >> 4, c16 = id & 15; const uint4 vq = V_; u16* dv = VT + (c16 * 8) * 72 + i; \
      dv[0 * 72] = (u16)(vq.x & 0xffff); dv[1 * 72] = (u16)(vq.x >> 16); dv[2 * 72] = (u16)(vq.y & 0xffff); dv[3 * 72] = (u16)(vq.y >> 16); \
      dv[4 * 72] = (u16)(vq.z & 0xffff); dv[5 * 72] = (u16)(vq.z >> 16); dv[6 * 72] = (u16)(vq.w & 0xffff); dv[7 * 72] = (u16)(vq.w >> 16); } while (0)
  SCANB_PREFETCH(0);
#pragma unroll 1
  for (int step = 0; step < 36; ++step) {
    const int tok0 = SCANB_TOK0(step);
    __syncthreads();
    SCANB_STKQ(0, pk0, pq0); SCANB_STKQ(1, pk1, pq1);
    SCANB_STV(0, pv0); SCANB_STV(1, pv1); SCANB_STV(2, pv2); SCANB_STV(3, pv3);
    if (tid < 64) {
      const int i = tid;
      const float gI = pgI + bI;
      const float gF = pgF + bF;
      const float lf = fminf(gF, 0.f) - log1pf(expf(-fabsf(gF)));
      float b = lf;
#pragma unroll
      for (int d = 1; d < 64; d <<= 1) { float t = __shfl_up(b, d); if (lane >= d) b += t; }
      const float u = gI - b;
      float pm = u;
#pragma unroll
      for (int d = 1; d < 64; d <<= 1) { float t = __shfl_up(pm, d); if (lane >= d) pm = fmaxf(pm, t); }
      const float mt = b + fmaxf(m, pm);
      const float wi = expf(b + m - mt);
      const float mnew = __shfl(mt, 63), b63 = __shfl(b, 63);
      const float dec = expf(b63 + m - mnew);
      const float wk = expf(b63 - b + gI - mnew);
      IG[i] = gI; LF[i] = lf; BV[i] = b; UV[i] = u; MT[i] = mt; WI[i] = wi; WK[i] = wk;
      BL2[i] = (b - mt) * LOG2E; UL2[i] = u * LOG2E; EMT[i] = expf(-mt);
      if (i == 0) { SC[0] = mnew; SC[1] = dec; }
    }
    __syncthreads();
    {
      const int tt = wid >> 1, st = wid & 1;
      f32x16 a16;
#pragma unroll
      for (int e = 0; e < 16; ++e) a16[e] = 0.f;
#pragma unroll
      for (int ks = 0; ks < 4; ++ks) {
        bf16x8 a = *(const bf16x8*)(QB + (tt * 32 + r) * 72 + ks * 16 + h * 8);
        bf16x8 b = *(const bf16x8*)(KB + (st * 32 + r) * 72 + ks * 16 + h * 8);
        a16 = MFMA(a, b, a16);
      }
      const int s = st * 32 + r;
      const float us = UL2[s];
#pragma unroll
      for (int e = 0; e < 16; ++e) {
        const int t = tt * 32 + crow(e, h);
        float v = 0.f;
        if (s <= t) v = a16[e] * ex2(BL2[t] + us);
        SM[t * 72 + s] = f2bf(v);
      }
    }
#pragma unroll
    for (int j = 0; j < 2; ++j) {
      const int id = tid + 256 * j, i = id >> 3, c8 = id & 7;
      float kv[8];
      unpack8(*(const uint4*)(KB + i * 72 + c8 * 8), kv);
      const float wk = WK[i];
#pragma unroll
      for (int e = 0; e < 8; ++e) KWT[(c8 * 8 + e) * 72 + i] = f2bf(kv[e] * wk);
    }
    __syncthreads();
    const float mnew = SC[0], dec = SC[1];
    if (tid < 64) {
      const int t = tid;
      float rsum = 0.f, qn = 0.f;
#pragma unroll
      for (int c8 = 0; c8 < 8; ++c8) {
        float sv[8], qv[8];
        unpack8(*(const uint4*)(SM + t * 72 + c8 * 8), sv);
        unpack8(*(const uint4*)(QB + t * 72 + c8 * 8), qv);
#pragma unroll
        for (int e = 0; e < 8; ++e) { rsum += sv[e]; qn += qv[e] * NV[cur * 64 + c8 * 8 + e]; }
      }
      DEN[t] = 1.f / fmaxf(fabsf(WI[t] * qn + rsum), EMT[t]);
    } else if (tid < 128) {
      const int f = tid - 64;
      float ns = 0.f;
#pragma unroll
      for (int c8 = 0; c8 < 8; ++c8) {
        float kv[8];
        unpack8(*(const uint4*)(KWT + f * 72 + c8 * 8), kv);
#pragma unroll
        for (int e = 0; e < 8; ++e) ns += kv[e];
      }
      NV[(cur ^ 1) * 64 + f] = dec * NV[cur * 64 + f] + ns;
    }
    __syncthreads();
    if (step + 1 < 36) SCANB_PREFETCH(step + 1);
    f32x16 num[2];
#pragma unroll
    for (int tt = 0; tt < 2; ++tt)
#pragma unroll
      for (int e = 0; e < 16; ++e) num[tt][e] = 0.f;
#pragma unroll
    for (int ft = 0; ft < 2; ++ft)
#pragma unroll
      for (int s = 0; s < 2; ++s) {
        bf16x8 pb = pack8(C[ft], s);
#pragma unroll
        for (int tt = 0; tt < 2; ++tt) {
          const u16* qb = QB + (tt * 32 + r) * 72 + ft * 32 + s * 16 + 4 * h;
          bf16x8 a = cat4(*(const s16x4*)qb, *(const s16x4*)(qb + 8));
          num[tt] = MFMA(a, pb, num[tt]);
        }
      }
#pragma unroll
    for (int tt = 0; tt < 2; ++tt)
#pragma unroll
      for (int e = 0; e < 16; ++e) num[tt][e] *= WI[tt * 32 + crow(e, h)];
    bf16x8 bv[4];
#pragma unroll
    for (int ks = 0; ks < 4; ++ks) bv[ks] = *(const bf16x8*)(VT + (wid * 32 + r) * 72 + ks * 16 + h * 8);
#pragma unroll
    for (int ks = 0; ks < 4; ++ks)
#pragma unroll
      for (int tt = 0; tt < 2; ++tt) {
        bf16x8 a = *(const bf16x8*)(SM + (tt * 32 + r) * 72 + ks * 16 + h * 8);
        num[tt] = MFMA(a, bv[ks], num[tt]);
      }
#pragma unroll
    for (int tt = 0; tt < 2; ++tt)
#pragma unroll
      for (int e = 0; e < 16; ++e) {
        const int i = tt * 32 + crow(e, h);
        const int tok = tok0 + (dir ? 63 - i : i);
        Ob[(size_t)tok * 512 + hd * 128 + wid * 32 + r] = f2bf(num[tt][e] * DEN[i]);
      }
#pragma unroll
    for (int ft = 0; ft < 2; ++ft) {
#pragma unroll
      for (int e = 0; e < 16; ++e) C[ft][e] *= dec;
#pragma unroll
      for (int ks = 0; ks < 4; ++ks) {
        bf16x8 a = *(const bf16x8*)(KWT + (ft * 32 + r) * 72 + ks * 16 + h * 8);
        C[ft] = MFMA(a, bv[ks], C[ft]);
      }
    }
    m = mnew;
    cur ^= 1;
  }
#undef SCANB_PREFETCH
#undef SCANB_LDKQ
#undef SCANB_LDV
#undef SCANB_STKQ
#undef SCANB_STV
#undef SCANB_TOK0
}

__device__ void phase_mixers(const Params& p, int l, int g, char* lds, int cbase = 0, bool scans_only = false, bool a_only = false) {
  int* s_item = (int*)(lds + LDS_BYTES - 16);
  int* cnt = (int*)(p.ws + OFF_CNT) + cbase + (l * NG + g);
  const u16* P = (const u16*)(p.ws + OFF_P);
  const u16* Qd = (const u16*)(p.ws + OFF_QD);
  const u16* Kd = (const u16*)(p.ws + OFF_KD);
  const u16* Vd = (const u16*)(p.ws + OFF_VD);
  u16* Y = (u16*)((char*)p.out);
  const float* rc = (const float*)(p.ws + OFF_ROPE);
  constexpr int NSA = NB * 8, NSB = NB * 4;
  constexpr int ND_L = NB * 4 * 8, NC_L = NB * 2 * 32, ND_C = NB * 4, NC_C = NB * 2 * 4;
  constexpr int I1 = NSA, I2 = I1 + NSB, I3 = I2 + ND_L, I4 = I3 + NC_L, I5 = I4 + ND_C, I6 = I5 + NC_C;
  const float scC = 0.125f * LOG2E, scD = 0.07216878364870322f * LOG2E;
  while (true) {
    __syncthreads();
    if (otid() == 0) *s_item = atomicAdd(cnt, 1);
    __syncthreads();
    const int it = *s_item;
    if (it >= (a_only ? I1 : (scans_only ? I2 : (l == DEPTH - 1 ? I4 : I6)))) break;
    if (it < I1) scanA_unit(p, l, it, lds);
    else if (it < I2) scanB_unit(p, l, it - I1, lds);
    else {
      bool isD, isLat; int q;
      if (it < I3) { isD = true; isLat = true; q = it - I2; }
      else if (it < I4) { isD = false; isLat = true; q = it - I3; }
      else if (it < I5) { isD = true; isLat = false; q = it - I4; }
      else { isD = false; isLat = false; q = it - I5; }
      const int tid = otid(), lane = tid & 63, wid = tid >> 6, r = lane & 31;
      const int nkeys = isLat ? TPB : CTXL;
      if (isD) {
        const int nqt = isLat ? 8 : 1;
        const int qt = q % nqt, hd = (q / nqt) % 4, bl = q / (nqt * 4);
        const int tokk = bl * TPB, ql = qt * 256 + wid * 32 + r;
        const int tokq = tokk + (isLat ? CTXL : 0) + ql;
        attn_item<192, 128, true>(Qd + (size_t)tokq * 768 + hd * 192, Kd + (size_t)tokk * 768 + hd * 192, 768,
                                  Vd + (size_t)tokk * 512 + hd * 128, 512, Y + (size_t)tokq * 2048 + 1536 + hd * 128,
                                  nkeys, scD, isLat ? ql : -1, rc, lds);
      } else {
        const int nqt = isLat ? 32 : 4;
        const int qt = q % nqt, kvh = (q / nqt) % 2, bl = q / (nqt * 2);
        const int hq = kvh * 4 + (wid >> 1);
        const int tokk = bl * TPB, ql = qt * 64 + (wid & 1) * 32 + r;
        const int tokq = tokk + (isLat ? CTXL : 0) + ql;
        attn_item<64, 64, false>(P + (size_t)tokq * PS + C_Q + hq * 64, P + (size_t)tokk * PS + C_K + kvh * 64, PS,
                                 P + (size_t)tokk * PS + C_V + kvh * 64, PS, Y + (size_t)tokq * 2048 + 1024 + hq * 64,
                                 nkeys, scC, -1, rc, lds);
      }
    }
  }
}

__device__ void phase_readout(const Params& p, int l) {
  const int tid = otid(), lane = tid & 63, wid = tid >> 6;
  const u16* P = (const u16*)(p.ws + OFF_P);
  const u16* Oa = (const u16*)(p.ws + OFF_OA);
  const u16* Ob = (const u16*)(p.ws + OFF_OB);
  u16* Y = (u16*)((char*)p.out);
  const int col = lane * 8;
  for (int tok = blockIdx.x * 8 + wid; tok < NTOK; tok += gridDim.x * 8) {
    if (l == DEPTH - 1 && (tok % TPB) < CTXL) continue;
    uint4 ra[2], rb[2], rg[2];
#pragma unroll
    for (int mix = 0; mix < 2; ++mix) {
      const u16* O = mix == 0 ? Oa : Ob;
      ra[mix] = *(const uint4*)(O + (size_t)tok * 512 + col);
      rb[mix] = *(const uint4*)(O + ((size_t)NTOK + tok) * 512 + col);
      rg[mix] = *(const uint4*)(P + (size_t)tok * PS + (mix == 0 ? A_G : B_O) + col);
    }
    uint4 outv[2];
#pragma unroll
    for (int mix = 0; mix < 2; ++mix) {
      float a[8], b[8], gt[8], o[8];
      unpack8(ra[mix], a); unpack8(rb[mix], b); unpack8(rg[mix], gt);
      float ss = 0.f;
#pragma unroll
      for (int e = 0; e < 8; ++e) { a[e] += b[e]; ss += a[e] * a[e]; }
      ss += __shfl_xor(ss, 1); ss += __shfl_xor(ss, 2); ss += __shfl_xor(ss, 4); ss += __shfl_xor(ss, 8);
      const float rstd = rsqrtf(ss * (1.f / 128.f) + EPS);
      const float* gn = (mix == 0 ? p.hnorm : p.mnorm) + l * 128 + (col & 127);
#pragma unroll
      for (int e = 0; e < 8; ++e) {
        float y = a[e] * rstd * gn[e];
        o[e] = y * (mix == 0 ? siluf_(gt[e]) : sigmoidf_(gt[e]));
      }
      outv[mix] = pack8f(o);
    }
    *(uint4*)(Y + (size_t)tok * 2048 + col) = outv[0];
    *(uint4*)(Y + (size_t)tok * 2048 + 512 + col) = outv[1];
  }
}

struct EpiInproj {
  u16* P; float* Gb;
  DI bool operator()(f32x4 (&acc)[2][2][4][2], const pg8::UDesc& u, int wr, int wc, int fr, int fq) const {
    const int row0 = u.pm * 256 + wr * 64 + fr, col0 = u.pn * 256 + wc * 32 + 8 * fq;
    const bool gate = (u.pn == 9) && (wc == 0) && (fq < 2);
#pragma unroll
    for (int ai = 0; ai < 2; ++ai)
#pragma unroll
      for (int m = 0; m < 4; ++m) {
        const size_t row = (size_t)(row0 + ai * 128 + m * 16);
#pragma unroll
        for (int bj = 0; bj < 2; ++bj) *(uint4*)(P + row * PS + col0 + bj * 128) = pk8(acc[ai][bj][m][0], acc[ai][bj][m][1]);
        if (gate) { *(f32x4*)(Gb + row * 16 + 8 * fq) = acc[ai][0][m][0]; *(f32x4*)(Gb + row * 16 + 8 * fq + 4) = acc[ai][0][m][1]; }
      }
    return false;
  }
};
__device__ void phase_inproj(const Params& p, int l, char* lds) {
  pg8::PlainSched S{p.ws + OFF_H, wsel(p, l) + OFF_WINT, 2048u, 2048u, 16, NTOK / 256, PS / 256, (int)gridDim.x, (int)blockIdx.x};
  EpiInproj E{(u16*)(p.ws + OFF_P), (float*)(p.ws + OFF_GB)};
  pg8::gemm_stream(( LAS unsigned char*)lds, S, E);
}

struct MlaSched {
  const char* P; const char* Wq; const char* Wk; const char* Wv; int G, c;
  DI bool next(int i, pg8::UDesc& u) const {
    const long L = (long)i * G + c; if (L >= (NTOK / 256) * 7) return false;
    const int pm = (int)(L / 7), j = (int)(L % 7);
    u.pm = pm; u.lda2 = PS * 2;
    if (j < 3) { u.tag = 0; u.pn = j; u.A = P + (size_t)pm * 256 * PS * 2 + D_CQ * 2; u.B = Wq + (size_t)j * 256 * 512; u.ldb2 = 512; u.nt = 4; }
    else if (j < 5) { u.tag = 1; u.pn = j - 3; u.A = P + (size_t)pm * 256 * PS * 2 + D_CKV * 2; u.B = Wk + (size_t)(j - 3) * 256 * 256; u.ldb2 = 256; u.nt = 2; }
    else { u.tag = 2; u.pn = j - 5; u.A = P + (size_t)pm * 256 * PS * 2 + D_CKV * 2; u.B = Wv + (size_t)(j - 5) * 256 * 256; u.ldb2 = 256; u.nt = 2; }
    return true;
  }
};
struct EpiMla {
  u16 *Qd, *Kd, *Vd;
  DI bool operator()(f32x4 (&acc)[2][2][4][2], const pg8::UDesc& u, int wr, int wc, int fr, int fq) const {
    const int row0 = u.pm * 256 + wr * 64 + fr, col0 = u.pn * 256 + wc * 32 + 8 * fq;
#pragma unroll
    for (int ai = 0; ai < 2; ++ai)
#pragma unroll
      for (int m = 0; m < 4; ++m) {
        const size_t row = (size_t)(row0 + ai * 128 + m * 16);
#pragma unroll
        for (int bj = 0; bj < 2; ++bj) {
          const int col = col0 + bj * 128;
          u16* dst = u.tag == 0 ? Qd + row * 768 + col : (u.tag == 1 ? Kd + row * 768 + (col >> 7) * 192 + (col & 127) : Vd + row * 512 + col);
          *(uint4*)dst = pk8(acc[ai][bj][m][0], acc[ai][bj][m][1]);
        }
      }
    return false;
  }
};
__device__ void phase_mlaup(const Params& p, int l, char* lds) {
  MlaSched S{p.ws + OFF_P, wsel(p, l) + OFF_WUQ, wsel(p, l) + OFF_WUK, wsel(p, l) + OFF_WUV, (int)gridDim.x, (int)blockIdx.x};
  EpiMla E{(u16*)(p.ws + OFF_QD), (u16*)(p.ws + OFF_KD), (u16*)(p.ws + OFF_VD)};
  pg8::gemm_stream((LAS unsigned char*)lds, S, E);
}

struct EpiGate {
  u16* Gt;
  DI bool operator()(f32x4 (&acc)[2][2][4][2], const pg8::UDesc& u, int wr, int wc, int fr, int fq) const {
    const int row0 = u.pm * 256 + wr * 64 + fr, col0 = u.pn * 256 + wc * 32 + 8 * fq;
#pragma unroll
    for (int ai = 0; ai < 2; ++ai)
#pragma unroll
      for (int m = 0; m < 4; ++m) {
        const size_t row = (size_t)(row0 + ai * 128 + m * 16);
#pragma unroll
        for (int bj = 0; bj < 2; ++bj) {
          f32x4 a = acc[ai][bj][m][0], b = acc[ai][bj][m][1];
#pragma unroll
          for (int e = 0; e < 4; ++e) { a[e] = fmaxf(sigmoidf_(a[e]), 1e-30f); b[e] = fmaxf(sigmoidf_(b[e]), 1e-30f); }
          *(uint4*)(Gt + row * 4096 + col0 + bj * 128) = pk8(a, b);
        }
      }
    return false;
  }
};
__device__ void phase_gate(const Params& p, int l, char* lds, int lat_only) {
  pg8::PlainSched S{p.ws + OFF_H, wsel(p, l) + OFF_WGT, 2048u, 2048u, 16, NTOK / 256, 16, (int)gridDim.x, (int)blockIdx.x, lat_only};
  EpiGate E{(u16*)(p.ws + OFF_P)};
  pg8::gemm_stream((LAS unsigned char*)lds, S, E);
}

struct BranchSched {
  const char* Y; const char* Wb; int G, c, lat_only;
  DI bool next(int i, pg8::UDesc& u) const {
    int pm, pn; if (!pg8::tile_order((long)(i >> 2) * G + c, lat_only ? NTOK / 256 - NB : NTOK / 256, 4, pm, pn)) return false;
    if (lat_only) pm = pm + (pm >> 3) + 1;
    const int r = i & 3;
    u.pm = pm; u.pn = pn; u.tag = r; u.lda2 = 4096; u.ldb2 = 1024; u.nt = 8;
    u.A = Y + (size_t)pm * 256 * 4096 + r * 1024; u.B = Wb + ((size_t)r * 1024 + pn * 256) * 1024;
    return true;
  }
};
struct EpiBranch {
  const u16* Gt; u16* Mg;
  DI bool operator()(f32x4 (&acc)[2][2][4][2], const pg8::UDesc& u, int wr, int wc, int fr, int fq) const {
    const int row0 = u.pm * 256 + wr * 64 + fr, col0 = u.pn * 256 + wc * 32 + 8 * fq, r = u.tag;
#pragma unroll
    for (int ai = 0; ai < 2; ++ai) {
      uint4 gin[4][2];
#pragma unroll
      for (int m = 0; m < 4; ++m)
#pragma unroll
        for (int bj = 0; bj < 2; ++bj) gin[m][bj] = *(const uint4*)(Gt + (size_t)(row0 + ai * 128 + m * 16) * 4096 + r * 1024 + col0 + bj * 128);
#pragma unroll
      for (int m = 0; m < 4; ++m) {
        const size_t row = (size_t)(row0 + ai * 128 + m * 16);
#pragma unroll
        for (int bj = 0; bj < 2; ++bj) {
          const int col = col0 + bj * 128;
          float gv[8];
          unpack8(gin[m][bj], gv);
          if (r < 3) {
            float gn[8];
            unpack8(*(const uint4*)(Gt + row * 4096 + (r + 1) * 1024 + col), gn);
#pragma unroll
            for (int e = 0; e < 4; ++e) {
              acc[ai][bj][m][0][e] *= gv[e] * __builtin_amdgcn_rcpf(gn[e]);
              acc[ai][bj][m][1][e] *= gv[4 + e] * __builtin_amdgcn_rcpf(gn[4 + e]);
            }
          } else {
            f32x4 a = acc[ai][bj][m][0], b = acc[ai][bj][m][1];
#pragma unroll
            for (int e = 0; e < 4; ++e) { a[e] *= gv[e]; b[e] *= gv[4 + e]; }
            *(uint4*)(Mg + row * 1024 + col) = pk8(a, b);
          }
        }
      }
    }
    return r < 3;
  }
};
__device__ void phase_branch(const Params& p, int l, char* lds, int lat_only) {
  BranchSched S{(const char*)p.out, wsel(p, l) + OFF_WBT, (int)gridDim.x, (int)blockIdx.x, lat_only};
  EpiBranch E{(const u16*)(p.ws + OFF_P), (u16*)(p.ws + OFF_OA)};
  pg8::gemm_stream((LAS unsigned char*)lds, S, E);
}

struct EpiResid {
  const Params* pp; const float* mod; int g, gidx; float* dummy;
  DI bool operator()(f32x4 (&acc)[2][2][4][2], const pg8::UDesc& u, int wr, int wc, int fr, int fq) const {
    int mr; u16* xb = xrow_ptr(*pp, g, u.pm * 256, mr);
    if (dummy) xb = (u16*)dummy + (size_t)u.pm * 256 * DM;
    const float* gate = mod + (size_t)mr * 6144 + gidx * DM;
    const int row0 = wr * 64 + fr, col0 = u.pn * 256 + wc * 32 + 8 * fq;
    f32x4 gv[2][2];
#pragma unroll
    for (int bj = 0; bj < 2; ++bj) { gv[bj][0] = *(const f32x4*)(gate + col0 + bj * 128); gv[bj][1] = *(const f32x4*)(gate + col0 + bj * 128 + 4); }
#pragma unroll
    for (int ai = 0; ai < 2; ++ai) {
      uint4 xin[4][2];
#pragma unroll
      for (int m = 0; m < 4; ++m)
#pragma unroll
        for (int bj = 0; bj < 2; ++bj) xin[m][bj] = *(const uint4*)(xb + (size_t)(row0 + ai * 128 + m * 16) * DM + col0 + bj * 128);
#pragma unroll
      for (int m = 0; m < 4; ++m) {
        u16* xr = xb + (size_t)(row0 + ai * 128 + m * 16) * DM + col0;
#pragma unroll
        for (int bj = 0; bj < 2; ++bj) {
          float xv[8];
          unpack8(xin[m][bj], xv);
          f32x4 x0 = {xv[0], xv[1], xv[2], xv[3]}, x1 = {xv[4], xv[5], xv[6], xv[7]};
          x0 += gv[bj][0] * acc[ai][bj][m][0]; x1 += gv[bj][1] * acc[ai][bj][m][1];
          *(uint4*)(xr + bj * 128) = pk8(x0, x1);
        }
      }
    }
    return false;
  }
};
__device__ void phase_resid_gemm(const Params& p, int l, int g, const char* A, const char* W, int K, int gidx, char* lds, float* dummy = nullptr) {
  pg8::PlainSched S{A, W, (unsigned)K * 2u, (unsigned)K * 2u, K / 64, NTOK / 256, 4, (int)gridDim.x, (int)blockIdx.x, (l == DEPTH - 1) ? 1 : 0};
  EpiResid E{&p, (const float*)(p.ws + OFF_MOD) + (size_t)l * 33 * 6144, g, gidx, dummy};
  pg8::gemm_stream((LAS unsigned char*)lds, S, E);
}

struct EpiFF1 {
  u16* Hid;
  DI bool operator()(f32x4 (&acc)[2][2][4][2], const pg8::UDesc& u, int wr, int wc, int fr, int fq) const {
    const int row0 = u.pm * 256 + wr * 64 + fr, col0 = u.pn * 256 + wc * 32 + 8 * fq;
#pragma unroll
    for (int ai = 0; ai < 2; ++ai)
#pragma unroll
      for (int m = 0; m < 4; ++m) {
        const size_t row = (size_t)(row0 + ai * 128 + m * 16);
#pragma unroll
        for (int bj = 0; bj < 2; ++bj) {
          f32x4 a = acc[ai][bj][m][0], b = acc[ai][bj][m][1];
#pragma unroll
          for (int e = 0; e < 4; ++e) { float t = fmaxf(a[e], 0.f); a[e] = t * t; t = fmaxf(b[e], 0.f); b[e] = t * t; }
          *(uint4*)(Hid + row * DFF + col0 + bj * 128) = pk8(a, b);
        }
      }
    return false;
  }
};
__device__ void phase_ff1(const Params& p, int l, char* lds, int lat_only) {
  pg8::PlainSched S{p.ws + OFF_H, wsel(p, l) + OFF_W1T, 2048u, 2048u, 16, NTOK / 256, 16, (int)gridDim.x, (int)blockIdx.x, lat_only};
  EpiFF1 E{(u16*)(p.ws + OFF_P)};
  pg8::gemm_stream((LAS unsigned char*)lds, S, E);
}

__device__ void phase_final(const Params& p) {
  const int tid = otid(), lane = tid & 63, wid = tid >> 6;
  for (int tok = blockIdx.x * 8 + wid; tok < NBATCH * SEQ; tok += gridDim.x * 8) {
    float* xr = p.out + (size_t)tok * DM;
    const u16* xs = (const u16*)(p.ws + OFF_XL) + (size_t)tok * DM;
    float4 v[4]; float ss = 0.f;
#pragma unroll
    for (int j = 0; j < 4; ++j) {
      const uint2 q = *(const uint2*)(xs + j * 256 + lane * 4);
      v[j].x = __uint_as_float(q.x << 16); v[j].y = __uint_as_float(q.x & 0xffff0000u); v[j].z = __uint_as_float(q.y << 16); v[j].w = __uint_as_float(q.y & 0xffff0000u);
      ss += v[j].x * v[j].x + v[j].y * v[j].y + v[j].z * v[j].z + v[j].w * v[j].w;
    }
    ss = wave_sum(ss);
    const float rstd = rsqrtf(ss * (1.f / DM) + EPS);
#pragma unroll
    for (int j = 0; j < 4; ++j) {
      int c = j * 256 + lane * 4;
      float4 gg = *(const float4*)(p.gfin + c);
      float4 o = {v[j].x * rstd * gg.x, v[j].y * rstd * gg.y, v[j].z * rstd * gg.z, v[j].w * rstd * gg.w};
      *(float4*)(xr + c) = o;
    }
  }
}

#define XB_TMO      128
#define XB_XCNT(j)  (256  + 64 * (j))
#define XB_XSUB(j)  (1280 + 64 * (j))
#define XB_XGEN(j)  (2304 + 64 * (j))
#define XB_TOP      3328
#define XB_TOPGEN   3392
#define XCD_BAR_WORDS 3456
#define XB_SPIN_CAP (1u << 18)
DI unsigned xb_ld(unsigned* p) { return __hip_atomic_load(p, __ATOMIC_RELAXED, __HIP_MEMORY_SCOPE_AGENT); }
DI unsigned xb_add(unsigned* p, unsigned v) { return __hip_atomic_fetch_add(p, v, __ATOMIC_RELAXED, __HIP_MEMORY_SCOPE_AGENT); }
DI unsigned xb_xcc_id() { return (unsigned)__builtin_amdgcn_s_getreg((3 << 11) | 20) & 0xFu; }
#define XB_SPIN(cond, bar) do { unsigned _sp = 0; while (cond) { __builtin_amdgcn_s_sleep(1); \
    if ((++_sp & 255u) == 0u) { if (xb_ld(&(bar)[XB_TMO])) break; if (_sp > XB_SPIN_CAP) { atomicAdd(&(bar)[XB_TMO], 1u); break; } } } } while (0)
struct XcdBarrier { unsigned* bar; unsigned x; volatile __attribute__((address_space(3))) unsigned* st; };
DI XcdBarrier xcd_barrier_post(unsigned* bar, volatile __attribute__((address_space(3))) unsigned* st) {
  XcdBarrier b; b.bar = bar; b.x = xb_xcc_id(); b.st = st;
  if (threadIdx.x == 0) (void)xb_add(&bar[XB_XCNT(b.x)], 1u);
  return b;
}
DI void xcd_barrier_complete(unsigned* bar, unsigned x, unsigned& nloc, unsigned& nx) {
  const unsigned G = gridDim.x * gridDim.y * gridDim.z;
  unsigned sum, cnt, mine, sp = 0u;
  for (;;) {
    sum = 0u; cnt = 0u; mine = 0u;
#pragma unroll
    for (unsigned j = 0; j < 16; ++j) { const unsigned c = xb_ld(&bar[XB_XCNT(j)]); sum += c; cnt += (c > 0u) ? 1u : 0u; mine = (j == x) ? c : mine; }
    if (sum == G) break;
    __builtin_amdgcn_s_sleep(1);
    if ((++sp & 255u) == 0u) { if (xb_ld(&bar[XB_TMO])) break; if (sp > XB_SPIN_CAP) { atomicAdd(&bar[XB_TMO], 1u); break; } }
  }
  nloc = mine > 0u ? mine : 1u; nx = cnt > 0u ? cnt : 1u;
}
DI void xcd_barrier(const XcdBarrier& b) {
  asm volatile("s_waitcnt vmcnt(0)" ::: "memory");
  __syncthreads();
  if (threadIdx.x == 0) {
    unsigned* bar = b.bar;
    __builtin_amdgcn_s_waitcnt(0);
    unsigned nloc = b.st[0], nx = b.st[1];
    if (nloc == 0u) { xcd_barrier_complete(bar, b.x, nloc, nx); b.st[0] = nloc; b.st[1] = nx; }
    const unsigned old = xb_add(&bar[XB_XSUB(b.x)], 1u);
    const unsigned gen = old / nloc;
    if (old + 1u == (gen + 1u) * nloc) {
      __builtin_amdgcn_fence(__ATOMIC_RELEASE, "agent");
      asm volatile("s_waitcnt vmcnt(0)" ::: "memory");
      const unsigned og = xb_add(&bar[XB_TOP], 1u);
      const unsigned tg = og / nx;
      if (og + 1u == (tg + 1u) * nx) xb_add(&bar[XB_TOPGEN], 1u);
      else XB_SPIN(xb_ld(&bar[XB_TOPGEN]) == tg, bar);
      __builtin_amdgcn_fence(__ATOMIC_ACQUIRE, "agent");
      xb_add(&bar[XB_XGEN(b.x)], 1u);
      asm volatile("s_waitcnt vmcnt(0)" ::: "memory");
    } else {
      XB_SPIN(xb_ld(&bar[XB_XGEN(b.x)]) == gen, bar);
      __builtin_amdgcn_fence(__ATOMIC_ACQUIRE, "agent");
      asm volatile("s_waitcnt vmcnt(0)" ::: "memory");
    }
  }
  __syncthreads();
}

constexpr int NSUB = 12;
constexpr int NPHASE = 1 + DEPTH * NG * NSUB + 1;

__global__ void __launch_bounds__(512) mega(Params p, int ph_lo, int ph_hi) {
  extern __shared__ __attribute__((aligned(16))) char lds[];
  volatile __attribute__((address_space(3))) unsigned* st = (volatile __attribute__((address_space(3))) unsigned*)(lds + LDS_BYTES - 32);
  if (threadIdx.x < 2) st[threadIdx.x] = 0u;
  __syncthreads();
  XcdBarrier xb{};
  if (ph_hi - ph_lo > 1) xb = xcd_barrier_post((unsigned*)(p.ws + OFF_BAR), st);
#define GSYNC() xcd_barrier(xb)
  for (int ph = ph_lo; ph < ph_hi; ++ph) {
    if (ph > 0 && ph < NPHASE - 1 && ((ph - 1) % NSUB) == 0 && ((ph - 1) / NSUB) != 0) continue;
    if (ph == 0) { phase_prep(p, lds); phase_wconv(p, 0, lds); }
    else if (ph == NPHASE - 1) phase_final(p);
    else {
      const int q = ph - 1, lg = q / NSUB, sub = q % NSUB, l = lg / NG, g = lg % NG;
      switch (sub) {
        case 0: if (lg == 0) phase_norm(p, l, g, 0); break;
        case 1: for (int rep = 0; rep < ((PROBE & 2) ? 2 : 1); ++rep) { if (rep) GSYNC(); phase_inproj(p, l, lds); } break;
        case 2: phase_tokprep(p, l); break;
        case 3: phase_mlaup(p, l, lds); break;
        case 4: phase_mixers(p, l, g, lds); if (PROBE & 1) { GSYNC(); phase_mixers(p, l, g, lds, 8); } if (PROBE & 4) { GSYNC(); phase_mixers(p, l, g, lds, 8, true); } if (PROBE & 16) { GSYNC(); phase_mixers(p, l, g, lds, 8, true, true); } break;
        case 5: for (int rep = 0; rep < ((PROBE & 8) ? 2 : 1); ++rep) { if (rep) GSYNC(); phase_readout(p, l); } break;
        case 6: for (int rep = 0; rep < ((PROBE & 2) ? 2 : 1); ++rep) { if (rep) GSYNC(); phase_gate(p, l, lds, l == DEPTH - 1); } break;
        case 7: for (int rep = 0; rep < ((PROBE & 32) ? 2 : 1); ++rep) { if (rep) GSYNC(); phase_branch(p, l, lds, l == DEPTH - 1); } if (g == 0 && l + 1 < DEPTH) phase_wconv(p, l + 1, lds, (int*)(p.ws + OFF_CNT) + 24 + l); break;
        case 8: for (int rep = 0; rep < ((PROBE & 64) ? 2 : 1); ++rep) { if (rep) GSYNC(); phase_resid_gemm(p, l, g, p.ws + OFF_OA, wsel(p, l) + OFF_WOT, DM, 2, lds, rep ? (float*)((char*)p.out) : nullptr); } break;
        case 9: for (int rep = 0; rep < ((PROBE & 8) ? 2 : 1); ++rep) { if (rep) GSYNC(); phase_norm(p, l, g, 1); } break;
        case 10: for (int rep = 0; rep < ((PROBE & 2) ? 2 : 1); ++rep) { if (rep) GSYNC(); phase_ff1(p, l, lds, l == DEPTH - 1); } break;
        default: for (int rep = 0; rep < ((PROBE & 64) ? 2 : 1); ++rep) { if (rep) GSYNC(); phase_resid_gemm(p, l, g, p.ws + OFF_P, wsel(p, l) + OFF_W2T, DFF, 5, lds, rep ? (float*)((char*)p.out) : nullptr); } if (lg + 1 < DEPTH * NG) phase_norm_dyn(p, (lg + 1) / NG, (lg + 1) % NG, (int*)(p.ws + OFF_CNT) + 16 + lg); break;
      }
    }
    if (ph + 1 < ph_hi) { if (ph == ph_lo) cg::this_grid().sync(); else GSYNC(); }
  }
}

extern "C" void kernel_launch(void* const* d_in, const int* in_sizes, int n_in, void* d_out, int out_size, void* d_ws,
                              size_t ws_size, hipStream_t stream) {
  static int grid_blocks = 0;
  if (!grid_blocks) {
    int dev = 0, cus = 0, per_cu = 0;
    (void)hipGetDevice(&dev);
    (void)hipDeviceGetAttribute(&cus, hipDeviceAttributeMultiprocessorCount, dev);
    (void)hipFuncSetAttribute((const void*)mega, hipFuncAttributeMaxDynamicSharedMemorySize, LDS_BYTES);
    (void)hipOccupancyMaxActiveBlocksPerMultiprocessor(&per_cu, mega, NTHR, LDS_BYTES);
    if (per_cu < 1) per_cu = 1;
    if (per_cu > 1) per_cu = 1;
    grid_blocks = cus * per_cu;
  }
  if (ws_size < WS_NEED) { fprintf(stderr, "workspace too small: %zu < %zu\n", ws_size, (size_t)WS_NEED); }
  Params p{};
  const float** pf = (const float**)&p;
  for (int i = 0; i < 26; ++i) pf[i] = (const float*)d_in[i];
  p.out = (float*)d_out;
  p.ws = (char*)d_ws;
  (void)hipMemsetAsync((char*)d_ws + OFF_CNT, 0, 256 + 3456 * 4, stream);
#if ONE_LAUNCH
  int lo = 0, hi = NPHASE;
  void* args[] = {&p, &lo, &hi};
  hipError_t e = hipLaunchCooperativeKernel((void*)mega, dim3(grid_blocks), dim3(NTHR), args, LDS_BYTES, stream);
  if (e != hipSuccess) fprintf(stderr, "cooperative launch failed: %s (grid %d)\n", hipGetErrorString(e), grid_blocks);
#else
  for (int ph = 0; ph < NPHASE; ++ph) mega<<<grid_blocks, NTHR, LDS_BYTES, stream>>>(p, ph, ph + 1);
#endif
}
```

```cpp
#include <hip/hip_runtime.h>
#include <hip/hip_cooperative_groups.h>
#include <cstdio>
#include <cstdint>
namespace cg = cooperative_groups;

#ifndef PROBE
#define PROBE 0
#endif
#ifndef ONE_LAUNCH
#define ONE_LAUNCH 1
#endif

typedef unsigned short u16;
typedef short bf16x8 __attribute__((ext_vector_type(8)));
typedef short s16x4 __attribute__((ext_vector_type(4)));
typedef float f32x16 __attribute__((ext_vector_type(16)));
typedef float f32x2v __attribute__((ext_vector_type(2)));
typedef __bf16 bf16x2v __attribute__((ext_vector_type(2)));
#define DI __device__ __forceinline__
#define MFMA(a, b, c) __builtin_amdgcn_mfma_f32_32x32x16_bf16((a), (b), (c), 0, 0, 0)

constexpr int DM = 1024, NBATCH = 32, SEQ = 2048, CTXL = 256, DEPTH = 4, DFF = 4096;
constexpr int NG = 2, NB = 16, TPB = 2304, NTOK = NB * TPB;
constexpr int PS = 5376, NPC = 5328, INW = 9424;
constexpr int A_I = 0, A_FF = 512, A_FB = 1024, B_K = 1536, B_V = 1792, B_G = 2304, C_K = 2320, C_V = 2448,
              D_CKV = 2576, D_KR = 2704, A_Q = 2768, A_G = 3280, B_Q = 3792, B_O = 4048, C_Q = 4560, D_CQ = 5072;
constexpr float EPS = 1e-6f;
constexpr float LOG2E = 1.4426950408889634f;

constexpr size_t al256(size_t x) { return (x + 255) & ~(size_t)255; }
constexpr size_t OFF_WINT = 0;
constexpr size_t OFF_WGT = OFF_WINT + al256((size_t)PS * 1024 * 2);
constexpr size_t OFF_WBT = OFF_WGT + al256((size_t)4096 * 1024 * 2);
constexpr size_t OFF_WOT = OFF_WBT + al256((size_t)4 * 1024 * 512 * 2);
constexpr size_t OFF_W1T = OFF_WOT + al256((size_t)1024 * 1024 * 2);
constexpr size_t OFF_W2T = OFF_W1T + al256((size_t)4096 * 1024 * 2);
constexpr size_t OFF_WUQ = OFF_W2T + al256((size_t)1024 * 4096 * 2);
constexpr size_t OFF_WUK = OFF_WUQ + al256((size_t)768 * 256 * 2);
constexpr size_t OFF_WUV = OFF_WUK + al256((size_t)512 * 128 * 2);
constexpr size_t OFF_MOD = OFF_WUV + al256((size_t)512 * 128 * 2);
constexpr size_t OFF_LB = OFF_MOD + al256((size_t)4 * 33 * 6144 * 4);
constexpr size_t OFF_ROPE = OFF_LB + al256((size_t)4 * 2 * 512 * 4);
constexpr size_t OFF_CNT = OFF_ROPE + al256((size_t)2 * 64 * 16 * 4);
constexpr size_t OFF_BAR = OFF_CNT + 256;
constexpr size_t OFF_XC = OFF_BAR + al256(3456 * 4);
constexpr size_t OFF_XL = OFF_XC + al256((size_t)NBATCH * CTXL * DM * 2);
constexpr size_t OFF_P = OFF_XL + al256((size_t)NBATCH * SEQ * DM * 2);
constexpr size_t OFF_GB = OFF_P + al256((size_t)NTOK * PS * 2);
constexpr size_t OFF_KQ = OFF_GB + al256((size_t)NTOK * 16 * 4);
constexpr size_t OFF_H = OFF_KQ + al256((size_t)NTOK * 512 * 2);
constexpr size_t OFF_QD = OFF_H + al256((size_t)NTOK * 1024 * 2);
constexpr size_t OFF_KD = OFF_QD + al256((size_t)NTOK * 768 * 2);
constexpr size_t OFF_VD = OFF_KD + al256((size_t)NTOK * 768 * 2);
constexpr size_t OFF_OA = OFF_VD + al256((size_t)NTOK * 512 * 2);
constexpr size_t OFF_OB = OFF_OA + al256((size_t)2 * NTOK * 512 * 2);
constexpr size_t OFF_W2ND = OFF_OB + al256((size_t)2 * NTOK * 512 * 2);
constexpr size_t WS_NEED = OFF_W2ND + (OFF_MOD - OFF_WINT);
constexpr int LDS_BYTES = 143360;
constexpr int LDSV = 69632;
constexpr int NTHR = 512;
constexpr size_t OFF_MF = OFF_QD;

struct Params {
  const float *x, *c, *ctx, *c_ctx, *w_ada, *b_ada, *g1, *g2, *w_in, *bgate, *lblog, *hnorm, *convw, *mnorm,
      *gqn, *gkn, *mqn, *mkvn, *wuq, *wuk, *wuv, *wbr, *wout, *wff1, *wff2, *gfin;
  float* out;
  char* ws;
};

DI int otid() { int t = threadIdx.x; asm volatile("" : "+v"(t)); return t; }
DI char* wsel(const Params& p, int l) { return p.ws + ((l & 1) ? OFF_W2ND : (size_t)0); }
DI float bf2f(u16 v) { return __uint_as_float(((unsigned)v) << 16); }
DI unsigned pack2(float a, float b) {
  f32x2v v = {a, b};
  bf16x2v r = __builtin_convertvector(v, bf16x2v);
  return __builtin_bit_cast(unsigned, r);
}
DI u16 f2bf(float a) { return (u16)(pack2(a, 0.f) & 0xffffu); }
DI int crow(int reg, int h) { return (reg & 3) + 8 * (reg >> 2) + 4 * h; }
DI float sigmoidf_(float x) { return 1.f / (1.f + __expf(-x)); }
DI float siluf_(float x) { return x / (1.f + __expf(-x)); }
DI float ex2(float x) { return __builtin_amdgcn_exp2f(x); }
DI bf16x8 pack8(const f32x16& x, int s) {
  union { unsigned u[4]; bf16x8 v; } t;
  t.u[0] = pack2(x[8 * s + 0], x[8 * s + 1]);
  t.u[1] = pack2(x[8 * s + 2], x[8 * s + 3]);
  t.u[2] = pack2(x[8 * s + 4], x[8 * s + 5]);
  t.u[3] = pack2(x[8 * s + 6], x[8 * s + 7]);
  return t.v;
}
DI bf16x8 cat4(s16x4 lo, s16x4 hi) { return __builtin_shufflevector(lo, hi, 0, 1, 2, 3, 4, 5, 6, 7); }
DI float wave_sum(float v) {
#pragma unroll
  for (int d = 32; d >= 1; d >>= 1) v += __shfl_xor(v, d);
  return v;
}
DI void unpack8(const uint4& q, float* f) {
  f[0] = __uint_as_float(q.x << 16); f[1] = __uint_as_float(q.x & 0xffff0000u);
  f[2] = __uint_as_float(q.y << 16); f[3] = __uint_as_float(q.y & 0xffff0000u);
  f[4] = __uint_as_float(q.z << 16); f[5] = __uint_as_float(q.z & 0xffff0000u);
  f[6] = __uint_as_float(q.w << 16); f[7] = __uint_as_float(q.w & 0xffff0000u);
}
DI uint4 pack8f(const float* f) {
  uint4 q;
  q.x = pack2(f[0], f[1]); q.y = pack2(f[2], f[3]); q.z = pack2(f[4], f[5]); q.w = pack2(f[6], f[7]);
  return q;
}

DI u16* xrow_ptr(const Params& p, int g, int tok, int& modrow) {
  int bl = tok / TPB, pp = tok - bl * TPB, b = g * NB + bl;
  if (pp < CTXL) { modrow = 32; return (u16*)(p.ws + OFF_XC) + ((size_t)b * CTXL + pp) * DM; }
  modrow = b;
  return (u16*)(p.ws + OFF_XL) + ((size_t)b * SEQ + (pp - CTXL)) * DM;
}

#define LAS __attribute__((address_space(3)))
typedef float f32x4 __attribute__((ext_vector_type(4)));
namespace pg8 {
constexpr int BM = 256, BK = 64, HALF = 128, HTB = HALF * BK * 2, STAGE_BYTES = 8 * HTB, NXCD = 8, WGM = 8;
DI int lds_byte(int r, int c) { const int st = (r >> 4) * 2 + (c >> 5), rr = r & 15, cc = c & 31, ob = rr * 64 + cc * 2; return st * 1024 + (ob ^ (((ob >> 9) & 1) << 5)); }
DI void stage_rc(int b, int& R, int& C) { const int st = b / 1024, sb = b % 1024, swz = sb ^ (((sb >> 9) & 1) << 5); R = (st >> 1) * 16 + swz / 64; C = (st & 1) * 32 + (swz % 64) / 2; }
DI int perm32(int rho) { const int n = rho >> 4, i = rho & 15; return 8 * (i >> 2) + 4 * n + (i & 3); }
struct UDesc { const char* A; const char* B; unsigned lda2, ldb2; int nt, pm, pn, tag; };
DI bool tile_order(long L, int nM, int nN, int& pm, int& pn) {
  const int nwg = nM * nN; if (L >= nwg) return false;
  int wgid = (int)L; { const int q = nwg / NXCD, r = nwg % NXCD, xcd = wgid % NXCD, off = wgid / NXCD; wgid = (xcd < r ? xcd * (q + 1) : r * (q + 1) + (xcd - r) * q) + off; }
  const int nig = WGM * nN, gid = wgid / nig, fm = gid * WGM, gsz = (nM - fm) < WGM ? (nM - fm) : WGM;
  pm = fm + ((wgid % nig) % gsz); pn = (wgid % nig) / gsz; return true;
}
template <class Epi, class Sched>
DI void gemm_stream(LAS unsigned char* lds, const Sched& S, const Epi& E) {
  const int tid = otid(), wid = __builtin_amdgcn_readfirstlane(tid >> 6), lane = tid & 63, wr = wid >> 2, wc = wid & 3, fr = lane & 15, fq = lane >> 4;
  int RA[2], RB[2], CC[2];
#pragma unroll
  for (int i = 0; i < 2; ++i) { int R, C; stage_rc(tid * 16 + i * 8192, R, C); RA[i] = R; RB[i] = (R & ~31) + perm32(R & 31); CC[i] = C * 2; }
  const size_t kstep = (size_t)(BK * 2);
  const unsigned ldsw = (unsigned)wid * 1024u;
  const int aoff = lds_byte(wr * 64 + fr, fq * 8), boff = lds_byte(wc * 32 + fr, fq * 8);
#define PG8_SA(b, h) (((b) * 2 + (h)) * HTB)
#define PG8_SB(b, h) ((4 + (b) * 2 + (h)) * HTB)
#define PG8_STAGE(bufoff, gbase, voff) do { _Pragma("unroll") for (int _i = 0; _i < 2; ++_i) \
    __builtin_amdgcn_global_load_lds((const unsigned*)((const char*)(gbase) + (voff)[_i]), (LAS unsigned*)(lds + (bufoff) + ldsw + _i * 8192), 16, 0, 0); } while (0)
#define PG8_LDA(dst, b, h) do { _Pragma("unroll") for (int m = 0; m < 4; ++m) _Pragma("unroll") for (int k = 0; k < 2; ++k) dst[m][k] = *(const LAS bf16x8*)(lds + PG8_SA(b, h) + aoff + m * 2048 + k * 1024); } while (0)
#define PG8_LDB(dst, b, h) do { _Pragma("unroll") for (int n = 0; n < 2; ++n) _Pragma("unroll") for (int k = 0; k < 2; ++k) dst[n][k] = *(const LAS bf16x8*)(lds + PG8_SB(b, h) + boff + n * 2048 + k * 1024); } while (0)
#define PG8_MMA(ai, bj, At, Bt) do { __builtin_amdgcn_s_setprio(1); _Pragma("unroll") for (int m = 0; m < 4; ++m) _Pragma("unroll") for (int n = 0; n < 2; ++n) _Pragma("unroll") for (int k = 0; k < 2; ++k) \
    acc[ai][bj][m][n] = __builtin_amdgcn_mfma_f32_16x16x32_bf16(Bt[n][k], At[m][k], acc[ai][bj][m][n], 0, 0, 0); __builtin_amdgcn_s_setprio(0); } while (0)
#define PG8_WAIT_V(n) asm volatile("s_waitcnt vmcnt(" #n ")" ::: "memory")
#define PG8_WAIT_L(n) asm volatile("s_waitcnt lgkmcnt(" #n ")" ::: "memory")
#define PG8_BAR __builtin_amdgcn_s_barrier()
#define PG8_SCHED __builtin_amdgcn_sched_barrier(0)
  UDesc cur, nxt; int ui = 0;
  if (!S.next(0, cur)) return;
  f32x4 acc[2][2][4][2];
#pragma unroll
  for (int a = 0; a < 2; ++a)
#pragma unroll
    for (int b = 0; b < 2; ++b)
#pragma unroll
      for (int m = 0; m < 4; ++m)
#pragma unroll
        for (int n = 0; n < 2; ++n) acc[a][b][m][n] = (f32x4){0.f, 0.f, 0.f, 0.f};
  bf16x8 At[4][2], B0[2][2], B1[2][2];
  const char* cA = cur.A; const char* cB = cur.B;
  unsigned vA[2], vB[2];
#pragma unroll
  for (int i = 0; i < 2; ++i) { vA[i] = (unsigned)RA[i] * cur.lda2 + CC[i]; vB[i] = (unsigned)RB[i] * cur.ldb2 + CC[i]; }
  size_t hA = (size_t)HALF * cur.lda2, hB = (size_t)HALF * cur.ldb2;
  PG8_STAGE(PG8_SB(0, 0), cB, vB); PG8_STAGE(PG8_SA(0, 0), cA, vA); PG8_STAGE(PG8_SB(0, 1), cB + hB, vB); PG8_STAGE(PG8_SA(0, 1), cA + hA, vA);
  if (wr == 1) PG8_BAR;
  PG8_WAIT_V(4); PG8_BAR;
  PG8_STAGE(PG8_SB(1, 0), cB + kstep, vB); PG8_STAGE(PG8_SA(1, 0), cA + kstep, vA); PG8_STAGE(PG8_SB(1, 1), cB + hB + kstep, vB);
  PG8_WAIT_V(6); PG8_BAR;
  for (;;) {
    const bool has_next = S.next(ui + 1, nxt);
    const char* nA = has_next ? nxt.A : cA; const char* nB = has_next ? nxt.B : cB;
    const unsigned nlda = has_next ? nxt.lda2 : cur.lda2, nldb = has_next ? nxt.ldb2 : cur.ldb2;
    unsigned nvA[2], nvB[2];
#pragma unroll
    for (int i = 0; i < 2; ++i) { nvA[i] = (unsigned)RA[i] * nlda + CC[i]; nvB[i] = (unsigned)RB[i] * nldb + CC[i]; }
    const size_t nhA = (size_t)HALF * nlda, nhB = (size_t)HALF * nldb;
    const int nt = cur.nt;
    for (int t = 0; t < nt; t += 2) {
      const bool last = (t == nt - 2);
      const char* a1 = cA + (size_t)(t + 1) * kstep;
      const char* a2 = last ? nA : cA + (size_t)(t + 2) * kstep; const char* b2 = last ? nB : cB + (size_t)(t + 2) * kstep;
      const char* a3 = a2 + kstep; const char* b3 = b2 + kstep;
      unsigned v2A[2], v2B[2];
#pragma unroll
      for (int i = 0; i < 2; ++i) { v2A[i] = last ? nvA[i] : vA[i]; v2B[i] = last ? nvB[i] : vB[i]; }
      const size_t h2A = last ? nhA : hA, h2B = last ? nhB : hB;
      PG8_LDB(B0, 0, 0); PG8_SCHED; PG8_LDA(At, 0, 0); PG8_STAGE(PG8_SA(1, 1), a1 + hA, vA);
      PG8_WAIT_L(8); PG8_BAR; PG8_WAIT_L(0); PG8_MMA(0, 0, At, B0); PG8_BAR; PG8_SCHED;
      PG8_LDB(B1, 0, 1); PG8_STAGE(PG8_SB(0, 0), b2, v2B);
      PG8_BAR; PG8_WAIT_L(0); PG8_MMA(0, 1, At, B1); PG8_BAR;
      PG8_LDA(At, 0, 1); PG8_STAGE(PG8_SA(0, 0), a2, v2A);
      PG8_BAR; PG8_WAIT_L(0); PG8_MMA(1, 0, At, B0); PG8_BAR; PG8_SCHED;
      PG8_STAGE(PG8_SB(0, 1), b2 + h2B, v2B);
      PG8_WAIT_V(6); PG8_BAR; PG8_MMA(1, 1, At, B1); PG8_BAR;
      PG8_LDB(B0, 1, 0); PG8_SCHED; PG8_LDA(At, 1, 0); PG8_STAGE(PG8_SA(0, 1), a2 + h2A, v2A);
      PG8_WAIT_L(8); PG8_BAR; PG8_WAIT_L(0); PG8_MMA(0, 0, At, B0); PG8_BAR; PG8_SCHED;
      PG8_LDB(B1, 1, 1); PG8_STAGE(PG8_SB(1, 0), b3, v2B);
      PG8_BAR; PG8_WAIT_L(0); PG8_MMA(0, 1, At, B1); PG8_BAR;
      PG8_LDA(At, 1, 1); PG8_STAGE(PG8_SA(1, 0), a3, v2A);
      PG8_BAR; PG8_WAIT_L(0); PG8_MMA(1, 0, At, B0); PG8_BAR; PG8_SCHED;
      PG8_STAGE(PG8_SB(1, 1), b3 + h2B, v2B);
      PG8_WAIT_V(6); PG8_BAR; PG8_MMA(1, 1, At, B1); PG8_BAR;
    }
    const bool keep = E(acc, cur, wr, wc, fr, fq);
    if (!has_next) break;
    if (!keep) {
#pragma unroll
      for (int a = 0; a < 2; ++a)
#pragma unroll
        for (int b = 0; b < 2; ++b)
#pragma unroll
          for (int m = 0; m < 4; ++m)
#pragma unroll
            for (int n = 0; n < 2; ++n) acc[a][b][m][n] = (f32x4){0.f, 0.f, 0.f, 0.f};
    }
    cur = nxt; cA = nA; cB = nB; hA = nhA; hB = nhB;
#pragma unroll
    for (int i = 0; i < 2; ++i) { vA[i] = nvA[i]; vB[i] = nvB[i]; }
    ++ui;
  }
  PG8_WAIT_V(0);
  if (wr == 0) PG8_BAR;
  PG8_BAR;
#undef PG8_SA
#undef PG8_SB
#undef PG8_STAGE
#undef PG8_LDA
#undef PG8_LDB
#undef PG8_MMA
#undef PG8_WAIT_V
#undef PG8_WAIT_L
#undef PG8_BAR
#undef PG8_SCHED
}
struct PlainSched {
  const char* A; const char* B; unsigned lda2, ldb2; int nt, nM, nN, G, c; int lat_only = 0;
  DI bool next(int i, UDesc& u) const {
    int pm, pn; if (!tile_order((long)i * G + c, lat_only ? nM - NB : nM, nN, pm, pn)) return false;
    if (lat_only) pm = pm + (pm >> 3) + 1;
    u.A = A + (size_t)pm * 256 * lda2; u.B = B + (size_t)pn * 256 * ldb2; u.lda2 = lda2; u.ldb2 = ldb2; u.nt = nt; u.pm = pm; u.pn = pn; u.tag = 0; return true;
  }
};
}

DI uint4 pk8(const f32x4& a, const f32x4& b) {
  uint4 q; q.x = pack2(a[0], a[1]); q.y = pack2(a[2], a[3]); q.z = pack2(b[0], b[1]); q.w = pack2(b[2], b[3]); return q;
}

__device__ void phase_prep(const Params& p, char* lds) {
  const int tid = otid(), nthr = gridDim.x * NTHR, gt = blockIdx.x * NTHR + tid;
  {
    const float4* s = (const float4*)p.x; uint2* d = (uint2*)(p.ws + OFF_XL);
    const size_t n = (size_t)NBATCH * SEQ * DM / 4;
    for (size_t i = gt; i < n; i += nthr) { const float4 v = s[i]; uint2 o; o.x = pack2(v.x, v.y); o.y = pack2(v.z, v.w); d[i] = o; }
    const float4* s2 = (const float4*)p.ctx; uint2* d2 = (uint2*)(p.ws + OFF_XC);
    const size_t n2 = (size_t)NBATCH * CTXL * DM / 4;
    for (size_t i = gt; i < n2; i += nthr) { const float4 v = s2[i]; uint2 o; o.x = pack2(v.x, v.y); o.y = pack2(v.z, v.w); d2[i] = o; }
  }
  if (gt < 1024) {
    float v[DEPTH], mx = -1e30f;
    for (int l = 0; l < DEPTH; ++l) { v[l] = p.lblog[l * 1024 + gt]; mx = fmaxf(mx, v[l]); }
    float sum = 0.f;
    for (int l = 0; l < DEPTH; ++l) { v[l] = expf(v[l] - mx); sum += v[l]; }
    float* lb = (float*)(p.ws + OFF_LB);
    float run = 0.f;
    for (int l = 0; l < DEPTH; ++l) { lb[l * 1024 + gt] = run; if (l + 1 < DEPTH) run += v[l + 1] / sum; }
  }
  if (gt >= 1024 && gt < 2048) {
    int i = gt - 1024, pos = i >> 4, fi = i & 15;
    float inv = powf(10000.f, -(float)fi / 16.f);
    float ang = (float)pos * inv;
    float* rc = (float*)(p.ws + OFF_ROPE);
    rc[i] = cosf(ang); rc[1024 + i] = sinf(ang);
  }
  float* ssm = (float*)lds;
  float* red = (float*)lds + 2 * 33 * 32;
  for (int item = blockIdx.x; item < DEPTH * 24; item += gridDim.x) {
    const int l = item / 24, kh = tid >> 8, tl = tid & 255, j = (item % 24) * 256 + tl;
    float acc[33];
#pragma unroll
    for (int r = 0; r < 33; ++r) acc[r] = 0.f;
    const float* W = p.w_ada + (size_t)l * DM * 6144;
    for (int k0 = kh * 512; k0 < kh * 512 + 512; k0 += 32) {
      __syncthreads();
      for (int idx = tl; idx < 33 * 32; idx += 256) {
        int rr = idx >> 5, kk = idx & 31;
        float cv = rr < 32 ? p.c[rr * DM + k0 + kk] : p.c_ctx[k0 + kk];
        ssm[kh * 33 * 32 + idx] = cv / (1.f + expf(-cv));
      }
      __syncthreads();
#pragma unroll 16
      for (int kk = 0; kk < 32; ++kk) {
        float w = W[(size_t)(k0 + kk) * 6144 + j];
#pragma unroll
        for (int r = 0; r < 33; ++r) acc[r] += ssm[kh * 33 * 32 + r * 32 + kk] * w;
      }
    }
    __syncthreads();
    if (kh == 1) {
#pragma unroll
      for (int r = 0; r < 33; ++r) red[r * 256 + tl] = acc[r];
    }
    __syncthreads();
    if (kh == 0) {
      float bb = p.b_ada[l * 6144 + j];
      float* mod = (float*)(p.ws + OFF_MOD) + (size_t)l * 33 * 6144;
#pragma unroll
      for (int r = 0; r < 33; ++r) mod[r * 6144 + j] = acc[r] + red[r * 256 + tl] + bb;
    }
  }
  __syncthreads();
}

DI u16* wdst(char* wb, int type, int sub, int n) {
  switch (type) {
    case 0: return n < NPC ? (u16*)(wb + OFF_WINT) + (size_t)n * 1024 : (u16*)(wb + OFF_WGT) + (size_t)(n - NPC) * 1024;
    case 1: return (u16*)(wb + OFF_WBT) + ((size_t)sub * 1024 + n) * 512;
    case 2: return (u16*)(wb + OFF_WOT) + (size_t)n * 1024;
    case 3: return (u16*)(wb + OFF_W1T) + (size_t)n * 1024;
    case 4: return (u16*)(wb + OFF_W2T) + (size_t)n * 4096;
    case 5: return (u16*)(wb + OFF_WUQ) + (size_t)n * 256;
    case 6: return (u16*)(wb + OFF_WUK) + (size_t)n * 128;
    default: return (u16*)(wb + OFF_WUV) + (size_t)n * 128;
  }
}
__device__ void phase_wconv(const Params& p, int l, char* lds, int* cnt = nullptr) {
  char* wb = wsel(p, l);
  int* s_item = (int*)(lds + LDS_BYTES - 16);
  float* tile = (float*)lds;
  const int tid = otid();
  {
    unsigned* z = (unsigned*)((u16*)(wb + OFF_WINT) + (size_t)NPC * 1024);
    for (int i = blockIdx.x * NTHR + tid; i < (PS - NPC) * 1024 / 2; i += gridDim.x * NTHR) z[i] = 0u;
  }
  constexpr int T0 = 16 * 148, T1 = T0 + 4 * 128, T2 = T1 + 256, T3 = T2 + 1024, T4 = T3 + 1024, T5 = T4 + 48, T6 = T5 + 16, T7 = T6 + 16;
  for (int itk = 0;; ++itk) {
    int it;
    if (cnt) { __syncthreads(); if (tid == 0) *s_item = atomicAdd(cnt, 1); __syncthreads(); it = *s_item; }
    else it = blockIdx.x + itk * gridDim.x;
    if (it >= T7) break;
    int type, sub = 0, K, N, kt, nt;
    const float* src;
    if (it < T0) { type = 0; K = 1024; N = INW; int q = it; kt = q / 148; nt = q % 148; src = p.w_in + (size_t)l * 1024 * INW; }
    else if (it < T1) { type = 1; K = 512; N = 1024; int q = it - T0; sub = q / 128; q %= 128; kt = q / 16; nt = q % 16; src = p.wbr + ((size_t)l * 4 + sub) * 512 * 1024; }
    else if (it < T2) { type = 2; K = 1024; N = 1024; int q = it - T1; kt = q / 16; nt = q % 16; src = p.wout + (size_t)l * 1024 * 1024; }
    else if (it < T3) { type = 3; K = 1024; N = 4096; int q = it - T2; kt = q / 64; nt = q % 64; src = p.wff1 + (size_t)l * 1024 * 4096; }
    else if (it < T4) { type = 4; K = 4096; N = 1024; int q = it - T3; kt = q / 16; nt = q % 16; src = p.wff2 + (size_t)l * 4096 * 1024; }
    else if (it < T5) { type = 5; K = 256; N = 768; int q = it - T4; kt = q / 12; nt = q % 12; src = p.wuq + (size_t)l * 256 * 768; }
    else if (it < T6) { type = 6; K = 128; N = 512; int q = it - T5; kt = q / 8; nt = q % 8; src = p.wuk + (size_t)l * 128 * 512; }
    else { type = 7; K = 128; N = 512; int q = it - T6; kt = q / 8; nt = q % 8; src = p.wuv + (size_t)l * 128 * 512; }
    (void)K;
    const int k0 = kt * 64, n0 = nt * 64;
    __syncthreads();
    {
      const int nn = tid & 63, ks = tid >> 6;
#pragma unroll 4
      for (int j = 0; j < 8; ++j) {
        int k = ks + 8 * j;
        tile[k * 65 + nn] = (n0 + nn < N) ? src[(size_t)(k0 + k) * N + n0 + nn] : 0.f;
      }
    }
    __syncthreads();
    {
      const int kp = tid & 31, nn = tid >> 5;
#pragma unroll 4
      for (int j = 0; j < 4; ++j) {
        int n = nn + 16 * j;
        if (n0 + n < N) {
          unsigned v = pack2(tile[(2 * kp) * 65 + n], tile[(2 * kp + 1) * 65 + n]);
          *(unsigned*)(wdst(wb, type, sub, n0 + n) + k0 + 2 * kp) = v;
        }
      }
    }
  }
  __syncthreads();
}

DI void norm_token(const Params& p, int l, int g, int which, int tok, int lane, const float* gn, const float* mod, u16* H) {
  int mr; const u16* xr = xrow_ptr(p, g, tok, mr);
  const float* shift = mod + (size_t)mr * 6144 + (which == 0 ? 0 : 3) * DM;
  const float* scale = shift + DM;
  float4 v[4]; float ss = 0.f;
#pragma unroll
  for (int j = 0; j < 4; ++j) {
    const uint2 q = *(const uint2*)(xr + j * 256 + lane * 4);
    v[j].x = __uint_as_float(q.x << 16); v[j].y = __uint_as_float(q.x & 0xffff0000u); v[j].z = __uint_as_float(q.y << 16); v[j].w = __uint_as_float(q.y & 0xffff0000u);
    ss += v[j].x * v[j].x + v[j].y * v[j].y + v[j].z * v[j].z + v[j].w * v[j].w;
  }
  ss = wave_sum(ss);
  const float rstd = rsqrtf(ss * (1.f / DM) + EPS);
#pragma unroll
  for (int j = 0; j < 4; ++j) {
    int c = j * 256 + lane * 4;
    float4 gg = *(const float4*)(gn + c), sh = *(const float4*)(shift + c), sc = *(const float4*)(scale + c);
    float o0 = v[j].x * rstd * gg.x * (1.f + sc.x) + sh.x;
    float o1 = v[j].y * rstd * gg.y * (1.f + sc.y) + sh.y;
    float o2 = v[j].z * rstd * gg.z * (1.f + sc.z) + sh.z;
    float o3 = v[j].w * rstd * gg.w * (1.f + sc.w) + sh.w;
    uint2 o; o.x = pack2(o0, o1); o.y = pack2(o2, o3);
    *(uint2*)(H + (size_t)tok * DM + c) = o;
  }
}
DI void norm_load(const u16* xr, int lane, uint2 (&q)[4]) {
#pragma unroll
  for (int j = 0; j < 4; ++j) q[j] = *(const uint2*)(xr + j * 256 + lane * 4);
}
DI void norm_finish(const uint2 (&q)[4], int lane, const float* gn, const float* shift, u16* hrow) {
  const float* scale = shift + DM;
  float4 v[4]; float ss = 0.f;
#pragma unroll
  for (int j = 0; j < 4; ++j) {
    v[j].x = __uint_as_float(q[j].x << 16); v[j].y = __uint_as_float(q[j].x & 0xffff0000u); v[j].z = __uint_as_float(q[j].y << 16); v[j].w = __uint_as_float(q[j].y & 0xffff0000u);
    ss += v[j].x * v[j].x + v[j].y * v[j].y + v[j].z * v[j].z + v[j].w * v[j].w;
  }
  float4 ggv[4], shv[4], scv[4];
#pragma unroll
  for (int j = 0; j < 4; ++j) { const int c = j * 256 + lane * 4; ggv[j] = *(const float4*)(gn + c); shv[j] = *(const float4*)(shift + c); scv[j] = *(const float4*)(scale + c); }
  ss = wave_sum(ss);
  const float rstd = rsqrtf(ss * (1.f / DM) + EPS);
#pragma unroll
  for (int j = 0; j < 4; ++j) {
    int c = j * 256 + lane * 4;
    const float4 gg = ggv[j], sh = shv[j], sc = scv[j];
    float o0 = v[j].x * rstd * gg.x * (1.f + sc.x) + sh.x;
    float o1 = v[j].y * rstd * gg.y * (1.f + sc.y) + sh.y;
    float o2 = v[j].z * rstd * gg.z * (1.f + sc.z) + sh.z;
    float o3 = v[j].w * rstd * gg.w * (1.f + sc.w) + sh.w;
    uint2 o; o.x = pack2(o0, o1); o.y = pack2(o2, o3);
    *(uint2*)(hrow + c) = o;
  }
}
__device__ void phase_norm(const Params& p, int l, int g, int which) {
  const int tid = otid(), lane = tid & 63, wid = tid >> 6;
  const float* gn = (which == 0 ? p.g1 : p.g2) + l * DM;
  const float* mod = (const float*)(p.ws + OFF_MOD) + (size_t)l * 33 * 6144;
  u16* H = (u16*)(p.ws + OFF_H);
  const int stride = gridDim.x * 8;
  const bool skipc = which == 1 && l == DEPTH - 1;
  for (int tok = blockIdx.x * 8 + wid; tok < NTOK; tok += 2 * stride) {
    const int tokB = tok + stride;
    const bool doA = !(skipc && (tok % TPB) < CTXL), doB = tokB < NTOK && !(skipc && (tokB % TPB) < CTXL);
    int mrA = 0, mrB = 0;
    const u16* xa = xrow_ptr(p, g, tok, mrA);
    const u16* xb = xrow_ptr(p, g, doB ? tokB : tok, mrB);
    uint2 qa[4], qb[4];
    norm_load(xa, lane, qa);
    norm_load(xb, lane, qb);
    if (doA) norm_finish(qa, lane, gn, mod + (size_t)mrA * 6144 + (which == 0 ? 0 : 3) * DM, H + (size_t)tok * DM);
    if (doB) norm_finish(qb, lane, gn, mod + (size_t)mrB * 6144 + (which == 0 ? 0 : 3) * DM, H + (size_t)tokB * DM);
  }
}
__device__ void phase_norm_dyn(const Params& p, int l, int g, int* cnt) {
  const int tid = otid(), lane = tid & 63;
  const float* gn = p.g1 + l * DM;
  const float* mod = (const float*)(p.ws + OFF_MOD) + (size_t)l * 33 * 6144;
  u16* H = (u16*)(p.ws + OFF_H);
  for (;;) {
    int c = 0;
    if (lane == 0) c = atomicAdd(cnt, 1);
    c = __shfl(c, 0);
    if (c >= NTOK / 8) break;
#pragma unroll 1
    for (int t = 0; t < 8; t += 2) {
      const int tokA = c * 8 + t, tokB = tokA + 1;
      int mrA = 0, mrB = 0;
      const u16* xa = xrow_ptr(p, g, tokA, mrA);
      const u16* xb = xrow_ptr(p, g, tokB, mrB);
      uint2 qa[4], qb[4];
      norm_load(xa, lane, qa);
      norm_load(xb, lane, qb);
      norm_finish(qa, lane, gn, mod + (size_t)mrA * 6144, H + (size_t)tokA * DM);
      norm_finish(qb, lane, gn, mod + (size_t)mrB * 6144, H + (size_t)tokB * DM);
    }
  }
}

__device__ void phase_tokprep(const Params& p, int l) {
  const int tid = otid(), lane = tid & 63, wid = tid >> 6;
  u16* P = (u16*)(p.ws + OFF_P);
  u16* KQ = (u16*)(p.ws + OFF_KQ);
  u16* Kd = (u16*)(p.ws + OFF_KD);
  const float* rc = (const float*)(p.ws + OFF_ROPE);
  const float* rs = rc + 1024;
  const int c8 = lane & 7;
  const bool isk_ = lane < 32;
  float cwv[24], gqv[8], gkv[8], gmv[8];
  {
    const float* cw = p.convw + ((size_t)l * 2 + (isk_ ? 1 : 0)) * 3 * 256 + (isk_ ? lane : lane - 32) * 8;
#pragma unroll
    for (int e = 0; e < 8; ++e) { cwv[e] = cw[e]; cwv[8 + e] = cw[256 + e]; cwv[16 + e] = cw[512 + e]; }
    const float* gq = p.gqn + l * 64 + c8 * 8; const float* gk = p.gkn + l * 64 + c8 * 8;
    const float* gm = lane < 16 ? p.mkvn + l * 128 + lane * 8 : p.mqn + l * 256 + ((lane >= 32 ? lane - 32 : 0)) * 8;
#pragma unroll
    for (int e = 0; e < 8; ++e) { gqv[e] = gq[e]; gkv[e] = gk[e]; gmv[e] = gm[e]; }
  }
  for (int tok = blockIdx.x * 8 + wid; tok < NTOK; tok += gridDim.x * 8) {
    const int pp = tok % TPB;
    const bool lat = pp >= CTXL;
    const int pos = pp - CTXL, prow = pos >> 6, pcol = pos & 63;
    u16* row = P + (size_t)tok * PS;
    const uint4 zz = {0u, 0u, 0u, 0u};
    const uint4 pl_q = *(const uint4*)(row + C_Q + lane * 8);
    const uint4 pl_k = lane < 16 ? *(const uint4*)(row + C_K + lane * 8) : zz;
    const uint4 pl_m = *(const uint4*)(row + (lane < 16 ? D_CKV + lane * 8 : (lane >= 32 ? D_CQ + (lane - 32) * 8 : D_KR + ((lane - 16) & 7) * 8)));
    float csv[8], snv[8];
    {
      const int ppos0 = (c8 & 4) ? pcol : prow;
      if (lat) {
        const float4 c0 = *(const float4*)(rc + ppos0 * 16 + (c8 & 1) * 8), c1 = *(const float4*)(rc + ppos0 * 16 + (c8 & 1) * 8 + 4);
        const float4 s0 = *(const float4*)(rs + ppos0 * 16 + (c8 & 1) * 8), s1 = *(const float4*)(rs + ppos0 * 16 + (c8 & 1) * 8 + 4);
        csv[0] = c0.x; csv[1] = c0.y; csv[2] = c0.z; csv[3] = c0.w; csv[4] = c1.x; csv[5] = c1.y; csv[6] = c1.z; csv[7] = c1.w;
        snv[0] = s0.x; snv[1] = s0.y; snv[2] = s0.z; snv[3] = s0.w; snv[4] = s1.x; snv[5] = s1.y; snv[6] = s1.z; snv[7] = s1.w;
      } else {
#pragma unroll
        for (int e = 0; e < 8; ++e) { csv[e] = 1.f; snv[e] = 0.f; }
      }
    }
    {
      const bool isk = lane < 32;
      const int cc = (isk ? lane : lane - 32) * 8;
      const int colb = (isk ? B_K : B_Q) + cc;
      const bool hasp = !(pp == 0 || pp == CTXL), hasn = !(pp == CTXL - 1 || pp == TPB - 1);
      float x0[8], x1[8], x2[8];
      uint4 q1 = *(const uint4*)(row + colb); unpack8(q1, x1);
      if (hasp) { uint4 q0 = *(const uint4*)(row - PS + colb); unpack8(q0, x0); } else { for (int e = 0; e < 8; ++e) x0[e] = 0.f; }
      if (hasn) { uint4 q2 = *(const uint4*)(row + PS + colb); unpack8(q2, x2); } else { for (int e = 0; e < 8; ++e) x2[e] = 0.f; }
      float o[8];
#pragma unroll
      for (int e = 0; e < 8; ++e) {
        float a = cwv[e] * x0[e] + cwv[8 + e] * x1[e] + cwv[16 + e] * x2[e];
        a = siluf_(a);
        o[e] = isk ? a * 0.125f : a;
      }
      *(uint4*)(KQ + (size_t)tok * 512 + (isk ? 0 : 256) + cc) = pack8f(o);
    }
#pragma unroll
    for (int pass = 0; pass < 2; ++pass) {
      const bool act = pass == 0 || lane < 16;
      const int colb = (pass == 0 ? C_Q : C_K) + lane * 8;
      float x[8];
      unpack8(pass == 0 ? pl_q : pl_k, x);
      float ss = 0.f;
#pragma unroll
      for (int e = 0; e < 8; ++e) ss += x[e] * x[e];
      ss += __shfl_xor(ss, 1); ss += __shfl_xor(ss, 2); ss += __shfl_xor(ss, 4);
      const float rstd = rsqrtf(ss * (1.f / 64.f) + EPS);
#pragma unroll
      for (int e = 0; e < 8; ++e) x[e] = x[e] * rstd * (pass == 0 ? gqv[e] : gkv[e]);
      float o[8];
#pragma unroll
      for (int e = 0; e < 8; ++e) {
        float other = __shfl_xor(x[e], 2);
        const float cs = csv[e], sn = snv[e];
        o[e] = (c8 & 2) ? (x[e] * cs + other * sn) : (x[e] * cs - other * sn);
      }
      if (act) *(uint4*)(row + colb) = pack8f(o);
    }
    {
      const bool isckv = lane < 16, iscq = lane >= 32, iskr = lane >= 16 && lane < 24;
      int colb = isckv ? D_CKV + lane * 8 : (iscq ? D_CQ + (lane - 32) * 8 : D_KR + ((lane - 16) & 7) * 8);
      float x[8];
      unpack8(pl_m, x);
      float ss = 0.f;
#pragma unroll
      for (int e = 0; e < 8; ++e) ss += x[e] * x[e];
      ss += __shfl_xor(ss, 1); ss += __shfl_xor(ss, 2); ss += __shfl_xor(ss, 4); ss += __shfl_xor(ss, 8);
      float ss32 = ss + __shfl_xor(ss, 16);
      float o[8];
      if (isckv) {
        const float rstd = rsqrtf(ss * (1.f / 128.f) + EPS);
        for (int e = 0; e < 8; ++e) o[e] = x[e] * rstd * gmv[e];
      } else if (iscq) {
        const float rstd = rsqrtf(ss32 * (1.f / 256.f) + EPS);
        for (int e = 0; e < 8; ++e) o[e] = x[e] * rstd * gmv[e];
      } else {
        for (int e = 0; e < 8; ++e) o[e] = x[e];
      }
      float orot[8];
#pragma unroll
      for (int e = 0; e < 8; ++e) {
        float other = __shfl_xor(x[e], 2);
        const int ck = lane & 7;
        const float cs = csv[e], sn = snv[e];
        orot[e] = (ck & 2) ? (x[e] * cs + other * sn) : (x[e] * cs - other * sn);
      }
      if (isckv || iscq) *(uint4*)(row + colb) = pack8f(o);
      if (iskr) {
        uint4 q = pack8f(orot);
        const int ck = lane & 7;
#pragma unroll
        for (int hd = 0; hd < 4; ++hd) *(uint4*)(Kd + (size_t)tok * 768 + hd * 192 + 128 + ck * 8) = q;
      }
    }
  }
}

template <int DK, int DV, bool ROPEQ>
__device__ void attn_item(const u16* __restrict__ qrow, const u16* __restrict__ Kp, int kst, const u16* __restrict__ Vp, int vst,
                          u16* __restrict__ orow, int nkeys, float sc, int pos, const float* __restrict__ rc, char* lds) {
  constexpr int KLD = DK + 8, VLD = DV + 32;
  constexpr int KB = 64 * KLD, VB = 64 * VLD;
  u16* KS = (u16*)lds;
  u16* VS = KS + 2 * KB;
  const int tid = otid(), lane = tid & 63, r = lane & 31, h = lane >> 5;
  bf16x8 qf[DK / 16];
  {
#pragma unroll
    for (int s = 0; s < DK / 16; ++s) qf[s] = *(const bf16x8*)(qrow + h * 8 + s * 16);
    if (ROPEQ && pos >= 0) {
      const int prow = pos >> 6, pcol = pos & 63;
      const float* rs = rc + 1024;
      constexpr int s0 = (DK - 64) / 16;
#pragma unroll
      for (int part = 0; part < 2; ++part) {
        const int ppos = part ? pcol : prow;
#pragma unroll
        for (int j = 0; j < 8; ++j) {
          const int fi = 8 * h + j;
          float cs = rc[ppos * 16 + fi], sn = rs[ppos * 16 + fi];
          float x1 = bf2f((u16)qf[s0 + 2 * part][j]), x2 = bf2f((u16)qf[s0 + 2 * part + 1][j]);
          qf[s0 + 2 * part][j] = (short)f2bf(x1 * cs - x2 * sn);
          qf[s0 + 2 * part + 1][j] = (short)f2bf(x2 * cs + x1 * sn);
        }
      }
    }
  }
  f32x16 oT[DV / 32];
#pragma unroll
  for (int d = 0; d < DV / 32; ++d)
#pragma unroll
    for (int e = 0; e < 16; ++e) oT[d][e] = 0.f;
  float m = -1e30f, lsum = 0.f;
  const int ntile = nkeys >> 6;
  constexpr int NKP = KB * 2 / 1024, NVP = VB * 2 / 1024, NKJ = (NKP + 7) / 8, NVJ = (NVP + 7) / 8;
  const int wu = __builtin_amdgcn_readfirstlane(tid >> 6);
  unsigned ksrc[NKJ], vsrc[NVJ];
#pragma unroll
  for (int j = 0; j < NKJ; ++j) { const int o = (wu + 8 * j) * 1024 + lane * 16, row = o / (KLD * 2), col = (o % (KLD * 2)) / 2; ksrc[j] = (unsigned)(row * kst + (col < DK ? col : 0)) * 2u; }
#pragma unroll
  for (int j = 0; j < NVJ; ++j) { const int o = (wu + 8 * j) * 1024 + lane * 16, row = o / (VLD * 2), col = (o % (VLD * 2)) / 2; vsrc[j] = (unsigned)(row * vst + (col < DV ? col : 0)) * 2u; }
#define ATT_DMA(kt_, buf_) do { \
    const char* kg_ = (const char*)Kp + (size_t)(kt_) * 64 * kst * 2; const char* vg_ = (const char*)Vp + (size_t)(kt_) * 64 * vst * 2; \
    _Pragma("unroll") for (int j = 0; j < NKJ; ++j) if (wu + 8 * j < NKP) \
      __builtin_amdgcn_global_load_lds((const unsigned*)(kg_ + ksrc[j]), (LAS unsigned*)((char*)KS + (buf_) * KB * 2 + (wu + 8 * j) * 1024), 16, 0, 0); \
    _Pragma("unroll") for (int j = 0; j < NVJ; ++j) if (wu + 8 * j < NVP) \
      __builtin_amdgcn_global_load_lds((const unsigned*)(vg_ + vsrc[j]), (LAS unsigned*)((char*)VS + (buf_) * VB * 2 + (wu + 8 * j) * 1024), 16, 0, 0); \
  } while (0)
  __syncthreads();
  ATT_DMA(0, 0);
  asm volatile("s_waitcnt vmcnt(0)" ::: "memory");
  __syncthreads();
  const int troff = ((lane & 15) >> 2) * VLD + 16 * ((lane >> 4) & 1) + 4 * (lane & 3) + 4 * h * VLD;
#pragma unroll 1
  for (int kt = 0; kt < ntile; ++kt) {
    const int buf = kt & 1;
    if (kt + 1 < ntile) ATT_DMA(kt + 1, buf ^ 1);
    const u16* KSb = KS + buf * KB;
    const u16* VSb = VS + buf * VB;
    f32x16 sT[2];
#pragma unroll
    for (int kk = 0; kk < 2; ++kk) {
#pragma unroll
      for (int e = 0; e < 16; ++e) sT[kk][e] = 0.f;
#pragma unroll
      for (int s = 0; s < DK / 16; ++s) {
        bf16x8 a = *(const bf16x8*)(KSb + (kk * 32 + r) * KLD + s * 16 + h * 8);
        sT[kk] = MFMA(a, qf[s], sT[kk]);
      }
    }
    float mx = -1e30f;
#pragma unroll
    for (int kk = 0; kk < 2; ++kk)
#pragma unroll
      for (int e = 0; e < 16; ++e) mx = fmaxf(mx, sT[kk][e]);
    mx = fmaxf(mx, __shfl_xor(mx, 32));
    const float mn = fmaxf(m, mx * sc);
    const float alpha = ex2(m - mn);
    m = mn;
    lsum *= alpha;
#pragma unroll
    for (int kk = 0; kk < 2; ++kk) {
      sT[kk] = sT[kk] * sc - mn;
#pragma unroll
      for (int e = 0; e < 16; ++e) sT[kk][e] = ex2(sT[kk][e]);
    }
    {
      f32x16 t16 = sT[0] + sT[1];
      typedef float f32x8v __attribute__((ext_vector_type(8)));
      typedef float f32x4v __attribute__((ext_vector_type(4)));
      f32x8v t8 = __builtin_shufflevector(t16, t16, 0, 1, 2, 3, 4, 5, 6, 7) + __builtin_shufflevector(t16, t16, 8, 9, 10, 11, 12, 13, 14, 15);
      f32x4v t4 = __builtin_shufflevector(t8, t8, 0, 1, 2, 3) + __builtin_shufflevector(t8, t8, 4, 5, 6, 7);
      lsum += (t4[0] + t4[1]) + (t4[2] + t4[3]);
    }
#pragma unroll
    for (int d = 0; d < DV / 32; ++d) oT[d] = oT[d] * alpha;
#pragma unroll
    for (int kk = 0; kk < 2; ++kk)
#pragma unroll
      for (int s2 = 0; s2 < 2; ++s2) {
        bf16x8 pb = pack8(sT[kk], s2);
#pragma unroll
        for (int d = 0; d < DV / 32; ++d) {
          const u16* vb = VSb + (kk * 32 + s2 * 16) * VLD + d * 32 + troff;
          s16x4 lo = __builtin_amdgcn_ds_read_tr16_b64_v4i16((LAS s16x4*)vb);
          s16x4 hi = __builtin_amdgcn_ds_read_tr16_b64_v4i16((LAS s16x4*)(vb + 8 * VLD));
          oT[d] = MFMA(cat4(lo, hi), pb, oT[d]);
        }
      }
    asm volatile("s_waitcnt vmcnt(0)" ::: "memory");
    __syncthreads();
  }
#undef ATT_DMA
  lsum += __shfl_xor(lsum, 32);
  const float inv = 1.f / lsum;
#pragma unroll
  for (int d = 0; d < DV / 32; ++d)
#pragma unroll
    for (int gq = 0; gq < 4; ++gq) {
      uint2 o;
      o.x = pack2(oT[d][4 * gq] * inv, oT[d][4 * gq + 1] * inv);
      o.y = pack2(oT[d][4 * gq + 2] * inv, oT[d][4 * gq + 3] * inv);
      *(uint2*)(orow + d * 32 + 8 * gq + 4 * h) = o;
    }
}

__device__ void scanA_unit(const Params& p, int l, int unit, char* lds) {
  const int tid = otid(), lane = tid & 63, wid = tid >> 6, r = lane & 31, h = lane >> 5;
  const int bl = unit >> 3, hd = (unit >> 1) & 3, dir = unit & 1;
  const u16* P = (const u16*)(p.ws + OFF_P);
  u16* Oa = (u16*)(p.ws + OFF_OA) + (size_t)dir * NTOK * 512;
  float* BC = (float*)lds;
  u16* Qs = (u16*)(lds + 33792);
  u16* KKs = (u16*)(lds + 51200);
  u16* AM = (u16*)(lds + 51200);
  u16* KT = (u16*)(lds + 68608);
  u16* VT = (u16*)(lds + 87040);
  u16* ST = (u16*)(lds + 105472);
  float* EL = (float*)(lds + 140288);
  float* QTOT = (float*)(lds + 140800);
  const int ch = tid & 15;
  float lbv[8];
  {
    const float* lb = (const float*)(p.ws + OFF_LB) + (size_t)l * 1024 + dir * 512 + hd * 128 + ch * 8;
#pragma unroll
    for (int e = 0; e < 8; ++e) lbv[e] = lb[e];
  }
  const int vt = wid & 3, th = wid >> 2;
  f32x16 S[2];
#pragma unroll
  for (int j = 0; j < 2; ++j)
#pragma unroll
    for (int e = 0; e < 16; ++e) S[j][e] = 0.f;
  __syncthreads();
  for (int i = tid; i < 128 * 136 / 2; i += NTHR) ((unsigned*)ST)[i] = 0u;
  uint4 pqr[2], pfr[2], pvr[2];
#define SCANA_TOK0(st_) (bl * TPB + ((st_) >= 4 ? CTXL : 0) + (dir ? ((st_) >= 4 ? 31 - ((st_) - 4) : 3 - (st_)) : ((st_) >= 4 ? (st_) - 4 : (st_))) * 64)
#define SCANA_PREFETCH(st_) do { const int t0_ = SCANA_TOK0(st_); \
    _Pragma("unroll") for (int j = 0; j < 2; ++j) { const int i = (tid >> 4) + 32 * j; \
      const u16* row = P + (size_t)(t0_ + (dir ? 63 - i : i)) * PS + hd * 128 + ch * 8; \
      pqr[j] = *(const uint4*)(row + A_Q); pfr[j] = *(const uint4*)(row + (dir ? A_FB : A_FF)); pvr[j] = *(const uint4*)(row + A_I); } } while (0)
  SCANA_PREFETCH(0);
#pragma unroll 1
  for (int step = 0; step < 36; ++step) {
    const int tok0 = SCANA_TOK0(step);
    __syncthreads();
#pragma unroll
    for (int j = 0; j < 2; ++j) {
      const int i = (tid >> 4) + 32 * j;
      uint4 qraw = pqr[j];
      uint4 fraw = pfr[j];
      uint4 vq = pvr[j];
      float qv[8], fv[8], kkv[8];
      unpack8(qraw, qv); unpack8(fraw, fv);
#pragma unroll
      for (int e = 0; e < 8; ++e) {
        qv[e] = siluf_(qv[e]);
        const float ex = __expf(-fv[e]);
        const float sg = 1.f / (1.f + ex);
        const float sgn = ex / (1.f + ex);
        const float f = lbv[e] + (1.f - lbv[e]) * sg;
        kkv[e] = (1.f - lbv[e]) * (fv[e] > 30.f ? 0.f : (fv[e] < -30.f ? 1.f : sgn));
        BC[i * 132 + ch * 8 + e] = __log2f(fmaxf(f, 1e-37f));
      }
      *(uint4*)(Qs + i * 136 + ch * 8) = pack8f(qv);
      *(uint4*)(KKs + i * 136 + ch * 8) = pack8f(kkv);
      u16* dv = VT + (ch * 8) * 72 + i;
      dv[0 * 72] = (u16)(vq.x & 0xffff); dv[1 * 72] = (u16)(vq.x >> 16); dv[2 * 72] = (u16)(vq.y & 0xffff); dv[3 * 72] = (u16)(vq.y >> 16);
      dv[4 * 72] = (u16)(vq.z & 0xffff); dv[5 * 72] = (u16)(vq.z >> 16); dv[6 * 72] = (u16)(vq.w & 0xffff); dv[7 * 72] = (u16)(vq.w >> 16);
    }
    __syncthreads();
    {
      const int k = tid & 127, qd = tid >> 7;
      float run = 0.f;
      for (int i = qd * 16; i < qd * 16 + 16; ++i) { run += BC[i * 132 + k]; BC[i * 132 + k] = run; }
      QTOT[qd * 128 + k] = run;
    }
    __syncthreads();
    {
      const int k = tid & 127, qd = tid >> 7;
      float off = 0.f;
      for (int q2 = 0; q2 < qd; ++q2) off += QTOT[q2 * 128 + k];
      if (qd > 0) for (int i = qd * 16; i < qd * 16 + 16; ++i) BC[i * 132 + k] += off;
    }
    __syncthreads();
    f32x4 cod[2];
#pragma unroll
    for (int jj = 0; jj < 2; ++jj) {
      cod[jj] = (f32x4){0.f, 0.f, 0.f, 0.f};
      const int job = wid + 8 * jj;
      if (job < 10) {
        const int bI = job < 1 ? 0 : (job < 3 ? 1 : (job < 6 ? 2 : 3));
        const int bJ = job - (bI * (bI + 1)) / 2;
        const int l16 = lane & 15, kg = lane >> 4;
        const int t = 16 * bI + l16, s = 16 * bJ + l16, rr = 16 * bI;
#pragma unroll
        for (int ks = 0; ks < 4; ++ks) {
          const int k0 = ks * 32 + kg * 8;
          float qv[8], kv[8];
          unpack8(*(const uint4*)(Qs + t * 136 + k0), qv);
          unpack8(*(const uint4*)(KKs + s * 136 + k0), kv);
#pragma unroll
          for (int e = 0; e < 8; ++e) {
            const float br = BC[rr * 132 + k0 + e];
            qv[e] *= ex2(BC[t * 132 + k0 + e] - br);
            kv[e] *= ex2(fminf(br - BC[s * 132 + k0 + e], 120.f));
          }
          union { uint4 u; bf16x8 v; } ua, ub;
          ua.u = pack8f(qv); ub.u = pack8f(kv);
          cod[jj] = __builtin_amdgcn_mfma_f32_16x16x32_bf16(ua.v, ub.v, cod[jj], 0, 0, 0);
        }
      }
    }
    if (tid < 128) EL[tid] = ex2(BC[63 * 132 + tid]);
#pragma unroll
    for (int j = 0; j < 2; ++j) {
      const int i = (tid >> 4) + 32 * j;
      float kv[8];
      unpack8(*(const uint4*)(KKs + i * 136 + ch * 8), kv);
      u16* dk = KT + (ch * 8) * 72 + i;
#pragma unroll
      for (int e = 0; e < 8; ++e) {
        const float b = BC[i * 132 + ch * 8 + e], bl_ = BC[63 * 132 + ch * 8 + e];
        dk[e * 72] = f2bf(kv[e] * ex2(bl_ - b));
      }
    }
    __syncthreads();
#pragma unroll
    for (int j = 0; j < 2; ++j) {
      const int i = (tid >> 4) + 32 * j;
      float qv[8];
      unpack8(*(const uint4*)(Qs + i * 136 + ch * 8), qv);
#pragma unroll
      for (int e = 0; e < 8; ++e) qv[e] *= ex2(BC[i * 132 + ch * 8 + e]);
      *(uint4*)(Qs + i * 136 + ch * 8) = pack8f(qv);
    }
    for (int i = tid; i < 64 * 72 / 2; i += NTHR) ((unsigned*)AM)[i] = 0u;
    __syncthreads();
#pragma unroll
    for (int jj = 0; jj < 2; ++jj) {
      const int job = wid + 8 * jj;
      if (job < 10) {
        const int bI = job < 1 ? 0 : (job < 3 ? 1 : (job < 6 ? 2 : 3));
        const int bJ = job - (bI * (bI + 1)) / 2;
        const int l16 = lane & 15, kg = lane >> 4;
#pragma unroll
        for (int e = 0; e < 4; ++e) {
          const int tp = 4 * kg + e;
          const float v = (bJ < bI || l16 <= tp) ? cod[jj][e] : 0.f;
          AM[(16 * bI + tp) * 72 + 16 * bJ + l16] = f2bf(v);
        }
      }
    }
    __syncthreads();
    if (step + 1 < 36) SCANA_PREFETCH(step + 1);
    f32x16 o;
#pragma unroll
    for (int e = 0; e < 16; ++e) o[e] = 0.f;
#pragma unroll
    for (int ks = 0; ks < 8; ++ks) {
      bf16x8 a = *(const bf16x8*)(Qs + (th * 32 + r) * 136 + ks * 16 + h * 8);
      bf16x8 b = *(const bf16x8*)(ST + (vt * 32 + r) * 136 + ks * 16 + h * 8);
      o = MFMA(a, b, o);
    }
    bf16x8 bv[4];
#pragma unroll
    for (int ks = 0; ks < 4; ++ks) bv[ks] = *(const bf16x8*)(VT + (vt * 32 + r) * 72 + ks * 16 + h * 8);
#pragma unroll
    for (int ks = 0; ks < 4; ++ks) {
      bf16x8 a = *(const bf16x8*)(AM + (th * 32 + r) * 72 + ks * 16 + h * 8);
      o = MFMA(a, bv[ks], o);
    }
    {
      u16* ob = Oa + (size_t)tok0 * 512 + hd * 128 + vt * 32 + r;
#pragma unroll
      for (int e = 0; e < 16; ++e) {
        const int i = th * 32 + crow(e, h);
        ob[(dir ? 63 - i : i) * 512] = f2bf(o[e]);
      }
    }
    __syncthreads();
#pragma unroll
    for (int j = 0; j < 2; ++j) {
      const int kt = 2 * th + j;
#pragma unroll
      for (int e = 0; e < 16; ++e) S[j][e] *= EL[kt * 32 + crow(e, h)];
#pragma unroll
      for (int ks = 0; ks < 4; ++ks) {
        bf16x8 a = *(const bf16x8*)(KT + (kt * 32 + r) * 72 + ks * 16 + h * 8);
        S[j] = MFMA(a, bv[ks], S[j]);
      }
#pragma unroll
      for (int gq = 0; gq < 4; ++gq) {
        uint2 w;
        w.x = pack2(S[j][4 * gq], S[j][4 * gq + 1]); w.y = pack2(S[j][4 * gq + 2], S[j][4 * gq + 3]);
        *(uint2*)(ST + (vt * 32 + r) * 136 + kt * 32 + 8 * gq + 4 * h) = w;
      }
    }
  }
#undef SCANA_PREFETCH
#undef SCANA_TOK0
}

__device__ void scanB_unit(const Params& p, int l, int unit2, char* lds) {
  const int tid0 = otid(), vb = tid0 >> 8, tid = tid0 & 255, lane = tid & 63, wid = tid >> 6, r = lane & 31, h = lane >> 5;
  const int unit = unit2 * 2 + vb;
  lds += vb * LDSV;
  const int bl = unit >> 3, hd = (unit >> 1) & 3, dir = unit & 1;
  const u16* P = (const u16*)(p.ws + OFF_P);
  const u16* KQ = (const u16*)(p.ws + OFF_KQ);
  const float* Gb = (const float*)(p.ws + OFF_GB);
  u16* Ob = (u16*)(p.ws + OFF_OB) + (size_t)dir * NTOK * 512;
  u16* QB = (u16*)lds;
  u16* KB = (u16*)(lds + 9216);
  u16* SM = (u16*)(lds + 18432);
  u16* KWT = (u16*)(lds + 27648);
  u16* VT = (u16*)(lds + 36864);
  float* vec = (float*)(lds + 55296);
  float *IG = vec, *LF = vec + 64, *BV = vec + 128, *UV = vec + 192, *MT = vec + 256, *WI = vec + 320, *WK = vec + 384,
        *DEN = vec + 448, *NV = vec + 512  , *SC = vec + 640, *BL2 = vec + 704, *UL2 = vec + 768, *EMT = vec + 832;
  const float bI = p.bgate[l * 16 + (2 * dir) * 4 + hd], bF = p.bgate[l * 16 + (2 * dir + 1) * 4 + hd];
  f32x16 C[2];
#pragma unroll
  for (int ft = 0; ft < 2; ++ft)
#pragma unroll
    for (int e = 0; e < 16; ++e) C[ft][e] = 0.f;
  float m = -1e30f;
  __syncthreads();
  if (tid < 128) NV[tid] = 0.f;
  int cur = 0;
  uint4 pk0, pk1, pq0, pq1, pv0, pv1, pv2, pv3; float pgI = 0.f, pgF = 0.f;
#define SCANB_TOK0(st_) (bl * TPB + ((st_) >= 4 ? CTXL : 0) + (dir ? ((st_) >= 4 ? 31 - ((st_) - 4) : 3 - (st_)) : ((st_) >= 4 ? (st_) - 4 : (st_))) * 64)
#define SCANB_LDKQ(j, K_, Q_) do { const int id = tid + 256 * (j), i = id >> 3, c8 = id & 7; \
      const u16* row = KQ + (size_t)(t0_ + (dir ? 63 - i : i)) * 512 + hd * 64 + c8 * 8; K_ = *(const uint4*)(row); Q_ = *(const uint4*)(row + 256); } while (0)
#define SCANB_LDV(j, V_) do { const int id = tid + 256 * (j), i = id >> 4, c16 = id & 15; \
      V_ = *(const uint4*)(P + (size_t)(t0_ + (dir ? 63 - i : i)) * PS + B_V + hd * 128 + c16 * 8); } while (0)
#define SCANB_PREFETCH(st_) do { const int t0_ = SCANB_TOK0(st_); \
    SCANB_LDKQ(0, pk0, pq0); SCANB_LDKQ(1, pk1, pq1); SCANB_LDV(0, pv0); SCANB_LDV(1, pv1); SCANB_LDV(2, pv2); SCANB_LDV(3, pv3); \
    if (tid < 64) { const int tok = t0_ + (dir ? 63 - tid : tid); pgI = Gb[(size_t)tok * 16 + (2 * dir) * 4 + hd]; pgF = Gb[(size_t)tok * 16 + (2 * dir + 1) * 4 + hd]; } } while (0)
#define SCANB_STKQ(j, K_, Q_) do { const int id = tid + 256 * (j), i = id >> 3, c8 = id & 7; \
      *(uint4*)(KB + i * 72 + c8 * 8) = K_; *(uint4*)(QB + i * 72 + c8 * 8) = Q_; } while (0)
#define SCANB_STV(j, V_) do { const int id = tid + 256 * (j), i = id >> 4, c16 = id & 15; const uint4 vq = V_; u16* dv = VT + (c16 * 8) * 72 + i; \
      dv[0 * 72] = (u16)(vq.x & 0xffff); dv[1 * 72] = (u16)(vq.x >> 16); dv[2 * 72] = (u16)(vq.y & 0xffff); dv[3 * 72] = (u16)(vq.y >> 16); \
      dv[4 * 72] = (u16)(vq.z & 0xffff); dv[5 * 72] = (u16)(vq.z >> 16); dv[6 * 72] = (u16)(vq.w & 0xffff); dv[7 * 72] = (u16)(vq.w >> 16); } while (0)
  SCANB_PREFETCH(0);
#pragma unroll 1
  for (int step = 0; step < 36; ++step) {
    const int tok0 = SCANB_TOK0(step);
    __syncthreads();
    SCANB_STKQ(0, pk0, pq0); SCANB_STKQ(1, pk1, pq1);
    SCANB_STV(0, pv0); SCANB_STV(1, pv1); SCANB_STV(2, pv2); SCANB_STV(3, pv3);
    if (tid < 64) {
      const int i = tid;
      const float gI = pgI + bI;
      const float gF = pgF + bF;
      const float lf = fminf(gF, 0.f) - log1pf(expf(-fabsf(gF)));
      float b = lf;
#pragma unroll
      for (int d = 1; d < 64; d <<= 1) { float t = __shfl_up(b, d); if (lane >= d) b += t; }
      const float u = gI - b;
      float pm = u;
#pragma unroll
      for (int d = 1; d < 64; d <<= 1) { float t = __shfl_up(pm, d); if (lane >= d) pm = fmaxf(pm, t); }
      const float mt = b + fmaxf(m, pm);
      const float wi = expf(b + m - mt);
      const float mnew = __shfl(mt, 63), b63 = __shfl(b, 63);
      const float dec = expf(b63 + m - mnew);
      const float wk = expf(b63 - b + gI - mnew);
      IG[i] = gI; LF[i] = lf; BV[i] = b; UV[i] = u; MT[i] = mt; WI[i] = wi; WK[i] = wk;
      BL2[i] = (b - mt) * LOG2E; UL2[i] = u * LOG2E; EMT[i] = expf(-mt);
      if (i == 0) { SC[0] = mnew; SC[1] = dec; }
    }
    __syncthreads();
    {
      const int tt = wid >> 1, st = wid & 1;
      f32x16 a16;
#pragma unroll
      for (int e = 0; e < 16; ++e) a16[e] = 0.f;
#pragma unroll
      for (int ks = 0; ks < 4; ++ks) {
        bf16x8 a = *(const bf16x8*)(QB + (tt * 32 + r) * 72 + ks * 16 + h * 8);
        bf16x8 b = *(const bf16x8*)(KB + (st * 32 + r) * 72 + ks * 16 + h * 8);
        a16 = MFMA(a, b, a16);
      }
      const int s = st * 32 + r;
      const float us = UL2[s];
#pragma unroll
      for (int e = 0; e < 16; ++e) {
        const int t = tt * 32 + crow(e, h);
        float v = 0.f;
        if (s <= t) v = a16[e] * ex2(BL2[t] + us);
        SM[t * 72 + s] = f2bf(v);
      }
    }
#pragma unroll
    for (int j = 0; j < 2; ++j) {
      const int id = tid + 256 * j, i = id >> 3, c8 = id & 7;
      float kv[8];
      unpack8(*(const uint4*)(KB + i * 72 + c8 * 8), kv);
      const float wk = WK[i];
#pragma unroll
      for (int e = 0; e < 8; ++e) KWT[(c8 * 8 + e) * 72 + i] = f2bf(kv[e] * wk);
    }
    __syncthreads();
    const float mnew = SC[0], dec = SC[1];
    if (tid < 64) {
      const int t = tid;
      float rsum = 0.f, qn = 0.f;
#pragma unroll
      for (int c8 = 0; c8 < 8; ++c8) {
        float sv[8], qv[8];
        unpack8(*(const uint4*)(SM + t * 72 + c8 * 8), sv);
        unpack8(*(const uint4*)(QB + t * 72 + c8 * 8), qv);
#pragma unroll
        for (int e = 0; e < 8; ++e) { rsum += sv[e]; qn += qv[e] * NV[cur * 64 + c8 * 8 + e]; }
      }
      DEN[t] = 1.f / fmaxf(fabsf(WI[t] * qn + rsum), EMT[t]);
    } else if (tid < 128) {
      const int f = tid - 64;
      float ns = 0.f;
#pragma unroll
      for (int c8 = 0; c8 < 8; ++c8) {
        float kv[8];
        unpack8(*(const uint4*)(KWT + f * 72 + c8 * 8), kv);
#pragma unroll
        for (int e = 0; e < 8; ++e) ns += kv[e];
      }
      NV[(cur ^ 1) * 64 + f] = dec * NV[cur * 64 + f] + ns;
    }
    __syncthreads();
    if (step + 1 < 36) SCANB_PREFETCH(step + 1);
    f32x16 num[2];
#pragma unroll
    for (int tt = 0; tt < 2; ++tt)
#pragma unroll
      for (int e = 0; e < 16; ++e) num[tt][e] = 0.f;
#pragma unroll
    for (int ft = 0; ft < 2; ++ft)
#pragma unroll
      for (int s = 0; s < 2; ++s) {
        bf16x8 pb = pack8(C[ft], s);
#pragma unroll
        for (int tt = 0; tt < 2; ++tt) {
          const u16* qb = QB + (tt * 32 + r) * 72 + ft * 32 + s * 16 + 4 * h;
          bf16x8 a = cat4(*(const s16x4*)qb, *(const s16x4*)(qb + 8));
          num[tt] = MFMA(a, pb, num[tt]);
        }
      }
#pragma unroll
    for (int tt = 0; tt < 2; ++tt)
#pragma unroll
      for (int e = 0; e < 16; ++e) num[tt][e] *= WI[tt * 32 + crow(e, h)];
    bf16x8 bv[4];
#pragma unroll
    for (int ks = 0; ks < 4; ++ks) bv[ks] = *(const bf16x8*)(VT + (wid * 32 + r) * 72 + ks * 16 + h * 8);
#pragma unroll
    for (int ks = 0; ks < 4; ++ks)
#pragma unroll
      for (int tt = 0; tt < 2; ++tt) {
        bf16x8 a = *(const bf16x8*)(SM + (tt * 32 + r) * 72 + ks * 16 + h * 8);
        num[tt] = MFMA(a, bv[ks], num[tt]);
      }
#pragma unroll
    for (int tt = 0; tt < 2; ++tt)
#pragma unroll
      for (int e = 0; e < 16; ++e) {
        const int i = tt * 32 + crow(e, h);
        const int tok = tok0 + (dir ? 63 - i : i);
        Ob[(size_t)tok * 512 + hd * 128 + wid * 32 + r] = f2bf(num[tt][e] * DEN[i]);
      }
#pragma unroll
    for (int ft = 0; ft < 2; ++ft) {
#pragma unroll
      for (int e = 0; e < 16; ++e) C[ft][e] *= dec;
#pragma unroll
      for (int ks = 0; ks < 4; ++ks) {
        bf16x8 a = *(const bf16x8*)(KWT + (ft * 32 + r) * 72 + ks * 16 + h * 8);
        C[ft] = MFMA(a, bv[ks], C[ft]);
      }
    }
    m = mnew;
    cur ^= 1;
  }
#undef SCANB_PREFETCH
#undef SCANB_LDKQ
#undef SCANB_LDV
#undef SCANB_STKQ
#undef SCANB_STV
#undef SCANB_TOK0
}

__device__ void phase_mixers(const Params& p, int l, int g, char* lds, int cbase = 0, bool scans_only = false, bool a_only = false) {
  int* s_item = (int*)(lds + LDS_BYTES - 16);
  int* cnt = (int*)(p.ws + OFF_CNT) + cbase + (l * NG + g);
  const u16* P = (const u16*)(p.ws + OFF_P);
  const u16* Qd = (const u16*)(p.ws + OFF_QD);
  const u16* Kd = (const u16*)(p.ws + OFF_KD);
  const u16* Vd = (const u16*)(p.ws + OFF_VD);
  u16* Y = (u16*)((char*)p.out);
  const float* rc = (const float*)(p.ws + OFF_ROPE);
  constexpr int NSA = NB * 8, NSB = NB * 4;
  constexpr int ND_L = NB * 4 * 8, NC_L = NB * 2 * 32, ND_C = NB * 4, NC_C = NB * 2 * 4;
  constexpr int I1 = NSA, I2 = I1 + NSB, I3 = I2 + ND_L, I4 = I3 + NC_L, I5 = I4 + ND_C, I6 = I5 + NC_C;
  const float scC = 0.125f * LOG2E, scD = 0.07216878364870322f * LOG2E;
  while (true) {
    __syncthreads();
    if (otid() == 0) *s_item = atomicAdd(cnt, 1);
    __syncthreads();
    const int it = *s_item;
    if (it >= (a_only ? I1 : (scans_only ? I2 : (l == DEPTH - 1 ? I4 : I6)))) break;
    if (it < I1) scanA_unit(p, l, it, lds);
    else if (it < I2) scanB_unit(p, l, it - I1, lds);
    else {
      bool isD, isLat; int q;
      if (it < I3) { isD = true; isLat = true; q = it - I2; }
      else if (it < I4) { isD = false; isLat = true; q = it - I3; }
      else if (it < I5) { isD = true; isLat = false; q = it - I4; }
      else { isD = false; isLat = false; q = it - I5; }
      const int tid = otid(), lane = tid & 63, wid = tid >> 6, r = lane & 31;
      const int nkeys = isLat ? TPB : CTXL;
      if (isD) {
        const int nqt = isLat ? 8 : 1;
        const int qt = q % nqt, hd = (q / nqt) % 4, bl = q / (nqt * 4);
        const int tokk = bl * TPB, ql = qt * 256 + wid * 32 + r;
        const int tokq = tokk + (isLat ? CTXL : 0) + ql;
        attn_item<192, 128, true>(Qd + (size_t)tokq * 768 + hd * 192, Kd + (size_t)tokk * 768 + hd * 192, 768,
                                  Vd + (size_t)tokk * 512 + hd * 128, 512, Y + (size_t)tokq * 2048 + 1536 + hd * 128,
                                  nkeys, scD, isLat ? ql : -1, rc, lds);
      } else {
        const int nqt = isLat ? 32 : 4;
        const int qt = q % nqt, kvh = (q / nqt) % 2, bl = q / (nqt * 2);
        const int hq = kvh * 4 + (wid >> 1);
        const int tokk = bl * TPB, ql = qt * 64 + (wid & 1) * 32 + r;
        const int tokq = tokk + (isLat ? CTXL : 0) + ql;
        attn_item<64, 64, false>(P + (size_t)tokq * PS + C_Q + hq * 64, P + (size_t)tokk * PS + C_K + kvh * 64, PS,
                                 P + (size_t)tokk * PS + C_V + kvh * 64, PS, Y + (size_t)tokq * 2048 + 1024 + hq * 64,
                                 nkeys, scC, -1, rc, lds);
      }
    }
  }
}

__device__ void phase_readout(const Params& p, int l) {
  const int tid = otid(), lane = tid & 63, wid = tid >> 6;
  const u16* P = (const u16*)(p.ws + OFF_P);
  const u16* Oa = (const u16*)(p.ws + OFF_OA);
  const u16* Ob = (const u16*)(p.ws + OFF_OB);
  u16* Y = (u16*)((char*)p.out);
  const int col = lane * 8;
  float gnv[2][8];
#pragma unroll
  for (int mix = 0; mix < 2; ++mix)
#pragma unroll
    for (int e = 0; e < 8; ++e) gnv[mix][e] = ((mix == 0 ? p.hnorm : p.mnorm) + l * 128 + (col & 127))[e];
  const int stride = gridDim.x * 8;
  const bool skipc = l == DEPTH - 1;
  for (int tok0 = blockIdx.x * 8 + wid; tok0 < NTOK; tok0 += 2 * stride) {
    int tk[2]; bool doit[2];
    tk[0] = tok0; tk[1] = tok0 + stride;
    doit[0] = !(skipc && (tk[0] % TPB) < CTXL);
    doit[1] = tk[1] < NTOK && !(skipc && (tk[1] % TPB) < CTXL);
    if (!doit[1]) tk[1] = tk[0];
    uint4 ra[2][2], rb[2][2], rg[2][2];
#pragma unroll
    for (int u = 0; u < 2; ++u)
#pragma unroll
      for (int mix = 0; mix < 2; ++mix) {
        const u16* O = mix == 0 ? Oa : Ob;
        ra[u][mix] = *(const uint4*)(O + (size_t)tk[u] * 512 + col);
        rb[u][mix] = *(const uint4*)(O + ((size_t)NTOK + tk[u]) * 512 + col);
        rg[u][mix] = *(const uint4*)(P + (size_t)tk[u] * PS + (mix == 0 ? A_G : B_O) + col);
      }
#pragma unroll
    for (int u = 0; u < 2; ++u) {
      uint4 outv[2];
#pragma unroll
      for (int mix = 0; mix < 2; ++mix) {
        float a[8], b[8], gt[8], o[8];
        unpack8(ra[u][mix], a); unpack8(rb[u][mix], b); unpack8(rg[u][mix], gt);
        float ss = 0.f;
#pragma unroll
        for (int e = 0; e < 8; ++e) { a[e] += b[e]; ss += a[e] * a[e]; }
        ss += __shfl_xor(ss, 1); ss += __shfl_xor(ss, 2); ss += __shfl_xor(ss, 4); ss += __shfl_xor(ss, 8);
        const float rstd = rsqrtf(ss * (1.f / 128.f) + EPS);
#pragma unroll
        for (int e = 0; e < 8; ++e) {
          float y = a[e] * rstd * gnv[mix][e];
          o[e] = y * (mix == 0 ? siluf_(gt[e]) : sigmoidf_(gt[e]));
        }
        outv[mix] = pack8f(o);
      }
      if (doit[u]) {
        *(uint4*)(Y + (size_t)tk[u] * 2048 + col) = outv[0];
        *(uint4*)(Y + (size_t)tk[u] * 2048 + 512 + col) = outv[1];
      }
    }
  }
}

struct EpiInproj {
  u16* P; float* Gb;
  DI bool operator()(f32x4 (&acc)[2][2][4][2], const pg8::UDesc& u, int wr, int wc, int fr, int fq) const {
    const int row0 = u.pm * 256 + wr * 64 + fr, col0 = u.pn * 256 + wc * 32 + 8 * fq;
    const bool gate = (u.pn == 9) && (wc == 0) && (fq < 2);
#pragma unroll
    for (int ai = 0; ai < 2; ++ai)
#pragma unroll
      for (int m = 0; m < 4; ++m) {
        const size_t row = (size_t)(row0 + ai * 128 + m * 16);
#pragma unroll
        for (int bj = 0; bj < 2; ++bj) *(uint4*)(P + row * PS + col0 + bj * 128) = pk8(acc[ai][bj][m][0], acc[ai][bj][m][1]);
        if (gate) { *(f32x4*)(Gb + row * 16 + 8 * fq) = acc[ai][0][m][0]; *(f32x4*)(Gb + row * 16 + 8 * fq + 4) = acc[ai][0][m][1]; }
      }
    return false;
  }
};
__device__ void phase_inproj(const Params& p, int l, char* lds) {
  pg8::PlainSched S{p.ws + OFF_H, wsel(p, l) + OFF_WINT, 2048u, 2048u, 16, NTOK / 256, PS / 256, (int)gridDim.x, (int)blockIdx.x};
  EpiInproj E{(u16*)(p.ws + OFF_P), (float*)(p.ws + OFF_GB)};
  pg8::gemm_stream(( LAS unsigned char*)lds, S, E);
}

struct MlaSched {
  const char* P; const char* Wq; const char* Wk; const char* Wv; int G, c;
  DI bool next(int i, pg8::UDesc& u) const {
    const long L = (long)i * G + c; if (L >= (NTOK / 256) * 7) return false;
    const int pm = (int)(L / 7), j = (int)(L % 7);
    u.pm = pm; u.lda2 = PS * 2;
    if (j < 3) { u.tag = 0; u.pn = j; u.A = P + (size_t)pm * 256 * PS * 2 + D_CQ * 2; u.B = Wq + (size_t)j * 256 * 512; u.ldb2 = 512; u.nt = 4; }
    else if (j < 5) { u.tag = 1; u.pn = j - 3; u.A = P + (size_t)pm * 256 * PS * 2 + D_CKV * 2; u.B = Wk + (size_t)(j - 3) * 256 * 256; u.ldb2 = 256; u.nt = 2; }
    else { u.tag = 2; u.pn = j - 5; u.A = P + (size_t)pm * 256 * PS * 2 + D_CKV * 2; u.B = Wv + (size_t)(j - 5) * 256 * 256; u.ldb2 = 256; u.nt = 2; }
    return true;
  }
};
struct EpiMla {
  u16 *Qd, *Kd, *Vd;
  DI bool operator()(f32x4 (&acc)[2][2][4][2], const pg8::UDesc& u, int wr, int wc, int fr, int fq) const {
    const int row0 = u.pm * 256 + wr * 64 + fr, col0 = u.pn * 256 + wc * 32 + 8 * fq;
#pragma unroll
    for (int ai = 0; ai < 2; ++ai)
#pragma unroll
      for (int m = 0; m < 4; ++m) {
        const size_t row = (size_t)(row0 + ai * 128 + m * 16);
#pragma unroll
        for (int bj = 0; bj < 2; ++bj) {
          const int col = col0 + bj * 128;
          u16* dst = u.tag == 0 ? Qd + row * 768 + col : (u.tag == 1 ? Kd + row * 768 + (col >> 7) * 192 + (col & 127) : Vd + row * 512 + col);
          *(uint4*)dst = pk8(acc[ai][bj][m][0], acc[ai][bj][m][1]);
        }
      }
    return false;
  }
};
__device__ void phase_mlaup(const Params& p, int l, char* lds) {
  MlaSched S{p.ws + OFF_P, wsel(p, l) + OFF_WUQ, wsel(p, l) + OFF_WUK, wsel(p, l) + OFF_WUV, (int)gridDim.x, (int)blockIdx.x};
  EpiMla E{(u16*)(p.ws + OFF_QD), (u16*)(p.ws + OFF_KD), (u16*)(p.ws + OFF_VD)};
  pg8::gemm_stream((LAS unsigned char*)lds, S, E);
}

struct EpiGate {
  u16* Gt;
  DI bool operator()(f32x4 (&acc)[2][2][4][2], const pg8::UDesc& u, int wr, int wc, int fr, int fq) const {
    const int row0 = u.pm * 256 + wr * 64 + fr, col0 = u.pn * 256 + wc * 32 + 8 * fq;
#pragma unroll
    for (int ai = 0; ai < 2; ++ai)
#pragma unroll
      for (int m = 0; m < 4; ++m) {
        const size_t row = (size_t)(row0 + ai * 128 + m * 16);
#pragma unroll
        for (int bj = 0; bj < 2; ++bj) {
          f32x4 a = acc[ai][bj][m][0], b = acc[ai][bj][m][1];
#pragma unroll
          for (int e = 0; e < 4; ++e) { a[e] = fmaxf(sigmoidf_(a[e]), 1e-30f); b[e] = fmaxf(sigmoidf_(b[e]), 1e-30f); }
          *(uint4*)(Gt + row * 4096 + col0 + bj * 128) = pk8(a, b);
        }
      }
    return false;
  }
};
__device__ void phase_gate(const Params& p, int l, char* lds, int lat_only) {
  pg8::PlainSched S{p.ws + OFF_H, wsel(p, l) + OFF_WGT, 2048u, 2048u, 16, NTOK / 256, 16, (int)gridDim.x, (int)blockIdx.x, lat_only};
  EpiGate E{(u16*)(p.ws + OFF_P)};
  pg8::gemm_stream((LAS unsigned char*)lds, S, E);
}

struct BranchSched {
  const char* Y; const char* Wb; int G, c, lat_only;
  DI bool next(int i, pg8::UDesc& u) const {
    int pm, pn; if (!pg8::tile_order((long)(i >> 2) * G + c, lat_only ? NTOK / 256 - NB : NTOK / 256, 4, pm, pn)) return false;
    if (lat_only) pm = pm + (pm >> 3) + 1;
    const int r = i & 3;
    u.pm = pm; u.pn = pn; u.tag = r; u.lda2 = 4096; u.ldb2 = 1024; u.nt = 8;
    u.A = Y + (size_t)pm * 256 * 4096 + r * 1024; u.B = Wb + ((size_t)r * 1024 + pn * 256) * 1024;
    return true;
  }
};
struct EpiBranch {
  const u16* Gt; u16* Mg;
  DI bool operator()(f32x4 (&acc)[2][2][4][2], const pg8::UDesc& u, int wr, int wc, int fr, int fq) const {
    const int row0 = u.pm * 256 + wr * 64 + fr, col0 = u.pn * 256 + wc * 32 + 8 * fq, r = u.tag;
    const int rn = r < 3 ? r + 1 : r;
#pragma unroll
    for (int ai = 0; ai < 2; ++ai)
#pragma unroll
      for (int mh = 0; mh < 2; ++mh) {
        uint4 gin[2][2], gnn[2][2];
#pragma unroll
        for (int mm = 0; mm < 2; ++mm)
#pragma unroll
          for (int bj = 0; bj < 2; ++bj) {
            const u16* gp = Gt + (size_t)(row0 + ai * 128 + (mh * 2 + mm) * 16) * 4096 + col0 + bj * 128;
            gin[mm][bj] = *(const uint4*)(gp + r * 1024);
            gnn[mm][bj] = *(const uint4*)(gp + rn * 1024);
          }
#pragma unroll
        for (int mm = 0; mm < 2; ++mm) {
          const int m = mh * 2 + mm;
          const size_t row = (size_t)(row0 + ai * 128 + m * 16);
#pragma unroll
          for (int bj = 0; bj < 2; ++bj) {
            const int col = col0 + bj * 128;
            float gv[8];
            unpack8(gin[mm][bj], gv);
            if (r < 3) {
              float gn[8];
              unpack8(gnn[mm][bj], gn);
#pragma unroll
              for (int e = 0; e < 4; ++e) {
                acc[ai][bj][m][0][e] *= gv[e] * __builtin_amdgcn_rcpf(gn[e]);
                acc[ai][bj][m][1][e] *= gv[4 + e] * __builtin_amdgcn_rcpf(gn[4 + e]);
              }
            } else {
              f32x4 a = acc[ai][bj][m][0], b = acc[ai][bj][m][1];
#pragma unroll
              for (int e = 0; e < 4; ++e) { a[e] *= gv[e]; b[e] *= gv[4 + e]; }
              *(uint4*)(Mg + row * 1024 + col) = pk8(a, b);
            }
          }
        }
      }
    return r < 3;
  }
};
__device__ void phase_branch(const Params& p, int l, char* lds, int lat_only) {
  BranchSched S{(const char*)p.out, wsel(p, l) + OFF_WBT, (int)gridDim.x, (int)blockIdx.x, lat_only};
  EpiBranch E{(const u16*)(p.ws + OFF_P), (u16*)(p.ws + OFF_OA)};
  pg8::gemm_stream((LAS unsigned char*)lds, S, E);
}

struct EpiResid {
  const Params* pp; const float* mod; int g, gidx; float* dummy;
  DI bool operator()(f32x4 (&acc)[2][2][4][2], const pg8::UDesc& u, int wr, int wc, int fr, int fq) const {
    int mr; u16* xb = xrow_ptr(*pp, g, u.pm * 256, mr);
    if (dummy) xb = (u16*)dummy + (size_t)u.pm * 256 * DM;
    const float* gate = mod + (size_t)mr * 6144 + gidx * DM;
    const int row0 = wr * 64 + fr, col0 = u.pn * 256 + wc * 32 + 8 * fq;
    f32x4 gv[2][2];
#pragma unroll
    for (int bj = 0; bj < 2; ++bj) { gv[bj][0] = *(const f32x4*)(gate + col0 + bj * 128); gv[bj][1] = *(const f32x4*)(gate + col0 + bj * 128 + 4); }
#pragma unroll
    for (int ai = 0; ai < 2; ++ai) {
      uint4 xin[4][2];
#pragma unroll
      for (int m = 0; m < 4; ++m)
#pragma unroll
        for (int bj = 0; bj < 2; ++bj) xin[m][bj] = *(const uint4*)(xb + (size_t)(row0 + ai * 128 + m * 16) * DM + col0 + bj * 128);
#pragma unroll
      for (int m = 0; m < 4; ++m) {
        u16* xr = xb + (size_t)(row0 + ai * 128 + m * 16) * DM + col0;
#pragma unroll
        for (int bj = 0; bj < 2; ++bj) {
          float xv[8];
          unpack8(xin[m][bj], xv);
          f32x4 x0 = {xv[0], xv[1], xv[2], xv[3]}, x1 = {xv[4], xv[5], xv[6], xv[7]};
          x0 += gv[bj][0] * acc[ai][bj][m][0]; x1 += gv[bj][1] * acc[ai][bj][m][1];
          *(uint4*)(xr + bj * 128) = pk8(x0, x1);
        }
      }
    }
    return false;
  }
};
__device__ void phase_resid_gemm(const Params& p, int l, int g, const char* A, const char* W, int K, int gidx, char* lds, float* dummy = nullptr) {
  pg8::PlainSched S{A, W, (unsigned)K * 2u, (unsigned)K * 2u, K / 64, NTOK / 256, 4, (int)gridDim.x, (int)blockIdx.x, (l == DEPTH - 1) ? 1 : 0};
  EpiResid E{&p, (const float*)(p.ws + OFF_MOD) + (size_t)l * 33 * 6144, g, gidx, dummy};
  pg8::gemm_stream((LAS unsigned char*)lds, S, E);
}

struct EpiFF1 {
  u16* Hid;
  DI bool operator()(f32x4 (&acc)[2][2][4][2], const pg8::UDesc& u, int wr, int wc, int fr, int fq) const {
    const int row0 = u.pm * 256 + wr * 64 + fr, col0 = u.pn * 256 + wc * 32 + 8 * fq;
#pragma unroll
    for (int ai = 0; ai < 2; ++ai)
#pragma unroll
      for (int m = 0; m < 4; ++m) {
        const size_t row = (size_t)(row0 + ai * 128 + m * 16);
#pragma unroll
        for (int bj = 0; bj < 2; ++bj) {
          f32x4 a = acc[ai][bj][m][0], b = acc[ai][bj][m][1];
#pragma unroll
          for (int e = 0; e < 4; ++e) { float t = fmaxf(a[e], 0.f); a[e] = t * t; t = fmaxf(b[e], 0.f); b[e] = t * t; }
          *(uint4*)(Hid + row * DFF + col0 + bj * 128) = pk8(a, b);
        }
      }
    return false;
  }
};
__device__ void phase_ff1(const Params& p, int l, char* lds, int lat_only) {
  pg8::PlainSched S{p.ws + OFF_H, wsel(p, l) + OFF_W1T, 2048u, 2048u, 16, NTOK / 256, 16, (int)gridDim.x, (int)blockIdx.x, lat_only};
  EpiFF1 E{(u16*)(p.ws + OFF_P)};
  pg8::gemm_stream((LAS unsigned char*)lds, S, E);
}

__device__ void phase_final(const Params& p) {
  const int tid = otid(), lane = tid & 63, wid = tid >> 6;
  for (int tok = blockIdx.x * 8 + wid; tok < NBATCH * SEQ; tok += gridDim.x * 8) {
    float* xr = p.out + (size_t)tok * DM;
    const u16* xs = (const u16*)(p.ws + OFF_XL) + (size_t)tok * DM;
    float4 v[4]; float ss = 0.f;
#pragma unroll
    for (int j = 0; j < 4; ++j) {
      const uint2 q = *(const uint2*)(xs + j * 256 + lane * 4);
      v[j].x = __uint_as_float(q.x << 16); v[j].y = __uint_as_float(q.x & 0xffff0000u); v[j].z = __uint_as_float(q.y << 16); v[j].w = __uint_as_float(q.y & 0xffff0000u);
      ss += v[j].x * v[j].x + v[j].y * v[j].y + v[j].z * v[j].z + v[j].w * v[j].w;
    }
    ss = wave_sum(ss);
    const float rstd = rsqrtf(ss * (1.f / DM) + EPS);
#pragma unroll
    for (int j = 0; j < 4; ++j) {
      int c = j * 256 + lane * 4;
      float4 gg = *(const float4*)(p.gfin + c);
      float4 o = {v[j].x * rstd * gg.x, v[j].y * rstd * gg.y, v[j].z * rstd * gg.z, v[j].w * rstd * gg.w};
      *(float4*)(xr + c) = o;
    }
  }
}

#define XB_TMO      128
#define XB_XCNT(j)  (256  + 64 * (j))
#define XB_XSUB(j)  (1280 + 64 * (j))
#define XB_XGEN(j)  (2304 + 64 * (j))
#define XB_TOP      3328
#define XB_TOPGEN   3392
#define XCD_BAR_WORDS 3456
#define XB_SPIN_CAP (1u << 18)
DI unsigned xb_ld(unsigned* p) { return __hip_atomic_load(p, __ATOMIC_RELAXED, __HIP_MEMORY_SCOPE_AGENT); }
DI unsigned xb_add(unsigned* p, unsigned v) { return __hip_atomic_fetch_add(p, v, __ATOMIC_RELAXED, __HIP_MEMORY_SCOPE_AGENT); }
DI unsigned xb_xcc_id() { return (unsigned)__builtin_amdgcn_s_getreg((3 << 11) | 20) & 0xFu; }
#define XB_SPIN(cond, bar) do { unsigned _sp = 0; while (cond) { __builtin_amdgcn_s_sleep(1); \
    if ((++_sp & 255u) == 0u) { if (xb_ld(&(bar)[XB_TMO])) break; if (_sp > XB_SPIN_CAP) { atomicAdd(&(bar)[XB_TMO], 1u); break; } } } } while (0)
struct XcdBarrier { unsigned* bar; unsigned x; volatile __attribute__((address_space(3))) unsigned* st; };
DI XcdBarrier xcd_barrier_post(unsigned* bar, volatile __attribute__((address_space(3))) unsigned* st) {
  XcdBarrier b; b.bar = bar; b.x = xb_xcc_id(); b.st = st;
  if (threadIdx.x == 0) (void)xb_add(&bar[XB_XCNT(b.x)], 1u);
  return b;
}
DI void xcd_barrier_complete(unsigned* bar, unsigned x, unsigned& nloc, unsigned& nx) {
  const unsigned G = gridDim.x * gridDim.y * gridDim.z;
  unsigned sum, cnt, mine, sp = 0u;
  for (;;) {
    sum = 0u; cnt = 0u; mine = 0u;
#pragma unroll
    for (unsigned j = 0; j < 16; ++j) { const unsigned c = xb_ld(&bar[XB_XCNT(j)]); sum += c; cnt += (c > 0u) ? 1u : 0u; mine = (j == x) ? c : mine; }
    if (sum == G) break;
    __builtin_amdgcn_s_sleep(1);
    if ((++sp & 255u) == 0u) { if (xb_ld(&bar[XB_TMO])) break; if (sp > XB_SPIN_CAP) { atomicAdd(&bar[XB_TMO], 1u); break; } }
  }
  nloc = mine > 0u ? mine : 1u; nx = cnt > 0u ? cnt : 1u;
}
DI void xcd_barrier(const XcdBarrier& b) {
  asm volatile("s_waitcnt vmcnt(0)" ::: "memory");
  __syncthreads();
  if (threadIdx.x == 0) {
    unsigned* bar = b.bar;
    __builtin_amdgcn_s_waitcnt(0);
    unsigned nloc = b.st[0], nx = b.st[1];
    if (nloc == 0u) { xcd_barrier_complete(bar, b.x, nloc, nx); b.st[0] = nloc; b.st[1] = nx; }
    const unsigned old = xb_add(&bar[XB_XSUB(b.x)], 1u);
    const unsigned gen = old / nloc;
    if (old + 1u == (gen + 1u) * nloc) {
      __builtin_amdgcn_fence(__ATOMIC_RELEASE, "agent");
      asm volatile("s_waitcnt vmcnt(0)" ::: "memory");
      const unsigned og = xb_add(&bar[XB_TOP], 1u);
      const unsigned tg = og / nx;
      if (og + 1u == (tg + 1u) * nx) xb_add(&bar[XB_TOPGEN], 1u);
      else XB_SPIN(xb_ld(&bar[XB_TOPGEN]) == tg, bar);
      __builtin_amdgcn_fence(__ATOMIC_ACQUIRE, "agent");
      xb_add(&bar[XB_XGEN(b.x)], 1u);
      asm volatile("s_waitcnt vmcnt(0)" ::: "memory");
    } else {
      XB_SPIN(xb_ld(&bar[XB_XGEN(b.x)]) == gen, bar);
      __builtin_amdgcn_fence(__ATOMIC_ACQUIRE, "agent");
      asm volatile("s_waitcnt vmcnt(0)" ::: "memory");
    }
  }
  __syncthreads();
}

constexpr int NSUB = 12;
constexpr int NPHASE = 1 + DEPTH * NG * NSUB + 1;

__global__ void __launch_bounds__(512) mega(Params p, int ph_lo, int ph_hi) {
  extern __shared__ __attribute__((aligned(16))) char lds[];
  volatile __attribute__((address_space(3))) unsigned* st = (volatile __attribute__((address_space(3))) unsigned*)(lds + LDS_BYTES - 32);
  if (threadIdx.x < 2) st[threadIdx.x] = 0u;
  __syncthreads();
  XcdBarrier xb{};
  if (ph_hi - ph_lo > 1) xb = xcd_barrier_post((unsigned*)(p.ws + OFF_BAR), st);
#define GSYNC() xcd_barrier(xb)
  for (int ph = ph_lo; ph < ph_hi; ++ph) {
    if (ph > 0 && ph < NPHASE - 1 && ((ph - 1) % NSUB) == 0 && ((ph - 1) / NSUB) != 0) continue;
    if (ph == 0) { phase_prep(p, lds); phase_wconv(p, 0, lds); }
    else if (ph == NPHASE - 1) phase_final(p);
    else {
      const int q = ph - 1, lg = q / NSUB, sub = q % NSUB, l = lg / NG, g = lg % NG;
      switch (sub) {
        case 0: if (lg == 0) phase_norm(p, l, g, 0); break;
        case 1: for (int rep = 0; rep < ((PROBE & 2) ? 2 : 1); ++rep) { if (rep) GSYNC(); phase_inproj(p, l, lds); } break;
        case 2: phase_tokprep(p, l); break;
        case 3: phase_mlaup(p, l, lds); break;
        case 4: phase_mixers(p, l, g, lds); if (PROBE & 1) { GSYNC(); phase_mixers(p, l, g, lds, 8); } if (PROBE & 4) { GSYNC(); phase_mixers(p, l, g, lds, 8, true); } if (PROBE & 16) { GSYNC(); phase_mixers(p, l, g, lds, 8, true, true); } break;
        case 5: for (int rep = 0; rep < ((PROBE & 8) ? 2 : 1); ++rep) { if (rep) GSYNC(); phase_readout(p, l); } break;
        case 6: for (int rep = 0; rep < ((PROBE & 2) ? 2 : 1); ++rep) { if (rep) GSYNC(); phase_gate(p, l, lds, l == DEPTH - 1); } break;
        case 7: for (int rep = 0; rep < ((PROBE & 32) ? 2 : 1); ++rep) { if (rep) GSYNC(); phase_branch(p, l, lds, l == DEPTH - 1); } if (g == 0 && l + 1 < DEPTH) phase_wconv(p, l + 1, lds, (int*)(p.ws + OFF_CNT) + 24 + l); break;
        case 8: for (int rep = 0; rep < ((PROBE & 64) ? 2 : 1); ++rep) { if (rep) GSYNC(); phase_resid_gemm(p, l, g, p.ws + OFF_OA, wsel(p, l) + OFF_WOT, DM, 2, lds, rep ? (float*)((char*)p.out) : nullptr); } break;
        case 9: for (int rep = 0; rep < ((PROBE & 8) ? 2 : 1); ++rep) { if (rep) GSYNC(); phase_norm(p, l, g, 1); } break;
        case 10: for (int rep = 0; rep < ((PROBE & 2) ? 2 : 1); ++rep) { if (rep) GSYNC(); phase_ff1(p, l, lds, l == DEPTH - 1); } break;
        default: for (int rep = 0; rep < ((PROBE & 64) ? 2 : 1); ++rep) { if (rep) GSYNC(); phase_resid_gemm(p, l, g, p.ws + OFF_P, wsel(p, l) + OFF_W2T, DFF, 5, lds, rep ? (float*)((char*)p.out) : nullptr); } if (lg + 1 < DEPTH * NG) phase_norm_dyn(p, (lg + 1) / NG, (lg + 1) % NG, (int*)(p.ws + OFF_CNT) + 16 + lg); break;
      }
    }
    if (ph + 1 < ph_hi) { if (ph == ph_lo) cg::this_grid().sync(); else GSYNC(); }
  }
}

extern "C" void kernel_launch(void* const* d_in, const int* in_sizes, int n_in, void* d_out, int out_size, void* d_ws,
                              size_t ws_size, hipStream_t stream) {
  static int grid_blocks = 0;
  if (!grid_blocks) {
    int dev = 0, cus = 0, per_cu = 0;
    (void)hipGetDevice(&dev);
    (void)hipDeviceGetAttribute(&cus, hipDeviceAttributeMultiprocessorCount, dev);
    (void)hipFuncSetAttribute((const void*)mega, hipFuncAttributeMaxDynamicSharedMemorySize, LDS_BYTES);
    (void)hipOccupancyMaxActiveBlocksPerMultiprocessor(&per_cu, mega, NTHR, LDS_BYTES);
    if (per_cu < 1) per_cu = 1;
    if (per_cu > 1) per_cu = 1;
    grid_blocks = cus * per_cu;
  }
  if (ws_size < WS_NEED) { fprintf(stderr, "workspace too small: %zu < %zu\n", ws_size, (size_t)WS_NEED); }
  Params p{};
  const float** pf = (const float**)&p;
  for (int i = 0; i < 26; ++i) pf[i] = (const float*)d_in[i];
  p.out = (float*)d_out;
  p.ws = (char*)d_ws;
  (void)hipMemsetAsync((char*)d_ws + OFF_CNT, 0, 256 + 3456 * 4, stream);
#if ONE_LAUNCH
  int lo = 0, hi = NPHASE;
  void* args[] = {&p, &lo, &hi};
  hipError_t e = hipLaunchCooperativeKernel((void*)mega, dim3(grid_blocks), dim3(NTHR), args, LDS_BYTES, stream);
  if (e != hipSuccess) fprintf(stderr, "cooperative launch failed: %s (grid %d)\n", hipGetErrorString(e), grid_blocks);
#else
  for (int ph = 0; ph < NPHASE; ++ph) mega<<<grid_blocks, NTHR, LDS_BYTES, stream>>>(p, ph, ph + 1);
#endif
}
```

```cpp
#include <hip/hip_runtime.h>
#include <hip/hip_cooperative_groups.h>
#include <cstdio>
#include <cstdint>
namespace cg = cooperative_groups;

#ifndef PROBE
#define PROBE 0
#endif
#ifndef ONE_LAUNCH
#define ONE_LAUNCH 1
#endif

typedef unsigned short u16;
typedef short bf16x8 __attribute__((ext_vector_type(8)));
typedef short s16x4 __attribute__((ext_vector_type(4)));
typedef float f32x16 __attribute__((ext_vector_type(16)));
typedef float f32x2v __attribute__((ext_vector_type(2)));
typedef __bf16 bf16x2v __attribute__((ext_vector_type(2)));
#define DI __device__ __forceinline__
#define MFMA(a, b, c) __builtin_amdgcn_mfma_f32_32x32x16_bf16((a), (b), (c), 0, 0, 0)

constexpr int DM = 1024, NBATCH = 32, SEQ = 2048, CTXL = 256, DEPTH = 4, DFF = 4096;
constexpr int NG = 2, NB = 16, TPB = 2304, NTOK = NB * TPB;
constexpr int PS = 5376, NPC = 5328, INW = 9424;
constexpr int A_I = 0, A_FF = 512, A_FB = 1024, B_K = 1536, B_V = 1792, B_G = 2304, C_K = 2320, C_V = 2448,
              D_CKV = 2576, D_KR = 2704, A_Q = 2768, A_G = 3280, B_Q = 3792, B_O = 4048, C_Q = 4560, D_CQ = 5072;
constexpr float EPS = 1e-6f;
constexpr float LOG2E = 1.4426950408889634f;

constexpr size_t al256(size_t x) { return (x + 255) & ~(size_t)255; }
constexpr size_t OFF_WINT = 0;
constexpr size_t OFF_WGT = OFF_WINT + al256((size_t)PS * 1024 * 2);
constexpr size_t OFF_WBT = OFF_WGT + al256((size_t)4096 * 1024 * 2);
constexpr size_t OFF_WOT = OFF_WBT + al256((size_t)4 * 1024 * 512 * 2);
constexpr size_t OFF_W1T = OFF_WOT + al256((size_t)1024 * 1024 * 2);
constexpr size_t OFF_W2T = OFF_W1T + al256((size_t)4096 * 1024 * 2);
constexpr size_t OFF_WUQ = OFF_W2T + al256((size_t)1024 * 4096 * 2);
constexpr size_t OFF_WUK = OFF_WUQ + al256((size_t)768 * 256 * 2);
constexpr size_t OFF_WUV = OFF_WUK + al256((size_t)512 * 128 * 2);
constexpr size_t OFF_MOD = OFF_WUV + al256((size_t)512 * 128 * 2);
constexpr size_t OFF_LB = OFF_MOD + al256((size_t)4 * 33 * 6144 * 4);
constexpr size_t OFF_ROPE = OFF_LB + al256((size_t)4 * 2 * 512 * 4);
constexpr size_t OFF_CNT = OFF_ROPE + al256((size_t)2 * 64 * 16 * 4);
constexpr size_t OFF_BAR = OFF_CNT + 256;
constexpr size_t OFF_XC = OFF_BAR + al256(3456 * 4);
constexpr size_t OFF_XL = OFF_XC + al256((size_t)NBATCH * CTXL * DM * 2);
constexpr size_t OFF_P = OFF_XL + al256((size_t)NBATCH * SEQ * DM * 2);
constexpr size_t OFF_GB = OFF_P + al256((size_t)NTOK * PS * 2);
constexpr size_t OFF_KQ = OFF_GB + al256((size_t)NTOK * 16 * 4);
constexpr size_t OFF_H = OFF_KQ + al256((size_t)NTOK * 512 * 2);
constexpr size_t OFF_QD = OFF_H + al256((size_t)NTOK * 1024 * 2);
constexpr size_t OFF_KD = OFF_QD + al256((size_t)NTOK * 768 * 2);
constexpr size_t OFF_VD = OFF_KD + al256((size_t)NTOK * 768 * 2);
constexpr size_t OFF_OA = OFF_VD + al256((size_t)NTOK * 512 * 2);
constexpr size_t OFF_OB = OFF_OA + al256((size_t)2 * NTOK * 512 * 2);
constexpr size_t OFF_W2ND = OFF_OB + al256((size_t)2 * NTOK * 512 * 2);
constexpr size_t WS_NEED = OFF_W2ND + (OFF_MOD - OFF_WINT);
constexpr int LDS_BYTES = 143360;
constexpr int LDSV = 69632;
constexpr int NTHR = 512;
constexpr size_t OFF_MF = OFF_QD;

struct Params {
  const float *x, *c, *ctx, *c_ctx, *w_ada, *b_ada, *g1, *g2, *w_in, *bgate, *lblog, *hnorm, *convw, *mnorm,
      *gqn, *gkn, *mqn, *mkvn, *wuq, *wuk, *wuv, *wbr, *wout, *wff1, *wff2, *gfin;
  float* out;
  char* ws;
};

DI int otid() { int t = threadIdx.x; asm volatile("" : "+v"(t)); return t; }
DI char* wsel(const Params& p, int l) { return p.ws + ((l & 1) ? OFF_W2ND : (size_t)0); }
DI float bf2f(u16 v) { return __uint_as_float(((unsigned)v) << 16); }
DI unsigned pack2(float a, float b) {
  f32x2v v = {a, b};
  bf16x2v r = __builtin_convertvector(v, bf16x2v);
  return __builtin_bit_cast(unsigned, r);
}
DI u16 f2bf(float a) { return (u16)(pack2(a, 0.f) & 0xffffu); }
DI int crow(int reg, int h) { return (reg & 3) + 8 * (reg >> 2) + 4 * h; }
DI float sigmoidf_(float x) { return 1.f / (1.f + __expf(-x)); }
DI float siluf_(float x) { return x / (1.f + __expf(-x)); }
DI float ex2(float x) { return __builtin_amdgcn_exp2f(x); }
DI bf16x8 pack8(const f32x16& x, int s) {
  union { unsigned u[4]; bf16x8 v; } t;
  t.u[0] = pack2(x[8 * s + 0], x[8 * s + 1]);
  t.u[1] = pack2(x[8 * s + 2], x[8 * s + 3]);
  t.u[2] = pack2(x[8 * s + 4], x[8 * s + 5]);
  t.u[3] = pack2(x[8 * s + 6], x[8 * s + 7]);
  return t.v;
}
DI bf16x8 cat4(s16x4 lo, s16x4 hi) { return __builtin_shufflevector(lo, hi, 0, 1, 2, 3, 4, 5, 6, 7); }
DI float wave_sum(float v) {
#pragma unroll
  for (int d = 32; d >= 1; d >>= 1) v += __shfl_xor(v, d);
  return v;
}
DI void unpack8(const uint4& q, float* f) {
  f[0] = __uint_as_float(q.x << 16); f[1] = __uint_as_float(q.x & 0xffff0000u);
  f[2] = __uint_as_float(q.y << 16); f[3] = __uint_as_float(q.y & 0xffff0000u);
  f[4] = __uint_as_float(q.z << 16); f[5] = __uint_as_float(q.z & 0xffff0000u);
  f[6] = __uint_as_float(q.w << 16); f[7] = __uint_as_float(q.w & 0xffff0000u);
}
DI uint4 pack8f(const float* f) {
  uint4 q;
  q.x = pack2(f[0], f[1]); q.y = pack2(f[2], f[3]); q.z = pack2(f[4], f[5]); q.w = pack2(f[6], f[7]);
  return q;
}

DI u16* xrow_ptr(const Params& p, int g, int tok, int& modrow) {
  int bl = tok / TPB, pp = tok - bl * TPB, b = g * NB + bl;
  if (pp < CTXL) { modrow = 32; return (u16*)(p.ws + OFF_XC) + ((size_t)b * CTXL + pp) * DM; }
  modrow = b;
  return (u16*)(p.ws + OFF_XL) + ((size_t)b * SEQ + (pp - CTXL)) * DM;
}

#define LAS __attribute__((address_space(3)))
typedef float f32x4 __attribute__((ext_vector_type(4)));
namespace pg8 {
constexpr int BM = 256, BK = 64, HALF = 128, HTB = HALF * BK * 2, STAGE_BYTES = 8 * HTB, NXCD = 8, WGM = 8;
DI int lds_byte(int r, int c) { const int st = (r >> 4) * 2 + (c >> 5), rr = r & 15, cc = c & 31, ob = rr * 64 + cc * 2; return st * 1024 + (ob ^ (((ob >> 9) & 1) << 5)); }
DI void stage_rc(int b, int& R, int& C) { const int st = b / 1024, sb = b % 1024, swz = sb ^ (((sb >> 9) & 1) << 5); R = (st >> 1) * 16 + swz / 64; C = (st & 1) * 32 + (swz % 64) / 2; }
DI int perm32(int rho) { const int n = rho >> 4, i = rho & 15; return 8 * (i >> 2) + 4 * n + (i & 3); }
struct UDesc { const char* A; const char* B; unsigned lda2, ldb2; int nt, pm, pn, tag; };
DI bool tile_order(long L, int nM, int nN, int& pm, int& pn) {
  const int nwg = nM * nN; if (L >= nwg) return false;
  int wgid = (int)L; { const int q = nwg / NXCD, r = nwg % NXCD, xcd = wgid % NXCD, off = wgid / NXCD; wgid = (xcd < r ? xcd * (q + 1) : r * (q + 1) + (xcd - r) * q) + off; }
  const int nig = WGM * nN, gid = wgid / nig, fm = gid * WGM, gsz = (nM - fm) < WGM ? (nM - fm) : WGM;
  pm = fm + ((wgid % nig) % gsz); pn = (wgid % nig) / gsz; return true;
}
template <class Epi, class Sched>
DI void gemm_stream(LAS unsigned char* lds, const Sched& S, const Epi& E) {
  const int tid = otid(), wid = __builtin_amdgcn_readfirstlane(tid >> 6), lane = tid & 63, wr = wid >> 2, wc = wid & 3, fr = lane & 15, fq = lane >> 4;
  int RA[2], RB[2], CC[2];
#pragma unroll
  for (int i = 0; i < 2; ++i) { int R, C; stage_rc(tid * 16 + i * 8192, R, C); RA[i] = R; RB[i] = (R & ~31) + perm32(R & 31); CC[i] = C * 2; }
  const size_t kstep = (size_t)(BK * 2);
  const unsigned ldsw = (unsigned)wid * 1024u;
  const int aoff = lds_byte(wr * 64 + fr, fq * 8), boff = lds_byte(wc * 32 + fr, fq * 8);
#define PG8_SA(b, h) (((b) * 2 + (h)) * HTB)
#define PG8_SB(b, h) ((4 + (b) * 2 + (h)) * HTB)
#define PG8_STAGE(bufoff, gbase, voff) do { _Pragma("unroll") for (int _i = 0; _i < 2; ++_i) \
    __builtin_amdgcn_global_load_lds((const unsigned*)((const char*)(gbase) + (voff)[_i]), (LAS unsigned*)(lds + (bufoff) + ldsw + _i * 8192), 16, 0, 0); } while (0)
#define PG8_LDA(dst, b, h) do { _Pragma("unroll") for (int m = 0; m < 4; ++m) _Pragma("unroll") for (int k = 0; k < 2; ++k) dst[m][k] = *(const LAS bf16x8*)(lds + PG8_SA(b, h) + aoff + m * 2048 + k * 1024); } while (0)
#define PG8_LDB(dst, b, h) do { _Pragma("unroll") for (int n = 0; n < 2; ++n) _Pragma("unroll") for (int k = 0; k < 2; ++k) dst[n][k] = *(const LAS bf16x8*)(lds + PG8_SB(b, h) + boff + n * 2048 + k * 1024); } while (0)
#define PG8_MMA(ai, bj, At, Bt) do { __builtin_amdgcn_s_setprio(1); _Pragma("unroll") for (int m = 0; m < 4; ++m) _Pragma("unroll") for (int n = 0; n < 2; ++n) _Pragma("unroll") for (int k = 0; k < 2; ++k) \
    acc[ai][bj][m][n] = __builtin_amdgcn_mfma_f32_16x16x32_bf16(Bt[n][k], At[m][k], acc[ai][bj][m][n], 0, 0, 0); __builtin_amdgcn_s_setprio(0); } while (0)
#define PG8_WAIT_V(n) asm volatile("s_waitcnt vmcnt(" #n ")" ::: "memory")
#define PG8_WAIT_L(n) asm volatile("s_waitcnt lgkmcnt(" #n ")" ::: "memory")
#define PG8_BAR __builtin_amdgcn_s_barrier()
#define PG8_SCHED __builtin_amdgcn_sched_barrier(0)
  UDesc cur, nxt; int ui = 0;
  if (!S.next(0, cur)) return;
  f32x4 acc[2][2][4][2];
#pragma unroll
  for (int a = 0; a < 2; ++a)
#pragma unroll
    for (int b = 0; b < 2; ++b)
#pragma unroll
      for (int m = 0; m < 4; ++m)
#pragma unroll
        for (int n = 0; n < 2; ++n) acc[a][b][m][n] = (f32x4){0.f, 0.f, 0.f, 0.f};
  bf16x8 At[4][2], B0[2][2], B1[2][2];
  const char* cA = cur.A; const char* cB = cur.B;
  unsigned vA[2], vB[2];
#pragma unroll
  for (int i = 0; i < 2; ++i) { vA[i] = (unsigned)RA[i] * cur.lda2 + CC[i]; vB[i] = (unsigned)RB[i] * cur.ldb2 + CC[i]; }
  size_t hA = (size_t)HALF * cur.lda2, hB = (size_t)HALF * cur.ldb2;
  PG8_STAGE(PG8_SB(0, 0), cB, vB); PG8_STAGE(PG8_SA(0, 0), cA, vA); PG8_STAGE(PG8_SB(0, 1), cB + hB, vB); PG8_STAGE(PG8_SA(0, 1), cA + hA, vA);
  if (wr == 1) PG8_BAR;
  PG8_WAIT_V(4); PG8_BAR;
  PG8_STAGE(PG8_SB(1, 0), cB + kstep, vB); PG8_STAGE(PG8_SA(1, 0), cA + kstep, vA); PG8_STAGE(PG8_SB(1, 1), cB + hB + kstep, vB);
  PG8_WAIT_V(6); PG8_BAR;
  for (;;) {
    const bool has_next = S.next(ui + 1, nxt);
    const char* nA = has_next ? nxt.A : cA; const char* nB = has_next ? nxt.B : cB;
    const unsigned nlda = has_next ? nxt.lda2 : cur.lda2, nldb = has_next ? nxt.ldb2 : cur.ldb2;
    unsigned nvA[2], nvB[2];
#pragma unroll
    for (int i = 0; i < 2; ++i) { nvA[i] = (unsigned)RA[i] * nlda + CC[i]; nvB[i] = (unsigned)RB[i] * nldb + CC[i]; }
    const size_t nhA = (size_t)HALF * nlda, nhB = (size_t)HALF * nldb;
    const int nt = cur.nt;
    for (int t = 0; t < nt; t += 2) {
      const bool last = (t == nt - 2);
      const char* a1 = cA + (size_t)(t + 1) * kstep;
      const char* a2 = last ? nA : cA + (size_t)(t + 2) * kstep; const char* b2 = last ? nB : cB + (size_t)(t + 2) * kstep;
      const char* a3 = a2 + kstep; const char* b3 = b2 + kstep;
      unsigned v2A[2], v2B[2];
#pragma unroll
      for (int i = 0; i < 2; ++i) { v2A[i] = last ? nvA[i] : vA[i]; v2B[i] = last ? nvB[i] : vB[i]; }
      const size_t h2A = last ? nhA : hA, h2B = last ? nhB : hB;
      PG8_LDB(B0, 0, 0); PG8_SCHED; PG8_LDA(At, 0, 0); PG8_STAGE(PG8_SA(1, 1), a1 + hA, vA);
      PG8_WAIT_L(8); PG8_BAR; PG8_WAIT_L(0); PG8_MMA(0, 0, At, B0); PG8_BAR; PG8_SCHED;
      PG8_LDB(B1, 0, 1); PG8_STAGE(PG8_SB(0, 0), b2, v2B);
      PG8_BAR; PG8_WAIT_L(0); PG8_MMA(0, 1, At, B1); PG8_BAR;
      PG8_LDA(At, 0, 1); PG8_STAGE(PG8_SA(0, 0), a2, v2A);
      PG8_BAR; PG8_WAIT_L(0); PG8_MMA(1, 0, At, B0); PG8_BAR; PG8_SCHED;
      PG8_STAGE(PG8_SB(0, 1), b2 + h2B, v2B);
      PG8_WAIT_V(6); PG8_BAR; PG8_MMA(1, 1, At, B1); PG8_BAR;
      PG8_LDB(B0, 1, 0); PG8_SCHED; PG8_LDA(At, 1, 0); PG8_STAGE(PG8_SA(0, 1), a2 + h2A, v2A);
      PG8_WAIT_L(8); PG8_BAR; PG8_WAIT_L(0); PG8_MMA(0, 0, At, B0); PG8_BAR; PG8_SCHED;
      PG8_LDB(B1, 1, 1); PG8_STAGE(PG8_SB(1, 0), b3, v2B);
      PG8_BAR; PG8_WAIT_L(0); PG8_MMA(0, 1, At, B1); PG8_BAR;
      PG8_LDA(At, 1, 1); PG8_STAGE(PG8_SA(1, 0), a3, v2A);
      PG8_BAR; PG8_WAIT_L(0); PG8_MMA(1, 0, At, B0); PG8_BAR; PG8_SCHED;
      PG8_STAGE(PG8_SB(1, 1), b3 + h2B, v2B);
      PG8_WAIT_V(6); PG8_BAR; PG8_MMA(1, 1, At, B1); PG8_BAR;
    }
    const bool keep = E(acc, cur, wr, wc, fr, fq);
    if (!has_next) break;
    if (!keep) {
#pragma unroll
      for (int a = 0; a < 2; ++a)
#pragma unroll
        for (int b = 0; b < 2; ++b)
#pragma unroll
          for (int m = 0; m < 4; ++m)
#pragma unroll
            for (int n = 0; n < 2; ++n) acc[a][b][m][n] = (f32x4){0.f, 0.f, 0.f, 0.f};
    }
    cur = nxt; cA = nA; cB = nB; hA = nhA; hB = nhB;
#pragma unroll
    for (int i = 0; i < 2; ++i) { vA[i] = nvA[i]; vB[i] = nvB[i]; }
    ++ui;
  }
  PG8_WAIT_V(0);
  if (wr == 0) PG8_BAR;
  PG8_BAR;
#undef PG8_SA
#undef PG8_SB
#undef PG8_STAGE
#undef PG8_LDA
#undef PG8_LDB
#undef PG8_MMA
#undef PG8_WAIT_V
#undef PG8_WAIT_L
#undef PG8_BAR
#undef PG8_SCHED
}
struct PlainSched {
  const char* A; const char* B; unsigned lda2, ldb2; int nt, nM, nN, G, c; int lat_only = 0;
  DI bool next(int i, UDesc& u) const {
    int pm, pn; if (!tile_order((long)i * G + c, lat_only ? nM - NB : nM, nN, pm, pn)) return false;
    if (lat_only) pm = pm + (pm >> 3) + 1;
    u.A = A + (size_t)pm * 256 * lda2; u.B = B + (size_t)pn * 256 * ldb2; u.lda2 = lda2; u.ldb2 = ldb2; u.nt = nt; u.pm = pm; u.pn = pn; u.tag = 0; return true;
  }
};
}

DI uint4 pk8(const f32x4& a, const f32x4& b) {
  uint4 q; q.x = pack2(a[0], a[1]); q.y = pack2(a[2], a[3]); q.z = pack2(b[0], b[1]); q.w = pack2(b[2], b[3]); return q;
}

__device__ void phase_prep(const Params& p, char* lds) {
  const int tid = otid(), nthr = gridDim.x * NTHR, gt = blockIdx.x * NTHR + tid;
  {
    const float4* s = (const float4*)p.x; uint2* d = (uint2*)(p.ws + OFF_XL);
    const size_t n = (size_t)NBATCH * SEQ * DM / 4;
    for (size_t i = gt; i < n; i += nthr) { const float4 v = s[i]; uint2 o; o.x = pack2(v.x, v.y); o.y = pack2(v.z, v.w); d[i] = o; }
    const float4* s2 = (const float4*)p.ctx; uint2* d2 = (uint2*)(p.ws + OFF_XC);
    const size_t n2 = (size_t)NBATCH * CTXL * DM / 4;
    for (size_t i = gt; i < n2; i += nthr) { const float4 v = s2[i]; uint2 o; o.x = pack2(v.x, v.y); o.y = pack2(v.z, v.w); d2[i] = o; }
  }
  if (gt < 1024) {
    float v[DEPTH], mx = -1e30f;
    for (int l = 0; l < DEPTH; ++l) { v[l] = p.lblog[l * 1024 + gt]; mx = fmaxf(mx, v[l]); }
    float sum = 0.f;
    for (int l = 0; l < DEPTH; ++l) { v[l] = expf(v[l] - mx); sum += v[l]; }
    float* lb = (float*)(p.ws + OFF_LB);
    float run = 0.f;
    for (int l = 0; l < DEPTH; ++l) { lb[l * 1024 + gt] = run; if (l + 1 < DEPTH) run += v[l + 1] / sum; }
  }
  if (gt >= 1024 && gt < 2048) {
    int i = gt - 1024, pos = i >> 4, fi = i & 15;
    float inv = powf(10000.f, -(float)fi / 16.f);
    float ang = (float)pos * inv;
    float* rc = (float*)(p.ws + OFF_ROPE);
    rc[i] = cosf(ang); rc[1024 + i] = sinf(ang);
  }
  float* ssm = (float*)lds;
  float* red = (float*)lds + 2 * 33 * 32;
  for (int item = blockIdx.x; item < DEPTH * 24; item += gridDim.x) {
    const int l = item / 24, kh = tid >> 8, tl = tid & 255, j = (item % 24) * 256 + tl;
    float acc[33];
#pragma unroll
    for (int r = 0; r < 33; ++r) acc[r] = 0.f;
    const float* W = p.w_ada + (size_t)l * DM * 6144;
    for (int k0 = kh * 512; k0 < kh * 512 + 512; k0 += 32) {
      __syncthreads();
      for (int idx = tl; idx < 33 * 32; idx += 256) {
        int rr = idx >> 5, kk = idx & 31;
        float cv = rr < 32 ? p.c[rr * DM + k0 + kk] : p.c_ctx[k0 + kk];
        ssm[kh * 33 * 32 + idx] = cv / (1.f + expf(-cv));
      }
      __syncthreads();
#pragma unroll 16
      for (int kk = 0; kk < 32; ++kk) {
        float w = W[(size_t)(k0 + kk) * 6144 + j];
#pragma unroll
        for (int r = 0; r < 33; ++r) acc[r] += ssm[kh * 33 * 32 + r * 32 + kk] * w;
      }
    }
    __syncthreads();
    if (kh == 1) {
#pragma unroll
      for (int r = 0; r < 33; ++r) red[r * 256 + tl] = acc[r];
    }
    __syncthreads();
    if (kh == 0) {
      float bb = p.b_ada[l * 6144 + j];
      float* mod = (float*)(p.ws + OFF_MOD) + (size_t)l * 33 * 6144;
#pragma unroll
      for (int r = 0; r < 33; ++r) mod[r * 6144 + j] = acc[r] + red[r * 256 + tl] + bb;
    }
  }
  __syncthreads();
}

DI u16* wdst(char* wb, int type, int sub, int n) {
  switch (type) {
    case 0: return n < NPC ? (u16*)(wb + OFF_WINT) + (size_t)n * 1024 : (u16*)(wb + OFF_WGT) + (size_t)(n - NPC) * 1024;
    case 1: return (u16*)(wb + OFF_WBT) + ((size_t)sub * 1024 + n) * 512;
    case 2: return (u16*)(wb + OFF_WOT) + (size_t)n * 1024;
    case 3: return (u16*)(wb + OFF_W1T) + (size_t)n * 1024;
    case 4: return (u16*)(wb + OFF_W2T) + (size_t)n * 4096;
    case 5: return (u16*)(wb + OFF_WUQ) + (size_t)n * 256;
    case 6: return (u16*)(wb + OFF_WUK) + (size_t)n * 128;
    default: return (u16*)(wb + OFF_WUV) + (size_t)n * 128;
  }
}
__device__ void phase_wconv(const Params& p, int l, char* lds, int* cnt = nullptr) {
  char* wb = wsel(p, l);
  int* s_item = (int*)(lds + LDS_BYTES - 16);
  float* tile = (float*)lds;
  const int tid = otid();
  {
    unsigned* z = (unsigned*)((u16*)(wb + OFF_WINT) + (size_t)NPC * 1024);
    for (int i = blockIdx.x * NTHR + tid; i < (PS - NPC) * 1024 / 2; i += gridDim.x * NTHR) z[i] = 0u;
  }
  constexpr int T0 = 16 * 148, T1 = T0 + 4 * 128, T2 = T1 + 256, T3 = T2 + 1024, T4 = T3 + 1024, T5 = T4 + 48, T6 = T5 + 16, T7 = T6 + 16;
  for (int itk = 0;; ++itk) {
    int it;
    if (cnt) { __syncthreads(); if (tid == 0) *s_item = atomicAdd(cnt, 1); __syncthreads(); it = *s_item; }
    else it = blockIdx.x + itk * gridDim.x;
    if (it >= T7) break;
    int type, sub = 0, K, N, kt, nt;
    const float* src;
    if (it < T0) { type = 0; K = 1024; N = INW; int q = it; kt = q / 148; nt = q % 148; src = p.w_in + (size_t)l * 1024 * INW; }
    else if (it < T1) { type = 1; K = 512; N = 1024; int q = it - T0; sub = q / 128; q %= 128; kt = q / 16; nt = q % 16; src = p.wbr + ((size_t)l * 4 + sub) * 512 * 1024; }
    else if (it < T2) { type = 2; K = 1024; N = 1024; int q = it - T1; kt = q / 16; nt = q % 16; src = p.wout + (size_t)l * 1024 * 1024; }
    else if (it < T3) { type = 3; K = 1024; N = 4096; int q = it - T2; kt = q / 64; nt = q % 64; src = p.wff1 + (size_t)l * 1024 * 4096; }
    else if (it < T4) { type = 4; K = 4096; N = 1024; int q = it - T3; kt = q / 16; nt = q % 16; src = p.wff2 + (size_t)l * 4096 * 1024; }
    else if (it < T5) { type = 5; K = 256; N = 768; int q = it - T4; kt = q / 12; nt = q % 12; src = p.wuq + (size_t)l * 256 * 768; }
    else if (it < T6) { type = 6; K = 128; N = 512; int q = it - T5; kt = q / 8; nt = q % 8; src = p.wuk + (size_t)l * 128 * 512; }
    else { type = 7; K = 128; N = 512; int q = it - T6; kt = q / 8; nt = q % 8; src = p.wuv + (size_t)l * 128 * 512; }
    (void)K;
    const int k0 = kt * 64, n0 = nt * 64;
    __syncthreads();
    {
      const int nn = tid & 63, ks = tid >> 6;
#pragma unroll 4
      for (int j = 0; j < 8; ++j) {
        int k = ks + 8 * j;
        tile[k * 65 + nn] = (n0 + nn < N) ? src[(size_t)(k0 + k) * N + n0 + nn] : 0.f;
      }
    }
    __syncthreads();
    {
      const int kp = tid & 31, nn = tid >> 5;
#pragma unroll 4
      for (int j = 0; j < 4; ++j) {
        int n = nn + 16 * j;
        if (n0 + n < N) {
          unsigned v = pack2(tile[(2 * kp) * 65 + n], tile[(2 * kp + 1) * 65 + n]);
          *(unsigned*)(wdst(wb, type, sub, n0 + n) + k0 + 2 * kp) = v;
        }
      }
    }
  }
  __syncthreads();
}

DI void norm_token(const Params& p, int l, int g, int which, int tok, int lane, const float* gn, const float* mod, u16* H) {
  int mr; const u16* xr = xrow_ptr(p, g, tok, mr);
  const float* shift = mod + (size_t)mr * 6144 + (which == 0 ? 0 : 3) * DM;
  const float* scale = shift + DM;
  float4 v[4]; float ss = 0.f;
#pragma unroll
  for (int j = 0; j < 4; ++j) {
    const uint2 q = *(const uint2*)(xr + j * 256 + lane * 4);
    v[j].x = __uint_as_float(q.x << 16); v[j].y = __uint_as_float(q.x & 0xffff0000u); v[j].z = __uint_as_float(q.y << 16); v[j].w = __uint_as_float(q.y & 0xffff0000u);
    ss += v[j].x * v[j].x + v[j].y * v[j].y + v[j].z * v[j].z + v[j].w * v[j].w;
  }
  ss = wave_sum(ss);
  const float rstd = rsqrtf(ss * (1.f / DM) + EPS);
#pragma unroll
  for (int j = 0; j < 4; ++j) {
    int c = j * 256 + lane * 4;
    float4 gg = *(const float4*)(gn + c), sh = *(const float4*)(shift + c), sc = *(const float4*)(scale + c);
    float o0 = v[j].x * rstd * gg.x * (1.f + sc.x) + sh.x;
    float o1 = v[j].y * rstd * gg.y * (1.f + sc.y) + sh.y;
    float o2 = v[j].z * rstd * gg.z * (1.f + sc.z) + sh.z;
    float o3 = v[j].w * rstd * gg.w * (1.f + sc.w) + sh.w;
    uint2 o; o.x = pack2(o0, o1); o.y = pack2(o2, o3);
    *(uint2*)(H + (size_t)tok * DM + c) = o;
  }
}
DI void norm_load(const u16* xr, int lane, uint2 (&q)[4]) {
#pragma unroll
  for (int j = 0; j < 4; ++j) q[j] = *(const uint2*)(xr + j * 256 + lane * 4);
}
DI void norm_mod_load(const float* shift, int lane, float4 (&shv)[4], float4 (&scv)[4]) {
#pragma unroll
  for (int j = 0; j < 4; ++j) { const int c = j * 256 + lane * 4; shv[j] = *(const float4*)(shift + c); scv[j] = *(const float4*)(shift + DM + c); }
}
DI void norm_finish2(const uint2 (&q)[4], int lane, const float4 (&ggv)[4], const float4 (&shv)[4], const float4 (&scv)[4], u16* hrow) {
  float4 v[4]; float ss = 0.f;
#pragma unroll
  for (int j = 0; j < 4; ++j) {
    v[j].x = __uint_as_float(q[j].x << 16); v[j].y = __uint_as_float(q[j].x & 0xffff0000u); v[j].z = __uint_as_float(q[j].y << 16); v[j].w = __uint_as_float(q[j].y & 0xffff0000u);
    ss += v[j].x * v[j].x + v[j].y * v[j].y + v[j].z * v[j].z + v[j].w * v[j].w;
  }
  ss = wave_sum(ss);
  const float rstd = rsqrtf(ss * (1.f / DM) + EPS);
#pragma unroll
  for (int j = 0; j < 4; ++j) {
    const int c = j * 256 + lane * 4;
    const float4 gg = ggv[j], sh = shv[j], sc = scv[j];
    float o0 = v[j].x * rstd * gg.x * (1.f + sc.x) + sh.x;
    float o1 = v[j].y * rstd * gg.y * (1.f + sc.y) + sh.y;
    float o2 = v[j].z * rstd * gg.z * (1.f + sc.z) + sh.z;
    float o3 = v[j].w * rstd * gg.w * (1.f + sc.w) + sh.w;
    uint2 o; o.x = pack2(o0, o1); o.y = pack2(o2, o3);
    *(uint2*)(hrow + c) = o;
  }
}
DI void norm_finish(const uint2 (&q)[4], int lane, const float* gn, const float* shift, u16* hrow) {
  float4 ggv[4], shv[4], scv[4];
#pragma unroll
  for (int j = 0; j < 4; ++j) ggv[j] = *(const float4*)(gn + j * 256 + lane * 4);
  norm_mod_load(shift, lane, shv, scv);
  norm_finish2(q, lane, ggv, shv, scv, hrow);
}
__device__ void phase_norm(const Params& p, int l, int g, int which) {
  const int tid = otid(), lane = tid & 63, wid = tid >> 6;
  const float* gn = (which == 0 ? p.g1 : p.g2) + l * DM;
  const float* mod = (const float*)(p.ws + OFF_MOD) + (size_t)l * 33 * 6144;
  u16* H = (u16*)(p.ws + OFF_H);
  const int stride = gridDim.x * 8;
  float4 ggh[4];
#pragma unroll
  for (int j = 0; j < 4; ++j) ggh[j] = *(const float4*)(gn + j * 256 + lane * 4);
  const bool skipc = which == 1 && l == DEPTH - 1;
  for (int tok = blockIdx.x * 8 + wid; tok < NTOK; tok += 2 * stride) {
    const int tokB = tok + stride;
    const bool doA = !(skipc && (tok % TPB) < CTXL), doB = tokB < NTOK && !(skipc && (tokB % TPB) < CTXL);
    int mrA = 0, mrB = 0;
    const u16* xa = xrow_ptr(p, g, tok, mrA);
    const u16* xb = xrow_ptr(p, g, doB ? tokB : tok, mrB);
    uint2 qa[4], qb[4];
    float4 shA[4], scA[4], shB[4], scB[4];
    norm_load(xa, lane, qa);
    norm_load(xb, lane, qb);
    norm_mod_load(mod + (size_t)mrA * 6144 + (which == 0 ? 0 : 3) * DM, lane, shA, scA);
    norm_mod_load(mod + (size_t)mrB * 6144 + (which == 0 ? 0 : 3) * DM, lane, shB, scB);
    if (doA) norm_finish2(qa, lane, ggh, shA, scA, H + (size_t)tok * DM);
    if (doB) norm_finish2(qb, lane, ggh, shB, scB, H + (size_t)tokB * DM);
  }
}
__device__ void phase_norm_dyn(const Params& p, int l, int g, int* cnt) {
  const int tid = otid(), lane = tid & 63;
  const float* gn = p.g1 + l * DM;
  const float* mod = (const float*)(p.ws + OFF_MOD) + (size_t)l * 33 * 6144;
  u16* H = (u16*)(p.ws + OFF_H);
  for (;;) {
    int c = 0;
    if (lane == 0) c = atomicAdd(cnt, 1);
    c = __shfl(c, 0);
    if (c >= NTOK / 8) break;
#pragma unroll 1
    for (int t = 0; t < 8; t += 2) {
      const int tokA = c * 8 + t, tokB = tokA + 1;
      int mrA = 0, mrB = 0;
      const u16* xa = xrow_ptr(p, g, tokA, mrA);
      const u16* xb = xrow_ptr(p, g, tokB, mrB);
      uint2 qa[4], qb[4];
      norm_load(xa, lane, qa);
      norm_load(xb, lane, qb);
      norm_finish(qa, lane, gn, mod + (size_t)mrA * 6144, H + (size_t)tokA * DM);
      norm_finish(qb, lane, gn, mod + (size_t)mrB * 6144, H + (size_t)tokB * DM);
    }
  }
}

__device__ void phase_tokprep(const Params& p, int l) {
  const int tid = otid(), lane = tid & 63, wid = tid >> 6;
  u16* P = (u16*)(p.ws + OFF_P);
  u16* KQ = (u16*)(p.ws + OFF_KQ);
  u16* Kd = (u16*)(p.ws + OFF_KD);
  const float* rc = (const float*)(p.ws + OFF_ROPE);
  const float* rs = rc + 1024;
  const int c8 = lane & 7;
  const bool isk_ = lane < 32;
  float cwv[24], gqv[8], gkv[8], gmv[8];
  {
    const float* cw = p.convw + ((size_t)l * 2 + (isk_ ? 1 : 0)) * 3 * 256 + (isk_ ? lane : lane - 32) * 8;
#pragma unroll
    for (int e = 0; e < 8; ++e) { cwv[e] = cw[e]; cwv[8 + e] = cw[256 + e]; cwv[16 + e] = cw[512 + e]; }
    const float* gq = p.gqn + l * 64 + c8 * 8; const float* gk = p.gkn + l * 64 + c8 * 8;
    const float* gm = lane < 16 ? p.mkvn + l * 128 + lane * 8 : p.mqn + l * 256 + ((lane >= 32 ? lane - 32 : 0)) * 8;
#pragma unroll
    for (int e = 0; e < 8; ++e) { gqv[e] = gq[e]; gkv[e] = gk[e]; gmv[e] = gm[e]; }
  }
  const uint4 zz = {0u, 0u, 0u, 0u};
  const int convcol = (isk_ ? B_K : B_Q) + (isk_ ? lane : lane - 32) * 8;
  const int mcol = lane < 16 ? D_CKV + lane * 8 : (lane >= 32 ? D_CQ + (lane - 32) * 8 : D_KR + ((lane - 16) & 7) * 8);
  uint4 n_q = zz, n_k = zz, n_m = zz, n_c0 = zz, n_c1 = zz, n_c2 = zz;
#define TOKPREP_LOAD(tok_) do { const int pp_ = (tok_) % TPB; const u16* row_ = P + (size_t)(tok_) * PS; \
    n_q = *(const uint4*)(row_ + C_Q + lane * 8); n_k = lane < 16 ? *(const uint4*)(row_ + C_K + lane * 8) : zz; n_m = *(const uint4*)(row_ + mcol); \
    n_c1 = *(const uint4*)(row_ + convcol); \
    n_c0 = !(pp_ == 0 || pp_ == CTXL) ? *(const uint4*)(row_ - PS + convcol) : zz; \
    n_c2 = !(pp_ == CTXL - 1 || pp_ == TPB - 1) ? *(const uint4*)(row_ + PS + convcol) : zz; } while (0)
  const int tstride = gridDim.x * 8;
  if (blockIdx.x * 8 + wid < NTOK) TOKPREP_LOAD(blockIdx.x * 8 + wid);
  for (int tok = blockIdx.x * 8 + wid; tok < NTOK; tok += tstride) {
    const int pp = tok % TPB;
    const bool lat = pp >= CTXL;
    const int pos = pp - CTXL, prow = pos >> 6, pcol = pos & 63;
    u16* row = P + (size_t)tok * PS;
    const uint4 pl_q = n_q, pl_k = n_k, pl_m = n_m, pl_c0 = n_c0, pl_c1 = n_c1, pl_c2 = n_c2;
    if (tok + tstride < NTOK) TOKPREP_LOAD(tok + tstride);
    float csv[8], snv[8];
    {
      const int ppos0 = (c8 & 4) ? pcol : prow;
      if (lat) {
        const float4 c0 = *(const float4*)(rc + ppos0 * 16 + (c8 & 1) * 8), c1 = *(const float4*)(rc + ppos0 * 16 + (c8 & 1) * 8 + 4);
        const float4 s0 = *(const float4*)(rs + ppos0 * 16 + (c8 & 1) * 8), s1 = *(const float4*)(rs + ppos0 * 16 + (c8 & 1) * 8 + 4);
        csv[0] = c0.x; csv[1] = c0.y; csv[2] = c0.z; csv[3] = c0.w; csv[4] = c1.x; csv[5] = c1.y; csv[6] = c1.z; csv[7] = c1.w;
        snv[0] = s0.x; snv[1] = s0.y; snv[2] = s0.z; snv[3] = s0.w; snv[4] = s1.x; snv[5] = s1.y; snv[6] = s1.z; snv[7] = s1.w;
      } else {
#pragma unroll
        for (int e = 0; e < 8; ++e) { csv[e] = 1.f; snv[e] = 0.f; }
      }
    }
    {
      const bool isk = lane < 32;
      const int cc = (isk ? lane : lane - 32) * 8;
      float x0[8], x1[8], x2[8];
      unpack8(pl_c1, x1); unpack8(pl_c0, x0); unpack8(pl_c2, x2);
      float o[8];
#pragma unroll
      for (int e = 0; e < 8; ++e) {
        float a = cwv[e] * x0[e] + cwv[8 + e] * x1[e] + cwv[16 + e] * x2[e];
        a = siluf_(a);
        o[e] = isk ? a * 0.125f : a;
      }
      *(uint4*)(KQ + (size_t)tok * 512 + (isk ? 0 : 256) + cc) = pack8f(o);
    }
#pragma unroll
    for (int pass = 0; pass < 2; ++pass) {
      const bool act = pass == 0 || lane < 16;
      const int colb = (pass == 0 ? C_Q : C_K) + lane * 8;
      float x[8];
      unpack8(pass == 0 ? pl_q : pl_k, x);
      float ss = 0.f;
#pragma unroll
      for (int e = 0; e < 8; ++e) ss += x[e] * x[e];
      ss += __shfl_xor(ss, 1); ss += __shfl_xor(ss, 2); ss += __shfl_xor(ss, 4);
      const float rstd = rsqrtf(ss * (1.f / 64.f) + EPS);
#pragma unroll
      for (int e = 0; e < 8; ++e) x[e] = x[e] * rstd * (pass == 0 ? gqv[e] : gkv[e]);
      float o[8];
#pragma unroll
      for (int e = 0; e < 8; ++e) {
        float other = __shfl_xor(x[e], 2);
        const float cs = csv[e], sn = snv[e];
        o[e] = (c8 & 2) ? (x[e] * cs + other * sn) : (x[e] * cs - other * sn);
      }
      if (act) *(uint4*)(row + colb) = pack8f(o);
    }
    {
      const bool isckv = lane < 16, iscq = lane >= 32, iskr = lane >= 16 && lane < 24;
      int colb = isckv ? D_CKV + lane * 8 : (iscq ? D_CQ + (lane - 32) * 8 : D_KR + ((lane - 16) & 7) * 8);
      float x[8];
      unpack8(pl_m, x);
      float ss = 0.f;
#pragma unroll
      for (int e = 0; e < 8; ++e) ss += x[e] * x[e];
      ss += __shfl_xor(ss, 1); ss += __shfl_xor(ss, 2); ss += __shfl_xor(ss, 4); ss += __shfl_xor(ss, 8);
      float ss32 = ss + __shfl_xor(ss, 16);
      float o[8];
      if (isckv) {
        const float rstd = rsqrtf(ss * (1.f / 128.f) + EPS);
        for (int e = 0; e < 8; ++e) o[e] = x[e] * rstd * gmv[e];
      } else if (iscq) {
        const float rstd = rsqrtf(ss32 * (1.f / 256.f) + EPS);
        for (int e = 0; e < 8; ++e) o[e] = x[e] * rstd * gmv[e];
      } else {
        for (int e = 0; e < 8; ++e) o[e] = x[e];
      }
      float orot[8];
#pragma unroll
      for (int e = 0; e < 8; ++e) {
        float other = __shfl_xor(x[e], 2);
        const int ck = lane & 7;
        const float cs = csv[e], sn = snv[e];
        orot[e] = (ck & 2) ? (x[e] * cs + other * sn) : (x[e] * cs - other * sn);
      }
      if (isckv || iscq) *(uint4*)(row + colb) = pack8f(o);
      if (iskr) {
        uint4 q = pack8f(orot);
        const int ck = lane & 7;
#pragma unroll
        for (int hd = 0; hd < 4; ++hd) *(uint4*)(Kd + (size_t)tok * 768 + hd * 192 + 128 + ck * 8) = q;
      }
    }
  }
#undef TOKPREP_LOAD
}

template <int DK, int DV, bool ROPEQ>
__device__ void attn_item(const u16* __restrict__ qrow, const u16* __restrict__ Kp, int kst, const u16* __restrict__ Vp, int vst,
                          u16* __restrict__ orow, int nkeys, float sc, int pos, const float* __restrict__ rc, char* lds) {
  constexpr int KLD = DK + 8, VLD = DV + 32;
  constexpr int KB = 64 * KLD, VB = 64 * VLD;
  u16* KS = (u16*)lds;
  u16* VS = KS + 2 * KB;
  const int tid = otid(), lane = tid & 63, r = lane & 31, h = lane >> 5;
  bf16x8 qf[DK / 16];
  {
#pragma unroll
    for (int s = 0; s < DK / 16; ++s) qf[s] = *(const bf16x8*)(qrow + h * 8 + s * 16);
    if (ROPEQ && pos >= 0) {
      const int prow = pos >> 6, pcol = pos & 63;
      const float* rs = rc + 1024;
      constexpr int s0 = (DK - 64) / 16;
#pragma unroll
      for (int part = 0; part < 2; ++part) {
        const int ppos = part ? pcol : prow;
#pragma unroll
        for (int j = 0; j < 8; ++j) {
          const int fi = 8 * h + j;
          float cs = rc[ppos * 16 + fi], sn = rs[ppos * 16 + fi];
          float x1 = bf2f((u16)qf[s0 + 2 * part][j]), x2 = bf2f((u16)qf[s0 + 2 * part + 1][j]);
          qf[s0 + 2 * part][j] = (short)f2bf(x1 * cs - x2 * sn);
          qf[s0 + 2 * part + 1][j] = (short)f2bf(x2 * cs + x1 * sn);
        }
      }
    }
  }
  f32x16 oT[DV / 32];
#pragma unroll
  for (int d = 0; d < DV / 32; ++d)
#pragma unroll
    for (int e = 0; e < 16; ++e) oT[d][e] = 0.f;
  float m = -1e30f, lsum = 0.f;
  const int ntile = nkeys >> 6;
  constexpr int NKP = KB * 2 / 1024, NVP = VB * 2 / 1024, NKJ = (NKP + 7) / 8, NVJ = (NVP + 7) / 8;
  const int wu = __builtin_amdgcn_readfirstlane(tid >> 6);
  unsigned ksrc[NKJ], vsrc[NVJ];
#pragma unroll
  for (int j = 0; j < NKJ; ++j) { const int o = (wu + 8 * j) * 1024 + lane * 16, row = o / (KLD * 2), col = (o % (KLD * 2)) / 2; ksrc[j] = (unsigned)(row * kst + (col < DK ? col : 0)) * 2u; }
#pragma unroll
  for (int j = 0; j < NVJ; ++j) { const int o = (wu + 8 * j) * 1024 + lane * 16, row = o / (VLD * 2), col = (o % (VLD * 2)) / 2; vsrc[j] = (unsigned)(row * vst + (col < DV ? col : 0)) * 2u; }
#define ATT_DMA(kt_, buf_) do { \
    const char* kg_ = (const char*)Kp + (size_t)(kt_) * 64 * kst * 2; const char* vg_ = (const char*)Vp + (size_t)(kt_) * 64 * vst * 2; \
    _Pragma("unroll") for (int j = 0; j < NKJ; ++j) if (wu + 8 * j < NKP) \
      __builtin_amdgcn_global_load_lds((const unsigned*)(kg_ + ksrc[j]), (LAS unsigned*)((char*)KS + (buf_) * KB * 2 + (wu + 8 * j) * 1024), 16, 0, 0); \
    _Pragma("unroll") for (int j = 0; j < NVJ; ++j) if (wu + 8 * j < NVP) \
      __builtin_amdgcn_global_load_lds((const unsigned*)(vg_ + vsrc[j]), (LAS unsigned*)((char*)VS + (buf_) * VB * 2 + (wu + 8 * j) * 1024), 16, 0, 0); \
  } while (0)
  __syncthreads();
  ATT_DMA(0, 0);
  asm volatile("s_waitcnt vmcnt(0)" ::: "memory");
  __syncthreads();
  const int troff = ((lane & 15) >> 2) * VLD + 16 * ((lane >> 4) & 1) + 4 * (lane & 3) + 4 * h * VLD;
#pragma unroll 1
  for (int kt = 0; kt < ntile; ++kt) {
    const int buf = kt & 1;
    if (kt + 1 < ntile) ATT_DMA(kt + 1, buf ^ 1);
    const u16* KSb = KS + buf * KB;
    const u16* VSb = VS + buf * VB;
    f32x16 sT[2];
#pragma unroll
    for (int kk = 0; kk < 2; ++kk) {
#pragma unroll
      for (int e = 0; e < 16; ++e) sT[kk][e] = 0.f;
#pragma unroll
      for (int s = 0; s < DK / 16; ++s) {
        bf16x8 a = *(const bf16x8*)(KSb + (kk * 32 + r) * KLD + s * 16 + h * 8);
        sT[kk] = MFMA(a, qf[s], sT[kk]);
      }
    }
    float mx = -1e30f;
#pragma unroll
    for (int kk = 0; kk < 2; ++kk)
#pragma unroll
      for (int e = 0; e < 16; ++e) mx = fmaxf(mx, sT[kk][e]);
    mx = fmaxf(mx, __shfl_xor(mx, 32));
    const float mn = fmaxf(m, mx * sc);
    const float alpha = ex2(m - mn);
    m = mn;
    lsum *= alpha;
#pragma unroll
    for (int kk = 0; kk < 2; ++kk) {
      sT[kk] = sT[kk] * sc - mn;
#pragma unroll
      for (int e = 0; e < 16; ++e) sT[kk][e] = ex2(sT[kk][e]);
    }
    {
      f32x16 t16 = sT[0] + sT[1];
      typedef float f32x8v __attribute__((ext_vector_type(8)));
      typedef float f32x4v __attribute__((ext_vector_type(4)));
      f32x8v t8 = __builtin_shufflevector(t16, t16, 0, 1, 2, 3, 4, 5, 6, 7) + __builtin_shufflevector(t16, t16, 8, 9, 10, 11, 12, 13, 14, 15);
      f32x4v t4 = __builtin_shufflevector(t8, t8, 0, 1, 2, 3) + __builtin_shufflevector(t8, t8, 4, 5, 6, 7);
      lsum += (t4[0] + t4[1]) + (t4[2] + t4[3]);
    }
#pragma unroll
    for (int d = 0; d < DV / 32; ++d) oT[d] = oT[d] * alpha;
#pragma unroll
    for (int kk = 0; kk < 2; ++kk)
#pragma unroll
      for (int s2 = 0; s2 < 2; ++s2) {
        bf16x8 pb = pack8(sT[kk], s2);
#pragma unroll
        for (int d = 0; d < DV / 32; ++d) {
          const u16* vb = VSb + (kk * 32 + s2 * 16) * VLD + d * 32 + troff;
          s16x4 lo = __builtin_amdgcn_ds_read_tr16_b64_v4i16((LAS s16x4*)vb);
          s16x4 hi = __builtin_amdgcn_ds_read_tr16_b64_v4i16((LAS s16x4*)(vb + 8 * VLD));
          oT[d] = MFMA(cat4(lo, hi), pb, oT[d]);
        }
      }
    asm volatile("s_waitcnt vmcnt(0)" ::: "memory");
    __syncthreads();
  }
#undef ATT_DMA
  lsum += __shfl_xor(lsum, 32);
  const float inv = 1.f / lsum;
#pragma unroll
  for (int d = 0; d < DV / 32; ++d)
#pragma unroll
    for (int gq = 0; gq < 4; ++gq) {
      uint2 o;
      o.x = pack2(oT[d][4 * gq] * inv, oT[d][4 * gq + 1] * inv);
      o.y = pack2(oT[d][4 * gq + 2] * inv, oT[d][4 * gq + 3] * inv);
      *(uint2*)(orow + d * 32 + 8 * gq + 4 * h) = o;
    }
}

__device__ void scanA_unit(const Params& p, int l, int unit, char* lds) {
  const int tid = otid(), lane = tid & 63, wid = tid >> 6, r = lane & 31, h = lane >> 5;
  const int bl = unit >> 3, hd = (unit >> 1) & 3, dir = unit & 1;
  const u16* P = (const u16*)(p.ws + OFF_P);
  u16* Oa = (u16*)(p.ws + OFF_OA) + (size_t)dir * NTOK * 512;
  float* BC = (float*)lds;
  u16* Qs = (u16*)(lds + 33792);
  u16* KKs = (u16*)(lds + 51200);
  u16* AM = (u16*)(lds + 51200);
  u16* KT = (u16*)(lds + 68608);
  u16* VT = (u16*)(lds + 87040);
  u16* ST = (u16*)(lds + 105472);
  float* EL = (float*)(lds + 140288);
  float* QTOT = (float*)(lds + 140800);
  const int ch = tid & 15;
  float lbv[8];
  {
    const float* lb = (const float*)(p.ws + OFF_LB) + (size_t)l * 1024 + dir * 512 + hd * 128 + ch * 8;
#pragma unroll
    for (int e = 0; e < 8; ++e) lbv[e] = lb[e];
  }
  const int vt = wid & 3, th = wid >> 2;
  f32x16 S[2];
#pragma unroll
  for (int j = 0; j < 2; ++j)
#pragma unroll
    for (int e = 0; e < 16; ++e) S[j][e] = 0.f;
  __syncthreads();
  for (int i = tid; i < 128 * 136 / 2; i += NTHR) ((unsigned*)ST)[i] = 0u;
  uint4 pqr[2], pfr[2], pvr[2];
#define SCANA_TOK0(st_) (bl * TPB + ((st_) >= 4 ? CTXL : 0) + (dir ? ((st_) >= 4 ? 31 - ((st_) - 4) : 3 - (st_)) : ((st_) >= 4 ? (st_) - 4 : (st_))) * 64)
#define SCANA_PREFETCH(st_) do { const int t0_ = SCANA_TOK0(st_); \
    _Pragma("unroll") for (int j = 0; j < 2; ++j) { const int i = (tid >> 4) + 32 * j; \
      const u16* row = P + (size_t)(t0_ + (dir ? 63 - i : i)) * PS + hd * 128 + ch * 8; \
      pqr[j] = *(const uint4*)(row + A_Q); pfr[j] = *(const uint4*)(row + (dir ? A_FB : A_FF)); pvr[j] = *(const uint4*)(row + A_I); } } while (0)
  SCANA_PREFETCH(0);
#pragma unroll 1
  for (int step = 0; step < 36; ++step) {
    const int tok0 = SCANA_TOK0(step);
    __syncthreads();
#pragma unroll
    for (int j = 0; j < 2; ++j) {
      const int i = (tid >> 4) + 32 * j;
      uint4 qraw = pqr[j];
      uint4 fraw = pfr[j];
      uint4 vq = pvr[j];
      float qv[8], fv[8], kkv[8];
      unpack8(qraw, qv); unpack8(fraw, fv);
#pragma unroll
      for (int e = 0; e < 8; ++e) {
        qv[e] = siluf_(qv[e]);
        const float ex = __expf(-fv[e]);
        const float sg = 1.f / (1.f + ex);
        const float sgn = ex / (1.f + ex);
        const float f = lbv[e] + (1.f - lbv[e]) * sg;
        kkv[e] = (1.f - lbv[e]) * (fv[e] > 30.f ? 0.f : (fv[e] < -30.f ? 1.f : sgn));
        BC[i * 132 + ch * 8 + e] = __log2f(fmaxf(f, 1e-37f));
      }
      *(uint4*)(Qs + i * 136 + ch * 8) = pack8f(qv);
      *(uint4*)(KKs + i * 136 + ch * 8) = pack8f(kkv);
      u16* dv = VT + (ch * 8) * 72 + i;
      dv[0 * 72] = (u16)(vq.x & 0xffff); dv[1 * 72] = (u16)(vq.x >> 16); dv[2 * 72] = (u16)(vq.y & 0xffff); dv[3 * 72] = (u16)(vq.y >> 16);
      dv[4 * 72] = (u16)(vq.z & 0xffff); dv[5 * 72] = (u16)(vq.z >> 16); dv[6 * 72] = (u16)(vq.w & 0xffff); dv[7 * 72] = (u16)(vq.w >> 16);
    }
    __syncthreads();
    {
      const int k = tid & 127, qd = tid >> 7;
      float cv[16];
#pragma unroll
      for (int i = 0; i < 16; ++i) cv[i] = BC[(qd * 16 + i) * 132 + k];
      float run = 0.f;
#pragma unroll
      for (int i = 0; i < 16; ++i) { run += cv[i]; BC[(qd * 16 + i) * 132 + k] = run; }
      QTOT[qd * 128 + k] = run;
    }
    __syncthreads();
    {
      const int k = tid & 127, qd = tid >> 7;
      float off = 0.f;
      for (int q2 = 0; q2 < qd; ++q2) off += QTOT[q2 * 128 + k];
      if (qd > 0) {
        float cv[16];
#pragma unroll
        for (int i = 0; i < 16; ++i) cv[i] = BC[(qd * 16 + i) * 132 + k];
#pragma unroll
        for (int i = 0; i < 16; ++i) BC[(qd * 16 + i) * 132 + k] = cv[i] + off;
      }
    }
    __syncthreads();
    f32x4 cod[2];
#pragma unroll
    for (int jj = 0; jj < 2; ++jj) {
      cod[jj] = (f32x4){0.f, 0.f, 0.f, 0.f};
      const int job = wid + 8 * jj;
      if (job < 10) {
        const int bI = job < 1 ? 0 : (job < 3 ? 1 : (job < 6 ? 2 : 3));
        const int bJ = job - (bI * (bI + 1)) / 2;
        const int l16 = lane & 15, kg = lane >> 4;
        const int t = 16 * bI + l16, s = 16 * bJ + l16, rr = 16 * bI;
#pragma unroll
        for (int ks = 0; ks < 4; ++ks) {
          const int k0 = ks * 32 + kg * 8;
          float qv[8], kv[8];
          unpack8(*(const uint4*)(Qs + t * 136 + k0), qv);
          unpack8(*(const uint4*)(KKs + s * 136 + k0), kv);
#pragma unroll
          for (int e = 0; e < 8; ++e) {
            const float br = BC[rr * 132 + k0 + e];
            qv[e] *= ex2(BC[t * 132 + k0 + e] - br);
            kv[e] *= ex2(fminf(br - BC[s * 132 + k0 + e], 120.f));
          }
          union { uint4 u; bf16x8 v; } ua, ub;
          ua.u = pack8f(qv); ub.u = pack8f(kv);
          cod[jj] = __builtin_amdgcn_mfma_f32_16x16x32_bf16(ua.v, ub.v, cod[jj], 0, 0, 0);
        }
      }
    }
    if (tid < 128) EL[tid] = ex2(BC[63 * 132 + tid]);
#pragma unroll
    for (int j = 0; j < 2; ++j) {
      const int i = (tid >> 4) + 32 * j;
      float kv[8];
      unpack8(*(const uint4*)(KKs + i * 136 + ch * 8), kv);
      u16* dk = KT + (ch * 8) * 72 + i;
      float dv8[8];
#pragma unroll
      for (int e = 0; e < 8; ++e) dv8[e] = BC[63 * 132 + ch * 8 + e] - BC[i * 132 + ch * 8 + e];
#pragma unroll
      for (int e = 0; e < 8; ++e) dk[e * 72] = f2bf(kv[e] * ex2(dv8[e]));
    }
    __syncthreads();
#pragma unroll
    for (int j = 0; j < 2; ++j) {
      const int i = (tid >> 4) + 32 * j;
      float qv[8];
      unpack8(*(const uint4*)(Qs + i * 136 + ch * 8), qv);
#pragma unroll
      for (int e = 0; e < 8; ++e) qv[e] *= ex2(BC[i * 132 + ch * 8 + e]);
      *(uint4*)(Qs + i * 136 + ch * 8) = pack8f(qv);
    }
    for (int i = tid; i < 64 * 72 / 2; i += NTHR) ((unsigned*)AM)[i] = 0u;
    __syncthreads();
#pragma unroll
    for (int jj = 0; jj < 2; ++jj) {
      const int job = wid + 8 * jj;
      if (job < 10) {
        const int bI = job < 1 ? 0 : (job < 3 ? 1 : (job < 6 ? 2 : 3));
        const int bJ = job - (bI * (bI + 1)) / 2;
        const int l16 = lane & 15, kg = lane >> 4;
#pragma unroll
        for (int e = 0; e < 4; ++e) {
          const int tp = 4 * kg + e;
          const float v = (bJ < bI || l16 <= tp) ? cod[jj][e] : 0.f;
          AM[(16 * bI + tp) * 72 + 16 * bJ + l16] = f2bf(v);
        }
      }
    }
    __syncthreads();
    if (step + 1 < 36) SCANA_PREFETCH(step + 1);
    f32x16 o;
#pragma unroll
    for (int e = 0; e < 16; ++e) o[e] = 0.f;
#pragma unroll
    for (int ks = 0; ks < 8; ++ks) {
      bf16x8 a = *(const bf16x8*)(Qs + (th * 32 + r) * 136 + ks * 16 + h * 8);
      bf16x8 b = *(const bf16x8*)(ST + (vt * 32 + r) * 136 + ks * 16 + h * 8);
      o = MFMA(a, b, o);
    }
    bf16x8 bv[4];
#pragma unroll
    for (int ks = 0; ks < 4; ++ks) bv[ks] = *(const bf16x8*)(VT + (vt * 32 + r) * 72 + ks * 16 + h * 8);
#pragma unroll
    for (int ks = 0; ks < 4; ++ks) {
      bf16x8 a = *(const bf16x8*)(AM + (th * 32 + r) * 72 + ks * 16 + h * 8);
      o = MFMA(a, bv[ks], o);
    }
    {
      u16* ob = Oa + (size_t)tok0 * 512 + hd * 128 + vt * 32 + r;
#pragma unroll
      for (int e = 0; e < 16; ++e) {
        const int i = th * 32 + crow(e, h);
        ob[(dir ? 63 - i : i) * 512] = f2bf(o[e]);
      }
    }
    __syncthreads();
#pragma unroll
    for (int j = 0; j < 2; ++j) {
      const int kt = 2 * th + j;
#pragma unroll
      for (int e = 0; e < 16; ++e) S[j][e] *= EL[kt * 32 + crow(e, h)];
#pragma unroll
      for (int ks = 0; ks < 4; ++ks) {
        bf16x8 a = *(const bf16x8*)(KT + (kt * 32 + r) * 72 + ks * 16 + h * 8);
        S[j] = MFMA(a, bv[ks], S[j]);
      }
#pragma unroll
      for (int gq = 0; gq < 4; ++gq) {
        uint2 w;
        w.x = pack2(S[j][4 * gq], S[j][4 * gq + 1]); w.y = pack2(S[j][4 * gq + 2], S[j][4 * gq + 3]);
        *(uint2*)(ST + (vt * 32 + r) * 136 + kt * 32 + 8 * gq + 4 * h) = w;
      }
    }
  }
#undef SCANA_PREFETCH
#undef SCANA_TOK0
}

__device__ void scanB_unit(const Params& p, int l, int unit2, char* lds) {
  const int tid0 = otid(), vb = tid0 >> 8, tid = tid0 & 255, lane = tid & 63, wid = tid >> 6, r = lane & 31, h = lane >> 5;
  const int unit = unit2 * 2 + vb;
  lds += vb * LDSV;
  const int bl = unit >> 3, hd = (unit >> 1) & 3, dir = unit & 1;
  const u16* P = (const u16*)(p.ws + OFF_P);
  const u16* KQ = (const u16*)(p.ws + OFF_KQ);
  const float* Gb = (const float*)(p.ws + OFF_GB);
  u16* Ob = (u16*)(p.ws + OFF_OB) + (size_t)dir * NTOK * 512;
  u16* QB = (u16*)lds;
  u16* KB = (u16*)(lds + 9216);
  u16* SM = (u16*)(lds + 18432);
  u16* KWT = (u16*)(lds + 27648);
  u16* VT = (u16*)(lds + 36864);
  float* vec = (float*)(lds + 55296);
  float *IG = vec, *LF = vec + 64, *BV = vec + 128, *UV = vec + 192, *MT = vec + 256, *WI = vec + 320, *WK = vec + 384,
        *DEN = vec + 448, *NV = vec + 512  , *SC = vec + 640, *BL2 = vec + 704, *UL2 = vec + 768, *EMT = vec + 832;
  const float bI = p.bgate[l * 16 + (2 * dir) * 4 + hd], bF = p.bgate[l * 16 + (2 * dir + 1) * 4 + hd];
  f32x16 C[2];
#pragma unroll
  for (int ft = 0; ft < 2; ++ft)
#pragma unroll
    for (int e = 0; e < 16; ++e) C[ft][e] = 0.f;
  float m = -1e30f;
  __syncthreads();
  if (tid < 128) NV[tid] = 0.f;
  int cur = 0;
  uint4 pk0, pk1, pq0, pq1, pv0, pv1, pv2, pv3; float pgI = 0.f, pgF = 0.f;
#define SCANB_TOK0(st_) (bl * TPB + ((st_) >= 4 ? CTXL : 0) + (dir ? ((st_) >= 4 ? 31 - ((st_) - 4) : 3 - (st_)) : ((st_) >= 4 ? (st_) - 4 : (st_))) * 64)
#define SCANB_LDKQ(j, K_, Q_) do { const int id = tid + 256 * (j), i = id >> 3, c8 = id & 7; \
      const u16* row = KQ + (size_t)(t0_ + (dir ? 63 - i : i)) * 512 + hd * 64 + c8 * 8; K_ = *(const uint4*)(row); Q_ = *(const uint4*)(row + 256); } while (0)
#define SCANB_LDV(j, V_) do { const int id = tid + 256 * (j), i = id >> 4, c16 = id & 15; \
      V_ = *(const uint4*)(P + (size_t)(t0_ + (dir ? 63 - i : i)) * PS + B_V + hd * 128 + c16 * 8); } while (0)
#define SCANB_PREFETCH(st_) do { const int t0_ = SCANB_TOK0(st_); \
    SCANB_LDKQ(0, pk0, pq0); SCANB_LDKQ(1, pk1, pq1); SCANB_LDV(0, pv0); SCANB_LDV(1, pv1); SCANB_LDV(2, pv2); SCANB_LDV(3, pv3); \
    if (tid < 64) { const int tok = t0_ + (dir ? 63 - tid : tid); pgI = Gb[(size_t)tok * 16 + (2 * dir) * 4 + hd]; pgF = Gb[(size_t)tok * 16 + (2 * dir + 1) * 4 + hd]; } } while (0)
#define SCANB_STKQ(j, K_, Q_) do { const int id = tid + 256 * (j), i = id >> 3, c8 = id & 7; \
      *(uint4*)(KB + i * 72 + c8 * 8) = K_; *(uint4*)(QB + i * 72 + c8 * 8) = Q_; } while (0)
#define SCANB_STV(j, V_) do { const int id = tid + 256 * (j), i = id >> 4, c16 = id & 15; const uint4 vq = V_; u16* dv = VT + (c16 * 8) * 72 + i; \
      dv[0 * 72] = (u16)(vq.x & 0xffff); dv[1 * 72] = (u16)(vq.x >> 16); dv[2 * 72] = (u16)(vq.y & 0xffff); dv[3 * 72] = (u16)(vq.y >> 16); \
      dv[4 * 72] = (u16)(vq.z & 0xffff); dv[5 * 72] = (u16)(vq.z >> 16); dv[6 * 72] = (u16)(vq.w & 0xffff); dv[7 * 72] = (u16)(vq.w >> 16); } while (0)
  SCANB_PREFETCH(0);
#pragma unroll 1
  for (int step = 0; step < 36; ++step) {
    const int tok0 = SCANB_TOK0(step);
    __syncthreads();
    SCANB_STKQ(0, pk0, pq0); SCANB_STKQ(1, pk1, pq1);
    SCANB_STV(0, pv0); SCANB_STV(1, pv1); SCANB_STV(2, pv2); SCANB_STV(3, pv3);
    if (tid < 64) {
      const int i = tid;
      const float gI = pgI + bI;
      const float gF = pgF + bF;
      const float lf = fminf(gF, 0.f) - log1pf(expf(-fabsf(gF)));
      float b = lf;
#pragma unroll
      for (int d = 1; d < 64; d <<= 1) { float t = __shfl_up(b, d); if (lane >= d) b += t; }
      const float u = gI - b;
      float pm = u;
#pragma unroll
      for (int d = 1; d < 64; d <<= 1) { float t = __shfl_up(pm, d); if (lane >= d) pm = fmaxf(pm, t); }
      const float mt = b + fmaxf(m, pm);
      const float wi = expf(b + m - mt);
      const float mnew = __shfl(mt, 63), b63 = __shfl(b, 63);
      const float dec = expf(b63 + m - mnew);
      const float wk = expf(b63 - b + gI - mnew);
      IG[i] = gI; LF[i] = lf; BV[i] = b; UV[i] = u; MT[i] = mt; WI[i] = wi; WK[i] = wk;
      BL2[i] = (b - mt) * LOG2E; UL2[i] = u * LOG2E; EMT[i] = expf(-mt);
      if (i == 0) { SC[0] = mnew; SC[1] = dec; }
    }
    __syncthreads();
    {
      const int tt = wid >> 1, st = wid & 1;
      f32x16 a16;
#pragma unroll
      for (int e = 0; e < 16; ++e) a16[e] = 0.f;
#pragma unroll
      for (int ks = 0; ks < 4; ++ks) {
        bf16x8 a = *(const bf16x8*)(QB + (tt * 32 + r) * 72 + ks * 16 + h * 8);
        bf16x8 b = *(const bf16x8*)(KB + (st * 32 + r) * 72 + ks * 16 + h * 8);
        a16 = MFMA(a, b, a16);
      }
      const int s = st * 32 + r;
      const float us = UL2[s];
      float blv[16];
#pragma unroll
      for (int e = 0; e < 16; ++e) blv[e] = BL2[tt * 32 + crow(e, h)];
#pragma unroll
      for (int e = 0; e < 16; ++e) {
        const int t = tt * 32 + crow(e, h);
        float v = 0.f;
        if (s <= t) v = a16[e] * ex2(blv[e] + us);
        SM[t * 72 + s] = f2bf(v);
      }
    }
#pragma unroll
    for (int j = 0; j < 2; ++j) {
      const int id = tid + 256 * j, i = id >> 3, c8 = id & 7;
      float kv[8];
      unpack8(*(const uint4*)(KB + i * 72 + c8 * 8), kv);
      const float wk = WK[i];
#pragma unroll
      for (int e = 0; e < 8; ++e) KWT[(c8 * 8 + e) * 72 + i] = f2bf(kv[e] * wk);
    }
    __syncthreads();
    const float mnew = SC[0], dec = SC[1];
    if (tid < 64) {
      const int t = tid;
      float rsum = 0.f, qn = 0.f;
#pragma unroll
      for (int c8 = 0; c8 < 8; ++c8) {
        float sv[8], qv[8];
        unpack8(*(const uint4*)(SM + t * 72 + c8 * 8), sv);
        unpack8(*(const uint4*)(QB + t * 72 + c8 * 8), qv);
#pragma unroll
        for (int e = 0; e < 8; ++e) { rsum += sv[e]; qn += qv[e] * NV[cur * 64 + c8 * 8 + e]; }
      }
      DEN[t] = 1.f / fmaxf(fabsf(WI[t] * qn + rsum), EMT[t]);
    } else if (tid < 128) {
      const int f = tid - 64;
      float ns = 0.f;
#pragma unroll
      for (int c8 = 0; c8 < 8; ++c8) {
        float kv[8];
        unpack8(*(const uint4*)(KWT + f * 72 + c8 * 8), kv);
#pragma unroll
        for (int e = 0; e < 8; ++e) ns += kv[e];
      }
      NV[(cur ^ 1) * 64 + f] = dec * NV[cur * 64 + f] + ns;
    }
    __syncthreads();
    if (step + 1 < 36) SCANB_PREFETCH(step + 1);
    f32x16 num[2];
#pragma unroll
    for (int tt = 0; tt < 2; ++tt)
#pragma unroll
      for (int e = 0; e < 16; ++e) num[tt][e] = 0.f;
#pragma unroll
    for (int ft = 0; ft < 2; ++ft)
#pragma unroll
      for (int s = 0; s < 2; ++s) {
        bf16x8 pb = pack8(C[ft], s);
#pragma unroll
        for (int tt = 0; tt < 2; ++tt) {
          const u16* qb = QB + (tt * 32 + r) * 72 + ft * 32 + s * 16 + 4 * h;
          bf16x8 a = cat4(*(const s16x4*)qb, *(const s16x4*)(qb + 8));
          num[tt] = MFMA(a, pb, num[tt]);
        }
      }
#pragma unroll
    for (int tt = 0; tt < 2; ++tt)
#pragma unroll
      for (int e = 0; e < 16; ++e) num[tt][e] *= WI[tt * 32 + crow(e, h)];
    bf16x8 bv[4];
#pragma unroll
    for (int ks = 0; ks < 4; ++ks) bv[ks] = *(const bf16x8*)(VT + (wid * 32 + r) * 72 + ks * 16 + h * 8);
#pragma unroll
    for (int ks = 0; ks < 4; ++ks)
#pragma unroll
      for (int tt = 0; tt < 2; ++tt) {
        bf16x8 a = *(const bf16x8*)(SM + (tt * 32 + r) * 72 + ks * 16 + h * 8);
        num[tt] = MFMA(a, bv[ks], num[tt]);
      }
#pragma unroll
    for (int tt = 0; tt < 2; ++tt)
#pragma unroll
      for (int e = 0; e < 16; ++e) {
        const int i = tt * 32 + crow(e, h);
        const int tok = tok0 + (dir ? 63 - i : i);
        Ob[(size_t)tok * 512 + hd * 128 + wid * 32 + r] = f2bf(num[tt][e] * DEN[i]);
      }
#pragma unroll
    for (int ft = 0; ft < 2; ++ft) {
#pragma unroll
      for (int e = 0; e < 16; ++e) C[ft][e] *= dec;
#pragma unroll
      for (int ks = 0; ks < 4; ++ks) {
        bf16x8 a = *(const bf16x8*)(KWT + (ft * 32 + r) * 72 + ks * 16 + h * 8);
        C[ft] = MFMA(a, bv[ks], C[ft]);
      }
    }
    m = mnew;
    cur ^= 1;
  }
#undef SCANB_PREFETCH
#undef SCANB_LDKQ
#undef SCANB_LDV
#undef SCANB_STKQ
#undef SCANB_STV
#undef SCANB_TOK0
}

__device__ void phase_mixers(const Params& p, int l, int g, char* lds, int cbase = 0, bool scans_only = false, bool a_only = false) {
  int* s_item = (int*)(lds + LDS_BYTES - 16);
  int* cnt = (int*)(p.ws + OFF_CNT) + cbase + (l * NG + g);
  const u16* P = (const u16*)(p.ws + OFF_P);
  const u16* Qd = (const u16*)(p.ws + OFF_QD);
  const u16* Kd = (const u16*)(p.ws + OFF_KD);
  const u16* Vd = (const u16*)(p.ws + OFF_VD);
  u16* Y = (u16*)((char*)p.out);
  const float* rc = (const float*)(p.ws + OFF_ROPE);
  constexpr int NSA = NB * 8, NSB = NB * 4;
  constexpr int ND_L = NB * 4 * 8, NC_L = NB * 2 * 32, ND_C = NB * 4, NC_C = NB * 2 * 4;
  constexpr int I1 = NSA, I2 = I1 + NSB, I3 = I2 + ND_L, I4 = I3 + NC_L, I5 = I4 + ND_C, I6 = I5 + NC_C;
  const float scC = 0.125f * LOG2E, scD = 0.07216878364870322f * LOG2E;
  while (true) {
    __syncthreads();
    if (otid() == 0) *s_item = atomicAdd(cnt, 1);
    __syncthreads();
    const int it = *s_item;
    if (it >= (a_only ? I1 : (scans_only ? I2 : (l == DEPTH - 1 ? I4 : I6)))) break;
    if (it < I1) scanA_unit(p, l, it, lds);
    else if (it < I2) scanB_unit(p, l, it - I1, lds);
    else {
      bool isD, isLat; int q;
      if (it < I3) { isD = true; isLat = true; q = it - I2; }
      else if (it < I4) { isD = false; isLat = true; q = it - I3; }
      else if (it < I5) { isD = true; isLat = false; q = it - I4; }
      else { isD = false; isLat = false; q = it - I5; }
      const int tid = otid(), lane = tid & 63, wid = tid >> 6, r = lane & 31;
      const int nkeys = isLat ? TPB : CTXL;
      if (isD) {
        const int nqt = isLat ? 8 : 1;
        const int qt = q % nqt, hd = (q / nqt) % 4, bl = q / (nqt * 4);
        const int tokk = bl * TPB, ql = qt * 256 + wid * 32 + r;
        const int tokq = tokk + (isLat ? CTXL : 0) + ql;
        attn_item<192, 128, true>(Qd + (size_t)tokq * 768 + hd * 192, Kd + (size_t)tokk * 768 + hd * 192, 768,
                                  Vd + (size_t)tokk * 512 + hd * 128, 512, Y + (size_t)tokq * 2048 + 1536 + hd * 128,
                                  nkeys, scD, isLat ? ql : -1, rc, lds);
      } else {
        const int nqt = isLat ? 32 : 4;
        const int qt = q % nqt, kvh = (q / nqt) % 2, bl = q / (nqt * 2);
        const int hq = kvh * 4 + (wid >> 1);
        const int tokk = bl * TPB, ql = qt * 64 + (wid & 1) * 32 + r;
        const int tokq = tokk + (isLat ? CTXL : 0) + ql;
        attn_item<64, 64, false>(P + (size_t)tokq * PS + C_Q + hq * 64, P + (size_t)tokk * PS + C_K + kvh * 64, PS,
                                 P + (size_t)tokk * PS + C_V + kvh * 64, PS, Y + (size_t)tokq * 2048 + 1024 + hq * 64,
                                 nkeys, scC, -1, rc, lds);
      }
    }
  }
}

__device__ void phase_readout(const Params& p, int l) {
  const int tid = otid(), lane = tid & 63, wid = tid >> 6;
  const u16* P = (const u16*)(p.ws + OFF_P);
  const u16* Oa = (const u16*)(p.ws + OFF_OA);
  const u16* Ob = (const u16*)(p.ws + OFF_OB);
  u16* Y = (u16*)((char*)p.out);
  const int col = lane * 8;
  float gnv[2][8];
#pragma unroll
  for (int mix = 0; mix < 2; ++mix)
#pragma unroll
    for (int e = 0; e < 8; ++e) gnv[mix][e] = ((mix == 0 ? p.hnorm : p.mnorm) + l * 128 + (col & 127))[e];
  const int stride = gridDim.x * 8;
  const bool skipc = l == DEPTH - 1;
  for (int tok0 = blockIdx.x * 8 + wid; tok0 < NTOK; tok0 += 2 * stride) {
    int tk[2]; bool doit[2];
    tk[0] = tok0; tk[1] = tok0 + stride;
    doit[0] = !(skipc && (tk[0] % TPB) < CTXL);
    doit[1] = tk[1] < NTOK && !(skipc && (tk[1] % TPB) < CTXL);
    if (!doit[1]) tk[1] = tk[0];
    uint4 ra[2][2], rb[2][2], rg[2][2];
#pragma unroll
    for (int u = 0; u < 2; ++u)
#pragma unroll
      for (int mix = 0; mix < 2; ++mix) {
        const u16* O = mix == 0 ? Oa : Ob;
        ra[u][mix] = *(const uint4*)(O + (size_t)tk[u] * 512 + col);
        rb[u][mix] = *(const uint4*)(O + ((size_t)NTOK + tk[u]) * 512 + col);
        rg[u][mix] = *(const uint4*)(P + (size_t)tk[u] * PS + (mix == 0 ? A_G : B_O) + col);
      }
#pragma unroll
    for (int u = 0; u < 2; ++u) {
      uint4 outv[2];
#pragma unroll
      for (int mix = 0; mix < 2; ++mix) {
        float a[8], b[8], gt[8], o[8];
        unpack8(ra[u][mix], a); unpack8(rb[u][mix], b); unpack8(rg[u][mix], gt);
        float ss = 0.f;
#pragma unroll
        for (int e = 0; e < 8; ++e) { a[e] += b[e]; ss += a[e] * a[e]; }
        ss += __shfl_xor(ss, 1); ss += __shfl_xor(ss, 2); ss += __shfl_xor(ss, 4); ss += __shfl_xor(ss, 8);
        const float rstd = rsqrtf(ss * (1.f / 128.f) + EPS);
#pragma unroll
        for (int e = 0; e < 8; ++e) {
          float y = a[e] * rstd * gnv[mix][e];
          o[e] = y * (mix == 0 ? siluf_(gt[e]) : sigmoidf_(gt[e]));
        }
        outv[mix] = pack8f(o);
      }
      if (doit[u]) {
        *(uint4*)(Y + (size_t)tk[u] * 2048 + col) = outv[0];
        *(uint4*)(Y + (size_t)tk[u] * 2048 + 512 + col) = outv[1];
      }
    }
  }
}

struct EpiInproj {
  u16* P; float* Gb;
  DI bool operator()(f32x4 (&acc)[2][2][4][2], const pg8::UDesc& u, int wr, int wc, int fr, int fq) const {
    const int row0 = u.pm * 256 + wr * 64 + fr, col0 = u.pn * 256 + wc * 32 + 8 * fq;
    const bool gate = (u.pn == 9) && (wc == 0) && (fq < 2);
#pragma unroll
    for (int ai = 0; ai < 2; ++ai)
#pragma unroll
      for (int m = 0; m < 4; ++m) {
        const size_t row = (size_t)(row0 + ai * 128 + m * 16);
#pragma unroll
        for (int bj = 0; bj < 2; ++bj) *(uint4*)(P + row * PS + col0 + bj * 128) = pk8(acc[ai][bj][m][0], acc[ai][bj][m][1]);
        if (gate) { *(f32x4*)(Gb + row * 16 + 8 * fq) = acc[ai][0][m][0]; *(f32x4*)(Gb + row * 16 + 8 * fq + 4) = acc[ai][0][m][1]; }
      }
    return false;
  }
};
__device__ void phase_inproj(const Params& p, int l, char* lds) {
  pg8::PlainSched S{p.ws + OFF_H, wsel(p, l) + OFF_WINT, 2048u, 2048u, 16, NTOK / 256, PS / 256, (int)gridDim.x, (int)blockIdx.x};
  EpiInproj E{(u16*)(p.ws + OFF_P), (float*)(p.ws + OFF_GB)};
  pg8::gemm_stream(( LAS unsigned char*)lds, S, E);
}

struct MlaSched {
  const char* P; const char* Wq; const char* Wk; const char* Wv; int G, c;
  DI bool next(int i, pg8::UDesc& u) const {
    const long L = (long)i * G + c; if (L >= (NTOK / 256) * 7) return false;
    const int pm = (int)(L / 7), j = (int)(L % 7);
    u.pm = pm; u.lda2 = PS * 2;
    if (j < 3) { u.tag = 0; u.pn = j; u.A = P + (size_t)pm * 256 * PS * 2 + D_CQ * 2; u.B = Wq + (size_t)j * 256 * 512; u.ldb2 = 512; u.nt = 4; }
    else if (j < 5) { u.tag = 1; u.pn = j - 3; u.A = P + (size_t)pm * 256 * PS * 2 + D_CKV * 2; u.B = Wk + (size_t)(j - 3) * 256 * 256; u.ldb2 = 256; u.nt = 2; }
    else { u.tag = 2; u.pn = j - 5; u.A = P + (size_t)pm * 256 * PS * 2 + D_CKV * 2; u.B = Wv + (size_t)(j - 5) * 256 * 256; u.ldb2 = 256; u.nt = 2; }
    return true;
  }
};
struct EpiMla {
  u16 *Qd, *Kd, *Vd;
  DI bool operator()(f32x4 (&acc)[2][2][4][2], const pg8::UDesc& u, int wr, int wc, int fr, int fq) const {
    const int row0 = u.pm * 256 + wr * 64 + fr, col0 = u.pn * 256 + wc * 32 + 8 * fq;
#pragma unroll
    for (int ai = 0; ai < 2; ++ai)
#pragma unroll
      for (int m = 0; m < 4; ++m) {
        const size_t row = (size_t)(row0 + ai * 128 + m * 16);
#pragma unroll
        for (int bj = 0; bj < 2; ++bj) {
          const int col = col0 + bj * 128;
          u16* dst = u.tag == 0 ? Qd + row * 768 + col : (u.tag == 1 ? Kd + row * 768 + (col >> 7) * 192 + (col & 127) : Vd + row * 512 + col);
          *(uint4*)dst = pk8(acc[ai][bj][m][0], acc[ai][bj][m][1]);
        }
      }
    return false;
  }
};
__device__ void phase_mlaup(const Params& p, int l, char* lds) {
  MlaSched S{p.ws + OFF_P, wsel(p, l) + OFF_WUQ, wsel(p, l) + OFF_WUK, wsel(p, l) + OFF_WUV, (int)gridDim.x, (int)blockIdx.x};
  EpiMla E{(u16*)(p.ws + OFF_QD), (u16*)(p.ws + OFF_KD), (u16*)(p.ws + OFF_VD)};
  pg8::gemm_stream((LAS unsigned char*)lds, S, E);
}

struct EpiGate {
  u16* Gt;
  DI bool operator()(f32x4 (&acc)[2][2][4][2], const pg8::UDesc& u, int wr, int wc, int fr, int fq) const {
    const int row0 = u.pm * 256 + wr * 64 + fr, col0 = u.pn * 256 + wc * 32 + 8 * fq;
#pragma unroll
    for (int ai = 0; ai < 2; ++ai)
#pragma unroll
      for (int m = 0; m < 4; ++m) {
        const size_t row = (size_t)(row0 + ai * 128 + m * 16);
#pragma unroll
        for (int bj = 0; bj < 2; ++bj) {
          f32x4 a = acc[ai][bj][m][0], b = acc[ai][bj][m][1];
#pragma unroll
          for (int e = 0; e < 4; ++e) { a[e] = fmaxf(sigmoidf_(a[e]), 1e-30f); b[e] = fmaxf(sigmoidf_(b[e]), 1e-30f); }
          *(uint4*)(Gt + row * 4096 + col0 + bj * 128) = pk8(a, b);
        }
      }
    return false;
  }
};
__device__ void phase_gate(const Params& p, int l, char* lds, int lat_only) {
  pg8::PlainSched S{p.ws + OFF_H, wsel(p, l) + OFF_WGT, 2048u, 2048u, 16, NTOK / 256, 16, (int)gridDim.x, (int)blockIdx.x, lat_only};
  EpiGate E{(u16*)(p.ws + OFF_P)};
  pg8::gemm_stream((LAS unsigned char*)lds, S, E);
}

struct BranchSched {
  const char* Y; const char* Wb; int G, c, lat_only;
  DI bool next(int i, pg8::UDesc& u) const {
    int pm, pn; if (!pg8::tile_order((long)(i >> 2) * G + c, lat_only ? NTOK / 256 - NB : NTOK / 256, 4, pm, pn)) return false;
    if (lat_only) pm = pm + (pm >> 3) + 1;
    const int r = i & 3;
    u.pm = pm; u.pn = pn; u.tag = r; u.lda2 = 4096; u.ldb2 = 1024; u.nt = 8;
    u.A = Y + (size_t)pm * 256 * 4096 + r * 1024; u.B = Wb + ((size_t)r * 1024 + pn * 256) * 1024;
    return true;
  }
};
struct EpiBranch {
  const u16* Gt; u16* Mg;
  DI bool operator()(f32x4 (&acc)[2][2][4][2], const pg8::UDesc& u, int wr, int wc, int fr, int fq) const {
    const int row0 = u.pm * 256 + wr * 64 + fr, col0 = u.pn * 256 + wc * 32 + 8 * fq, r = u.tag;
    const int rn = r < 3 ? r + 1 : r;
    uint4 gin[2][2][2], gnn[2][2][2];
#define EPB_LOAD(slot, k_) do { const int ai_ = (k_) >> 1, mh_ = (k_) & 1; \
    _Pragma("unroll") for (int mm = 0; mm < 2; ++mm) _Pragma("unroll") for (int bj = 0; bj < 2; ++bj) { \
      const u16* gp = Gt + (size_t)(row0 + ai_ * 128 + (mh_ * 2 + mm) * 16) * 4096 + col0 + bj * 128; \
      gin[slot][mm][bj] = *(const uint4*)(gp + r * 1024); gnn[slot][mm][bj] = *(const uint4*)(gp + rn * 1024); } } while (0)
    EPB_LOAD(0, 0);
#pragma unroll
    for (int k = 0; k < 4; ++k) {
      const int ai = k >> 1, mh = k & 1, slot = k & 1;
      if (k + 1 < 4) EPB_LOAD(slot ^ 1, k + 1);
#pragma unroll
      for (int mm = 0; mm < 2; ++mm) {
        const int m = mh * 2 + mm;
        const size_t row = (size_t)(row0 + ai * 128 + m * 16);
#pragma unroll
        for (int bj = 0; bj < 2; ++bj) {
          const int col = col0 + bj * 128;
          float gv[8];
          unpack8(gin[slot][mm][bj], gv);
          if (r < 3) {
            float gn[8];
            unpack8(gnn[slot][mm][bj], gn);
#pragma unroll
            for (int e = 0; e < 4; ++e) {
              acc[ai][bj][m][0][e] *= gv[e] * __builtin_amdgcn_rcpf(gn[e]);
              acc[ai][bj][m][1][e] *= gv[4 + e] * __builtin_amdgcn_rcpf(gn[4 + e]);
            }
          } else {
            f32x4 a = acc[ai][bj][m][0], b = acc[ai][bj][m][1];
#pragma unroll
            for (int e = 0; e < 4; ++e) { a[e] *= gv[e]; b[e] *= gv[4 + e]; }
            *(uint4*)(Mg + row * 1024 + col) = pk8(a, b);
          }
        }
      }
    }
#undef EPB_LOAD
    return r < 3;
  }
};
__device__ void phase_branch(const Params& p, int l, char* lds, int lat_only) {
  BranchSched S{(const char*)p.out, wsel(p, l) + OFF_WBT, (int)gridDim.x, (int)blockIdx.x, lat_only};
  EpiBranch E{(const u16*)(p.ws + OFF_P), (u16*)(p.ws + OFF_OA)};
  pg8::gemm_stream((LAS unsigned char*)lds, S, E);
}

struct EpiResid {
  const Params* pp; const float* mod; int g, gidx; float* dummy;
  DI bool operator()(f32x4 (&acc)[2][2][4][2], const pg8::UDesc& u, int wr, int wc, int fr, int fq) const {
    int mr; u16* xb = xrow_ptr(*pp, g, u.pm * 256, mr);
    if (dummy) xb = (u16*)dummy + (size_t)u.pm * 256 * DM;
    const float* gate = mod + (size_t)mr * 6144 + gidx * DM;
    const int row0 = wr * 64 + fr, col0 = u.pn * 256 + wc * 32 + 8 * fq;
    f32x4 gv[2][2];
#pragma unroll
    for (int bj = 0; bj < 2; ++bj) { gv[bj][0] = *(const f32x4*)(gate + col0 + bj * 128); gv[bj][1] = *(const f32x4*)(gate + col0 + bj * 128 + 4); }
#pragma unroll
    for (int ai = 0; ai < 2; ++ai) {
      uint4 xin[4][2];
#pragma unroll
      for (int m = 0; m < 4; ++m)
#pragma unroll
        for (int bj = 0; bj < 2; ++bj) xin[m][bj] = *(const uint4*)(xb + (size_t)(row0 + ai * 128 + m * 16) * DM + col0 + bj * 128);
#pragma unroll
      for (int m = 0; m < 4; ++m) {
        u16* xr = xb + (size_t)(row0 + ai * 128 + m * 16) * DM + col0;
#pragma unroll
        for (int bj = 0; bj < 2; ++bj) {
          float xv[8];
          unpack8(xin[m][bj], xv);
          f32x4 x0 = {xv[0], xv[1], xv[2], xv[3]}, x1 = {xv[4], xv[5], xv[6], xv[7]};
          x0 += gv[bj][0] * acc[ai][bj][m][0]; x1 += gv[bj][1] * acc[ai][bj][m][1];
          *(uint4*)(xr + bj * 128) = pk8(x0, x1);
        }
      }
    }
    return false;
  }
};
__device__ void phase_resid_gemm(const Params& p, int l, int g, const char* A, const char* W, int K, int gidx, char* lds, float* dummy = nullptr) {
  pg8::PlainSched S{A, W, (unsigned)K * 2u, (unsigned)K * 2u, K / 64, NTOK / 256, 4, (int)gridDim.x, (int)blockIdx.x, (l == DEPTH - 1) ? 1 : 0};
  EpiResid E{&p, (const float*)(p.ws + OFF_MOD) + (size_t)l * 33 * 6144, g, gidx, dummy};
  pg8::gemm_stream((LAS unsigned char*)lds, S, E);
}

struct EpiFF1 {
  u16* Hid;
  DI bool operator()(f32x4 (&acc)[2][2][4][2], const pg8::UDesc& u, int wr, int wc, int fr, int fq) const {
    const int row0 = u.pm * 256 + wr * 64 + fr, col0 = u.pn * 256 + wc * 32 + 8 * fq;
#pragma unroll
    for (int ai = 0; ai < 2; ++ai)
#pragma unroll
      for (int m = 0; m < 4; ++m) {
        const size_t row = (size_t)(row0 + ai * 128 + m * 16);
#pragma unroll
        for (int bj = 0; bj < 2; ++bj) {
          f32x4 a = acc[ai][bj][m][0], b = acc[ai][bj][m][1];
#pragma unroll
          for (int e = 0; e < 4; ++e) { float t = fmaxf(a[e], 0.f); a[e] = t * t; t = fmaxf(b[e], 0.f); b[e] = t * t; }
          *(uint4*)(Hid + row * DFF + col0 + bj * 128) = pk8(a, b);
        }
      }
    return false;
  }
};
__device__ void phase_ff1(const Params& p, int l, char* lds, int lat_only) {
  pg8::PlainSched S{p.ws + OFF_H, wsel(p, l) + OFF_W1T, 2048u, 2048u, 16, NTOK / 256, 16, (int)gridDim.x, (int)blockIdx.x, lat_only};
  EpiFF1 E{(u16*)(p.ws + OFF_P)};
  pg8::gemm_stream((LAS unsigned char*)lds, S, E);
}

DI void final_finish(const uint2 (&q)[4], int lane, const float4 (&gfv)[4], float* orow) {
  float4 v[4]; float ss = 0.f;
#pragma unroll
  for (int j = 0; j < 4; ++j) {
    v[j].x = __uint_as_float(q[j].x << 16); v[j].y = __uint_as_float(q[j].x & 0xffff0000u); v[j].z = __uint_as_float(q[j].y << 16); v[j].w = __uint_as_float(q[j].y & 0xffff0000u);
    ss += v[j].x * v[j].x + v[j].y * v[j].y + v[j].z * v[j].z + v[j].w * v[j].w;
  }
  ss = wave_sum(ss);
  const float rstd = rsqrtf(ss * (1.f / DM) + EPS);
#pragma unroll
  for (int j = 0; j < 4; ++j) {
    const int c = j * 256 + lane * 4;
    const float4 gg = gfv[j];
    float4 o = {v[j].x * rstd * gg.x, v[j].y * rstd * gg.y, v[j].z * rstd * gg.z, v[j].w * rstd * gg.w};
    *(float4*)(orow + c) = o;
  }
}
__device__ void phase_final(const Params& p) {
  const int tid = otid(), lane = tid & 63, wid = tid >> 6;
  const int stride = gridDim.x * 8;
  const u16* X = (const u16*)(p.ws + OFF_XL);
  float4 gfv[4];
#pragma unroll
  for (int j = 0; j < 4; ++j) gfv[j] = *(const float4*)(p.gfin + j * 256 + lane * 4);
  for (int tok = blockIdx.x * 8 + wid; tok < NBATCH * SEQ; tok += 2 * stride) {
    const int tokB = tok + stride;
    const bool doB = tokB < NBATCH * SEQ;
    uint2 qa[4], qb[4];
    norm_load(X + (size_t)tok * DM, lane, qa);
    norm_load(X + (size_t)(doB ? tokB : tok) * DM, lane, qb);
    final_finish(qa, lane, gfv, p.out + (size_t)tok * DM);
    if (doB) final_finish(qb, lane, gfv, p.out + (size_t)tokB * DM);
  }
}

#define XB_TMO      128
#define XB_XCNT(j)  (256  + 64 * (j))
#define XB_XSUB(j)  (1280 + 64 * (j))
#define XB_XGEN(j)  (2304 + 64 * (j))
#define XB_TOP      3328
#define XB_TOPGEN   3392
#define XCD_BAR_WORDS 3456
#define XB_SPIN_CAP (1u << 18)
DI unsigned xb_ld(unsigned* p) { return __hip_atomic_load(p, __ATOMIC_RELAXED, __HIP_MEMORY_SCOPE_AGENT); }
DI unsigned xb_add(unsigned* p, unsigned v) { return __hip_atomic_fetch_add(p, v, __ATOMIC_RELAXED, __HIP_MEMORY_SCOPE_AGENT); }
DI unsigned xb_xcc_id() { return (unsigned)__builtin_amdgcn_s_getreg((3 << 11) | 20) & 0xFu; }
#define XB_SPIN(cond, bar) do { unsigned _sp = 0; while (cond) { __builtin_amdgcn_s_sleep(1); \
    if ((++_sp & 255u) == 0u) { if (xb_ld(&(bar)[XB_TMO])) break; if (_sp > XB_SPIN_CAP) { atomicAdd(&(bar)[XB_TMO], 1u); break; } } } } while (0)
struct XcdBarrier { unsigned* bar; unsigned x; volatile __attribute__((address_space(3))) unsigned* st; };
DI XcdBarrier xcd_barrier_post(unsigned* bar, volatile __attribute__((address_space(3))) unsigned* st) {
  XcdBarrier b; b.bar = bar; b.x = xb_xcc_id(); b.st = st;
  if (threadIdx.x == 0) (void)xb_add(&bar[XB_XCNT(b.x)], 1u);
  return b;
}
DI void xcd_barrier_complete(unsigned* bar, unsigned x, unsigned& nloc, unsigned& nx) {
  const unsigned G = gridDim.x * gridDim.y * gridDim.z;
  unsigned sum, cnt, mine, sp = 0u;
  for (;;) {
    sum = 0u; cnt = 0u; mine = 0u;
#pragma unroll
    for (unsigned j = 0; j < 16; ++j) { const unsigned c = xb_ld(&bar[XB_XCNT(j)]); sum += c; cnt += (c > 0u) ? 1u : 0u; mine = (j == x) ? c : mine; }
    if (sum == G) break;
    __builtin_amdgcn_s_sleep(1);
    if ((++sp & 255u) == 0u) { if (xb_ld(&bar[XB_TMO])) break; if (sp > XB_SPIN_CAP) { atomicAdd(&bar[XB_TMO], 1u); break; } }
  }
  nloc = mine > 0u ? mine : 1u; nx = cnt > 0u ? cnt : 1u;
}
DI void xcd_barrier(const XcdBarrier& b) {
  asm volatile("s_waitcnt vmcnt(0)" ::: "memory");
  __syncthreads();
  if (threadIdx.x == 0) {
    unsigned* bar = b.bar;
    __builtin_amdgcn_s_waitcnt(0);
    unsigned nloc = b.st[0], nx = b.st[1];
    if (nloc == 0u) { xcd_barrier_complete(bar, b.x, nloc, nx); b.st[0] = nloc; b.st[1] = nx; }
    const unsigned old = xb_add(&bar[XB_XSUB(b.x)], 1u);
    const unsigned gen = old / nloc;
    if (old + 1u == (gen + 1u) * nloc) {
      __builtin_amdgcn_fence(__ATOMIC_RELEASE, "agent");
      asm volatile("s_waitcnt vmcnt(0)" ::: "memory");
      const unsigned og = xb_add(&bar[XB_TOP], 1u);
      const unsigned tg = og / nx;
      if (og + 1u == (tg + 1u) * nx) xb_add(&bar[XB_TOPGEN], 1u);
      else XB_SPIN(xb_ld(&bar[XB_TOPGEN]) == tg, bar);
      __builtin_amdgcn_fence(__ATOMIC_ACQUIRE, "agent");
      xb_add(&bar[XB_XGEN(b.x)], 1u);
      asm volatile("s_waitcnt vmcnt(0)" ::: "memory");
    } else {
      XB_SPIN(xb_ld(&bar[XB_XGEN(b.x)]) == gen, bar);
      __builtin_amdgcn_fence(__ATOMIC_ACQUIRE, "agent");
      asm volatile("s_waitcnt vmcnt(0)" ::: "memory");
    }
  }
  __syncthreads();
}

constexpr int NSUB = 12;
constexpr int NPHASE = 1 + DEPTH * NG * NSUB + 1;

__global__ void __launch_bounds__(512) mega(Params p, int ph_lo, int ph_hi) {
  extern __shared__ __attribute__((aligned(16))) char lds[];
  volatile __attribute__((address_space(3))) unsigned* st = (volatile __attribute__((address_space(3))) unsigned*)(lds + LDS_BYTES - 32);
  if (threadIdx.x < 2) st[threadIdx.x] = 0u;
  __syncthreads();
  XcdBarrier xb{};
  if (ph_hi - ph_lo > 1) xb = xcd_barrier_post((unsigned*)(p.ws + OFF_BAR), st);
#define GSYNC() xcd_barrier(xb)
  for (int ph = ph_lo; ph < ph_hi; ++ph) {
    if (ph > 0 && ph < NPHASE - 1 && ((ph - 1) % NSUB) == 0 && ((ph - 1) / NSUB) != 0) continue;
    if (ph == 0) { phase_prep(p, lds); phase_wconv(p, 0, lds); }
    else if (ph == NPHASE - 1) phase_final(p);
    else {
      const int q = ph - 1, lg = q / NSUB, sub = q % NSUB, l = lg / NG, g = lg % NG;
      switch (sub) {
        case 0: if (lg == 0) phase_norm(p, l, g, 0); break;
        case 1: for (int rep = 0; rep < ((PROBE & 2) ? 2 : 1); ++rep) { if (rep) GSYNC(); phase_inproj(p, l, lds); } break;
        case 2: phase_tokprep(p, l); break;
        case 3: phase_mlaup(p, l, lds); break;
        case 4: phase_mixers(p, l, g, lds); if (PROBE & 1) { GSYNC(); phase_mixers(p, l, g, lds, 8); } if (PROBE & 4) { GSYNC(); phase_mixers(p, l, g, lds, 8, true); } if (PROBE & 16) { GSYNC(); phase_mixers(p, l, g, lds, 8, true, true); } break;
        case 5: for (int rep = 0; rep < ((PROBE & 8) ? 2 : 1); ++rep) { if (rep) GSYNC(); phase_readout(p, l); } break;
        case 6: for (int rep = 0; rep < ((PROBE & 2) ? 2 : 1); ++rep) { if (rep) GSYNC(); phase_gate(p, l, lds, l == DEPTH - 1); } break;
        case 7: for (int rep = 0; rep < ((PROBE & 32) ? 2 : 1); ++rep) { if (rep) GSYNC(); phase_branch(p, l, lds, l == DEPTH - 1); } if (g == 0 && l + 1 < DEPTH) phase_wconv(p, l + 1, lds, (int*)(p.ws + OFF_CNT) + 24 + l); break;
        case 8: for (int rep = 0; rep < ((PROBE & 64) ? 2 : 1); ++rep) { if (rep) GSYNC(); phase_resid_gemm(p, l, g, p.ws + OFF_OA, wsel(p, l) + OFF_WOT, DM, 2, lds, rep ? (float*)((char*)p.out) : nullptr); } break;
        case 9: for (int rep = 0; rep < ((PROBE & 8) ? 2 : 1); ++rep) { if (rep) GSYNC(); phase_norm(p, l, g, 1); } break;
        case 10: for (int rep = 0; rep < ((PROBE & 2) ? 2 : 1); ++rep) { if (rep) GSYNC(); phase_ff1(p, l, lds, l == DEPTH - 1); } break;
        default: for (int rep = 0; rep < ((PROBE & 64) ? 2 : 1); ++rep) { if (rep) GSYNC(); phase_resid_gemm(p, l, g, p.ws + OFF_P, wsel(p, l) + OFF_W2T, DFF, 5, lds, rep ? (float*)((char*)p.out) : nullptr); } if (lg + 1 < DEPTH * NG) phase_norm_dyn(p, (lg + 1) / NG, (lg + 1) % NG, (int*)(p.ws + OFF_CNT) + 16 + lg); break;
      }
    }
    if (ph + 1 < ph_hi) { if (ph == ph_lo) cg::this_grid().sync(); else GSYNC(); }
  }
}

extern "C" void kernel_launch(void* const* d_in, const int* in_sizes, int n_in, void* d_out, int out_size, void* d_ws,
                              size_t ws_size, hipStream_t stream) {
  static int grid_blocks = 0;
  if (!grid_blocks) {
    int dev = 0, cus = 0, per_cu = 0;
    (void)hipGetDevice(&dev);
    (void)hipDeviceGetAttribute(&cus, hipDeviceAttributeMultiprocessorCount, dev);
    (void)hipFuncSetAttribute((const void*)mega, hipFuncAttributeMaxDynamicSharedMemorySize, LDS_BYTES);
    (void)hipOccupancyMaxActiveBlocksPerMultiprocessor(&per_cu, mega, NTHR, LDS_BYTES);
    if (per_cu < 1) per_cu = 1;
    if (per_cu > 1) per_cu = 1;
    grid_blocks = cus * per_cu;
  }
  if (ws_size < WS_NEED) { fprintf(stderr, "workspace too small: %zu < %zu\n", ws_size, (size_t)WS_NEED); }
  Params p{};
  const float** pf = (const float**)&p;
  for (int i = 0; i < 26; ++i) pf[i] = (const float*)d_in[i];
  p.out = (float*)d_out;
  p.ws = (char*)d_ws;
  (void)hipMemsetAsync((char*)d_ws + OFF_CNT, 0, 256 + 3456 * 4, stream);
#if ONE_LAUNCH
  int lo = 0, hi = NPHASE;
  void* args[] = {&p, &lo, &hi};
  hipError_t e = hipLaunchCooperativeKernel((void*)mega, dim3(grid_blocks), dim3(NTHR), args, LDS_BYTES, stream);
  if (e != hipSuccess) fprintf(stderr, "cooperative launch failed: %s (grid %d)\n", hipGetErrorString(e), grid_blocks);
#else
  for (int ph = 0; ph < NPHASE; ++ph) mega<<<grid_blocks, NTHR, LDS_BYTES, stream>>>(p, ph, ph + 1);
#endif
}
```

```cpp
#include <hip/hip_runtime.h>
#include <hip/hip_cooperative_groups.h>
#include <cstdio>
#include <cstdint>
namespace cg = cooperative_groups;

#ifndef PROBE
#define PROBE 0
#endif
#ifndef ONE_LAUNCH
#define ONE_LAUNCH 1
#endif

typedef unsigned short u16;
typedef short bf16x8 __attribute__((ext_vector_type(8)));
typedef short s16x4 __attribute__((ext_vector_type(4)));
typedef float f32x16 __attribute__((ext_vector_type(16)));
typedef float f32x2v __attribute__((ext_vector_type(2)));
typedef __bf16 bf16x2v __attribute__((ext_vector_type(2)));
#define DI __device__ __forceinline__
#define MFMA(a, b, c) __builtin_amdgcn_mfma_f32_32x32x16_bf16((a), (b), (c), 0, 0, 0)

constexpr int DM = 1024, NBATCH = 32, SEQ = 2048, CTXL = 256, DEPTH = 4, DFF = 4096;
constexpr int NG = 2, NB = 16, TPB = 2304, NTOK = NB * TPB;
constexpr int PS = 5376, NPC = 5328, INW = 9424;
constexpr int A_I = 0, A_FF = 512, A_FB = 1024, B_K = 1536, B_V = 1792, B_G = 2304, C_K = 2320, C_V = 2448,
              D_CKV = 2576, D_KR = 2704, A_Q = 2768, A_G = 3280, B_Q = 3792, B_O = 4048, C_Q = 4560, D_CQ = 5072;
constexpr float EPS = 1e-6f;
constexpr float LOG2E = 1.4426950408889634f;

constexpr size_t al256(size_t x) { return (x + 255) & ~(size_t)255; }
constexpr size_t OFF_WINT = 0;
constexpr size_t OFF_WGT = OFF_WINT + al256((size_t)PS * 1024 * 2);
constexpr size_t OFF_WBT = OFF_WGT + al256((size_t)4096 * 1024 * 2);
constexpr size_t OFF_WOT = OFF_WBT + al256((size_t)4 * 1024 * 512 * 2);
constexpr size_t OFF_W1T = OFF_WOT + al256((size_t)1024 * 1024 * 2);
constexpr size_t OFF_W2T = OFF_W1T + al256((size_t)4096 * 1024 * 2);
constexpr size_t OFF_WUQ = OFF_W2T + al256((size_t)1024 * 4096 * 2);
constexpr size_t OFF_WUK = OFF_WUQ + al256((size_t)768 * 256 * 2);
constexpr size_t OFF_WUV = OFF_WUK + al256((size_t)512 * 128 * 2);
constexpr size_t OFF_MOD = OFF_WUV + al256((size_t)512 * 128 * 2);
constexpr size_t OFF_LB = OFF_MOD + al256((size_t)4 * 33 * 6144 * 4);
constexpr size_t OFF_ROPE = OFF_LB + al256((size_t)4 * 2 * 512 * 4);
constexpr size_t OFF_CNT = OFF_ROPE + al256((size_t)2 * 64 * 16 * 4);
constexpr size_t OFF_BAR = OFF_CNT + 256;
constexpr size_t OFF_XC = OFF_BAR + al256(3456 * 4);
constexpr size_t OFF_XL = OFF_XC + al256((size_t)NBATCH * CTXL * DM * 2);
constexpr size_t OFF_P = OFF_XL + al256((size_t)NBATCH * SEQ * DM * 2);
constexpr size_t OFF_GB = OFF_P + al256((size_t)NTOK * PS * 2);
constexpr size_t OFF_KQ = OFF_GB + al256((size_t)NTOK * 16 * 4);
constexpr size_t OFF_H = OFF_KQ + al256((size_t)NTOK * 512 * 2);
constexpr size_t OFF_QD = OFF_H + al256((size_t)NTOK * 1024 * 2);
constexpr size_t OFF_KD = OFF_QD + al256((size_t)NTOK * 768 * 2);
constexpr size_t OFF_VD = OFF_KD + al256((size_t)NTOK * 768 * 2);
constexpr size_t OFF_OA = OFF_VD + al256((size_t)NTOK * 512 * 2);
constexpr size_t OFF_OB = OFF_OA + al256((size_t)2 * NTOK * 512 * 2);
constexpr size_t OFF_W2ND = OFF_OB + al256((size_t)2 * NTOK * 512 * 2);
constexpr size_t WS_NEED = OFF_W2ND + (OFF_MOD - OFF_WINT);
constexpr int LDS_BYTES = 143360;
constexpr int LDSV = 69632;
constexpr int NTHR = 512;
constexpr size_t OFF_MF = OFF_QD;

struct Params {
  const float *x, *c, *ctx, *c_ctx, *w_ada, *b_ada, *g1, *g2, *w_in, *bgate, *lblog, *hnorm, *convw, *mnorm,
      *gqn, *gkn, *mqn, *mkvn, *wuq, *wuk, *wuv, *wbr, *wout, *wff1, *wff2, *gfin;
  float* out;
  char* ws;
};

DI int otid() { int t = threadIdx.x; asm volatile("" : "+v"(t)); return t; }
DI char* wsel(const Params& p, int l) { return p.ws + ((l & 1) ? OFF_W2ND : (size_t)0); }
DI float bf2f(u16 v) { return __uint_as_float(((unsigned)v) << 16); }
DI unsigned pack2(float a, float b) {
  f32x2v v = {a, b};
  bf16x2v r = __builtin_convertvector(v, bf16x2v);
  return __builtin_bit_cast(unsigned, r);
}
DI u16 f2bf(float a) { return (u16)(pack2(a, 0.f) & 0xffffu); }
DI int crow(int reg, int h) { return (reg & 3) + 8 * (reg >> 2) + 4 * h; }
DI float sigmoidf_(float x) { return 1.f / (1.f + __expf(-x)); }
DI float siluf_(float x) { return x / (1.f + __expf(-x)); }
DI float ex2(float x) { return __builtin_amdgcn_exp2f(x); }
DI bf16x8 pack8(const f32x16& x, int s) {
  union { unsigned u[4]; bf16x8 v; } t;
  t.u[0] = pack2(x[8 * s + 0], x[8 * s + 1]);
  t.u[1] = pack2(x[8 * s + 2], x[8 * s + 3]);
  t.u[2] = pack2(x[8 * s + 4], x[8 * s + 5]);
  t.u[3] = pack2(x[8 * s + 6], x[8 * s + 7]);
  return t.v;
}
DI bf16x8 cat4(s16x4 lo, s16x4 hi) { return __builtin_shufflevector(lo, hi, 0, 1, 2, 3, 4, 5, 6, 7); }
DI float wave_sum(float v) {
#pragma unroll
  for (int d = 32; d >= 1; d >>= 1) v += __shfl_xor(v, d);
  return v;
}
DI void unpack8(const uint4& q, float* f) {
  f[0] = __uint_as_float(q.x << 16); f[1] = __uint_as_float(q.x & 0xffff0000u);
  f[2] = __uint_as_float(q.y << 16); f[3] = __uint_as_float(q.y & 0xffff0000u);
  f[4] = __uint_as_float(q.z << 16); f[5] = __uint_as_float(q.z & 0xffff0000u);
  f[6] = __uint_as_float(q.w << 16); f[7] = __uint_as_float(q.w & 0xffff0000u);
}
DI uint4 pack8f(const float* f) {
  uint4 q;
  q.x = pack2(f[0], f[1]); q.y = pack2(f[2], f[3]); q.z = pack2(f[4], f[5]); q.w = pack2(f[6], f[7]);
  return q;
}

DI u16* xrow_ptr(const Params& p, int g, int tok, int& modrow) {
  int bl = tok / TPB, pp = tok - bl * TPB, b = g * NB + bl;
  if (pp < CTXL) { modrow = 32; return (u16*)(p.ws + OFF_XC) + ((size_t)b * CTXL + pp) * DM; }
  modrow = b;
  return (u16*)(p.ws + OFF_XL) + ((size_t)b * SEQ + (pp - CTXL)) * DM;
}

#define LAS __attribute__((address_space(3)))
typedef float f32x4 __attribute__((ext_vector_type(4)));
namespace pg8 {
constexpr int BM = 256, BK = 64, HALF = 128, HTB = HALF * BK * 2, STAGE_BYTES = 8 * HTB, NXCD = 8, WGM = 8;
DI int lds_byte(int r, int c) { const int st = (r >> 4) * 2 + (c >> 5), rr = r & 15, cc = c & 31, ob = rr * 64 + cc * 2; return st * 1024 + (ob ^ (((ob >> 9) & 1) << 5)); }
DI void stage_rc(int b, int& R, int& C) { const int st = b / 1024, sb = b % 1024, swz = sb ^ (((sb >> 9) & 1) << 5); R = (st >> 1) * 16 + swz / 64; C = (st & 1) * 32 + (swz % 64) / 2; }
DI int perm32(int rho) { const int n = rho >> 4, i = rho & 15; return 8 * (i >> 2) + 4 * n + (i & 3); }
struct UDesc { const char* A; const char* B; unsigned lda2, ldb2; int nt, pm, pn, tag; };
DI bool tile_order(long L, int nM, int nN, int& pm, int& pn) {
  const int nwg = nM * nN; if (L >= nwg) return false;
  int wgid = (int)L; { const int q = nwg / NXCD, r = nwg % NXCD, xcd = wgid % NXCD, off = wgid / NXCD; wgid = (xcd < r ? xcd * (q + 1) : r * (q + 1) + (xcd - r) * q) + off; }
  const int nig = WGM * nN, gid = wgid / nig, fm = gid * WGM, gsz = (nM - fm) < WGM ? (nM - fm) : WGM;
  pm = fm + ((wgid % nig) % gsz); pn = (wgid % nig) / gsz; return true;
}
template <class Epi, class Sched>
DI void gemm_stream(LAS unsigned char* lds, const Sched& S, const Epi& E) {
  const int tid = otid(), wid = __builtin_amdgcn_readfirstlane(tid >> 6), lane = tid & 63, wr = wid >> 2, wc = wid & 3, fr = lane & 15, fq = lane >> 4;
  int RA[2], RB[2], CC[2];
#pragma unroll
  for (int i = 0; i < 2; ++i) { int R, C; stage_rc(tid * 16 + i * 8192, R, C); RA[i] = R; RB[i] = (R & ~31) + perm32(R & 31); CC[i] = C * 2; }
  const size_t kstep = (size_t)(BK * 2);
  const unsigned ldsw = (unsigned)wid * 1024u;
  const int aoff = lds_byte(wr * 64 + fr, fq * 8), boff = lds_byte(wc * 32 + fr, fq * 8);
#define PG8_SA(b, h) (((b) * 2 + (h)) * HTB)
#define PG8_SB(b, h) ((4 + (b) * 2 + (h)) * HTB)
#define PG8_STAGE(bufoff, gbase, voff) do { _Pragma("unroll") for (int _i = 0; _i < 2; ++_i) \
    __builtin_amdgcn_global_load_lds((const unsigned*)((const char*)(gbase) + (voff)[_i]), (LAS unsigned*)(lds + (bufoff) + ldsw + _i * 8192), 16, 0, 0); } while (0)
#define PG8_LDA(dst, b, h) do { _Pragma("unroll") for (int m = 0; m < 4; ++m) _Pragma("unroll") for (int k = 0; k < 2; ++k) dst[m][k] = *(const LAS bf16x8*)(lds + PG8_SA(b, h) + aoff + m * 2048 + k * 1024); } while (0)
#define PG8_LDB(dst, b, h) do { _Pragma("unroll") for (int n = 0; n < 2; ++n) _Pragma("unroll") for (int k = 0; k < 2; ++k) dst[n][k] = *(const LAS bf16x8*)(lds + PG8_SB(b, h) + boff + n * 2048 + k * 1024); } while (0)
#define PG8_MMA(ai, bj, At, Bt) do { __builtin_amdgcn_s_setprio(1); _Pragma("unroll") for (int m = 0; m < 4; ++m) _Pragma("unroll") for (int n = 0; n < 2; ++n) _Pragma("unroll") for (int k = 0; k < 2; ++k) \
    acc[ai][bj][m][n] = __builtin_amdgcn_mfma_f32_16x16x32_bf16(Bt[n][k], At[m][k], acc[ai][bj][m][n], 0, 0, 0); __builtin_amdgcn_s_setprio(0); } while (0)
#define PG8_WAIT_V(n) asm volatile("s_waitcnt vmcnt(" #n ")" ::: "memory")
#define PG8_WAIT_L(n) asm volatile("s_waitcnt lgkmcnt(" #n ")" ::: "memory")
#define PG8_BAR __builtin_amdgcn_s_barrier()
#define PG8_SCHED __builtin_amdgcn_sched_barrier(0)
  UDesc cur, nxt; int ui = 0;
  if (!S.next(0, cur)) return;
  f32x4 acc[2][2][4][2];
#pragma unroll
  for (int a = 0; a < 2; ++a)
#pragma unroll
    for (int b = 0; b < 2; ++b)
#pragma unroll
      for (int m = 0; m < 4; ++m)
#pragma unroll
        for (int n = 0; n < 2; ++n) acc[a][b][m][n] = (f32x4){0.f, 0.f, 0.f, 0.f};
  bf16x8 At[4][2], B0[2][2], B1[2][2];
  const char* cA = cur.A; const char* cB = cur.B;
  unsigned vA[2], vB[2];
#pragma unroll
  for (int i = 0; i < 2; ++i) { vA[i] = (unsigned)RA[i] * cur.lda2 + CC[i]; vB[i] = (unsigned)RB[i] * cur.ldb2 + CC[i]; }
  size_t hA = (size_t)HALF * cur.lda2, hB = (size_t)HALF * cur.ldb2;
  PG8_STAGE(PG8_SB(0, 0), cB, vB); PG8_STAGE(PG8_SA(0, 0), cA, vA); PG8_STAGE(PG8_SB(0, 1), cB + hB, vB); PG8_STAGE(PG8_SA(0, 1), cA + hA, vA);
  if (wr == 1) PG8_BAR;
  PG8_WAIT_V(4); PG8_BAR;
  PG8_STAGE(PG8_SB(1, 0), cB + kstep, vB); PG8_STAGE(PG8_SA(1, 0), cA + kstep, vA); PG8_STAGE(PG8_SB(1, 1), cB + hB + kstep, vB);
  PG8_WAIT_V(6); PG8_BAR;
  for (;;) {
    const bool has_next = S.next(ui + 1, nxt);
    const char* nA = has_next ? nxt.A : cA; const char* nB = has_next ? nxt.B : cB;
    const unsigned nlda = has_next ? nxt.lda2 : cur.lda2, nldb = has_next ? nxt.ldb2 : cur.ldb2;
    unsigned nvA[2], nvB[2];
#pragma unroll
    for (int i = 0; i < 2; ++i) { nvA[i] = (unsigned)RA[i] * nlda + CC[i]; nvB[i] = (unsigned)RB[i] * nldb + CC[i]; }
    const size_t nhA = (size_t)HALF * nlda, nhB = (size_t)HALF * nldb;
    const int nt = cur.nt;
    for (int t = 0; t < nt; t += 2) {
      const bool last = (t == nt - 2);
      const char* a1 = cA + (size_t)(t + 1) * kstep;
      const char* a2 = last ? nA : cA + (size_t)(t + 2) * kstep; const char* b2 = last ? nB : cB + (size_t)(t + 2) * kstep;
      const char* a3 = a2 + kstep; const char* b3 = b2 + kstep;
      unsigned v2A[2], v2B[2];
#pragma unroll
      for (int i = 0; i < 2; ++i) { v2A[i] = last ? nvA[i] : vA[i]; v2B[i] = last ? nvB[i] : vB[i]; }
      const size_t h2A = last ? nhA : hA, h2B = last ? nhB : hB;
      PG8_LDB(B0, 0, 0); PG8_SCHED; PG8_LDA(At, 0, 0); PG8_STAGE(PG8_SA(1, 1), a1 + hA, vA);
      PG8_WAIT_L(8); PG8_BAR; PG8_WAIT_L(0); PG8_MMA(0, 0, At, B0); PG8_BAR; PG8_SCHED;
      PG8_LDB(B1, 0, 1); PG8_STAGE(PG8_SB(0, 0), b2, v2B);
      PG8_BAR; PG8_WAIT_L(0); PG8_MMA(0, 1, At, B1); PG8_BAR;
      PG8_LDA(At, 0, 1); PG8_STAGE(PG8_SA(0, 0), a2, v2A);
      PG8_BAR; PG8_WAIT_L(0); PG8_MMA(1, 0, At, B0); PG8_BAR; PG8_SCHED;
      PG8_STAGE(PG8_SB(0, 1), b2 + h2B, v2B);
      PG8_WAIT_V(6); PG8_BAR; PG8_MMA(1, 1, At, B1); PG8_BAR;
      PG8_LDB(B0, 1, 0); PG8_SCHED; PG8_LDA(At, 1, 0); PG8_STAGE(PG8_SA(0, 1), a2 + h2A, v2A);
      PG8_WAIT_L(8); PG8_BAR; PG8_WAIT_L(0); PG8_MMA(0, 0, At, B0); PG8_BAR; PG8_SCHED;
      PG8_LDB(B1, 1, 1); PG8_STAGE(PG8_SB(1, 0), b3, v2B);
      PG8_BAR; PG8_WAIT_L(0); PG8_MMA(0, 1, At, B1); PG8_BAR;
      PG8_LDA(At, 1, 1); PG8_STAGE(PG8_SA(1, 0), a3, v2A);
      PG8_BAR; PG8_WAIT_L(0); PG8_MMA(1, 0, At, B0); PG8_BAR; PG8_SCHED;
      PG8_STAGE(PG8_SB(1, 1), b3 + h2B, v2B);
      PG8_WAIT_V(6); PG8_BAR; PG8_MMA(1, 1, At, B1); PG8_BAR;
    }
    const bool keep = E(acc, cur, wr, wc, fr, fq);
    if (!has_next) break;
    if (!keep) {
#pragma unroll
      for (int a = 0; a < 2; ++a)
#pragma unroll
        for (int b = 0; b < 2; ++b)
#pragma unroll
          for (int m = 0; m < 4; ++m)
#pragma unroll
            for (int n = 0; n < 2; ++n) acc[a][b][m][n] = (f32x4){0.f, 0.f, 0.f, 0.f};
    }
    cur = nxt; cA = nA; cB = nB; hA = nhA; hB = nhB;
#pragma unroll
    for (int i = 0; i < 2; ++i) { vA[i] = nvA[i]; vB[i] = nvB[i]; }
    ++ui;
  }
  PG8_WAIT_V(0);
  if (wr == 0) PG8_BAR;
  PG8_BAR;
#undef PG8_SA
#undef PG8_SB
#undef PG8_STAGE
#undef PG8_LDA
#undef PG8_LDB
#undef PG8_MMA
#undef PG8_WAIT_V
#undef PG8_WAIT_L
#undef PG8_BAR
#undef PG8_SCHED
}
struct PlainSched {
  const char* A; const char* B; unsigned lda2, ldb2; int nt, nM, nN, G, c; int lat_only = 0;
  DI bool next(int i, UDesc& u) const {
    int pm, pn; if (!tile_order((long)i * G + c, lat_only ? nM - NB : nM, nN, pm, pn)) return false;
    if (lat_only) pm = pm + (pm >> 3) + 1;
    u.A = A + (size_t)pm * 256 * lda2; u.B = B + (size_t)pn * 256 * ldb2; u.lda2 = lda2; u.ldb2 = ldb2; u.nt = nt; u.pm = pm; u.pn = pn; u.tag = 0; return true;
  }
};
}

DI uint4 pk8(const f32x4& a, const f32x4& b) {
  uint4 q; q.x = pack2(a[0], a[1]); q.y = pack2(a[2], a[3]); q.z = pack2(b[0], b[1]); q.w = pack2(b[2], b[3]); return q;
}

__device__ void phase_prep(const Params& p, char* lds) {
  const int tid = otid(), nthr = gridDim.x * NTHR, gt = blockIdx.x * NTHR + tid;
  {
    const float4* s = (const float4*)p.x; uint2* d = (uint2*)(p.ws + OFF_XL);
    const size_t n = (size_t)NBATCH * SEQ * DM / 4;
    for (size_t i = gt; i < n; i += nthr) { const float4 v = s[i]; uint2 o; o.x = pack2(v.x, v.y); o.y = pack2(v.z, v.w); d[i] = o; }
    const float4* s2 = (const float4*)p.ctx; uint2* d2 = (uint2*)(p.ws + OFF_XC);
    const size_t n2 = (size_t)NBATCH * CTXL * DM / 4;
    for (size_t i = gt; i < n2; i += nthr) { const float4 v = s2[i]; uint2 o; o.x = pack2(v.x, v.y); o.y = pack2(v.z, v.w); d2[i] = o; }
  }
  if (gt < 1024) {
    float v[DEPTH], mx = -1e30f;
    for (int l = 0; l < DEPTH; ++l) { v[l] = p.lblog[l * 1024 + gt]; mx = fmaxf(mx, v[l]); }
    float sum = 0.f;
    for (int l = 0; l < DEPTH; ++l) { v[l] = expf(v[l] - mx); sum += v[l]; }
    float* lb = (float*)(p.ws + OFF_LB);
    float run = 0.f;
    for (int l = 0; l < DEPTH; ++l) { lb[l * 1024 + gt] = run; if (l + 1 < DEPTH) run += v[l + 1] / sum; }
  }
  if (gt >= 1024 && gt < 2048) {
    int i = gt - 1024, pos = i >> 4, fi = i & 15;
    float inv = powf(10000.f, -(float)fi / 16.f);
    float ang = (float)pos * inv;
    float* rc = (float*)(p.ws + OFF_ROPE);
    rc[i] = cosf(ang); rc[1024 + i] = sinf(ang);
  }
  float* ssm = (float*)lds;
  float* red = (float*)lds + 2 * 33 * 32;
  for (int item = blockIdx.x; item < DEPTH * 24; item += gridDim.x) {
    const int l = item / 24, kh = tid >> 8, tl = tid & 255, j = (item % 24) * 256 + tl;
    float acc[33];
#pragma unroll
    for (int r = 0; r < 33; ++r) acc[r] = 0.f;
    const float* W = p.w_ada + (size_t)l * DM * 6144;
    for (int k0 = kh * 512; k0 < kh * 512 + 512; k0 += 32) {
      __syncthreads();
      for (int idx = tl; idx < 33 * 32; idx += 256) {
        int rr = idx >> 5, kk = idx & 31;
        float cv = rr < 32 ? p.c[rr * DM + k0 + kk] : p.c_ctx[k0 + kk];
        ssm[kh * 33 * 32 + idx] = cv / (1.f + expf(-cv));
      }
      __syncthreads();
#pragma unroll 16
      for (int kk = 0; kk < 32; ++kk) {
        float w = W[(size_t)(k0 + kk) * 6144 + j];
#pragma unroll
        for (int r = 0; r < 33; ++r) acc[r] += ssm[kh * 33 * 32 + r * 32 + kk] * w;
      }
    }
    __syncthreads();
    if (kh == 1) {
#pragma unroll
      for (int r = 0; r < 33; ++r) red[r * 256 + tl] = acc[r];
    }
    __syncthreads();
    if (kh == 0) {
      float bb = p.b_ada[l * 6144 + j];
      float* mod = (float*)(p.ws + OFF_MOD) + (size_t)l * 33 * 6144;
#pragma unroll
      for (int r = 0; r < 33; ++r) mod[r * 6144 + j] = acc[r] + red[r * 256 + tl] + bb;
    }
  }
  __syncthreads();
}

DI u16* wdst(char* wb, int type, int sub, int n) {
  switch (type) {
    case 0: return n < NPC ? (u16*)(wb + OFF_WINT) + (size_t)n * 1024 : (u16*)(wb + OFF_WGT) + (size_t)(n - NPC) * 1024;
    case 1: return (u16*)(wb + OFF_WBT) + ((size_t)sub * 1024 + n) * 512;
    case 2: return (u16*)(wb + OFF_WOT) + (size_t)n * 1024;
    case 3: return (u16*)(wb + OFF_W1T) + (size_t)n * 1024;
    case 4: return (u16*)(wb + OFF_W2T) + (size_t)n * 4096;
    case 5: return (u16*)(wb + OFF_WUQ) + (size_t)n * 256;
    case 6: return (u16*)(wb + OFF_WUK) + (size_t)n * 128;
    default: return (u16*)(wb + OFF_WUV) + (size_t)n * 128;
  }
}
__device__ void phase_wconv(const Params& p, int l, char* lds, int* cnt = nullptr) {
  char* wb = wsel(p, l);
  int* s_item = (int*)(lds + LDS_BYTES - 16);
  float* tile = (float*)lds;
  const int tid = otid();
  {
    unsigned* z = (unsigned*)((u16*)(wb + OFF_WINT) + (size_t)NPC * 1024);
    for (int i = blockIdx.x * NTHR + tid; i < (PS - NPC) * 1024 / 2; i += gridDim.x * NTHR) z[i] = 0u;
  }
  constexpr int T0 = 16 * 148, T1 = T0 + 4 * 128, T2 = T1 + 256, T3 = T2 + 1024, T4 = T3 + 1024, T5 = T4 + 48, T6 = T5 + 16, T7 = T6 + 16;
  for (int itk = 0;; ++itk) {
    int it;
    if (cnt) { __syncthreads(); if (tid == 0) *s_item = atomicAdd(cnt, 1); __syncthreads(); it = *s_item; }
    else it = blockIdx.x + itk * gridDim.x;
    if (it >= T7) break;
    int type, sub = 0, K, N, kt, nt;
    const float* src;
    if (it < T0) { type = 0; K = 1024; N = INW; int q = it; kt = q / 148; nt = q % 148; src = p.w_in + (size_t)l * 1024 * INW; }
    else if (it < T1) { type = 1; K = 512; N = 1024; int q = it - T0; sub = q / 128; q %= 128; kt = q / 16; nt = q % 16; src = p.wbr + ((size_t)l * 4 + sub) * 512 * 1024; }
    else if (it < T2) { type = 2; K = 1024; N = 1024; int q = it - T1; kt = q / 16; nt = q % 16; src = p.wout + (size_t)l * 1024 * 1024; }
    else if (it < T3) { type = 3; K = 1024; N = 4096; int q = it - T2; kt = q / 64; nt = q % 64; src = p.wff1 + (size_t)l * 1024 * 4096; }
    else if (it < T4) { type = 4; K = 4096; N = 1024; int q = it - T3; kt = q / 16; nt = q % 16; src = p.wff2 + (size_t)l * 4096 * 1024; }
    else if (it < T5) { type = 5; K = 256; N = 768; int q = it - T4; kt = q / 12; nt = q % 12; src = p.wuq + (size_t)l * 256 * 768; }
    else if (it < T6) { type = 6; K = 128; N = 512; int q = it - T5; kt = q / 8; nt = q % 8; src = p.wuk + (size_t)l * 128 * 512; }
    else { type = 7; K = 128; N = 512; int q = it - T6; kt = q / 8; nt = q % 8; src = p.wuv + (size_t)l * 128 * 512; }
    (void)K;
    const int k0 = kt * 64, n0 = nt * 64;
    __syncthreads();
    {
      const int nn = tid & 63, ks = tid >> 6;
#pragma unroll 4
      for (int j = 0; j < 8; ++j) {
        int k = ks + 8 * j;
        tile[k * 65 + nn] = (n0 + nn < N) ? src[(size_t)(k0 + k) * N + n0 + nn] : 0.f;
      }
    }
    __syncthreads();
    {
      const int kp = tid & 31, nn = tid >> 5;
#pragma unroll 4
      for (int j = 0; j < 4; ++j) {
        int n = nn + 16 * j;
        if (n0 + n < N) {
          unsigned v = pack2(tile[(2 * kp) * 65 + n], tile[(2 * kp + 1) * 65 + n]);
          *(unsigned*)(wdst(wb, type, sub, n0 + n) + k0 + 2 * kp) = v;
        }
      }
    }
  }
  __syncthreads();
}

DI void norm_token(const Params& p, int l, int g, int which, int tok, int lane, const float* gn, const float* mod, u16* H) {
  int mr; const u16* xr = xrow_ptr(p, g, tok, mr);
  const float* shift = mod + (size_t)mr * 6144 + (which == 0 ? 0 : 3) * DM;
  const float* scale = shift + DM;
  float4 v[4]; float ss = 0.f;
#pragma unroll
  for (int j = 0; j < 4; ++j) {
    const uint2 q = *(const uint2*)(xr + j * 256 + lane * 4);
    v[j].x = __uint_as_float(q.x << 16); v[j].y = __uint_as_float(q.x & 0xffff0000u); v[j].z = __uint_as_float(q.y << 16); v[j].w = __uint_as_float(q.y & 0xffff0000u);
    ss += v[j].x * v[j].x + v[j].y * v[j].y + v[j].z * v[j].z + v[j].w * v[j].w;
  }
  ss = wave_sum(ss);
  const float rstd = rsqrtf(ss * (1.f / DM) + EPS);
#pragma unroll
  for (int j = 0; j < 4; ++j) {
    int c = j * 256 + lane * 4;
    float4 gg = *(const float4*)(gn + c), sh = *(const float4*)(shift + c), sc = *(const float4*)(scale + c);
    float o0 = v[j].x * rstd * gg.x * (1.f + sc.x) + sh.x;
    float o1 = v[j].y * rstd * gg.y * (1.f + sc.y) + sh.y;
    float o2 = v[j].z * rstd * gg.z * (1.f + sc.z) + sh.z;
    float o3 = v[j].w * rstd * gg.w * (1.f + sc.w) + sh.w;
    uint2 o; o.x = pack2(o0, o1); o.y = pack2(o2, o3);
    *(uint2*)(H + (size_t)tok * DM + c) = o;
  }
}
DI void norm_load(const u16* xr, int lane, uint2 (&q)[4]) {
#pragma unroll
  for (int j = 0; j < 4; ++j) q[j] = *(const uint2*)(xr + j * 256 + lane * 4);
}
DI void norm_mod_load(const float* shift, int lane, float4 (&shv)[4], float4 (&scv)[4]) {
#pragma unroll
  for (int j = 0; j < 4; ++j) { const int c = j * 256 + lane * 4; shv[j] = *(const float4*)(shift + c); scv[j] = *(const float4*)(shift + DM + c); }
}
DI void norm_finish2(const uint2 (&q)[4], int lane, const float4 (&ggv)[4], const float4 (&shv)[4], const float4 (&scv)[4], u16* hrow) {
  float4 v[4]; float ss = 0.f;
#pragma unroll
  for (int j = 0; j < 4; ++j) {
    v[j].x = __uint_as_float(q[j].x << 16); v[j].y = __uint_as_float(q[j].x & 0xffff0000u); v[j].z = __uint_as_float(q[j].y << 16); v[j].w = __uint_as_float(q[j].y & 0xffff0000u);
    ss += v[j].x * v[j].x + v[j].y * v[j].y + v[j].z * v[j].z + v[j].w * v[j].w;
  }
  ss = wave_sum(ss);
  const float rstd = rsqrtf(ss * (1.f / DM) + EPS);
#pragma unroll
  for (int j = 0; j < 4; ++j) {
    const int c = j * 256 + lane * 4;
    const float4 gg = ggv[j], sh = shv[j], sc = scv[j];
    float o0 = v[j].x * rstd * gg.x * (1.f + sc.x) + sh.x;
    float o1 = v[j].y * rstd * gg.y * (1.f + sc.y) + sh.y;
    float o2 = v[j].z * rstd * gg.z * (1.f + sc.z) + sh.z;
    float o3 = v[j].w * rstd * gg.w * (1.f + sc.w) + sh.w;
    uint2 o; o.x = pack2(o0, o1); o.y = pack2(o2, o3);
    *(uint2*)(hrow + c) = o;
  }
}
DI void norm_finish(const uint2 (&q)[4], int lane, const float* gn, const float* shift, u16* hrow) {
  float4 ggv[4], shv[4], scv[4];
#pragma unroll
  for (int j = 0; j < 4; ++j) ggv[j] = *(const float4*)(gn + j * 256 + lane * 4);
  norm_mod_load(shift, lane, shv, scv);
  norm_finish2(q, lane, ggv, shv, scv, hrow);
}
__device__ void phase_norm(const Params& p, int l, int g, int which) {
  const int tid = otid(), lane = tid & 63, wid = tid >> 6;
  const float* gn = (which == 0 ? p.g1 : p.g2) + l * DM;
  const float* mod = (const float*)(p.ws + OFF_MOD) + (size_t)l * 33 * 6144;
  u16* H = (u16*)(p.ws + OFF_H);
  const int stride = gridDim.x * 8;
  float4 ggh[4];
#pragma unroll
  for (int j = 0; j < 4; ++j) ggh[j] = *(const float4*)(gn + j * 256 + lane * 4);
  const bool skipc = which == 1 && l == DEPTH - 1;
  for (int tok = blockIdx.x * 8 + wid; tok < NTOK; tok += 2 * stride) {
    const int tokB = tok + stride;
    const bool doA = !(skipc && (tok % TPB) < CTXL), doB = tokB < NTOK && !(skipc && (tokB % TPB) < CTXL);
    int mrA = 0, mrB = 0;
    const u16* xa = xrow_ptr(p, g, tok, mrA);
    const u16* xb = xrow_ptr(p, g, doB ? tokB : tok, mrB);
    uint2 qa[4], qb[4];
    float4 shA[4], scA[4], shB[4], scB[4];
    norm_load(xa, lane, qa);
    norm_load(xb, lane, qb);
    norm_mod_load(mod + (size_t)mrA * 6144 + (which == 0 ? 0 : 3) * DM, lane, shA, scA);
    norm_mod_load(mod + (size_t)mrB * 6144 + (which == 0 ? 0 : 3) * DM, lane, shB, scB);
    if (doA) norm_finish2(qa, lane, ggh, shA, scA, H + (size_t)tok * DM);
    if (doB) norm_finish2(qb, lane, ggh, shB, scB, H + (size_t)tokB * DM);
  }
}
__device__ void phase_norm_dyn(const Params& p, int l, int g, int* cnt) {
  const int tid = otid(), lane = tid & 63;
  const float* gn = p.g1 + l * DM;
  const float* mod = (const float*)(p.ws + OFF_MOD) + (size_t)l * 33 * 6144;
  u16* H = (u16*)(p.ws + OFF_H);
  for (;;) {
    int c = 0;
    if (lane == 0) c = atomicAdd(cnt, 1);
    c = __shfl(c, 0);
    if (c >= NTOK / 8) break;
#pragma unroll 1
    for (int t = 0; t < 8; t += 2) {
      const int tokA = c * 8 + t, tokB = tokA + 1;
      int mrA = 0, mrB = 0;
      const u16* xa = xrow_ptr(p, g, tokA, mrA);
      const u16* xb = xrow_ptr(p, g, tokB, mrB);
      uint2 qa[4], qb[4];
      norm_load(xa, lane, qa);
      norm_load(xb, lane, qb);
      norm_finish(qa, lane, gn, mod + (size_t)mrA * 6144, H + (size_t)tokA * DM);
      norm_finish(qb, lane, gn, mod + (size_t)mrB * 6144, H + (size_t)tokB * DM);
    }
  }
}

__device__ void phase_tokprep(const Params& p, int l) {
  const int tid = otid(), lane = tid & 63, wid = tid >> 6;
  u16* P = (u16*)(p.ws + OFF_P);
  u16* KQ = (u16*)(p.ws + OFF_KQ);
  u16* Kd = (u16*)(p.ws + OFF_KD);
  const float* rc = (const float*)(p.ws + OFF_ROPE);
  const float* rs = rc + 1024;
  const int c8 = lane & 7;
  const bool isk_ = lane < 32;
  float cwv[24], gqv[8], gkv[8], gmv[8];
  {
    const float* cw = p.convw + ((size_t)l * 2 + (isk_ ? 1 : 0)) * 3 * 256 + (isk_ ? lane : lane - 32) * 8;
#pragma unroll
    for (int e = 0; e < 8; ++e) { cwv[e] = cw[e]; cwv[8 + e] = cw[256 + e]; cwv[16 + e] = cw[512 + e]; }
    const float* gq = p.gqn + l * 64 + c8 * 8; const float* gk = p.gkn + l * 64 + c8 * 8;
    const float* gm = lane < 16 ? p.mkvn + l * 128 + lane * 8 : p.mqn + l * 256 + ((lane >= 32 ? lane - 32 : 0)) * 8;
#pragma unroll
    for (int e = 0; e < 8; ++e) { gqv[e] = gq[e]; gkv[e] = gk[e]; gmv[e] = gm[e]; }
  }
  const uint4 zz = {0u, 0u, 0u, 0u};
  const int convcol = (isk_ ? B_K : B_Q) + (isk_ ? lane : lane - 32) * 8;
  const int mcol = lane < 16 ? D_CKV + lane * 8 : (lane >= 32 ? D_CQ + (lane - 32) * 8 : D_KR + ((lane - 16) & 7) * 8);
  uint4 n_q = zz, n_k = zz, n_m = zz, n_c0 = zz, n_c1 = zz, n_c2 = zz;
#define TOKPREP_LOAD(tok_) do { const int pp_ = (tok_) % TPB; const u16* row_ = P + (size_t)(tok_) * PS; \
    n_q = *(const uint4*)(row_ + C_Q + lane * 8); n_k = lane < 16 ? *(const uint4*)(row_ + C_K + lane * 8) : zz; n_m = *(const uint4*)(row_ + mcol); \
    n_c1 = *(const uint4*)(row_ + convcol); \
    n_c0 = !(pp_ == 0 || pp_ == CTXL) ? *(const uint4*)(row_ - PS + convcol) : zz; \
    n_c2 = !(pp_ == CTXL - 1 || pp_ == TPB - 1) ? *(const uint4*)(row_ + PS + convcol) : zz; } while (0)
  const int tstride = gridDim.x * 8;
  if (blockIdx.x * 8 + wid < NTOK) TOKPREP_LOAD(blockIdx.x * 8 + wid);
  for (int tok = blockIdx.x * 8 + wid; tok < NTOK; tok += tstride) {
    const int pp = tok % TPB;
    const bool lat = pp >= CTXL;
    const int pos = pp - CTXL, prow = pos >> 6, pcol = pos & 63;
    u16* row = P + (size_t)tok * PS;
    const uint4 pl_q = n_q, pl_k = n_k, pl_m = n_m, pl_c0 = n_c0, pl_c1 = n_c1, pl_c2 = n_c2;
    if (tok + tstride < NTOK) TOKPREP_LOAD(tok + tstride);
    float csv[8], snv[8];
    {
      const int ppos0 = (c8 & 4) ? pcol : prow;
      if (lat) {
        const float4 c0 = *(const float4*)(rc + ppos0 * 16 + (c8 & 1) * 8), c1 = *(const float4*)(rc + ppos0 * 16 + (c8 & 1) * 8 + 4);
        const float4 s0 = *(const float4*)(rs + ppos0 * 16 + (c8 & 1) * 8), s1 = *(const float4*)(rs + ppos0 * 16 + (c8 & 1) * 8 + 4);
        csv[0] = c0.x; csv[1] = c0.y; csv[2] = c0.z; csv[3] = c0.w; csv[4] = c1.x; csv[5] = c1.y; csv[6] = c1.z; csv[7] = c1.w;
        snv[0] = s0.x; snv[1] = s0.y; snv[2] = s0.z; snv[3] = s0.w; snv[4] = s1.x; snv[5] = s1.y; snv[6] = s1.z; snv[7] = s1.w;
      } else {
#pragma unroll
        for (int e = 0; e < 8; ++e) { csv[e] = 1.f; snv[e] = 0.f; }
      }
    }
    {
      const bool isk = lane < 32;
      const int cc = (isk ? lane : lane - 32) * 8;
      float x0[8], x1[8], x2[8];
      unpack8(pl_c1, x1); unpack8(pl_c0, x0); unpack8(pl_c2, x2);
      float o[8];
#pragma unroll
      for (int e = 0; e < 8; ++e) {
        float a = cwv[e] * x0[e] + cwv[8 + e] * x1[e] + cwv[16 + e] * x2[e];
        a = siluf_(a);
        o[e] = isk ? a * 0.125f : a;
      }
      *(uint4*)(KQ + (size_t)tok * 512 + (isk ? 0 : 256) + cc) = pack8f(o);
    }
#pragma unroll
    for (int pass = 0; pass < 2; ++pass) {
      const bool act = pass == 0 || lane < 16;
      const int colb = (pass == 0 ? C_Q : C_K) + lane * 8;
      float x[8];
      unpack8(pass == 0 ? pl_q : pl_k, x);
      float ss = 0.f;
#pragma unroll
      for (int e = 0; e < 8; ++e) ss += x[e] * x[e];
      ss += __shfl_xor(ss, 1); ss += __shfl_xor(ss, 2); ss += __shfl_xor(ss, 4);
      const float rstd = rsqrtf(ss * (1.f / 64.f) + EPS);
#pragma unroll
      for (int e = 0; e < 8; ++e) x[e] = x[e] * rstd * (pass == 0 ? gqv[e] : gkv[e]);
      float o[8];
#pragma unroll
      for (int e = 0; e < 8; ++e) {
        float other = __shfl_xor(x[e], 2);
        const float cs = csv[e], sn = snv[e];
        o[e] = (c8 & 2) ? (x[e] * cs + other * sn) : (x[e] * cs - other * sn);
      }
      if (act) *(uint4*)(row + colb) = pack8f(o);
    }
    {
      const bool isckv = lane < 16, iscq = lane >= 32, iskr = lane >= 16 && lane < 24;
      int colb = isckv ? D_CKV + lane * 8 : (iscq ? D_CQ + (lane - 32) * 8 : D_KR + ((lane - 16) & 7) * 8);
      float x[8];
      unpack8(pl_m, x);
      float ss = 0.f;
#pragma unroll
      for (int e = 0; e < 8; ++e) ss += x[e] * x[e];
      ss += __shfl_xor(ss, 1); ss += __shfl_xor(ss, 2); ss += __shfl_xor(ss, 4); ss += __shfl_xor(ss, 8);
      float ss32 = ss + __shfl_xor(ss, 16);
      float o[8];
      if (isckv) {
        const float rstd = rsqrtf(ss * (1.f / 128.f) + EPS);
        for (int e = 0; e < 8; ++e) o[e] = x[e] * rstd * gmv[e];
      } else if (iscq) {
        const float rstd = rsqrtf(ss32 * (1.f / 256.f) + EPS);
        for (int e = 0; e < 8; ++e) o[e] = x[e] * rstd * gmv[e];
      } else {
        for (int e = 0; e < 8; ++e) o[e] = x[e];
      }
      float orot[8];
#pragma unroll
      for (int e = 0; e < 8; ++e) {
        float other = __shfl_xor(x[e], 2);
        const int ck = lane & 7;
        const float cs = csv[e], sn = snv[e];
        orot[e] = (ck & 2) ? (x[e] * cs + other * sn) : (x[e] * cs - other * sn);
      }
      if (isckv || iscq) *(uint4*)(row + colb) = pack8f(o);
      if (iskr) {
        uint4 q = pack8f(orot);
        const int ck = lane & 7;
#pragma unroll
        for (int hd = 0; hd < 4; ++hd) *(uint4*)(Kd + (size_t)tok * 768 + hd * 192 + 128 + ck * 8) = q;
      }
    }
  }
#undef TOKPREP_LOAD
}

template <int DK, int DV, bool ROPEQ>
__device__ void attn_item(const u16* __restrict__ qrow, const u16* __restrict__ Kp, int kst, const u16* __restrict__ Vp, int vst,
                          u16* __restrict__ orow, int nkeys, float sc, int pos, const float* __restrict__ rc, char* lds) {
  constexpr int KLD = DK + 8, VLD = DV + 32;
  constexpr int KB = 64 * KLD, VB = 64 * VLD;
  u16* KS = (u16*)lds;
  u16* VS = KS + 2 * KB;
  const int tid = otid(), lane = tid & 63, r = lane & 31, h = lane >> 5;
  bf16x8 qf[DK / 16];
  {
#pragma unroll
    for (int s = 0; s < DK / 16; ++s) qf[s] = *(const bf16x8*)(qrow + h * 8 + s * 16);
    if (ROPEQ && pos >= 0) {
      const int prow = pos >> 6, pcol = pos & 63;
      const float* rs = rc + 1024;
      constexpr int s0 = (DK - 64) / 16;
#pragma unroll
      for (int part = 0; part < 2; ++part) {
        const int ppos = part ? pcol : prow;
#pragma unroll
        for (int j = 0; j < 8; ++j) {
          const int fi = 8 * h + j;
          float cs = rc[ppos * 16 + fi], sn = rs[ppos * 16 + fi];
          float x1 = bf2f((u16)qf[s0 + 2 * part][j]), x2 = bf2f((u16)qf[s0 + 2 * part + 1][j]);
          qf[s0 + 2 * part][j] = (short)f2bf(x1 * cs - x2 * sn);
          qf[s0 + 2 * part + 1][j] = (short)f2bf(x2 * cs + x1 * sn);
        }
      }
    }
  }
  f32x16 oT[DV / 32];
#pragma unroll
  for (int d = 0; d < DV / 32; ++d)
#pragma unroll
    for (int e = 0; e < 16; ++e) oT[d][e] = 0.f;
  float m = -1e30f, lsum = 0.f;
  const int ntile = nkeys >> 6;
  constexpr int NKP = KB * 2 / 1024, NVP = VB * 2 / 1024, NKJ = (NKP + 7) / 8, NVJ = (NVP + 7) / 8;
  const int wu = __builtin_amdgcn_readfirstlane(tid >> 6);
  unsigned ksrc[NKJ], vsrc[NVJ];
#pragma unroll
  for (int j = 0; j < NKJ; ++j) { const int o = (wu + 8 * j) * 1024 + lane * 16, row = o / (KLD * 2), col = (o % (KLD * 2)) / 2; ksrc[j] = (unsigned)(row * kst + (col < DK ? col : 0)) * 2u; }
#pragma unroll
  for (int j = 0; j < NVJ; ++j) { const int o = (wu + 8 * j) * 1024 + lane * 16, row = o / (VLD * 2), col = (o % (VLD * 2)) / 2; vsrc[j] = (unsigned)(row * vst + (col < DV ? col : 0)) * 2u; }
#define ATT_DMA(kt_, buf_) do { \
    const char* kg_ = (const char*)Kp + (size_t)(kt_) * 64 * kst * 2; const char* vg_ = (const char*)Vp + (size_t)(kt_) * 64 * vst * 2; \
    _Pragma("unroll") for (int j = 0; j < NKJ; ++j) if (wu + 8 * j < NKP) \
      __builtin_amdgcn_global_load_lds((const unsigned*)(kg_ + ksrc[j]), (LAS unsigned*)((char*)KS + (buf_) * KB * 2 + (wu + 8 * j) * 1024), 16, 0, 0); \
    _Pragma("unroll") for (int j = 0; j < NVJ; ++j) if (wu + 8 * j < NVP) \
      __builtin_amdgcn_global_load_lds((const unsigned*)(vg_ + vsrc[j]), (LAS unsigned*)((char*)VS + (buf_) * VB * 2 + (wu + 8 * j) * 1024), 16, 0, 0); \
  } while (0)
  __syncthreads();
  ATT_DMA(0, 0);
  asm volatile("s_waitcnt vmcnt(0)" ::: "memory");
  __syncthreads();
  const int troff = ((lane & 15) >> 2) * VLD + 16 * ((lane >> 4) & 1) + 4 * (lane & 3) + 4 * h * VLD;
#pragma unroll 1
  for (int kt = 0; kt < ntile; ++kt) {
    const int buf = kt & 1;
    if (kt + 1 < ntile) ATT_DMA(kt + 1, buf ^ 1);
    const u16* KSb = KS + buf * KB;
    const u16* VSb = VS + buf * VB;
    f32x16 sT[2];
#pragma unroll
    for (int kk = 0; kk < 2; ++kk) {
#pragma unroll
      for (int e = 0; e < 16; ++e) sT[kk][e] = 0.f;
#pragma unroll
      for (int s = 0; s < DK / 16; ++s) {
        bf16x8 a = *(const bf16x8*)(KSb + (kk * 32 + r) * KLD + s * 16 + h * 8);
        sT[kk] = MFMA(a, qf[s], sT[kk]);
      }
    }
    float mx = -1e30f;
#pragma unroll
    for (int kk = 0; kk < 2; ++kk)
#pragma unroll
      for (int e = 0; e < 16; ++e) mx = fmaxf(mx, sT[kk][e]);
    mx = fmaxf(mx, __shfl_xor(mx, 32));
    const float mn = fmaxf(m, mx * sc);
    const float alpha = ex2(m - mn);
    m = mn;
    lsum *= alpha;
#pragma unroll
    for (int kk = 0; kk < 2; ++kk) {
      sT[kk] = sT[kk] * sc - mn;
#pragma unroll
      for (int e = 0; e < 16; ++e) sT[kk][e] = ex2(sT[kk][e]);
    }
    {
      f32x16 t16 = sT[0] + sT[1];
      typedef float f32x8v __attribute__((ext_vector_type(8)));
      typedef float f32x4v __attribute__((ext_vector_type(4)));
      f32x8v t8 = __builtin_shufflevector(t16, t16, 0, 1, 2, 3, 4, 5, 6, 7) + __builtin_shufflevector(t16, t16, 8, 9, 10, 11, 12, 13, 14, 15);
      f32x4v t4 = __builtin_shufflevector(t8, t8, 0, 1, 2, 3) + __builtin_shufflevector(t8, t8, 4, 5, 6, 7);
      lsum += (t4[0] + t4[1]) + (t4[2] + t4[3]);
    }
#pragma unroll
    for (int d = 0; d < DV / 32; ++d) oT[d] = oT[d] * alpha;
#pragma unroll
    for (int kk = 0; kk < 2; ++kk)
#pragma unroll
      for (int s2 = 0; s2 < 2; ++s2) {
        bf16x8 pb = pack8(sT[kk], s2);
#pragma unroll
        for (int d = 0; d < DV / 32; ++d) {
          const u16* vb = VSb + (kk * 32 + s2 * 16) * VLD + d * 32 + troff;
          s16x4 lo = __builtin_amdgcn_ds_read_tr16_b64_v4i16((LAS s16x4*)vb);
          s16x4 hi = __builtin_amdgcn_ds_read_tr16_b64_v4i16((LAS s16x4*)(vb + 8 * VLD));
          oT[d] = MFMA(cat4(lo, hi), pb, oT[d]);
        }
      }
    asm volatile("s_waitcnt vmcnt(0)" ::: "memory");
    __syncthreads();
  }
#undef ATT_DMA
  lsum += __shfl_xor(lsum, 32);
  const float inv = 1.f / lsum;
#pragma unroll
  for (int d = 0; d < DV / 32; ++d)
#pragma unroll
    for (int gq = 0; gq < 4; ++gq) {
      uint2 o;
      o.x = pack2(oT[d][4 * gq] * inv, oT[d][4 * gq + 1] * inv);
      o.y = pack2(oT[d][4 * gq + 2] * inv, oT[d][4 * gq + 3] * inv);
      *(uint2*)(orow + d * 32 + 8 * gq + 4 * h) = o;
    }
}

__device__ void scanA_unit(const Params& p, int l, int unit, char* lds) {
  const int tid = otid(), lane = tid & 63, wid = tid >> 6, r = lane & 31, h = lane >> 5;
  const int bl = unit >> 3, hd = (unit >> 1) & 3, dir = unit & 1;
  const u16* P = (const u16*)(p.ws + OFF_P);
  u16* Oa = (u16*)(p.ws + OFF_OA) + (size_t)dir * NTOK * 512;
  float* BC = (float*)lds;
  u16* Qs = (u16*)(lds + 33792);
  u16* KKs = (u16*)(lds + 51200);
  u16* AM = (u16*)(lds + 51200);
  u16* KT = (u16*)(lds + 68608);
  u16* VT = (u16*)(lds + 87040);
  u16* ST = (u16*)(lds + 105472);
  float* EL = (float*)(lds + 140288);
  float* QTOT = (float*)(lds + 140800);
  const int ch = tid & 15;
  float lbv[8];
  {
    const float* lb = (const float*)(p.ws + OFF_LB) + (size_t)l * 1024 + dir * 512 + hd * 128 + ch * 8;
#pragma unroll
    for (int e = 0; e < 8; ++e) lbv[e] = lb[e];
  }
  const int vt = wid & 3, th = wid >> 2;
  f32x16 S[2];
#pragma unroll
  for (int j = 0; j < 2; ++j)
#pragma unroll
    for (int e = 0; e < 16; ++e) S[j][e] = 0.f;
  __syncthreads();
  for (int i = tid; i < 128 * 136 / 2; i += NTHR) ((unsigned*)ST)[i] = 0u;
  uint4 pqr[2], pfr[2], pvr[2];
#define SCANA_TOK0(st_) (bl * TPB + ((st_) >= 4 ? CTXL : 0) + (dir ? ((st_) >= 4 ? 31 - ((st_) - 4) : 3 - (st_)) : ((st_) >= 4 ? (st_) - 4 : (st_))) * 64)
#define SCANA_PREFETCH(st_) do { const int t0_ = SCANA_TOK0(st_); \
    _Pragma("unroll") for (int j = 0; j < 2; ++j) { const int i = (tid >> 4) + 32 * j; \
      const u16* row = P + (size_t)(t0_ + (dir ? 63 - i : i)) * PS + hd * 128 + ch * 8; \
      pqr[j] = *(const uint4*)(row + A_Q); pfr[j] = *(const uint4*)(row + (dir ? A_FB : A_FF)); pvr[j] = *(const uint4*)(row + A_I); } } while (0)
  SCANA_PREFETCH(0);
#pragma unroll 1
  for (int step = 0; step < 36; ++step) {
    const int tok0 = SCANA_TOK0(step);
    __syncthreads();
#pragma unroll
    for (int j = 0; j < 2; ++j) {
      const int i = (tid >> 4) + 32 * j;
      uint4 qraw = pqr[j];
      uint4 fraw = pfr[j];
      uint4 vq = pvr[j];
      float qv[8], fv[8], kkv[8];
      unpack8(qraw, qv); unpack8(fraw, fv);
#pragma unroll
      for (int e = 0; e < 8; ++e) {
        qv[e] = siluf_(qv[e]);
        const float ex = __expf(-fv[e]);
        const float sg = 1.f / (1.f + ex);
        const float sgn = ex / (1.f + ex);
        const float f = lbv[e] + (1.f - lbv[e]) * sg;
        kkv[e] = (1.f - lbv[e]) * (fv[e] > 30.f ? 0.f : (fv[e] < -30.f ? 1.f : sgn));
        BC[i * 132 + ch * 8 + e] = __log2f(fmaxf(f, 1e-37f));
      }
      *(uint4*)(Qs + i * 136 + ch * 8) = pack8f(qv);
      *(uint4*)(KKs + i * 136 + ch * 8) = pack8f(kkv);
      u16* dv = VT + (ch * 8) * 72 + ((((i >> 3) ^ (ch & 7)) << 3) | (i & 7));
      dv[0 * 72] = (u16)(vq.x & 0xffff); dv[1 * 72] = (u16)(vq.x >> 16); dv[2 * 72] = (u16)(vq.y & 0xffff); dv[3 * 72] = (u16)(vq.y >> 16);
      dv[4 * 72] = (u16)(vq.z & 0xffff); dv[5 * 72] = (u16)(vq.z >> 16); dv[6 * 72] = (u16)(vq.w & 0xffff); dv[7 * 72] = (u16)(vq.w >> 16);
    }
    __syncthreads();
    {
      const int k = tid & 127, qd = tid >> 7;
      float cv[16];
#pragma unroll
      for (int i = 0; i < 16; ++i) cv[i] = BC[(qd * 16 + i) * 132 + k];
      float run = 0.f;
#pragma unroll
      for (int i = 0; i < 16; ++i) { run += cv[i]; BC[(qd * 16 + i) * 132 + k] = run; }
      QTOT[qd * 128 + k] = run;
    }
    __syncthreads();
    {
      const int k = tid & 127, qd = tid >> 7;
      float off = 0.f;
      for (int q2 = 0; q2 < qd; ++q2) off += QTOT[q2 * 128 + k];
      if (qd > 0) {
        float cv[16];
#pragma unroll
        for (int i = 0; i < 16; ++i) cv[i] = BC[(qd * 16 + i) * 132 + k];
#pragma unroll
        for (int i = 0; i < 16; ++i) BC[(qd * 16 + i) * 132 + k] = cv[i] + off;
      }
    }
    __syncthreads();
    f32x4 cod[2];
#pragma unroll
    for (int jj = 0; jj < 2; ++jj) {
      cod[jj] = (f32x4){0.f, 0.f, 0.f, 0.f};
      const int job = wid + 8 * jj;
      if (job < 10) {
        const int bI = job < 1 ? 0 : (job < 3 ? 1 : (job < 6 ? 2 : 3));
        const int bJ = job - (bI * (bI + 1)) / 2;
        const int l16 = lane & 15, kg = lane >> 4;
        const int t = 16 * bI + l16, s = 16 * bJ + l16, rr = 16 * bI;
#pragma unroll
        for (int ks = 0; ks < 4; ++ks) {
          const int k0 = ks * 32 + kg * 8;
          float qv[8], kv[8];
          unpack8(*(const uint4*)(Qs + t * 136 + k0), qv);
          unpack8(*(const uint4*)(KKs + s * 136 + k0), kv);
#pragma unroll
          for (int e = 0; e < 8; ++e) {
            const float br = BC[rr * 132 + k0 + e];
            qv[e] *= ex2(BC[t * 132 + k0 + e] - br);
            kv[e] *= ex2(fminf(br - BC[s * 132 + k0 + e], 120.f));
          }
          union { uint4 u; bf16x8 v; } ua, ub;
          ua.u = pack8f(qv); ub.u = pack8f(kv);
          cod[jj] = __builtin_amdgcn_mfma_f32_16x16x32_bf16(ua.v, ub.v, cod[jj], 0, 0, 0);
        }
      }
    }
    if (tid < 128) EL[tid] = ex2(BC[63 * 132 + tid]);
#pragma unroll
    for (int j = 0; j < 2; ++j) {
      const int i = (tid >> 4) + 32 * j;
      float kv[8];
      unpack8(*(const uint4*)(KKs + i * 136 + ch * 8), kv);
      u16* dk = KT + (ch * 8) * 72 + ((((i >> 3) ^ (ch & 7)) << 3) | (i & 7));
      float dv8[8];
#pragma unroll
      for (int e = 0; e < 8; ++e) dv8[e] = BC[63 * 132 + ch * 8 + e] - BC[i * 132 + ch * 8 + e];
#pragma unroll
      for (int e = 0; e < 8; ++e) dk[e * 72] = f2bf(kv[e] * ex2(dv8[e]));
    }
    __syncthreads();
#pragma unroll
    for (int j = 0; j < 2; ++j) {
      const int i = (tid >> 4) + 32 * j;
      float qv[8];
      unpack8(*(const uint4*)(Qs + i * 136 + ch * 8), qv);
#pragma unroll
      for (int e = 0; e < 8; ++e) qv[e] *= ex2(BC[i * 132 + ch * 8 + e]);
      *(uint4*)(Qs + i * 136 + ch * 8) = pack8f(qv);
    }
    for (int i = tid; i < 64 * 72 / 2; i += NTHR) ((unsigned*)AM)[i] = 0u;
    __syncthreads();
#pragma unroll
    for (int jj = 0; jj < 2; ++jj) {
      const int job = wid + 8 * jj;
      if (job < 10) {
        const int bI = job < 1 ? 0 : (job < 3 ? 1 : (job < 6 ? 2 : 3));
        const int bJ = job - (bI * (bI + 1)) / 2;
        const int l16 = lane & 15, kg = lane >> 4;
#pragma unroll
        for (int e = 0; e < 4; ++e) {
          const int tp = 4 * kg + e;
          const float v = (bJ < bI || l16 <= tp) ? cod[jj][e] : 0.f;
          AM[(16 * bI + tp) * 72 + 16 * bJ + l16] = f2bf(v);
        }
      }
    }
    __syncthreads();
    if (step + 1 < 36) SCANA_PREFETCH(step + 1);
    f32x16 o;
#pragma unroll
    for (int e = 0; e < 16; ++e) o[e] = 0.f;
#pragma unroll
    for (int ks = 0; ks < 8; ++ks) {
      bf16x8 a = *(const bf16x8*)(Qs + (th * 32 + r) * 136 + ks * 16 + h * 8);
      bf16x8 b = *(const bf16x8*)(ST + (vt * 32 + r) * 136 + ks * 16 + h * 8);
      o = MFMA(a, b, o);
    }
    bf16x8 bv[4];
#pragma unroll
    for (int ks = 0; ks < 4; ++ks) bv[ks] = *(const bf16x8*)(VT + (vt * 32 + r) * 72 + (((ks * 2 + h) ^ (((vt * 32 + r) >> 3) & 7)) << 3));
#pragma unroll
    for (int ks = 0; ks < 4; ++ks) {
      bf16x8 a = *(const bf16x8*)(AM + (th * 32 + r) * 72 + ks * 16 + h * 8);
      o = MFMA(a, bv[ks], o);
    }
    {
      u16* ob = Oa + (size_t)tok0 * 512 + hd * 128 + vt * 32 + r;
#pragma unroll
      for (int e = 0; e < 16; ++e) {
        const int i = th * 32 + crow(e, h);
        ob[(dir ? 63 - i : i) * 512] = f2bf(o[e]);
      }
    }
    __syncthreads();
#pragma unroll
    for (int j = 0; j < 2; ++j) {
      const int kt = 2 * th + j;
#pragma unroll
      for (int e = 0; e < 16; ++e) S[j][e] *= EL[kt * 32 + crow(e, h)];
#pragma unroll
      for (int ks = 0; ks < 4; ++ks) {
        bf16x8 a = *(const bf16x8*)(KT + (kt * 32 + r) * 72 + (((ks * 2 + h) ^ (((kt * 32 + r) >> 3) & 7)) << 3));
        S[j] = MFMA(a, bv[ks], S[j]);
      }
#pragma unroll
      for (int gq = 0; gq < 4; ++gq) {
        uint2 w;
        w.x = pack2(S[j][4 * gq], S[j][4 * gq + 1]); w.y = pack2(S[j][4 * gq + 2], S[j][4 * gq + 3]);
        *(uint2*)(ST + (vt * 32 + r) * 136 + kt * 32 + 8 * gq + 4 * h) = w;
      }
    }
  }
#undef SCANA_PREFETCH
#undef SCANA_TOK0
}

__device__ void scanB_unit(const Params& p, int l, int unit2, char* lds) {
  const int tid0 = otid(), vb = tid0 >> 8, tid = tid0 & 255, lane = tid & 63, wid = tid >> 6, r = lane & 31, h = lane >> 5;
  const int unit = unit2 * 2 + vb;
  lds += vb * LDSV;
  const int bl = unit >> 3, hd = (unit >> 1) & 3, dir = unit & 1;
  const u16* P = (const u16*)(p.ws + OFF_P);
  const u16* KQ = (const u16*)(p.ws + OFF_KQ);
  const float* Gb = (const float*)(p.ws + OFF_GB);
  u16* Ob = (u16*)(p.ws + OFF_OB) + (size_t)dir * NTOK * 512;
  u16* QB = (u16*)lds;
  u16* KB = (u16*)(lds + 9216);
  u16* SM = (u16*)(lds + 18432);
  u16* KWT = (u16*)(lds + 27648);
  u16* VT = (u16*)(lds + 36864);
  float* vec = (float*)(lds + 55296);
  float *IG = vec, *LF = vec + 64, *BV = vec + 128, *UV = vec + 192, *MT = vec + 256, *WI = vec + 320, *WK = vec + 384,
        *DEN = vec + 448, *NV = vec + 512  , *SC = vec + 640, *BL2 = vec + 704, *UL2 = vec + 768, *EMT = vec + 832;
  const float bI = p.bgate[l * 16 + (2 * dir) * 4 + hd], bF = p.bgate[l * 16 + (2 * dir + 1) * 4 + hd];
  f32x16 C[2];
#pragma unroll
  for (int ft = 0; ft < 2; ++ft)
#pragma unroll
    for (int e = 0; e < 16; ++e) C[ft][e] = 0.f;
  float m = -1e30f;
  __syncthreads();
  if (tid < 128) NV[tid] = 0.f;
  int cur = 0;
  uint4 pk0, pk1, pq0, pq1, pv0, pv1, pv2, pv3; float pgI = 0.f, pgF = 0.f;
#define SCANB_TOK0(st_) (bl * TPB + ((st_) >= 4 ? CTXL : 0) + (dir ? ((st_) >= 4 ? 31 - ((st_) - 4) : 3 - (st_)) : ((st_) >= 4 ? (st_) - 4 : (st_))) * 64)
#define SCANB_LDKQ(j, K_, Q_) do { const int id = tid + 256 * (j), i = id >> 3, c8 = id & 7; \
      const u16* row = KQ + (size_t)(t0_ + (dir ? 63 - i : i)) * 512 + hd * 64 + c8 * 8; K_ = *(const uint4*)(row); Q_ = *(const uint4*)(row + 256); } while (0)
#define SCANB_LDV(j, V_) do { const int id = tid + 256 * (j), i = id >> 4, c16 = id & 15; \
      V_ = *(const uint4*)(P + (size_t)(t0_ + (dir ? 63 - i : i)) * PS + B_V + hd * 128 + c16 * 8); } while (0)
#define SCANB_PREFETCH(st_) do { const int t0_ = SCANB_TOK0(st_); \
    SCANB_LDKQ(0, pk0, pq0); SCANB_LDKQ(1, pk1, pq1); SCANB_LDV(0, pv0); SCANB_LDV(1, pv1); SCANB_LDV(2, pv2); SCANB_LDV(3, pv3); \
    if (tid < 64) { const int tok = t0_ + (dir ? 63 - tid : tid); pgI = Gb[(size_t)tok * 16 + (2 * dir) * 4 + hd]; pgF = Gb[(size_t)tok * 16 + (2 * dir + 1) * 4 + hd]; } } while (0)
#define SCANB_STKQ(j, K_, Q_) do { const int id = tid + 256 * (j), i = id >> 3, c8 = id & 7; \
      *(uint4*)(KB + i * 72 + c8 * 8) = K_; *(uint4*)(QB + i * 72 + c8 * 8) = Q_; } while (0)
#define SCANB_STV(j, V_) do { const int id = tid + 256 * (j), i = id >> 4, c16 = id & 15; const uint4 vq = V_; u16* dv = VT + (c16 * 8) * 72 + ((((i >> 3) ^ (c16 & 7)) << 3) | (i & 7)); \
      dv[0 * 72] = (u16)(vq.x & 0xffff); dv[1 * 72] = (u16)(vq.x >> 16); dv[2 * 72] = (u16)(vq.y & 0xffff); dv[3 * 72] = (u16)(vq.y >> 16); \
      dv[4 * 72] = (u16)(vq.z & 0xffff); dv[5 * 72] = (u16)(vq.z >> 16); dv[6 * 72] = (u16)(vq.w & 0xffff); dv[7 * 72] = (u16)(vq.w >> 16); } while (0)
  SCANB_PREFETCH(0);
#pragma unroll 1
  for (int step = 0; step < 36; ++step) {
    const int tok0 = SCANB_TOK0(step);
    __syncthreads();
    SCANB_STKQ(0, pk0, pq0); SCANB_STKQ(1, pk1, pq1);
    SCANB_STV(0, pv0); SCANB_STV(1, pv1); SCANB_STV(2, pv2); SCANB_STV(3, pv3);
    if (tid < 64) {
      const int i = tid;
      const float gI = pgI + bI;
      const float gF = pgF + bF;
      const float lf = fminf(gF, 0.f) - log1pf(expf(-fabsf(gF)));
      float b = lf;
#pragma unroll
      for (int d = 1; d < 64; d <<= 1) { float t = __shfl_up(b, d); if (lane >= d) b += t; }
      const float u = gI - b;
      float pm = u;
#pragma unroll
      for (int d = 1; d < 64; d <<= 1) { float t = __shfl_up(pm, d); if (lane >= d) pm = fmaxf(pm, t); }
      const float mt = b + fmaxf(m, pm);
      const float wi = expf(b + m - mt);
      const float mnew = __shfl(mt, 63), b63 = __shfl(b, 63);
      const float dec = expf(b63 + m - mnew);
      const float wk = expf(b63 - b + gI - mnew);
      IG[i] = gI; LF[i] = lf; BV[i] = b; UV[i] = u; MT[i] = mt; WI[i] = wi; WK[i] = wk;
      BL2[i] = (b - mt) * LOG2E; UL2[i] = u * LOG2E; EMT[i] = expf(-mt);
      if (i == 0) { SC[0] = mnew; SC[1] = dec; }
    }
    __syncthreads();
    {
      const int tt = wid >> 1, st = wid & 1;
      f32x16 a16;
#pragma unroll
      for (int e = 0; e < 16; ++e) a16[e] = 0.f;
#pragma unroll
      for (int ks = 0; ks < 4; ++ks) {
        bf16x8 a = *(const bf16x8*)(QB + (tt * 32 + r) * 72 + ks * 16 + h * 8);
        bf16x8 b = *(const bf16x8*)(KB + (st * 32 + r) * 72 + ks * 16 + h * 8);
        a16 = MFMA(a, b, a16);
      }
      const int s = st * 32 + r;
      const float us = UL2[s];
      float blv[16];
#pragma unroll
      for (int e = 0; e < 16; ++e) blv[e] = BL2[tt * 32 + crow(e, h)];
#pragma unroll
      for (int e = 0; e < 16; ++e) {
        const int t = tt * 32 + crow(e, h);
        float v = 0.f;
        if (s <= t) v = a16[e] * ex2(blv[e] + us);
        SM[t * 72 + s] = f2bf(v);
      }
    }
#pragma unroll
    for (int j = 0; j < 2; ++j) {
      const int id = tid + 256 * j, i = id >> 3, c8 = id & 7;
      float kv[8];
      unpack8(*(const uint4*)(KB + i * 72 + c8 * 8), kv);
      const float wk = WK[i];
#pragma unroll
      for (int e = 0; e < 8; ++e) KWT[(c8 * 8 + e) * 72 + ((((i >> 3) ^ c8) << 3) | (i & 7))] = f2bf(kv[e] * wk);
    }
    __syncthreads();
    const float mnew = SC[0], dec = SC[1];
    if (tid < 64) {
      const int t = tid;
      float rsum = 0.f, qn = 0.f;
#pragma unroll
      for (int c8 = 0; c8 < 8; ++c8) {
        float sv[8], qv[8];
        unpack8(*(const uint4*)(SM + t * 72 + c8 * 8), sv);
        unpack8(*(const uint4*)(QB + t * 72 + c8 * 8), qv);
#pragma unroll
        for (int e = 0; e < 8; ++e) { rsum += sv[e]; qn += qv[e] * NV[cur * 64 + c8 * 8 + e]; }
      }
      DEN[t] = 1.f / fmaxf(fabsf(WI[t] * qn + rsum), EMT[t]);
    } else if (tid < 128) {
      const int f = tid - 64;
      float ns = 0.f;
#pragma unroll
      for (int c8 = 0; c8 < 8; ++c8) {
        float kv[8];
        unpack8(*(const uint4*)(KWT + f * 72 + c8 * 8), kv);
#pragma unroll
        for (int e = 0; e < 8; ++e) ns += kv[e];
      }
      NV[(cur ^ 1) * 64 + f] = dec * NV[cur * 64 + f] + ns;
    }
    __syncthreads();
    if (step + 1 < 36) SCANB_PREFETCH(step + 1);
    f32x16 num[2];
#pragma unroll
    for (int tt = 0; tt < 2; ++tt)
#pragma unroll
      for (int e = 0; e < 16; ++e) num[tt][e] = 0.f;
#pragma unroll
    for (int ft = 0; ft < 2; ++ft)
#pragma unroll
      for (int s = 0; s < 2; ++s) {
        bf16x8 pb = pack8(C[ft], s);
#pragma unroll
        for (int tt = 0; tt < 2; ++tt) {
          const u16* qb = QB + (tt * 32 + r) * 72 + ft * 32 + s * 16 + 4 * h;
          bf16x8 a = cat4(*(const s16x4*)qb, *(const s16x4*)(qb + 8));
          num[tt] = MFMA(a, pb, num[tt]);
        }
      }
#pragma unroll
    for (int tt = 0; tt < 2; ++tt)
#pragma unroll
      for (int e = 0; e < 16; ++e) num[tt][e] *= WI[tt * 32 + crow(e, h)];
    bf16x8 bv[4];
#pragma unroll
    for (int ks = 0; ks < 4; ++ks) bv[ks] = *(const bf16x8*)(VT + (wid * 32 + r) * 72 + (((ks * 2 + h) ^ (((wid * 32 + r) >> 3) & 7)) << 3));
#pragma unroll
    for (int ks = 0; ks < 4; ++ks)
#pragma unroll
      for (int tt = 0; tt < 2; ++tt) {
        bf16x8 a = *(const bf16x8*)(SM + (tt * 32 + r) * 72 + ks * 16 + h * 8);
        num[tt] = MFMA(a, bv[ks], num[tt]);
      }
#pragma unroll
    for (int tt = 0; tt < 2; ++tt)
#pragma unroll
      for (int e = 0; e < 16; ++e) {
        const int i = tt * 32 + crow(e, h);
        const int tok = tok0 + (dir ? 63 - i : i);
        Ob[(size_t)tok * 512 + hd * 128 + wid * 32 + r] = f2bf(num[tt][e] * DEN[i]);
      }
#pragma unroll
    for (int ft = 0; ft < 2; ++ft) {
#pragma unroll
      for (int e = 0; e < 16; ++e) C[ft][e] *= dec;
#pragma unroll
      for (int ks = 0; ks < 4; ++ks) {
        bf16x8 a = *(const bf16x8*)(KWT + (ft * 32 + r) * 72 + (((ks * 2 + h) ^ (((ft * 32 + r) >> 3) & 7)) << 3));
        C[ft] = MFMA(a, bv[ks], C[ft]);
      }
    }
    m = mnew;
    cur ^= 1;
  }
#undef SCANB_PREFETCH
#undef SCANB_LDKQ
#undef SCANB_LDV
#undef SCANB_STKQ
#undef SCANB_STV
#undef SCANB_TOK0
}

__device__ void phase_mixers(const Params& p, int l, int g, char* lds, int cbase = 0, bool scans_only = false, bool a_only = false) {
  int* s_item = (int*)(lds + LDS_BYTES - 16);
  int* cnt = (int*)(p.ws + OFF_CNT) + cbase + (l * NG + g);
  const u16* P = (const u16*)(p.ws + OFF_P);
  const u16* Qd = (const u16*)(p.ws + OFF_QD);
  const u16* Kd = (const u16*)(p.ws + OFF_KD);
  const u16* Vd = (const u16*)(p.ws + OFF_VD);
  u16* Y = (u16*)((char*)p.out);
  const float* rc = (const float*)(p.ws + OFF_ROPE);
  constexpr int NSA = NB * 8, NSB = NB * 4;
  constexpr int ND_L = NB * 4 * 8, NC_L = NB * 2 * 32, ND_C = NB * 4, NC_C = NB * 2 * 4;
  constexpr int I1 = NSA, I2 = I1 + NSB, I3 = I2 + ND_L, I4 = I3 + NC_L, I5 = I4 + ND_C, I6 = I5 + NC_C;
  const float scC = 0.125f * LOG2E, scD = 0.07216878364870322f * LOG2E;
  while (true) {
    __syncthreads();
    if (otid() == 0) *s_item = atomicAdd(cnt, 1);
    __syncthreads();
    const int it = *s_item;
    if (it >= (a_only ? I1 : (scans_only ? I2 : (l == DEPTH - 1 ? I4 : I6)))) break;
    if (it < I1) scanA_unit(p, l, it, lds);
    else if (it < I2) scanB_unit(p, l, it - I1, lds);
    else {
      bool isD, isLat; int q;
      if (it < I3) { isD = true; isLat = true; q = it - I2; }
      else if (it < I4) { isD = false; isLat = true; q = it - I3; }
      else if (it < I5) { isD = true; isLat = false; q = it - I4; }
      else { isD = false; isLat = false; q = it - I5; }
      const int tid = otid(), lane = tid & 63, wid = tid >> 6, r = lane & 31;
      const int nkeys = isLat ? TPB : CTXL;
      if (isD) {
        const int nqt = isLat ? 8 : 1;
        const int qt = q % nqt, hd = (q / nqt) % 4, bl = q / (nqt * 4);
        const int tokk = bl * TPB, ql = qt * 256 + wid * 32 + r;
        const int tokq = tokk + (isLat ? CTXL : 0) + ql;
        attn_item<192, 128, true>(Qd + (size_t)tokq * 768 + hd * 192, Kd + (size_t)tokk * 768 + hd * 192, 768,
                                  Vd + (size_t)tokk * 512 + hd * 128, 512, Y + (size_t)tokq * 2048 + 1536 + hd * 128,
                                  nkeys, scD, isLat ? ql : -1, rc, lds);
      } else {
        const int nqt = isLat ? 32 : 4;
        const int qt = q % nqt, kvh = (q / nqt) % 2, bl = q / (nqt * 2);
        const int hq = kvh * 4 + (wid >> 1);
        const int tokk = bl * TPB, ql = qt * 64 + (wid & 1) * 32 + r;
        const int tokq = tokk + (isLat ? CTXL : 0) + ql;
        attn_item<64, 64, false>(P + (size_t)tokq * PS + C_Q + hq * 64, P + (size_t)tokk * PS + C_K + kvh * 64, PS,
                                 P + (size_t)tokk * PS + C_V + kvh * 64, PS, Y + (size_t)tokq * 2048 + 1024 + hq * 64,
                                 nkeys, scC, -1, rc, lds);
      }
    }
  }
}

__device__ void phase_readout(const Params& p, int l) {
  const int tid = otid(), lane = tid & 63, wid = tid >> 6;
  const u16* P = (const u16*)(p.ws + OFF_P);
  const u16* Oa = (const u16*)(p.ws + OFF_OA);
  const u16* Ob = (const u16*)(p.ws + OFF_OB);
  u16* Y = (u16*)((char*)p.out);
  const int col = lane * 8;
  float gnv[2][8];
#pragma unroll
  for (int mix = 0; mix < 2; ++mix)
#pragma unroll
    for (int e = 0; e < 8; ++e) gnv[mix][e] = ((mix == 0 ? p.hnorm : p.mnorm) + l * 128 + (col & 127))[e];
  const int stride = gridDim.x * 8;
  const bool skipc = l == DEPTH - 1;
  for (int tok0 = blockIdx.x * 8 + wid; tok0 < NTOK; tok0 += 2 * stride) {
    int tk[2]; bool doit[2];
    tk[0] = tok0; tk[1] = tok0 + stride;
    doit[0] = !(skipc && (tk[0] % TPB) < CTXL);
    doit[1] = tk[1] < NTOK && !(skipc && (tk[1] % TPB) < CTXL);
    if (!doit[1]) tk[1] = tk[0];
    uint4 ra[2][2], rb[2][2], rg[2][2];
#pragma unroll
    for (int u = 0; u < 2; ++u)
#pragma unroll
      for (int mix = 0; mix < 2; ++mix) {
        const u16* O = mix == 0 ? Oa : Ob;
        ra[u][mix] = *(const uint4*)(O + (size_t)tk[u] * 512 + col);
        rb[u][mix] = *(const uint4*)(O + ((size_t)NTOK + tk[u]) * 512 + col);
        rg[u][mix] = *(const uint4*)(P + (size_t)tk[u] * PS + (mix == 0 ? A_G : B_O) + col);
      }
#pragma unroll
    for (int u = 0; u < 2; ++u) {
      uint4 outv[2];
#pragma unroll
      for (int mix = 0; mix < 2; ++mix) {
        float a[8], b[8], gt[8], o[8];
        unpack8(ra[u][mix], a); unpack8(rb[u][mix], b); unpack8(rg[u][mix], gt);
        float ss = 0.f;
#pragma unroll
        for (int e = 0; e < 8; ++e) { a[e] += b[e]; ss += a[e] * a[e]; }
        ss += __shfl_xor(ss, 1); ss += __shfl_xor(ss, 2); ss += __shfl_xor(ss, 4); ss += __shfl_xor(ss, 8);
        const float rstd = rsqrtf(ss * (1.f / 128.f) + EPS);
#pragma unroll
        for (int e = 0; e < 8; ++e) {
          float y = a[e] * rstd * gnv[mix][e];
          o[e] = y * (mix == 0 ? siluf_(gt[e]) : sigmoidf_(gt[e]));
        }
        outv[mix] = pack8f(o);
      }
      if (doit[u]) {
        *(uint4*)(Y + (size_t)tk[u] * 2048 + col) = outv[0];
        *(uint4*)(Y + (size_t)tk[u] * 2048 + 512 + col) = outv[1];
      }
    }
  }
}

struct EpiInproj {
  u16* P; float* Gb;
  DI bool operator()(f32x4 (&acc)[2][2][4][2], const pg8::UDesc& u, int wr, int wc, int fr, int fq) const {
    const int row0 = u.pm * 256 + wr * 64 + fr, col0 = u.pn * 256 + wc * 32 + 8 * fq;
    const bool gate = (u.pn == 9) && (wc == 0) && (fq < 2);
#pragma unroll
    for (int ai = 0; ai < 2; ++ai)
#pragma unroll
      for (int m = 0; m < 4; ++m) {
        const size_t row = (size_t)(row0 + ai * 128 + m * 16);
#pragma unroll
        for (int bj = 0; bj < 2; ++bj) *(uint4*)(P + row * PS + col0 + bj * 128) = pk8(acc[ai][bj][m][0], acc[ai][bj][m][1]);
        if (gate) { *(f32x4*)(Gb + row * 16 + 8 * fq) = acc[ai][0][m][0]; *(f32x4*)(Gb + row * 16 + 8 * fq + 4) = acc[ai][0][m][1]; }
      }
    return false;
  }
};
__device__ void phase_inproj(const Params& p, int l, char* lds) {
  pg8::PlainSched S{p.ws + OFF_H, wsel(p, l) + OFF_WINT, 2048u, 2048u, 16, NTOK / 256, PS / 256, (int)gridDim.x, (int)blockIdx.x};
  EpiInproj E{(u16*)(p.ws + OFF_P), (float*)(p.ws + OFF_GB)};
  pg8::gemm_stream(( LAS unsigned char*)lds, S, E);
}

struct MlaSched {
  const char* P; const char* Wq; const char* Wk; const char* Wv; int G, c;
  DI bool next(int i, pg8::UDesc& u) const {
    const long L = (long)i * G + c; if (L >= (NTOK / 256) * 7) return false;
    const int pm = (int)(L / 7), j = (int)(L % 7);
    u.pm = pm; u.lda2 = PS * 2;
    if (j < 3) { u.tag = 0; u.pn = j; u.A = P + (size_t)pm * 256 * PS * 2 + D_CQ * 2; u.B = Wq + (size_t)j * 256 * 512; u.ldb2 = 512; u.nt = 4; }
    else if (j < 5) { u.tag = 1; u.pn = j - 3; u.A = P + (size_t)pm * 256 * PS * 2 + D_CKV * 2; u.B = Wk + (size_t)(j - 3) * 256 * 256; u.ldb2 = 256; u.nt = 2; }
    else { u.tag = 2; u.pn = j - 5; u.A = P + (size_t)pm * 256 * PS * 2 + D_CKV * 2; u.B = Wv + (size_t)(j - 5) * 256 * 256; u.ldb2 = 256; u.nt = 2; }
    return true;
  }
};
struct EpiMla {
  u16 *Qd, *Kd, *Vd;
  DI bool operator()(f32x4 (&acc)[2][2][4][2], const pg8::UDesc& u, int wr, int wc, int fr, int fq) const {
    const int row0 = u.pm * 256 + wr * 64 + fr, col0 = u.pn * 256 + wc * 32 + 8 * fq;
#pragma unroll
    for (int ai = 0; ai < 2; ++ai)
#pragma unroll
      for (int m = 0; m < 4; ++m) {
        const size_t row = (size_t)(row0 + ai * 128 + m * 16);
#pragma unroll
        for (int bj = 0; bj < 2; ++bj) {
          const int col = col0 + bj * 128;
          u16* dst = u.tag == 0 ? Qd + row * 768 + col : (u.tag == 1 ? Kd + row * 768 + (col >> 7) * 192 + (col & 127) : Vd + row * 512 + col);
          *(uint4*)dst = pk8(acc[ai][bj][m][0], acc[ai][bj][m][1]);
        }
      }
    return false;
  }
};
__device__ void phase_mlaup(const Params& p, int l, char* lds) {
  MlaSched S{p.ws + OFF_P, wsel(p, l) + OFF_WUQ, wsel(p, l) + OFF_WUK, wsel(p, l) + OFF_WUV, (int)gridDim.x, (int)blockIdx.x};
  EpiMla E{(u16*)(p.ws + OFF_QD), (u16*)(p.ws + OFF_KD), (u16*)(p.ws + OFF_VD)};
  pg8::gemm_stream((LAS unsigned char*)lds, S, E);
}

struct EpiGate {
  u16* Gt;
  DI bool operator()(f32x4 (&acc)[2][2][4][2], const pg8::UDesc& u, int wr, int wc, int fr, int fq) const {
    const int row0 = u.pm * 256 + wr * 64 + fr, col0 = u.pn * 256 + wc * 32 + 8 * fq;
#pragma unroll
    for (int ai = 0; ai < 2; ++ai)
#pragma unroll
      for (int m = 0; m < 4; ++m) {
        const size_t row = (size_t)(row0 + ai * 128 + m * 16);
#pragma unroll
        for (int bj = 0; bj < 2; ++bj) {
          f32x4 a = acc[ai][bj][m][0], b = acc[ai][bj][m][1];
#pragma unroll
          for (int e = 0; e < 4; ++e) { a[e] = fmaxf(sigmoidf_(a[e]), 1e-30f); b[e] = fmaxf(sigmoidf_(b[e]), 1e-30f); }
          *(uint4*)(Gt + row * 4096 + col0 + bj * 128) = pk8(a, b);
        }
      }
    return false;
  }
};
__device__ void phase_gate(const Params& p, int l, char* lds, int lat_only) {
  pg8::PlainSched S{p.ws + OFF_H, wsel(p, l) + OFF_WGT, 2048u, 2048u, 16, NTOK / 256, 16, (int)gridDim.x, (int)blockIdx.x, lat_only};
  EpiGate E{(u16*)(p.ws + OFF_P)};
  pg8::gemm_stream((LAS unsigned char*)lds, S, E);
}

struct BranchSched {
  const char* Y; const char* Wb; int G, c, lat_only;
  DI bool next(int i, pg8::UDesc& u) const {
    int pm, pn; if (!pg8::tile_order((long)(i >> 2) * G + c, lat_only ? NTOK / 256 - NB : NTOK / 256, 4, pm, pn)) return false;
    if (lat_only) pm = pm + (pm >> 3) + 1;
    const int r = i & 3;
    u.pm = pm; u.pn = pn; u.tag = r; u.lda2 = 4096; u.ldb2 = 1024; u.nt = 8;
    u.A = Y + (size_t)pm * 256 * 4096 + r * 1024; u.B = Wb + ((size_t)r * 1024 + pn * 256) * 1024;
    return true;
  }
};
struct EpiBranch {
  const u16* Gt; u16* Mg;
  DI bool operator()(f32x4 (&acc)[2][2][4][2], const pg8::UDesc& u, int wr, int wc, int fr, int fq) const {
    const int row0 = u.pm * 256 + wr * 64 + fr, col0 = u.pn * 256 + wc * 32 + 8 * fq, r = u.tag;
    const int rn = r < 3 ? r + 1 : r;
    uint4 gin[2][2][2], gnn[2][2][2];
#define EPB_LOAD(slot, k_) do { const int ai_ = (k_) >> 1, mh_ = (k_) & 1; \
    _Pragma("unroll") for (int mm = 0; mm < 2; ++mm) _Pragma("unroll") for (int bj = 0; bj < 2; ++bj) { \
      const u16* gp = Gt + (size_t)(row0 + ai_ * 128 + (mh_ * 2 + mm) * 16) * 4096 + col0 + bj * 128; \
      gin[slot][mm][bj] = *(const uint4*)(gp + r * 1024); gnn[slot][mm][bj] = *(const uint4*)(gp + rn * 1024); } } while (0)
    EPB_LOAD(0, 0);
#pragma unroll
    for (int k = 0; k < 4; ++k) {
      const int ai = k >> 1, mh = k & 1, slot = k & 1;
      if (k + 1 < 4) EPB_LOAD(slot ^ 1, k + 1);
#pragma unroll
      for (int mm = 0; mm < 2; ++mm) {
        const int m = mh * 2 + mm;
        const size_t row = (size_t)(row0 + ai * 128 + m * 16);
#pragma unroll
        for (int bj = 0; bj < 2; ++bj) {
          const int col = col0 + bj * 128;
          float gv[8];
          unpack8(gin[slot][mm][bj], gv);
          if (r < 3) {
            float gn[8];
            unpack8(gnn[slot][mm][bj], gn);
#pragma unroll
            for (int e = 0; e < 4; ++e) {
              acc[ai][bj][m][0][e] *= gv[e] * __builtin_amdgcn_rcpf(gn[e]);
              acc[ai][bj][m][1][e] *= gv[4 + e] * __builtin_amdgcn_rcpf(gn[4 + e]);
            }
          } else {
            f32x4 a = acc[ai][bj][m][0], b = acc[ai][bj][m][1];
#pragma unroll
            for (int e = 0; e < 4; ++e) { a[e] *= gv[e]; b[e] *= gv[4 + e]; }
            *(uint4*)(Mg + row * 1024 + col) = pk8(a, b);
          }
        }
      }
    }
#undef EPB_LOAD
    return r < 3;
  }
};
__device__ void phase_branch(const Params& p, int l, char* lds, int lat_only) {
  BranchSched S{(const char*)p.out, wsel(p, l) + OFF_WBT, (int)gridDim.x, (int)blockIdx.x, lat_only};
  EpiBranch E{(const u16*)(p.ws + OFF_P), (u16*)(p.ws + OFF_OA)};
  pg8::gemm_stream((LAS unsigned char*)lds, S, E);
}

struct EpiResid {
  const Params* pp; const float* mod; int g, gidx; float* dummy;
  DI bool operator()(f32x4 (&acc)[2][2][4][2], const pg8::UDesc& u, int wr, int wc, int fr, int fq) const {
    int mr; u16* xb = xrow_ptr(*pp, g, u.pm * 256, mr);
    if (dummy) xb = (u16*)dummy + (size_t)u.pm * 256 * DM;
    const float* gate = mod + (size_t)mr * 6144 + gidx * DM;
    const int row0 = wr * 64 + fr, col0 = u.pn * 256 + wc * 32 + 8 * fq;
    f32x4 gv[2][2];
#pragma unroll
    for (int bj = 0; bj < 2; ++bj) { gv[bj][0] = *(const f32x4*)(gate + col0 + bj * 128); gv[bj][1] = *(const f32x4*)(gate + col0 + bj * 128 + 4); }
#pragma unroll
    for (int ai = 0; ai < 2; ++ai) {
      uint4 xin[4][2];
#pragma unroll
      for (int m = 0; m < 4; ++m)
#pragma unroll
        for (int bj = 0; bj < 2; ++bj) xin[m][bj] = *(const uint4*)(xb + (size_t)(row0 + ai * 128 + m * 16) * DM + col0 + bj * 128);
#pragma unroll
      for (int m = 0; m < 4; ++m) {
        u16* xr = xb + (size_t)(row0 + ai * 128 + m * 16) * DM + col0;
#pragma unroll
        for (int bj = 0; bj < 2; ++bj) {
          float xv[8];
          unpack8(xin[m][bj], xv);
          f32x4 x0 = {xv[0], xv[1], xv[2], xv[3]}, x1 = {xv[4], xv[5], xv[6], xv[7]};
          x0 += gv[bj][0] * acc[ai][bj][m][0]; x1 += gv[bj][1] * acc[ai][bj][m][1];
          *(uint4*)(xr + bj * 128) = pk8(x0, x1);
        }
      }
    }
    return false;
  }
};
__device__ void phase_resid_gemm(const Params& p, int l, int g, const char* A, const char* W, int K, int gidx, char* lds, float* dummy = nullptr) {
  pg8::PlainSched S{A, W, (unsigned)K * 2u, (unsigned)K * 2u, K / 64, NTOK / 256, 4, (int)gridDim.x, (int)blockIdx.x, (l == DEPTH - 1) ? 1 : 0};
  EpiResid E{&p, (const float*)(p.ws + OFF_MOD) + (size_t)l * 33 * 6144, g, gidx, dummy};
  pg8::gemm_stream((LAS unsigned char*)lds, S, E);
}

struct EpiFF1 {
  u16* Hid;
  DI bool operator()(f32x4 (&acc)[2][2][4][2], const pg8::UDesc& u, int wr, int wc, int fr, int fq) const {
    const int row0 = u.pm * 256 + wr * 64 + fr, col0 = u.pn * 256 + wc * 32 + 8 * fq;
#pragma unroll
    for (int ai = 0; ai < 2; ++ai)
#pragma unroll
      for (int m = 0; m < 4; ++m) {
        const size_t row = (size_t)(row0 + ai * 128 + m * 16);
#pragma unroll
        for (int bj = 0; bj < 2; ++bj) {
          f32x4 a = acc[ai][bj][m][0], b = acc[ai][bj][m][1];
#pragma unroll
          for (int e = 0; e < 4; ++e) { float t = fmaxf(a[e], 0.f); a[e] = t * t; t = fmaxf(b[e], 0.f); b[e] = t * t; }
          *(uint4*)(Hid + row * DFF + col0 + bj * 128) = pk8(a, b);
        }
      }
    return false;
  }
};
__device__ void phase_ff1(const Params& p, int l, char* lds, int lat_only) {
  pg8::PlainSched S{p.ws + OFF_H, wsel(p, l) + OFF_W1T, 2048u, 2048u, 16, NTOK / 256, 16, (int)gridDim.x, (int)blockIdx.x, lat_only};
  EpiFF1 E{(u16*)(p.ws + OFF_P)};
  pg8::gemm_stream((LAS unsigned char*)lds, S, E);
}

DI void final_finish(const uint2 (&q)[4], int lane, const float4 (&gfv)[4], float* orow) {
  float4 v[4]; float ss = 0.f;
#pragma unroll
  for (int j = 0; j < 4; ++j) {
    v[j].x = __uint_as_float(q[j].x << 16); v[j].y = __uint_as_float(q[j].x & 0xffff0000u); v[j].z = __uint_as_float(q[j].y << 16); v[j].w = __uint_as_float(q[j].y & 0xffff0000u);
    ss += v[j].x * v[j].x + v[j].y * v[j].y + v[j].z * v[j].z + v[j].w * v[j].w;
  }
  ss = wave_sum(ss);
  const float rstd = rsqrtf(ss * (1.f / DM) + EPS);
#pragma unroll
  for (int j = 0; j < 4; ++j) {
    const int c = j * 256 + lane * 4;
    const float4 gg = gfv[j];
    float4 o = {v[j].x * rstd * gg.x, v[j].y * rstd * gg.y, v[j].z * rstd * gg.z, v[j].w * rstd * gg.w};
    *(float4*)(orow + c) = o;
  }
}
__device__ void phase_final(const Params& p) {
  const int tid = otid(), lane = tid & 63, wid = tid >> 6;
  const int stride = gridDim.x * 8;
  const u16* X = (const u16*)(p.ws + OFF_XL);
  float4 gfv[4];
#pragma unroll
  for (int j = 0; j < 4; ++j) gfv[j] = *(const float4*)(p.gfin + j * 256 + lane * 4);
  for (int tok = blockIdx.x * 8 + wid; tok < NBATCH * SEQ; tok += 2 * stride) {
    const int tokB = tok + stride;
    const bool doB = tokB < NBATCH * SEQ;
    uint2 qa[4], qb[4];
    norm_load(X + (size_t)tok * DM, lane, qa);
    norm_load(X + (size_t)(doB ? tokB : tok) * DM, lane, qb);
    final_finish(qa, lane, gfv, p.out + (size_t)tok * DM);
    if (doB) final_finish(qb, lane, gfv, p.out + (size_t)tokB * DM);
  }
}

#define XB_TMO      128
#define XB_XCNT(j)  (256  + 64 * (j))
#define XB_XSUB(j)  (1280 + 64 * (j))
#define XB_XGEN(j)  (2304 + 64 * (j))
#define XB_TOP      3328
#define XB_TOPGEN   3392
#define XCD_BAR_WORDS 3456
#define XB_SPIN_CAP (1u << 18)
DI unsigned xb_ld(unsigned* p) { return __hip_atomic_load(p, __ATOMIC_RELAXED, __HIP_MEMORY_SCOPE_AGENT); }
DI unsigned xb_add(unsigned* p, unsigned v) { return __hip_atomic_fetch_add(p, v, __ATOMIC_RELAXED, __HIP_MEMORY_SCOPE_AGENT); }
DI unsigned xb_xcc_id() { return (unsigned)__builtin_amdgcn_s_getreg((3 << 11) | 20) & 0xFu; }
#define XB_SPIN(cond, bar) do { unsigned _sp = 0; while (cond) { __builtin_amdgcn_s_sleep(1); \
    if ((++_sp & 255u) == 0u) { if (xb_ld(&(bar)[XB_TMO])) break; if (_sp > XB_SPIN_CAP) { atomicAdd(&(bar)[XB_TMO], 1u); break; } } } } while (0)
struct XcdBarrier { unsigned* bar; unsigned x; volatile __attribute__((address_space(3))) unsigned* st; };
DI XcdBarrier xcd_barrier_post(unsigned* bar, volatile __attribute__((address_space(3))) unsigned* st) {
  XcdBarrier b; b.bar = bar; b.x = xb_xcc_id(); b.st = st;
  if (threadIdx.x == 0) (void)xb_add(&bar[XB_XCNT(b.x)], 1u);
  return b;
}
DI void xcd_barrier_complete(unsigned* bar, unsigned x, unsigned& nloc, unsigned& nx) {
  const unsigned G = gridDim.x * gridDim.y * gridDim.z;
  unsigned sum, cnt, mine, sp = 0u;
  for (;;) {
    sum = 0u; cnt = 0u; mine = 0u;
#pragma unroll
    for (unsigned j = 0; j < 16; ++j) { const unsigned c = xb_ld(&bar[XB_XCNT(j)]); sum += c; cnt += (c > 0u) ? 1u : 0u; mine = (j == x) ? c : mine; }
    if (sum == G) break;
    __builtin_amdgcn_s_sleep(1);
    if ((++sp & 255u) == 0u) { if (xb_ld(&bar[XB_TMO])) break; if (sp > XB_SPIN_CAP) { atomicAdd(&bar[XB_TMO], 1u); break; } }
  }
  nloc = mine > 0u ? mine : 1u; nx = cnt > 0u ? cnt : 1u;
}
DI void xcd_barrier(const XcdBarrier& b) {
  asm volatile("s_waitcnt vmcnt(0)" ::: "memory");
  __syncthreads();
  if (threadIdx.x == 0) {
    unsigned* bar = b.bar;
    __builtin_amdgcn_s_waitcnt(0);
    unsigned nloc = b.st[0], nx = b.st[1];
    if (nloc == 0u) { xcd_barrier_complete(bar, b.x, nloc, nx); b.st[0] = nloc; b.st[1] = nx; }
    const unsigned old = xb_add(&bar[XB_XSUB(b.x)], 1u);
    const unsigned gen = old / nloc;
    if (old + 1u == (gen + 1u) * nloc) {
      __builtin_amdgcn_fence(__ATOMIC_RELEASE, "agent");
      asm volatile("s_waitcnt vmcnt(0)" ::: "memory");
      const unsigned og = xb_add(&bar[XB_TOP], 1u);
      const unsigned tg = og / nx;
      if (og + 1u == (tg + 1u) * nx) xb_add(&bar[XB_TOPGEN], 1u);
      else XB_SPIN(xb_ld(&bar[XB_TOPGEN]) == tg, bar);
      __builtin_amdgcn_fence(__ATOMIC_ACQUIRE, "agent");
      xb_add(&bar[XB_XGEN(b.x)], 1u);
      asm volatile("s_waitcnt vmcnt(0)" ::: "memory");
    } else {
      XB_SPIN(xb_ld(&bar[XB_XGEN(b.x)]) == gen, bar);
      __builtin_amdgcn_fence(__ATOMIC_ACQUIRE, "agent");
      asm volatile("s_waitcnt vmcnt(0)" ::: "memory");
    }
  }
  __syncthreads();
}

constexpr int NSUB = 12;
constexpr int NPHASE = 1 + DEPTH * NG * NSUB + 1;

__global__ void __launch_bounds__(512) mega(Params p, int ph_lo, int ph_hi) {
  extern __shared__ __attribute__((aligned(16))) char lds[];
  volatile __attribute__((address_space(3))) unsigned* st = (volatile __attribute__((address_space(3))) unsigned*)(lds + LDS_BYTES - 32);
  if (threadIdx.x < 2) st[threadIdx.x] = 0u;
  __syncthreads();
  XcdBarrier xb{};
  if (ph_hi - ph_lo > 1) xb = xcd_barrier_post((unsigned*)(p.ws + OFF_BAR), st);
#define GSYNC() xcd_barrier(xb)
  for (int ph = ph_lo; ph < ph_hi; ++ph) {
    if (ph > 0 && ph < NPHASE - 1 && ((ph - 1) % NSUB) == 0 && ((ph - 1) / NSUB) != 0) continue;
    if (ph == 0) { phase_prep(p, lds); phase_wconv(p, 0, lds); }
    else if (ph == NPHASE - 1) phase_final(p);
    else {
      const int q = ph - 1, lg = q / NSUB, sub = q % NSUB, l = lg / NG, g = lg % NG;
      switch (sub) {
        case 0: if (lg == 0) phase_norm(p, l, g, 0); break;
        case 1: for (int rep = 0; rep < ((PROBE & 2) ? 2 : 1); ++rep) { if (rep) GSYNC(); phase_inproj(p, l, lds); } break;
        case 2: phase_tokprep(p, l); break;
        case 3: phase_mlaup(p, l, lds); break;
        case 4: phase_mixers(p, l, g, lds); if (PROBE & 1) { GSYNC(); phase_mixers(p, l, g, lds, 8); } if (PROBE & 4) { GSYNC(); phase_mixers(p, l, g, lds, 8, true); } if (PROBE & 16) { GSYNC(); phase_mixers(p, l, g, lds, 8, true, true); } break;
        case 5: for (int rep = 0; rep < ((PROBE & 8) ? 2 : 1); ++rep) { if (rep) GSYNC(); phase_readout(p, l); } break;
        case 6: for (int rep = 0; rep < ((PROBE & 2) ? 2 : 1); ++rep) { if (rep) GSYNC(); phase_gate(p, l, lds, l == DEPTH - 1); } break;
        case 7: for (int rep = 0; rep < ((PROBE & 32) ? 2 : 1); ++rep) { if (rep) GSYNC(); phase_branch(p, l, lds, l == DEPTH - 1); } if (g == 0 && l + 1 < DEPTH) phase_wconv(p, l + 1, lds, (int*)(p.ws + OFF_CNT) + 24 + l); break;
        case 8: for (int rep = 0; rep < ((PROBE & 64) ? 2 : 1); ++rep) { if (rep) GSYNC(); phase_resid_gemm(p, l, g, p.ws + OFF_OA, wsel(p, l) + OFF_WOT, DM, 2, lds, rep ? (float*)((char*)p.out) : nullptr); } break;
        case 9: for (int rep = 0; rep < ((PROBE & 8) ? 2 : 1); ++rep) { if (rep) GSYNC(); phase_norm(p, l, g, 1); } break;
        case 10: for (int rep = 0; rep < ((PROBE & 2) ? 2 : 1); ++rep) { if (rep) GSYNC(); phase_ff1(p, l, lds, l == DEPTH - 1); } break;
        default: for (int rep = 0; rep < ((PROBE & 64) ? 2 : 1); ++rep) { if (rep) GSYNC(); phase_resid_gemm(p, l, g, p.ws + OFF_P, wsel(p, l) + OFF_W2T, DFF, 5, lds, rep ? (float*)((char*)p.out) : nullptr); } if (lg + 1 < DEPTH * NG) phase_norm_dyn(p, (lg + 1) / NG, (lg + 1) % NG, (int*)(p.ws + OFF_CNT) + 16 + lg); break;
      }
    }
    if (ph + 1 < ph_hi) { if (ph == ph_lo) cg::this_grid().sync(); else GSYNC(); }
  }
}

extern "C" void kernel_launch(void* const* d_in, const int* in_sizes, int n_in, void* d_out, int out_size, void* d_ws,
                              size_t ws_size, hipStream_t stream) {
  static int grid_blocks = 0;
  if (!grid_blocks) {
    int dev = 0, cus = 0, per_cu = 0;
    (void)hipGetDevice(&dev);
    (void)hipDeviceGetAttribute(&cus, hipDeviceAttributeMultiprocessorCount, dev);
    (void)hipFuncSetAttribute((const void*)mega, hipFuncAttributeMaxDynamicSharedMemorySize, LDS_BYTES);
    (void)hipOccupancyMaxActiveBlocksPerMultiprocessor(&per_cu, mega, NTHR, LDS_BYTES);
    if (per_cu < 1) per_cu = 1;
    if (per_cu > 1) per_cu = 1;
    grid_blocks = cus * per_cu;
  }
  if (ws_size < WS_NEED) { fprintf(stderr, "workspace too small: %zu < %zu\n", ws_size, (size_t)WS_NEED); }
  Params p{};
  const float** pf = (const float**)&p;
  for (int i = 0; i < 26; ++i) pf[i] = (const float*)d_in[i];
  p.out = (float*)d_out;
  p.ws = (char*)d_ws;
  (void)hipMemsetAsync((char*)d_ws + OFF_CNT, 0, 256 + 3456 * 4, stream);
#if ONE_LAUNCH
  int lo = 0, hi = NPHASE;
  void* args[] = {&p, &lo, &hi};
  hipError_t e = hipLaunchCooperativeKernel((void*)mega, dim3(grid_blocks), dim3(NTHR), args, LDS_BYTES, stream);
  if (e != hipSuccess) fprintf(stderr, "cooperative launch failed: %s (grid %d)\n", hipGetErrorString(e), grid_blocks);
#else
  for (int ph = 0; ph < NPHASE; ++ph) mega<<<grid_blocks, NTHR, LDS_BYTES, stream>>>(p, ph, ph + 1);
#endif
}
```

```cpp
#include <hip/hip_runtime.h>
#include <hip/hip_cooperative_groups.h>
#include <cstdio>
#include <cstdint>
namespace cg = cooperative_groups;

#ifndef PROBE
#define PROBE 0
#endif
#ifndef ONE_LAUNCH
#define ONE_LAUNCH 1
#endif

typedef unsigned short u16;
typedef short bf16x8 __attribute__((ext_vector_type(8)));
typedef short s16x4 __attribute__((ext_vector_type(4)));
typedef float f32x16 __attribute__((ext_vector_type(16)));
typedef float f32x2v __attribute__((ext_vector_type(2)));
typedef __bf16 bf16x2v __attribute__((ext_vector_type(2)));
#define DI __device__ __forceinline__
#define MFMA(a, b, c) __builtin_amdgcn_mfma_f32_32x32x16_bf16((a), (b), (c), 0, 0, 0)

constexpr int DM = 1024, NBATCH = 32, SEQ = 2048, CTXL = 256, DEPTH = 4, DFF = 4096;
constexpr int NG = 2, NB = 16, TPB = 2304, NTOK = NB * TPB;
constexpr int PS = 5376, NPC = 5328, INW = 9424;
constexpr int A_I = 0, A_FF = 512, A_FB = 1024, B_K = 1536, B_V = 1792, B_G = 2304, C_K = 2320, C_V = 2448,
              D_CKV = 2576, D_KR = 2704, A_Q = 2768, A_G = 3280, B_Q = 3792, B_O = 4048, C_Q = 4560, D_CQ = 5072;
constexpr float EPS = 1e-6f;
constexpr float LOG2E = 1.4426950408889634f;

constexpr size_t al256(size_t x) { return (x + 255) & ~(size_t)255; }
constexpr size_t OFF_WINT = 0;
constexpr size_t OFF_WGT = OFF_WINT + al256((size_t)PS * 1024 * 2);
constexpr size_t OFF_WBT = OFF_WGT + al256((size_t)4096 * 1024 * 2);
constexpr size_t OFF_WOT = OFF_WBT + al256((size_t)4 * 1024 * 512 * 2);
constexpr size_t OFF_W1T = OFF_WOT + al256((size_t)1024 * 1024 * 2);
constexpr size_t OFF_W2T = OFF_W1T + al256((size_t)4096 * 1024 * 2);
constexpr size_t OFF_WUQ = OFF_W2T + al256((size_t)1024 * 4096 * 2);
constexpr size_t OFF_WUK = OFF_WUQ + al256((size_t)768 * 256 * 2);
constexpr size_t OFF_WUV = OFF_WUK + al256((size_t)512 * 128 * 2);
constexpr size_t OFF_MOD = OFF_WUV + al256((size_t)512 * 128 * 2);
constexpr size_t OFF_LB = OFF_MOD + al256((size_t)4 * 33 * 6144 * 4);
constexpr size_t OFF_ROPE = OFF_LB + al256((size_t)4 * 2 * 512 * 4);
constexpr size_t OFF_CNT = OFF_ROPE + al256((size_t)2 * 64 * 16 * 4);
constexpr size_t OFF_BAR = OFF_CNT + 256;
constexpr size_t OFF_XC = OFF_BAR + al256(3456 * 4);
constexpr size_t OFF_XL = OFF_XC + al256((size_t)NBATCH * CTXL * DM * 2);
constexpr size_t OFF_P = OFF_XL + al256((size_t)NBATCH * SEQ * DM * 2);
constexpr size_t OFF_GB = OFF_P + al256((size_t)NTOK * PS * 2);
constexpr size_t OFF_KQ = OFF_GB + al256((size_t)NTOK * 16 * 4);
constexpr size_t OFF_H = OFF_KQ + al256((size_t)NTOK * 512 * 2);
constexpr size_t OFF_QD = OFF_H + al256((size_t)NTOK * 1024 * 2);
constexpr size_t OFF_KD = OFF_QD + al256((size_t)NTOK * 768 * 2);
constexpr size_t OFF_VD = OFF_KD + al256((size_t)NTOK * 768 * 2);
constexpr size_t OFF_OA = OFF_VD + al256((size_t)NTOK * 512 * 2);
constexpr size_t OFF_OB = OFF_OA + al256((size_t)2 * NTOK * 512 * 2);
constexpr size_t OFF_W2ND = OFF_OB + al256((size_t)2 * NTOK * 512 * 2);
constexpr size_t WS_NEED = OFF_W2ND + (OFF_MOD - OFF_WINT);
constexpr int LDS_BYTES = 143360;
constexpr int LDSV = 69632;
constexpr int NTHR = 512;
constexpr size_t OFF_MF = OFF_QD;

struct Params {
  const float *x, *c, *ctx, *c_ctx, *w_ada, *b_ada, *g1, *g2, *w_in, *bgate, *lblog, *hnorm, *convw, *mnorm,
      *gqn, *gkn, *mqn, *mkvn, *wuq, *wuk, *wuv, *wbr, *wout, *wff1, *wff2, *gfin;
  float* out;
  char* ws;
};

DI int otid() { int t = threadIdx.x; asm volatile("" : "+v"(t)); return t; }
DI char* wsel(const Params& p, int l) { return p.ws + ((l & 1) ? OFF_W2ND : (size_t)0); }
DI float bf2f(u16 v) { return __uint_as_float(((unsigned)v) << 16); }
DI unsigned pack2(float a, float b) {
  f32x2v v = {a, b};
  bf16x2v r = __builtin_convertvector(v, bf16x2v);
  return __builtin_bit_cast(unsigned, r);
}
DI u16 f2bf(float a) { return (u16)(pack2(a, 0.f) & 0xffffu); }
DI int crow(int reg, int h) { return (reg & 3) + 8 * (reg >> 2) + 4 * h; }
DI float sigmoidf_(float x) { return 1.f / (1.f + __expf(-x)); }
DI float siluf_(float x) { return x / (1.f + __expf(-x)); }
DI float ex2(float x) { return __builtin_amdgcn_exp2f(x); }
DI bf16x8 pack8(const f32x16& x, int s) {
  union { unsigned u[4]; bf16x8 v; } t;
  t.u[0] = pack2(x[8 * s + 0], x[8 * s + 1]);
  t.u[1] = pack2(x[8 * s + 2], x[8 * s + 3]);
  t.u[2] = pack2(x[8 * s + 4], x[8 * s + 5]);
  t.u[3] = pack2(x[8 * s + 6], x[8 * s + 7]);
  return t.v;
}
DI bf16x8 cat4(s16x4 lo, s16x4 hi) { return __builtin_shufflevector(lo, hi, 0, 1, 2, 3, 4, 5, 6, 7); }
DI float wave_sum(float v) {
#pragma unroll
  for (int d = 32; d >= 1; d >>= 1) v += __shfl_xor(v, d);
  return v;
}
DI void unpack8(const uint4& q, float* f) {
  f[0] = __uint_as_float(q.x << 16); f[1] = __uint_as_float(q.x & 0xffff0000u);
  f[2] = __uint_as_float(q.y << 16); f[3] = __uint_as_float(q.y & 0xffff0000u);
  f[4] = __uint_as_float(q.z << 16); f[5] = __uint_as_float(q.z & 0xffff0000u);
  f[6] = __uint_as_float(q.w << 16); f[7] = __uint_as_float(q.w & 0xffff0000u);
}
DI uint4 pack8f(const float* f) {
  uint4 q;
  q.x = pack2(f[0], f[1]); q.y = pack2(f[2], f[3]); q.z = pack2(f[4], f[5]); q.w = pack2(f[6], f[7]);
  return q;
}

DI u16* xrow_ptr(const Params& p, int g, int tok, int& modrow) {
  int bl = tok / TPB, pp = tok - bl * TPB, b = g * NB + bl;
  if (pp < CTXL) { modrow = 32; return (u16*)(p.ws + OFF_XC) + ((size_t)b * CTXL + pp) * DM; }
  modrow = b;
  return (u16*)(p.ws + OFF_XL) + ((size_t)b * SEQ + (pp - CTXL)) * DM;
}

#define LAS __attribute__((address_space(3)))
typedef float f32x4 __attribute__((ext_vector_type(4)));
namespace pg8 {
constexpr int BM = 256, BK = 64, HALF = 128, HTB = HALF * BK * 2, STAGE_BYTES = 8 * HTB, NXCD = 8, WGM = 8;
DI int lds_byte(int r, int c) { const int st = (r >> 4) * 2 + (c >> 5), rr = r & 15, cc = c & 31, ob = rr * 64 + cc * 2; return st * 1024 + (ob ^ (((ob >> 9) & 1) << 5)); }
DI void stage_rc(int b, int& R, int& C) { const int st = b / 1024, sb = b % 1024, swz = sb ^ (((sb >> 9) & 1) << 5); R = (st >> 1) * 16 + swz / 64; C = (st & 1) * 32 + (swz % 64) / 2; }
DI int perm32(int rho) { const int n = rho >> 4, i = rho & 15; return 8 * (i >> 2) + 4 * n + (i & 3); }
struct UDesc { const char* A; const char* B; unsigned lda2, ldb2; int nt, pm, pn, tag; };
DI bool tile_order(long L, int nM, int nN, int& pm, int& pn) {
  const int nwg = nM * nN; if (L >= nwg) return false;
  int wgid = (int)L; { const int q = nwg / NXCD, r = nwg % NXCD, xcd = wgid % NXCD, off = wgid / NXCD; wgid = (xcd < r ? xcd * (q + 1) : r * (q + 1) + (xcd - r) * q) + off; }
  const int nig = WGM * nN, gid = wgid / nig, fm = gid * WGM, gsz = (nM - fm) < WGM ? (nM - fm) : WGM;
  pm = fm + ((wgid % nig) % gsz); pn = (wgid % nig) / gsz; return true;
}
template <class Epi, class Sched>
DI void gemm_stream(LAS unsigned char* lds, const Sched& S, const Epi& E) {
  const int tid = otid(), wid = __builtin_amdgcn_readfirstlane(tid >> 6), lane = tid & 63, wr = wid >> 2, wc = wid & 3, fr = lane & 15, fq = lane >> 4;
  int RA[2], RB[2], CC[2];
#pragma unroll
  for (int i = 0; i < 2; ++i) { int R, C; stage_rc(tid * 16 + i * 8192, R, C); RA[i] = R; RB[i] = (R & ~31) + perm32(R & 31); CC[i] = C * 2; }
  const size_t kstep = (size_t)(BK * 2);
  const unsigned ldsw = (unsigned)wid * 1024u;
  const int aoff = lds_byte(wr * 64 + fr, fq * 8), boff = lds_byte(wc * 32 + fr, fq * 8);
#define PG8_SA(b, h) (((b) * 2 + (h)) * HTB)
#define PG8_SB(b, h) ((4 + (b) * 2 + (h)) * HTB)
#define PG8_STAGE(bufoff, gbase, voff) do { _Pragma("unroll") for (int _i = 0; _i < 2; ++_i) \
    __builtin_amdgcn_global_load_lds((const unsigned*)((const char*)(gbase) + (voff)[_i]), (LAS unsigned*)(lds + (bufoff) + ldsw + _i * 8192), 16, 0, 0); } while (0)
#define PG8_LDA(dst, b, h) do { _Pragma("unroll") for (int m = 0; m < 4; ++m) _Pragma("unroll") for (int k = 0; k < 2; ++k) dst[m][k] = *(const LAS bf16x8*)(lds + PG8_SA(b, h) + aoff + m * 2048 + k * 1024); } while (0)
#define PG8_LDB(dst, b, h) do { _Pragma("unroll") for (int n = 0; n < 2; ++n) _Pragma("unroll") for (int k = 0; k < 2; ++k) dst[n][k] = *(const LAS bf16x8*)(lds + PG8_SB(b, h) + boff + n * 2048 + k * 1024); } while (0)
#define PG8_MMA(ai, bj, At, Bt) do { __builtin_amdgcn_s_setprio(1); _Pragma("unroll") for (int m = 0; m < 4; ++m) _Pragma("unroll") for (int n = 0; n < 2; ++n) _Pragma("unroll") for (int k = 0; k < 2; ++k) \
    acc[ai][bj][m][n] = __builtin_amdgcn_mfma_f32_16x16x32_bf16(Bt[n][k], At[m][k], acc[ai][bj][m][n], 0, 0, 0); __builtin_amdgcn_s_setprio(0); } while (0)
#define PG8_WAIT_V(n) asm volatile("s_waitcnt vmcnt(" #n ")" ::: "memory")
#define PG8_WAIT_L(n) asm volatile("s_waitcnt lgkmcnt(" #n ")" ::: "memory")
#define PG8_BAR __builtin_amdgcn_s_barrier()
#define PG8_SCHED __builtin_amdgcn_sched_barrier(0)
  UDesc cur, nxt; int ui = 0;
  if (!S.next(0, cur)) return;
  f32x4 acc[2][2][4][2];
#pragma unroll
  for (int a = 0; a < 2; ++a)
#pragma unroll
    for (int b = 0; b < 2; ++b)
#pragma unroll
      for (int m = 0; m < 4; ++m)
#pragma unroll
        for (int n = 0; n < 2; ++n) acc[a][b][m][n] = (f32x4){0.f, 0.f, 0.f, 0.f};
  bf16x8 At[4][2], B0[2][2], B1[2][2];
  const char* cA = cur.A; const char* cB = cur.B;
  unsigned vA[2], vB[2];
#pragma unroll
  for (int i = 0; i < 2; ++i) { vA[i] = (unsigned)RA[i] * cur.lda2 + CC[i]; vB[i] = (unsigned)RB[i] * cur.ldb2 + CC[i]; }
  size_t hA = (size_t)HALF * cur.lda2, hB = (size_t)HALF * cur.ldb2;
  PG8_STAGE(PG8_SB(0, 0), cB, vB); PG8_STAGE(PG8_SA(0, 0), cA, vA); PG8_STAGE(PG8_SB(0, 1), cB + hB, vB); PG8_STAGE(PG8_SA(0, 1), cA + hA, vA);
  if (wr == 1) PG8_BAR;
  PG8_WAIT_V(4); PG8_BAR;
  PG8_STAGE(PG8_SB(1, 0), cB + kstep, vB); PG8_STAGE(PG8_SA(1, 0), cA + kstep, vA); PG8_STAGE(PG8_SB(1, 1), cB + hB + kstep, vB);
  PG8_WAIT_V(6); PG8_BAR;
  for (;;) {
    const bool has_next = S.next(ui + 1, nxt);
    const char* nA = has_next ? nxt.A : cA; const char* nB = has_next ? nxt.B : cB;
    const unsigned nlda = has_next ? nxt.lda2 : cur.lda2, nldb = has_next ? nxt.ldb2 : cur.ldb2;
    unsigned nvA[2], nvB[2];
#pragma unroll
    for (int i = 0; i < 2; ++i) { nvA[i] = (unsigned)RA[i] * nlda + CC[i]; nvB[i] = (unsigned)RB[i] * nldb + CC[i]; }
    const size_t nhA = (size_t)HALF * nlda, nhB = (size_t)HALF * nldb;
    const int nt = cur.nt;
    for (int t = 0; t < nt; t += 2) {
      const bool last = (t == nt - 2);
      const char* a1 = cA + (size_t)(t + 1) * kstep;
      const char* a2 = last ? nA : cA + (size_t)(t + 2) * kstep; const char* b2 = last ? nB : cB + (size_t)(t + 2) * kstep;
      const char* a3 = a2 + kstep; const char* b3 = b2 + kstep;
      unsigned v2A[2], v2B[2];
#pragma unroll
      for (int i = 0; i < 2; ++i) { v2A[i] = last ? nvA[i] : vA[i]; v2B[i] = last ? nvB[i] : vB[i]; }
      const size_t h2A = last ? nhA : hA, h2B = last ? nhB : hB;
      PG8_LDB(B0, 0, 0); PG8_SCHED; PG8_LDA(At, 0, 0); PG8_STAGE(PG8_SA(1, 1), a1 + hA, vA);
      PG8_WAIT_L(8); PG8_BAR; PG8_WAIT_L(0); PG8_MMA(0, 0, At, B0); PG8_BAR; PG8_SCHED;
      PG8_LDB(B1, 0, 1); PG8_STAGE(PG8_SB(0, 0), b2, v2B);
      PG8_BAR; PG8_WAIT_L(0); PG8_MMA(0, 1, At, B1); PG8_BAR;
      PG8_LDA(At, 0, 1); PG8_STAGE(PG8_SA(0, 0), a2, v2A);
      PG8_BAR; PG8_WAIT_L(0); PG8_MMA(1, 0, At, B0); PG8_BAR; PG8_SCHED;
      PG8_STAGE(PG8_SB(0, 1), b2 + h2B, v2B);
      PG8_WAIT_V(6); PG8_BAR; PG8_MMA(1, 1, At, B1); PG8_BAR;
      PG8_LDB(B0, 1, 0); PG8_SCHED; PG8_LDA(At, 1, 0); PG8_STAGE(PG8_SA(0, 1), a2 + h2A, v2A);
      PG8_WAIT_L(8); PG8_BAR; PG8_WAIT_L(0); PG8_MMA(0, 0, At, B0); PG8_BAR; PG8_SCHED;
      PG8_LDB(B1, 1, 1); PG8_STAGE(PG8_SB(1, 0), b3, v2B);
      PG8_BAR; PG8_WAIT_L(0); PG8_MMA(0, 1, At, B1); PG8_BAR;
      PG8_LDA(At, 1, 1); PG8_STAGE(PG8_SA(1, 0), a3, v2A);
      PG8_BAR; PG8_WAIT_L(0); PG8_MMA(1, 0, At, B0); PG8_BAR; PG8_SCHED;
      PG8_STAGE(PG8_SB(1, 1), b3 + h2B, v2B);
      PG8_WAIT_V(6); PG8_BAR; PG8_MMA(1, 1, At, B1); PG8_BAR;
    }
    const bool keep = E(acc, cur, wr, wc, fr, fq);
    if (!has_next) break;
    if (!keep) {
#pragma unroll
      for (int a = 0; a < 2; ++a)
#pragma unroll
        for (int b = 0; b < 2; ++b)
#pragma unroll
          for (int m = 0; m < 4; ++m)
#pragma unroll
            for (int n = 0; n < 2; ++n) acc[a][b][m][n] = (f32x4){0.f, 0.f, 0.f, 0.f};
    }
    cur = nxt; cA = nA; cB = nB; hA = nhA; hB = nhB;
#pragma unroll
    for (int i = 0; i < 2; ++i) { vA[i] = nvA[i]; vB[i] = nvB[i]; }
    ++ui;
  }
  PG8_WAIT_V(0);
  if (wr == 0) PG8_BAR;
  PG8_BAR;
#undef PG8_SA
#undef PG8_SB
#undef PG8_STAGE
#undef PG8_LDA
#undef PG8_LDB
#undef PG8_MMA
#undef PG8_WAIT_V
#undef PG8_WAIT_L
#undef PG8_BAR
#undef PG8_SCHED
}
struct PlainSched {
  const char* A; const char* B; unsigned lda2, ldb2; int nt, nM, nN, G, c; int lat_only = 0;
  DI bool next(int i, UDesc& u) const {
    int pm, pn; if (!tile_order((long)i * G + c, lat_only ? nM - NB : nM, nN, pm, pn)) return false;
    if (lat_only) pm = pm + (pm >> 3) + 1;
    u.A = A + (size_t)pm * 256 * lda2; u.B = B + (size_t)pn * 256 * ldb2; u.lda2 = lda2; u.ldb2 = ldb2; u.nt = nt; u.pm = pm; u.pn = pn; u.tag = 0; return true;
  }
};
}

DI uint4 pk8(const f32x4& a, const f32x4& b) {
  uint4 q; q.x = pack2(a[0], a[1]); q.y = pack2(a[2], a[3]); q.z = pack2(b[0], b[1]); q.w = pack2(b[2], b[3]); return q;
}

__device__ void phase_prep(const Params& p, char* lds) {
  const int tid = otid(), nthr = gridDim.x * NTHR, gt = blockIdx.x * NTHR + tid;
  {
    const float4* s = (const float4*)p.x; uint2* d = (uint2*)(p.ws + OFF_XL);
    const size_t n = (size_t)NBATCH * SEQ * DM / 4;
    for (size_t i = gt; i < n; i += nthr) { const float4 v = s[i]; uint2 o; o.x = pack2(v.x, v.y); o.y = pack2(v.z, v.w); d[i] = o; }
    const float4* s2 = (const float4*)p.ctx; uint2* d2 = (uint2*)(p.ws + OFF_XC);
    const size_t n2 = (size_t)NBATCH * CTXL * DM / 4;
    for (size_t i = gt; i < n2; i += nthr) { const float4 v = s2[i]; uint2 o; o.x = pack2(v.x, v.y); o.y = pack2(v.z, v.w); d2[i] = o; }
  }
  if (gt < 1024) {
    float v[DEPTH], mx = -1e30f;
    for (int l = 0; l < DEPTH; ++l) { v[l] = p.lblog[l * 1024 + gt]; mx = fmaxf(mx, v[l]); }
    float sum = 0.f;
    for (int l = 0; l < DEPTH; ++l) { v[l] = expf(v[l] - mx); sum += v[l]; }
    float* lb = (float*)(p.ws + OFF_LB);
    float run = 0.f;
    for (int l = 0; l < DEPTH; ++l) { lb[l * 1024 + gt] = run; if (l + 1 < DEPTH) run += v[l + 1] / sum; }
  }
  if (gt >= 1024 && gt < 2048) {
    int i = gt - 1024, pos = i >> 4, fi = i & 15;
    float inv = powf(10000.f, -(float)fi / 16.f);
    float ang = (float)pos * inv;
    float* rc = (float*)(p.ws + OFF_ROPE);
    rc[i] = cosf(ang); rc[1024 + i] = sinf(ang);
  }
  float* ssm = (float*)lds;
  float* red = (float*)lds + 2 * 33 * 32;
  for (int item = blockIdx.x; item < DEPTH * 24; item += gridDim.x) {
    const int l = item / 24, kh = tid >> 8, tl = tid & 255, j = (item % 24) * 256 + tl;
    float acc[33];
#pragma unroll
    for (int r = 0; r < 33; ++r) acc[r] = 0.f;
    const float* W = p.w_ada + (size_t)l * DM * 6144;
    for (int k0 = kh * 512; k0 < kh * 512 + 512; k0 += 32) {
      __syncthreads();
      for (int idx = tl; idx < 33 * 32; idx += 256) {
        int rr = idx >> 5, kk = idx & 31;
        float cv = rr < 32 ? p.c[rr * DM + k0 + kk] : p.c_ctx[k0 + kk];
        ssm[kh * 33 * 32 + idx] = cv / (1.f + expf(-cv));
      }
      __syncthreads();
#pragma unroll 16
      for (int kk = 0; kk < 32; ++kk) {
        float w = W[(size_t)(k0 + kk) * 6144 + j];
#pragma unroll
        for (int r = 0; r < 33; ++r) acc[r] += ssm[kh * 33 * 32 + r * 32 + kk] * w;
      }
    }
    __syncthreads();
    if (kh == 1) {
#pragma unroll
      for (int r = 0; r < 33; ++r) red[r * 256 + tl] = acc[r];
    }
    __syncthreads();
    if (kh == 0) {
      float bb = p.b_ada[l * 6144 + j];
      float* mod = (float*)(p.ws + OFF_MOD) + (size_t)l * 33 * 6144;
#pragma unroll
      for (int r = 0; r < 33; ++r) mod[r * 6144 + j] = acc[r] + red[r * 256 + tl] + bb;
    }
  }
  __syncthreads();
}

DI u16* wdst(char* wb, int type, int sub, int n) {
  switch (type) {
    case 0: return n < NPC ? (u16*)(wb + OFF_WINT) + (size_t)n * 1024 : (u16*)(wb + OFF_WGT) + (size_t)(n - NPC) * 1024;
    case 1: return (u16*)(wb + OFF_WBT) + ((size_t)sub * 1024 + n) * 512;
    case 2: return (u16*)(wb + OFF_WOT) + (size_t)n * 1024;
    case 3: return (u16*)(wb + OFF_W1T) + (size_t)n * 1024;
    case 4: return (u16*)(wb + OFF_W2T) + (size_t)n * 4096;
    case 5: return (u16*)(wb + OFF_WUQ) + (size_t)n * 256;
    case 6: return (u16*)(wb + OFF_WUK) + (size_t)n * 128;
    default: return (u16*)(wb + OFF_WUV) + (size_t)n * 128;
  }
}
__device__ void phase_wconv(const Params& p, int l, char* lds, int* cnt = nullptr) {
  char* wb = wsel(p, l);
  int* s_item = (int*)(lds + LDS_BYTES - 16);
  float* tile = (float*)lds;
  const int tid = otid();
  {
    unsigned* z = (unsigned*)((u16*)(wb + OFF_WINT) + (size_t)NPC * 1024);
    for (int i = blockIdx.x * NTHR + tid; i < (PS - NPC) * 1024 / 2; i += gridDim.x * NTHR) z[i] = 0u;
  }
  constexpr int T0 = 16 * 148, T1 = T0 + 4 * 128, T2 = T1 + 256, T3 = T2 + 1024, T4 = T3 + 1024, T5 = T4 + 48, T6 = T5 + 16, T7 = T6 + 16;
  for (int itk = 0;; ++itk) {
    int it;
    if (cnt) { __syncthreads(); if (tid == 0) *s_item = atomicAdd(cnt, 1); __syncthreads(); it = *s_item; }
    else it = blockIdx.x + itk * gridDim.x;
    if (it >= T7) break;
    int type, sub = 0, K, N, kt, nt;
    const float* src;
    if (it < T0) { type = 0; K = 1024; N = INW; int q = it; kt = q / 148; nt = q % 148; src = p.w_in + (size_t)l * 1024 * INW; }
    else if (it < T1) { type = 1; K = 512; N = 1024; int q = it - T0; sub = q / 128; q %= 128; kt = q / 16; nt = q % 16; src = p.wbr + ((size_t)l * 4 + sub) * 512 * 1024; }
    else if (it < T2) { type = 2; K = 1024; N = 1024; int q = it - T1; kt = q / 16; nt = q % 16; src = p.wout + (size_t)l * 1024 * 1024; }
    else if (it < T3) { type = 3; K = 1024; N = 4096; int q = it - T2; kt = q / 64; nt = q % 64; src = p.wff1 + (size_t)l * 1024 * 4096; }
    else if (it < T4) { type = 4; K = 4096; N = 1024; int q = it - T3; kt = q / 16; nt = q % 16; src = p.wff2 + (size_t)l * 4096 * 1024; }
    else if (it < T5) { type = 5; K = 256; N = 768; int q = it - T4; kt = q / 12; nt = q % 12; src = p.wuq + (size_t)l * 256 * 768; }
    else if (it < T6) { type = 6; K = 128; N = 512; int q = it - T5; kt = q / 8; nt = q % 8; src = p.wuk + (size_t)l * 128 * 512; }
    else { type = 7; K = 128; N = 512; int q = it - T6; kt = q / 8; nt = q % 8; src = p.wuv + (size_t)l * 128 * 512; }
    (void)K;
    const int k0 = kt * 64, n0 = nt * 64;
    __syncthreads();
    {
      const int nn = tid & 63, ks = tid >> 6;
#pragma unroll 4
      for (int j = 0; j < 8; ++j) {
        int k = ks + 8 * j;
        tile[k * 65 + nn] = (n0 + nn < N) ? src[(size_t)(k0 + k) * N + n0 + nn] : 0.f;
      }
    }
    __syncthreads();
    {
      const int kp = tid & 31, nn = tid >> 5;
#pragma unroll 4
      for (int j = 0; j < 4; ++j) {
        int n = nn + 16 * j;
        if (n0 + n < N) {
          unsigned v = pack2(tile[(2 * kp) * 65 + n], tile[(2 * kp + 1) * 65 + n]);
          *(unsigned*)(wdst(wb, type, sub, n0 + n) + k0 + 2 * kp) = v;
        }
      }
    }
  }
  __syncthreads();
}

DI void norm_token(const Params& p, int l, int g, int which, int tok, int lane, const float* gn, const float* mod, u16* H) {
  int mr; const u16* xr = xrow_ptr(p, g, tok, mr);
  const float* shift = mod + (size_t)mr * 6144 + (which == 0 ? 0 : 3) * DM;
  const float* scale = shift + DM;
  float4 v[4]; float ss = 0.f;
#pragma unroll
  for (int j = 0; j < 4; ++j) {
    const uint2 q = *(const uint2*)(xr + j * 256 + lane * 4);
    v[j].x = __uint_as_float(q.x << 16); v[j].y = __uint_as_float(q.x & 0xffff0000u); v[j].z = __uint_as_float(q.y << 16); v[j].w = __uint_as_float(q.y & 0xffff0000u);
    ss += v[j].x * v[j].x + v[j].y * v[j].y + v[j].z * v[j].z + v[j].w * v[j].w;
  }
  ss = wave_sum(ss);
  const float rstd = rsqrtf(ss * (1.f / DM) + EPS);
#pragma unroll
  for (int j = 0; j < 4; ++j) {
    int c = j * 256 + lane * 4;
    float4 gg = *(const float4*)(gn + c), sh = *(const float4*)(shift + c), sc = *(const float4*)(scale + c);
    float o0 = v[j].x * rstd * gg.x * (1.f + sc.x) + sh.x;
    float o1 = v[j].y * rstd * gg.y * (1.f + sc.y) + sh.y;
    float o2 = v[j].z * rstd * gg.z * (1.f + sc.z) + sh.z;
    float o3 = v[j].w * rstd * gg.w * (1.f + sc.w) + sh.w;
    uint2 o; o.x = pack2(o0, o1); o.y = pack2(o2, o3);
    *(uint2*)(H + (size_t)tok * DM + c) = o;
  }
}
DI void norm_load(const u16* xr, int lane, uint2 (&q)[4]) {
#pragma unroll
  for (int j = 0; j < 4; ++j) q[j] = *(const uint2*)(xr + j * 256 + lane * 4);
}
DI void norm_mod_load(const float* shift, int lane, float4 (&shv)[4], float4 (&scv)[4]) {
#pragma unroll
  for (int j = 0; j < 4; ++j) { const int c = j * 256 + lane * 4; shv[j] = *(const float4*)(shift + c); scv[j] = *(const float4*)(shift + DM + c); }
}
DI void norm_finish2(const uint2 (&q)[4], int lane, const float4 (&ggv)[4], const float4 (&shv)[4], const float4 (&scv)[4], u16* hrow) {
  float4 v[4]; float ss = 0.f;
#pragma unroll
  for (int j = 0; j < 4; ++j) {
    v[j].x = __uint_as_float(q[j].x << 16); v[j].y = __uint_as_float(q[j].x & 0xffff0000u); v[j].z = __uint_as_float(q[j].y << 16); v[j].w = __uint_as_float(q[j].y & 0xffff0000u);
    ss += v[j].x * v[j].x + v[j].y * v[j].y + v[j].z * v[j].z + v[j].w * v[j].w;
  }
  ss = wave_sum(ss);
  const float rstd = rsqrtf(ss * (1.f / DM) + EPS);
#pragma unroll
  for (int j = 0; j < 4; ++j) {
    const int c = j * 256 + lane * 4;
    const float4 gg = ggv[j], sh = shv[j], sc = scv[j];
    float o0 = v[j].x * rstd * gg.x * (1.f + sc.x) + sh.x;
    float o1 = v[j].y * rstd * gg.y * (1.f + sc.y) + sh.y;
    float o2 = v[j].z * rstd * gg.z * (1.f + sc.z) + sh.z;
    float o3 = v[j].w * rstd * gg.w * (1.f + sc.w) + sh.w;
    uint2 o; o.x = pack2(o0, o1); o.y = pack2(o2, o3);
    *(uint2*)(hrow + c) = o;
  }
}
DI void norm_finish(const uint2 (&q)[4], int lane, const float* gn, const float* shift, u16* hrow) {
  float4 ggv[4], shv[4], scv[4];
#pragma unroll
  for (int j = 0; j < 4; ++j) ggv[j] = *(const float4*)(gn + j * 256 + lane * 4);
  norm_mod_load(shift, lane, shv, scv);
  norm_finish2(q, lane, ggv, shv, scv, hrow);
}
__device__ void phase_norm(const Params& p, int l, int g, int which) {
  const int tid = otid(), lane = tid & 63, wid = tid >> 6;
  const float* gn = (which == 0 ? p.g1 : p.g2) + l * DM;
  const float* mod = (const float*)(p.ws + OFF_MOD) + (size_t)l * 33 * 6144;
  u16* H = (u16*)(p.ws + OFF_H);
  const int stride = gridDim.x * 8;
  float4 ggh[4];
#pragma unroll
  for (int j = 0; j < 4; ++j) ggh[j] = *(const float4*)(gn + j * 256 + lane * 4);
  const bool skipc = which == 1 && l == DEPTH - 1;
  for (int tok = blockIdx.x * 8 + wid; tok < NTOK; tok += 2 * stride) {
    const int tokB = tok + stride;
    const bool doA = !(skipc && (tok % TPB) < CTXL), doB = tokB < NTOK && !(skipc && (tokB % TPB) < CTXL);
    int mrA = 0, mrB = 0;
    const u16* xa = xrow_ptr(p, g, tok, mrA);
    const u16* xb = xrow_ptr(p, g, doB ? tokB : tok, mrB);
    uint2 qa[4], qb[4];
    float4 shA[4], scA[4], shB[4], scB[4];
    norm_load(xa, lane, qa);
    norm_load(xb, lane, qb);
    norm_mod_load(mod + (size_t)mrA * 6144 + (which == 0 ? 0 : 3) * DM, lane, shA, scA);
    norm_mod_load(mod + (size_t)mrB * 6144 + (which == 0 ? 0 : 3) * DM, lane, shB, scB);
    if (doA) norm_finish2(qa, lane, ggh, shA, scA, H + (size_t)tok * DM);
    if (doB) norm_finish2(qb, lane, ggh, shB, scB, H + (size_t)tokB * DM);
  }
}
__device__ void phase_norm_dyn(const Params& p, int l, int g, int* cnt) {
  const int tid = otid(), lane = tid & 63;
  const float* gn = p.g1 + l * DM;
  const float* mod = (const float*)(p.ws + OFF_MOD) + (size_t)l * 33 * 6144;
  u16* H = (u16*)(p.ws + OFF_H);
  for (;;) {
    int c = 0;
    if (lane == 0) c = atomicAdd(cnt, 1);
    c = __shfl(c, 0);
    if (c >= NTOK / 8) break;
#pragma unroll 1
    for (int t = 0; t < 8; t += 2) {
      const int tokA = c * 8 + t, tokB = tokA + 1;
      int mrA = 0, mrB = 0;
      const u16* xa = xrow_ptr(p, g, tokA, mrA);
      const u16* xb = xrow_ptr(p, g, tokB, mrB);
      uint2 qa[4], qb[4];
      norm_load(xa, lane, qa);
      norm_load(xb, lane, qb);
      norm_finish(qa, lane, gn, mod + (size_t)mrA * 6144, H + (size_t)tokA * DM);
      norm_finish(qb, lane, gn, mod + (size_t)mrB * 6144, H + (size_t)tokB * DM);
    }
  }
}

__device__ void phase_tokprep(const Params& p, int l) {
  const int tid = otid(), lane = tid & 63, wid = tid >> 6;
  u16* P = (u16*)(p.ws + OFF_P);
  u16* KQ = (u16*)(p.ws + OFF_KQ);
  u16* Kd = (u16*)(p.ws + OFF_KD);
  const float* rc = (const float*)(p.ws + OFF_ROPE);
  const float* rs = rc + 1024;
  const int c8 = lane & 7;
  const bool isk_ = lane < 32;
  float cwv[24], gqv[8], gkv[8], gmv[8];
  {
    const float* cw = p.convw + ((size_t)l * 2 + (isk_ ? 1 : 0)) * 3 * 256 + (isk_ ? lane : lane - 32) * 8;
#pragma unroll
    for (int e = 0; e < 8; ++e) { cwv[e] = cw[e]; cwv[8 + e] = cw[256 + e]; cwv[16 + e] = cw[512 + e]; }
    const float* gq = p.gqn + l * 64 + c8 * 8; const float* gk = p.gkn + l * 64 + c8 * 8;
    const float* gm = lane < 16 ? p.mkvn + l * 128 + lane * 8 : p.mqn + l * 256 + ((lane >= 32 ? lane - 32 : 0)) * 8;
#pragma unroll
    for (int e = 0; e < 8; ++e) { gqv[e] = gq[e]; gkv[e] = gk[e]; gmv[e] = gm[e]; }
  }
  const uint4 zz = {0u, 0u, 0u, 0u};
  const int convcol = (isk_ ? B_K : B_Q) + (isk_ ? lane : lane - 32) * 8;
  const int mcol = lane < 16 ? D_CKV + lane * 8 : (lane >= 32 ? D_CQ + (lane - 32) * 8 : D_KR + ((lane - 16) & 7) * 8);
  uint4 n_q = zz, n_k = zz, n_m = zz, n_c0 = zz, n_c1 = zz, n_c2 = zz;
#define TOKPREP_LOAD(tok_) do { const int pp_ = (tok_) % TPB; const u16* row_ = P + (size_t)(tok_) * PS; \
    n_q = *(const uint4*)(row_ + C_Q + lane * 8); n_k = lane < 16 ? *(const uint4*)(row_ + C_K + lane * 8) : zz; n_m = *(const uint4*)(row_ + mcol); \
    n_c1 = *(const uint4*)(row_ + convcol); \
    n_c0 = !(pp_ == 0 || pp_ == CTXL) ? *(const uint4*)(row_ - PS + convcol) : zz; \
    n_c2 = !(pp_ == CTXL - 1 || pp_ == TPB - 1) ? *(const uint4*)(row_ + PS + convcol) : zz; } while (0)
  const int tstride = gridDim.x * 8;
  if (blockIdx.x * 8 + wid < NTOK) TOKPREP_LOAD(blockIdx.x * 8 + wid);
  for (int tok = blockIdx.x * 8 + wid; tok < NTOK; tok += tstride) {
    const int pp = tok % TPB;
    const bool lat = pp >= CTXL;
    const int pos = pp - CTXL, prow = pos >> 6, pcol = pos & 63;
    u16* row = P + (size_t)tok * PS;
    const uint4 pl_q = n_q, pl_k = n_k, pl_m = n_m, pl_c0 = n_c0, pl_c1 = n_c1, pl_c2 = n_c2;
    if (tok + tstride < NTOK) TOKPREP_LOAD(tok + tstride);
    float csv[8], snv[8];
    {
      const int ppos0 = (c8 & 4) ? pcol : prow;
      if (lat) {
        const float4 c0 = *(const float4*)(rc + ppos0 * 16 + (c8 & 1) * 8), c1 = *(const float4*)(rc + ppos0 * 16 + (c8 & 1) * 8 + 4);
        const float4 s0 = *(const float4*)(rs + ppos0 * 16 + (c8 & 1) * 8), s1 = *(const float4*)(rs + ppos0 * 16 + (c8 & 1) * 8 + 4);
        csv[0] = c0.x; csv[1] = c0.y; csv[2] = c0.z; csv[3] = c0.w; csv[4] = c1.x; csv[5] = c1.y; csv[6] = c1.z; csv[7] = c1.w;
        snv[0] = s0.x; snv[1] = s0.y; snv[2] = s0.z; snv[3] = s0.w; snv[4] = s1.x; snv[5] = s1.y; snv[6] = s1.z; snv[7] = s1.w;
      } else {
#pragma unroll
        for (int e = 0; e < 8; ++e) { csv[e] = 1.f; snv[e] = 0.f; }
      }
    }
    {
      const bool isk = lane < 32;
      const int cc = (isk ? lane : lane - 32) * 8;
      float x0[8], x1[8], x2[8];
      unpack8(pl_c1, x1); unpack8(pl_c0, x0); unpack8(pl_c2, x2);
      float o[8];
#pragma unroll
      for (int e = 0; e < 8; ++e) {
        float a = cwv[e] * x0[e] + cwv[8 + e] * x1[e] + cwv[16 + e] * x2[e];
        a = siluf_(a);
        o[e] = isk ? a * 0.125f : a;
      }
      *(uint4*)(KQ + (size_t)tok * 512 + (isk ? 0 : 256) + cc) = pack8f(o);
    }
#pragma unroll
    for (int pass = 0; pass < 2; ++pass) {
      const bool act = pass == 0 || lane < 16;
      const int colb = (pass == 0 ? C_Q : C_K) + lane * 8;
      float x[8];
      unpack8(pass == 0 ? pl_q : pl_k, x);
      float ss = 0.f;
#pragma unroll
      for (int e = 0; e < 8; ++e) ss += x[e] * x[e];
      ss += __shfl_xor(ss, 1); ss += __shfl_xor(ss, 2); ss += __shfl_xor(ss, 4);
      const float rstd = rsqrtf(ss * (1.f / 64.f) + EPS);
#pragma unroll
      for (int e = 0; e < 8; ++e) x[e] = x[e] * rstd * (pass == 0 ? gqv[e] : gkv[e]);
      float o[8];
#pragma unroll
      for (int e = 0; e < 8; ++e) {
        float other = __shfl_xor(x[e], 2);
        const float cs = csv[e], sn = snv[e];
        o[e] = (c8 & 2) ? (x[e] * cs + other * sn) : (x[e] * cs - other * sn);
      }
      if (act) *(uint4*)(row + colb) = pack8f(o);
    }
    {
      const bool isckv = lane < 16, iscq = lane >= 32, iskr = lane >= 16 && lane < 24;
      int colb = isckv ? D_CKV + lane * 8 : (iscq ? D_CQ + (lane - 32) * 8 : D_KR + ((lane - 16) & 7) * 8);
      float x[8];
      unpack8(pl_m, x);
      float ss = 0.f;
#pragma unroll
      for (int e = 0; e < 8; ++e) ss += x[e] * x[e];
      ss += __shfl_xor(ss, 1); ss += __shfl_xor(ss, 2); ss += __shfl_xor(ss, 4); ss += __shfl_xor(ss, 8);
      float ss32 = ss + __shfl_xor(ss, 16);
      float o[8];
      if (isckv) {
        const float rstd = rsqrtf(ss * (1.f / 128.f) + EPS);
        for (int e = 0; e < 8; ++e) o[e] = x[e] * rstd * gmv[e];
      } else if (iscq) {
        const float rstd = rsqrtf(ss32 * (1.f / 256.f) + EPS);
        for (int e = 0; e < 8; ++e) o[e] = x[e] * rstd * gmv[e];
      } else {
        for (int e = 0; e < 8; ++e) o[e] = x[e];
      }
      float orot[8];
#pragma unroll
      for (int e = 0; e < 8; ++e) {
        float other = __shfl_xor(x[e], 2);
        const int ck = lane & 7;
        const float cs = csv[e], sn = snv[e];
        orot[e] = (ck & 2) ? (x[e] * cs + other * sn) : (x[e] * cs - other * sn);
      }
      if (isckv || iscq) *(uint4*)(row + colb) = pack8f(o);
      if (iskr) {
        uint4 q = pack8f(orot);
        const int ck = lane & 7;
#pragma unroll
        for (int hd = 0; hd < 4; ++hd) *(uint4*)(Kd + (size_t)tok * 768 + hd * 192 + 128 + ck * 8) = q;
      }
    }
  }
#undef TOKPREP_LOAD
}

template <int DK, int DV, bool ROPEQ>
__device__ void attn_item(const u16* __restrict__ qrow, const u16* __restrict__ Kp, int kst, const u16* __restrict__ Vp, int vst,
                          u16* __restrict__ orow, int nkeys, float sc, int pos, const float* __restrict__ rc, char* lds) {
  constexpr int KLD = DK + 8, VLD = DV + 32;
  constexpr int KB = 64 * KLD, VB = 64 * VLD;
  u16* KS = (u16*)lds;
  u16* VS = KS + 2 * KB;
  const int tid = otid(), lane = tid & 63, r = lane & 31, h = lane >> 5;
  bf16x8 qf[DK / 16];
  {
#pragma unroll
    for (int s = 0; s < DK / 16; ++s) qf[s] = *(const bf16x8*)(qrow + h * 8 + s * 16);
    if (ROPEQ && pos >= 0) {
      const int prow = pos >> 6, pcol = pos & 63;
      const float* rs = rc + 1024;
      constexpr int s0 = (DK - 64) / 16;
#pragma unroll
      for (int part = 0; part < 2; ++part) {
        const int ppos = part ? pcol : prow;
#pragma unroll
        for (int j = 0; j < 8; ++j) {
          const int fi = 8 * h + j;
          float cs = rc[ppos * 16 + fi], sn = rs[ppos * 16 + fi];
          float x1 = bf2f((u16)qf[s0 + 2 * part][j]), x2 = bf2f((u16)qf[s0 + 2 * part + 1][j]);
          qf[s0 + 2 * part][j] = (short)f2bf(x1 * cs - x2 * sn);
          qf[s0 + 2 * part + 1][j] = (short)f2bf(x2 * cs + x1 * sn);
        }
      }
    }
  }
  f32x16 oT[DV / 32];
#pragma unroll
  for (int d = 0; d < DV / 32; ++d)
#pragma unroll
    for (int e = 0; e < 16; ++e) oT[d][e] = 0.f;
  float m = -1e30f, lsum = 0.f;
  const int ntile = nkeys >> 6;
  constexpr int NKP = KB * 2 / 1024, NVP = VB * 2 / 1024, NKJ = (NKP + 7) / 8, NVJ = (NVP + 7) / 8;
  const int wu = __builtin_amdgcn_readfirstlane(tid >> 6);
  unsigned ksrc[NKJ], vsrc[NVJ];
#pragma unroll
  for (int j = 0; j < NKJ; ++j) { const int o = (wu + 8 * j) * 1024 + lane * 16, row = o / (KLD * 2), col = (o % (KLD * 2)) / 2; ksrc[j] = (unsigned)(row * kst + (col < DK ? col : 0)) * 2u; }
#pragma unroll
  for (int j = 0; j < NVJ; ++j) { const int o = (wu + 8 * j) * 1024 + lane * 16, row = o / (VLD * 2), col = (o % (VLD * 2)) / 2; vsrc[j] = (unsigned)(row * vst + (col < DV ? col : 0)) * 2u; }
#define ATT_DMA(kt_, buf_) do { \
    const char* kg_ = (const char*)Kp + (size_t)(kt_) * 64 * kst * 2; const char* vg_ = (const char*)Vp + (size_t)(kt_) * 64 * vst * 2; \
    _Pragma("unroll") for (int j = 0; j < NKJ; ++j) if (wu + 8 * j < NKP) \
      __builtin_amdgcn_global_load_lds((const unsigned*)(kg_ + ksrc[j]), (LAS unsigned*)((char*)KS + (buf_) * KB * 2 + (wu + 8 * j) * 1024), 16, 0, 0); \
    _Pragma("unroll") for (int j = 0; j < NVJ; ++j) if (wu + 8 * j < NVP) \
      __builtin_amdgcn_global_load_lds((const unsigned*)(vg_ + vsrc[j]), (LAS unsigned*)((char*)VS + (buf_) * VB * 2 + (wu + 8 * j) * 1024), 16, 0, 0); \
  } while (0)
  __syncthreads();
  ATT_DMA(0, 0);
  asm volatile("s_waitcnt vmcnt(0)" ::: "memory");
  __syncthreads();
  const int troff = ((lane & 15) >> 2) * VLD + 16 * ((lane >> 4) & 1) + 4 * (lane & 3) + 4 * h * VLD;
#pragma unroll 1
  for (int kt = 0; kt < ntile; ++kt) {
    const int buf = kt & 1;
    if (kt + 1 < ntile) ATT_DMA(kt + 1, buf ^ 1);
    const u16* KSb = KS + buf * KB;
    const u16* VSb = VS + buf * VB;
    f32x16 sT[2];
#pragma unroll
    for (int kk = 0; kk < 2; ++kk) {
#pragma unroll
      for (int e = 0; e < 16; ++e) sT[kk][e] = 0.f;
#pragma unroll
      for (int s = 0; s < DK / 16; ++s) {
        bf16x8 a = *(const bf16x8*)(KSb + (kk * 32 + r) * KLD + s * 16 + h * 8);
        sT[kk] = MFMA(a, qf[s], sT[kk]);
      }
    }
    float mx = -1e30f;
#pragma unroll
    for (int kk = 0; kk < 2; ++kk)
#pragma unroll
      for (int e = 0; e < 16; ++e) mx = fmaxf(mx, sT[kk][e]);
    mx = fmaxf(mx, __shfl_xor(mx, 32));
    const float mn = fmaxf(m, mx * sc);
    const float alpha = ex2(m - mn);
    m = mn;
    lsum *= alpha;
#pragma unroll
    for (int kk = 0; kk < 2; ++kk) {
      sT[kk] = sT[kk] * sc - mn;
#pragma unroll
      for (int e = 0; e < 16; ++e) sT[kk][e] = ex2(sT[kk][e]);
    }
    {
      f32x16 t16 = sT[0] + sT[1];
      typedef float f32x8v __attribute__((ext_vector_type(8)));
      typedef float f32x4v __attribute__((ext_vector_type(4)));
      f32x8v t8 = __builtin_shufflevector(t16, t16, 0, 1, 2, 3, 4, 5, 6, 7) + __builtin_shufflevector(t16, t16, 8, 9, 10, 11, 12, 13, 14, 15);
      f32x4v t4 = __builtin_shufflevector(t8, t8, 0, 1, 2, 3) + __builtin_shufflevector(t8, t8, 4, 5, 6, 7);
      lsum += (t4[0] + t4[1]) + (t4[2] + t4[3]);
    }
#pragma unroll
    for (int d = 0; d < DV / 32; ++d) oT[d] = oT[d] * alpha;
#pragma unroll
    for (int kk = 0; kk < 2; ++kk)
#pragma unroll
      for (int s2 = 0; s2 < 2; ++s2) {
        bf16x8 pb = pack8(sT[kk], s2);
#pragma unroll
        for (int d = 0; d < DV / 32; ++d) {
          const u16* vb = VSb + (kk * 32 + s2 * 16) * VLD + d * 32 + troff;
          s16x4 lo = __builtin_amdgcn_ds_read_tr16_b64_v4i16((LAS s16x4*)vb);
          s16x4 hi = __builtin_amdgcn_ds_read_tr16_b64_v4i16((LAS s16x4*)(vb + 8 * VLD));
          oT[d] = MFMA(cat4(lo, hi), pb, oT[d]);
        }
      }
    asm volatile("s_waitcnt vmcnt(0)" ::: "memory");
    __syncthreads();
  }
#undef ATT_DMA
  lsum += __shfl_xor(lsum, 32);
  const float inv = 1.f / lsum;
#pragma unroll
  for (int d = 0; d < DV / 32; ++d)
#pragma unroll
    for (int gq = 0; gq < 4; ++gq) {
      uint2 o;
      o.x = pack2(oT[d][4 * gq] * inv, oT[d][4 * gq + 1] * inv);
      o.y = pack2(oT[d][4 * gq + 2] * inv, oT[d][4 * gq + 3] * inv);
      *(uint2*)(orow + d * 32 + 8 * gq + 4 * h) = o;
    }
}

DI void lds_ld8(const float* p, float* o) {
  const float4 a = *(const float4*)p, b = *(const float4*)(p + 4);
  o[0] = a.x; o[1] = a.y; o[2] = a.z; o[3] = a.w; o[4] = b.x; o[5] = b.y; o[6] = b.z; o[7] = b.w;
}
__device__ void scanA_unit(const Params& p, int l, int unit, char* lds) {
  const int tid = otid(), lane = tid & 63, wid = tid >> 6, r = lane & 31, h = lane >> 5;
  const int bl = unit >> 3, hd = (unit >> 1) & 3, dir = unit & 1;
  const u16* P = (const u16*)(p.ws + OFF_P);
  u16* Oa = (u16*)(p.ws + OFF_OA) + (size_t)dir * NTOK * 512;
  float* BC = (float*)lds;
  u16* Qs = (u16*)(lds + 33792);
  u16* KKs = (u16*)(lds + 51200);
  u16* AM = (u16*)(lds + 51200);
  u16* KT = (u16*)(lds + 68608);
  u16* VT = (u16*)(lds + 87040);
  u16* ST = (u16*)(lds + 105472);
  float* EL = (float*)(lds + 140288);
  float* QTOT = (float*)(lds + 140800);
  const int ch = tid & 15;
  float lbv[8];
  {
    const float* lb = (const float*)(p.ws + OFF_LB) + (size_t)l * 1024 + dir * 512 + hd * 128 + ch * 8;
#pragma unroll
    for (int e = 0; e < 8; ++e) lbv[e] = lb[e];
  }
  const int vt = wid & 3, th = wid >> 2;
  f32x16 S[2];
#pragma unroll
  for (int j = 0; j < 2; ++j)
#pragma unroll
    for (int e = 0; e < 16; ++e) S[j][e] = 0.f;
  __syncthreads();
  for (int i = tid; i < 128 * 136 / 2; i += NTHR) ((unsigned*)ST)[i] = 0u;
  uint4 pqr[2], pfr[2], pvr[2];
#define SCANA_TOK0(st_) (bl * TPB + ((st_) >= 4 ? CTXL : 0) + (dir ? ((st_) >= 4 ? 31 - ((st_) - 4) : 3 - (st_)) : ((st_) >= 4 ? (st_) - 4 : (st_))) * 64)
#define SCANA_PREFETCH(st_) do { const int t0_ = SCANA_TOK0(st_); \
    _Pragma("unroll") for (int j = 0; j < 2; ++j) { const int i = (tid >> 4) + 32 * j; \
      const u16* row = P + (size_t)(t0_ + (dir ? 63 - i : i)) * PS + hd * 128 + ch * 8; \
      pqr[j] = *(const uint4*)(row + A_Q); pfr[j] = *(const uint4*)(row + (dir ? A_FB : A_FF)); pvr[j] = *(const uint4*)(row + A_I); } } while (0)
  SCANA_PREFETCH(0);
#pragma unroll 1
  for (int step = 0; step < 36; ++step) {
    const int tok0 = SCANA_TOK0(step);
    __syncthreads();
#pragma unroll
    for (int j = 0; j < 2; ++j) {
      const int i = (tid >> 4) + 32 * j;
      uint4 qraw = pqr[j];
      uint4 fraw = pfr[j];
      uint4 vq = pvr[j];
      float qv[8], fv[8], kkv[8], lfv[8];
      unpack8(qraw, qv); unpack8(fraw, fv);
#pragma unroll
      for (int e = 0; e < 8; ++e) {
        qv[e] = siluf_(qv[e]);
        const float ex = __expf(-fv[e]);
        const float sg = 1.f / (1.f + ex);
        const float sgn = ex / (1.f + ex);
        const float f = lbv[e] + (1.f - lbv[e]) * sg;
        kkv[e] = (1.f - lbv[e]) * (fv[e] > 30.f ? 0.f : (fv[e] < -30.f ? 1.f : sgn));
        lfv[e] = __log2f(fmaxf(f, 1e-37f));
      }
      *(float4*)(BC + i * 132 + ch * 8) = (float4){lfv[0], lfv[1], lfv[2], lfv[3]};
      *(float4*)(BC + i * 132 + ch * 8 + 4) = (float4){lfv[4], lfv[5], lfv[6], lfv[7]};
      *(uint4*)(Qs + i * 136 + ch * 8) = pack8f(qv);
      *(uint4*)(KKs + i * 136 + ch * 8) = pack8f(kkv);
      u16* dv = VT + (ch * 8) * 72 + ((((i >> 3) ^ (ch & 7)) << 3) | (i & 7));
      dv[0 * 72] = (u16)(vq.x & 0xffff); dv[1 * 72] = (u16)(vq.x >> 16); dv[2 * 72] = (u16)(vq.y & 0xffff); dv[3 * 72] = (u16)(vq.y >> 16);
      dv[4 * 72] = (u16)(vq.z & 0xffff); dv[5 * 72] = (u16)(vq.z >> 16); dv[6 * 72] = (u16)(vq.w & 0xffff); dv[7 * 72] = (u16)(vq.w >> 16);
    }
    __syncthreads();
    {
      const int k = tid & 127, qd = tid >> 7;
      float cv[16];
#pragma unroll
      for (int i = 0; i < 16; ++i) cv[i] = BC[(qd * 16 + i) * 132 + k];
      float run = 0.f;
#pragma unroll
      for (int i = 0; i < 16; ++i) { run += cv[i]; BC[(qd * 16 + i) * 132 + k] = run; }
      QTOT[qd * 128 + k] = run;
    }
    __syncthreads();
    {
      const int k = tid & 127, qd = tid >> 7;
      float off = 0.f;
      for (int q2 = 0; q2 < qd; ++q2) off += QTOT[q2 * 128 + k];
      if (qd > 0) {
        float cv[16];
#pragma unroll
        for (int i = 0; i < 16; ++i) cv[i] = BC[(qd * 16 + i) * 132 + k];
#pragma unroll
        for (int i = 0; i < 16; ++i) BC[(qd * 16 + i) * 132 + k] = cv[i] + off;
      }
    }
    __syncthreads();
    f32x4 cod[2];
#pragma unroll
    for (int jj = 0; jj < 2; ++jj) {
      cod[jj] = (f32x4){0.f, 0.f, 0.f, 0.f};
      const int job = wid + 8 * jj;
      if (job < 10) {
        const int bI = job < 1 ? 0 : (job < 3 ? 1 : (job < 6 ? 2 : 3));
        const int bJ = job - (bI * (bI + 1)) / 2;
        const int l16 = lane & 15, kg = lane >> 4;
        const int t = 16 * bI + l16, s = 16 * bJ + l16, rr = 16 * bI;
#pragma unroll
        for (int ks = 0; ks < 4; ++ks) {
          const int k0 = ks * 32 + kg * 8;
          float qv[8], kv[8];
          unpack8(*(const uint4*)(Qs + t * 136 + k0), qv);
          unpack8(*(const uint4*)(KKs + s * 136 + k0), kv);
          float brv[8], btv[8], bsv8[8];
          lds_ld8(BC + rr * 132 + k0, brv); lds_ld8(BC + t * 132 + k0, btv); lds_ld8(BC + s * 132 + k0, bsv8);
#pragma unroll
          for (int e = 0; e < 8; ++e) {
            qv[e] *= ex2(btv[e] - brv[e]);
            kv[e] *= ex2(fminf(brv[e] - bsv8[e], 120.f));
          }
          union { uint4 u; bf16x8 v; } ua, ub;
          ua.u = pack8f(qv); ub.u = pack8f(kv);
          cod[jj] = __builtin_amdgcn_mfma_f32_16x16x32_bf16(ua.v, ub.v, cod[jj], 0, 0, 0);
        }
      }
    }
    if (tid < 128) EL[tid] = ex2(BC[63 * 132 + tid]);
#pragma unroll
    for (int j = 0; j < 2; ++j) {
      const int i = (tid >> 4) + 32 * j;
      float kv[8];
      unpack8(*(const uint4*)(KKs + i * 136 + ch * 8), kv);
      u16* dk = KT + (ch * 8) * 72 + ((((i >> 3) ^ (ch & 7)) << 3) | (i & 7));
      float dv8[8];
      { float bl8[8], bi8[8]; lds_ld8(BC + 63 * 132 + ch * 8, bl8); lds_ld8(BC + i * 132 + ch * 8, bi8);
#pragma unroll
        for (int e = 0; e < 8; ++e) dv8[e] = bl8[e] - bi8[e]; }
#pragma unroll
      for (int e = 0; e < 8; ++e) dk[e * 72] = f2bf(kv[e] * ex2(dv8[e]));
    }
    __syncthreads();
#pragma unroll
    for (int j = 0; j < 2; ++j) {
      const int i = (tid >> 4) + 32 * j;
      float qv[8];
      unpack8(*(const uint4*)(Qs + i * 136 + ch * 8), qv);
      { float bi8[8]; lds_ld8(BC + i * 132 + ch * 8, bi8);
#pragma unroll
        for (int e = 0; e < 8; ++e) qv[e] *= ex2(bi8[e]); }
      *(uint4*)(Qs + i * 136 + ch * 8) = pack8f(qv);
    }
    for (int i = tid; i < 64 * 72 / 2; i += NTHR) ((unsigned*)AM)[i] = 0u;
    __syncthreads();
#pragma unroll
    for (int jj = 0; jj < 2; ++jj) {
      const int job = wid + 8 * jj;
      if (job < 10) {
        const int bI = job < 1 ? 0 : (job < 3 ? 1 : (job < 6 ? 2 : 3));
        const int bJ = job - (bI * (bI + 1)) / 2;
        const int l16 = lane & 15, kg = lane >> 4;
#pragma unroll
        for (int e = 0; e < 4; ++e) {
          const int tp = 4 * kg + e;
          const float v = (bJ < bI || l16 <= tp) ? cod[jj][e] : 0.f;
          AM[(16 * bI + tp) * 72 + 16 * bJ + l16] = f2bf(v);
        }
      }
    }
    __syncthreads();
    if (step + 1 < 36) SCANA_PREFETCH(step + 1);
    f32x16 o;
#pragma unroll
    for (int e = 0; e < 16; ++e) o[e] = 0.f;
#pragma unroll
    for (int ks = 0; ks < 8; ++ks) {
      bf16x8 a = *(const bf16x8*)(Qs + (th * 32 + r) * 136 + ks * 16 + h * 8);
      bf16x8 b = *(const bf16x8*)(ST + (vt * 32 + r) * 136 + ks * 16 + h * 8);
      o = MFMA(a, b, o);
    }
    bf16x8 bv[4];
#pragma unroll
    for (int ks = 0; ks < 4; ++ks) bv[ks] = *(const bf16x8*)(VT + (vt * 32 + r) * 72 + (((ks * 2 + h) ^ (((vt * 32 + r) >> 3) & 7)) << 3));
#pragma unroll
    for (int ks = 0; ks < 4; ++ks) {
      bf16x8 a = *(const bf16x8*)(AM + (th * 32 + r) * 72 + ks * 16 + h * 8);
      o = MFMA(a, bv[ks], o);
    }
    {
      u16* ob = Oa + (size_t)tok0 * 512 + hd * 128 + vt * 32 + r;
#pragma unroll
      for (int e = 0; e < 16; ++e) {
        const int i = th * 32 + crow(e, h);
        ob[(dir ? 63 - i : i) * 512] = f2bf(o[e]);
      }
    }
    __syncthreads();
#pragma unroll
    for (int j = 0; j < 2; ++j) {
      const int kt = 2 * th + j;
#pragma unroll
      for (int e = 0; e < 16; ++e) S[j][e] *= EL[kt * 32 + crow(e, h)];
#pragma unroll
      for (int ks = 0; ks < 4; ++ks) {
        bf16x8 a = *(const bf16x8*)(KT + (kt * 32 + r) * 72 + (((ks * 2 + h) ^ (((kt * 32 + r) >> 3) & 7)) << 3));
        S[j] = MFMA(a, bv[ks], S[j]);
      }
#pragma unroll
      for (int gq = 0; gq < 4; ++gq) {
        uint2 w;
        w.x = pack2(S[j][4 * gq], S[j][4 * gq + 1]); w.y = pack2(S[j][4 * gq + 2], S[j][4 * gq + 3]);
        *(uint2*)(ST + (vt * 32 + r) * 136 + kt * 32 + 8 * gq + 4 * h) = w;
      }
    }
  }
#undef SCANA_PREFETCH
#undef SCANA_TOK0
}

__device__ void scanB_unit(const Params& p, int l, int unit2, char* lds) {
  const int tid0 = otid(), vb = tid0 >> 8, tid = tid0 & 255, lane = tid & 63, wid = tid >> 6, r = lane & 31, h = lane >> 5;
  const int unit = unit2 * 2 + vb;
  lds += vb * LDSV;
  const int bl = unit >> 3, hd = (unit >> 1) & 3, dir = unit & 1;
  const u16* P = (const u16*)(p.ws + OFF_P);
  const u16* KQ = (const u16*)(p.ws + OFF_KQ);
  const float* Gb = (const float*)(p.ws + OFF_GB);
  u16* Ob = (u16*)(p.ws + OFF_OB) + (size_t)dir * NTOK * 512;
  u16* QB = (u16*)lds;
  u16* KB = (u16*)(lds + 9216);
  u16* SM = (u16*)(lds + 18432);
  u16* KWT = (u16*)(lds + 27648);
  u16* VT = (u16*)(lds + 36864);
  float* vec = (float*)(lds + 55296);
  float *IG = vec, *LF = vec + 64, *BV = vec + 128, *UV = vec + 192, *MT = vec + 256, *WI = vec + 320, *WK = vec + 384,
        *DEN = vec + 448, *NV = vec + 512  , *SC = vec + 640, *BL2 = vec + 704, *UL2 = vec + 768, *EMT = vec + 832;
  const float bI = p.bgate[l * 16 + (2 * dir) * 4 + hd], bF = p.bgate[l * 16 + (2 * dir + 1) * 4 + hd];
  f32x16 C[2];
#pragma unroll
  for (int ft = 0; ft < 2; ++ft)
#pragma unroll
    for (int e = 0; e < 16; ++e) C[ft][e] = 0.f;
  float m = -1e30f;
  __syncthreads();
  if (tid < 128) NV[tid] = 0.f;
  int cur = 0;
  uint4 pk0, pk1, pq0, pq1, pv0, pv1, pv2, pv3; float pgI = 0.f, pgF = 0.f;
#define SCANB_TOK0(st_) (bl * TPB + ((st_) >= 4 ? CTXL : 0) + (dir ? ((st_) >= 4 ? 31 - ((st_) - 4) : 3 - (st_)) : ((st_) >= 4 ? (st_) - 4 : (st_))) * 64)
#define SCANB_LDKQ(j, K_, Q_) do { const int id = tid + 256 * (j), i = id >> 3, c8 = id & 7; \
      const u16* row = KQ + (size_t)(t0_ + (dir ? 63 - i : i)) * 512 + hd * 64 + c8 * 8; K_ = *(const uint4*)(row); Q_ = *(const uint4*)(row + 256); } while (0)
#define SCANB_LDV(j, V_) do { const int id = tid + 256 * (j), i = id >> 4, c16 = id & 15; \
      V_ = *(const uint4*)(P + (size_t)(t0_ + (dir ? 63 - i : i)) * PS + B_V + hd * 128 + c16 * 8); } while (0)
#define SCANB_PREFETCH(st_) do { const int t0_ = SCANB_TOK0(st_); \
    SCANB_LDKQ(0, pk0, pq0); SCANB_LDKQ(1, pk1, pq1); SCANB_LDV(0, pv0); SCANB_LDV(1, pv1); SCANB_LDV(2, pv2); SCANB_LDV(3, pv3); \
    if (tid < 64) { const int tok = t0_ + (dir ? 63 - tid : tid); pgI = Gb[(size_t)tok * 16 + (2 * dir) * 4 + hd]; pgF = Gb[(size_t)tok * 16 + (2 * dir + 1) * 4 + hd]; } } while (0)
#define SCANB_STKQ(j, K_, Q_) do { const int id = tid + 256 * (j), i = id >> 3, c8 = id & 7; \
      *(uint4*)(KB + i * 72 + c8 * 8) = K_; *(uint4*)(QB + i * 72 + c8 * 8) = Q_; } while (0)
#define SCANB_STV(j, V_) do { const int id = tid + 256 * (j), i = id >> 4, c16 = id & 15; const uint4 vq = V_; u16* dv = VT + (c16 * 8) * 72 + ((((i >> 3) ^ (c16 & 7)) << 3) | (i & 7)); \
      dv[0 * 72] = (u16)(vq.x & 0xffff); dv[1 * 72] = (u16)(vq.x >> 16); dv[2 * 72] = (u16)(vq.y & 0xffff); dv[3 * 72] = (u16)(vq.y >> 16); \
      dv[4 * 72] = (u16)(vq.z & 0xffff); dv[5 * 72] = (u16)(vq.z >> 16); dv[6 * 72] = (u16)(vq.w & 0xffff); dv[7 * 72] = (u16)(vq.w >> 16); } while (0)
  SCANB_PREFETCH(0);
#pragma unroll 1
  for (int step = 0; step < 36; ++step) {
    const int tok0 = SCANB_TOK0(step);
    __syncthreads();
    SCANB_STKQ(0, pk0, pq0); SCANB_STKQ(1, pk1, pq1);
    SCANB_STV(0, pv0); SCANB_STV(1, pv1); SCANB_STV(2, pv2); SCANB_STV(3, pv3);
    if (tid < 64) {
      const int i = tid;
      const float gI = pgI + bI;
      const float gF = pgF + bF;
      const float lf = fminf(gF, 0.f) - log1pf(expf(-fabsf(gF)));
      float b = lf;
#pragma unroll
      for (int d = 1; d < 64; d <<= 1) { float t = __shfl_up(b, d); if (lane >= d) b += t; }
      const float u = gI - b;
      float pm = u;
#pragma unroll
      for (int d = 1; d < 64; d <<= 1) { float t = __shfl_up(pm, d); if (lane >= d) pm = fmaxf(pm, t); }
      const float mt = b + fmaxf(m, pm);
      const float wi = expf(b + m - mt);
      const float mnew = __shfl(mt, 63), b63 = __shfl(b, 63);
      const float dec = expf(b63 + m - mnew);
      const float wk = expf(b63 - b + gI - mnew);
      IG[i] = gI; LF[i] = lf; BV[i] = b; UV[i] = u; MT[i] = mt; WI[i] = wi; WK[i] = wk;
      BL2[i] = (b - mt) * LOG2E; UL2[i] = u * LOG2E; EMT[i] = expf(-mt);
      if (i == 0) { SC[0] = mnew; SC[1] = dec; }
    }
    __syncthreads();
    {
      const int tt = wid >> 1, st = wid & 1;
      f32x16 a16;
#pragma unroll
      for (int e = 0; e < 16; ++e) a16[e] = 0.f;
#pragma unroll
      for (int ks = 0; ks < 4; ++ks) {
        bf16x8 a = *(const bf16x8*)(QB + (tt * 32 + r) * 72 + ks * 16 + h * 8);
        bf16x8 b = *(const bf16x8*)(KB + (st * 32 + r) * 72 + ks * 16 + h * 8);
        a16 = MFMA(a, b, a16);
      }
      const int s = st * 32 + r;
      const float us = UL2[s];
      float blv[16];
#pragma unroll
      for (int e = 0; e < 16; ++e) blv[e] = BL2[tt * 32 + crow(e, h)];
#pragma unroll
      for (int e = 0; e < 16; ++e) {
        const int t = tt * 32 + crow(e, h);
        float v = 0.f;
        if (s <= t) v = a16[e] * ex2(blv[e] + us);
        SM[t * 72 + s] = f2bf(v);
      }
    }
#pragma unroll
    for (int j = 0; j < 2; ++j) {
      const int id = tid + 256 * j, i = id >> 3, c8 = id & 7;
      float kv[8];
      unpack8(*(const uint4*)(KB + i * 72 + c8 * 8), kv);
      const float wk = WK[i];
#pragma unroll
      for (int e = 0; e < 8; ++e) KWT[(c8 * 8 + e) * 72 + ((((i >> 3) ^ c8) << 3) | (i & 7))] = f2bf(kv[e] * wk);
    }
    __syncthreads();
    const float mnew = SC[0], dec = SC[1];
    {
      const int t = tid >> 2, part = tid & 3;
      float rsum = 0.f, qn = 0.f, ns = 0.f;
#pragma unroll
      for (int cc = 0; cc < 2; ++cc) {
        const int c8 = part * 2 + cc;
        float sv[8], qv[8], kv[8];
        unpack8(*(const uint4*)(SM + t * 72 + c8 * 8), sv);
        unpack8(*(const uint4*)(QB + t * 72 + c8 * 8), qv);
        unpack8(*(const uint4*)(KWT + t * 72 + c8 * 8), kv);
#pragma unroll
        for (int e = 0; e < 8; ++e) { rsum += sv[e]; qn += qv[e] * NV[cur * 64 + c8 * 8 + e]; ns += kv[e]; }
      }
      rsum += __shfl_xor(rsum, 1); qn += __shfl_xor(qn, 1); ns += __shfl_xor(ns, 1);
      rsum += __shfl_xor(rsum, 2); qn += __shfl_xor(qn, 2); ns += __shfl_xor(ns, 2);
      if (part == 0) {
        DEN[t] = 1.f / fmaxf(fabsf(WI[t] * qn + rsum), EMT[t]);
        NV[(cur ^ 1) * 64 + t] = dec * NV[cur * 64 + t] + ns;
      }
    }
    __syncthreads();
    if (step + 1 < 36) SCANB_PREFETCH(step + 1);
    f32x16 num[2];
#pragma unroll
    for (int tt = 0; tt < 2; ++tt)
#pragma unroll
      for (int e = 0; e < 16; ++e) num[tt][e] = 0.f;
#pragma unroll
    for (int ft = 0; ft < 2; ++ft)
#pragma unroll
      for (int s = 0; s < 2; ++s) {
        bf16x8 pb = pack8(C[ft], s);
#pragma unroll
        for (int tt = 0; tt < 2; ++tt) {
          const u16* qb = QB + (tt * 32 + r) * 72 + ft * 32 + s * 16 + 4 * h;
          bf16x8 a = cat4(*(const s16x4*)qb, *(const s16x4*)(qb + 8));
          num[tt] = MFMA(a, pb, num[tt]);
        }
      }
#pragma unroll
    for (int tt = 0; tt < 2; ++tt)
#pragma unroll
      for (int e = 0; e < 16; ++e) num[tt][e] *= WI[tt * 32 + crow(e, h)];
    bf16x8 bv[4];
#pragma unroll
    for (int ks = 0; ks < 4; ++ks) bv[ks] = *(const bf16x8*)(VT + (wid * 32 + r) * 72 + (((ks * 2 + h) ^ (((wid * 32 + r) >> 3) & 7)) << 3));
#pragma unroll
    for (int ks = 0; ks < 4; ++ks)
#pragma unroll
      for (int tt = 0; tt < 2; ++tt) {
        bf16x8 a = *(const bf16x8*)(SM + (tt * 32 + r) * 72 + ks * 16 + h * 8);
        num[tt] = MFMA(a, bv[ks], num[tt]);
      }
#pragma unroll
    for (int tt = 0; tt < 2; ++tt)
#pragma unroll
      for (int e = 0; e < 16; ++e) {
        const int i = tt * 32 + crow(e, h);
        const int tok = tok0 + (dir ? 63 - i : i);
        Ob[(size_t)tok * 512 + hd * 128 + wid * 32 + r] = f2bf(num[tt][e] * DEN[i]);
      }
#pragma unroll
    for (int ft = 0; ft < 2; ++ft) {
#pragma unroll
      for (int e = 0; e < 16; ++e) C[ft][e] *= dec;
#pragma unroll
      for (int ks = 0; ks < 4; ++ks) {
        bf16x8 a = *(const bf16x8*)(KWT + (ft * 32 + r) * 72 + (((ks * 2 + h) ^ (((ft * 32 + r) >> 3) & 7)) << 3));
        C[ft] = MFMA(a, bv[ks], C[ft]);
      }
    }
    m = mnew;
    cur ^= 1;
  }
#undef SCANB_PREFETCH
#undef SCANB_LDKQ
#undef SCANB_LDV
#undef SCANB_STKQ
#undef SCANB_STV
#undef SCANB_TOK0
}

__device__ void phase_mixers(const Params& p, int l, int g, char* lds, int cbase = 0, bool scans_only = false, bool a_only = false) {
  int* s_item = (int*)(lds + LDS_BYTES - 16);
  int* cnt = (int*)(p.ws + OFF_CNT) + cbase + (l * NG + g);
  const u16* P = (const u16*)(p.ws + OFF_P);
  const u16* Qd = (const u16*)(p.ws + OFF_QD);
  const u16* Kd = (const u16*)(p.ws + OFF_KD);
  const u16* Vd = (const u16*)(p.ws + OFF_VD);
  u16* Y = (u16*)((char*)p.out);
  const float* rc = (const float*)(p.ws + OFF_ROPE);
  constexpr int NSA = NB * 8, NSB = NB * 4;
  constexpr int ND_L = NB * 4 * 8, NC_L = NB * 2 * 32, ND_C = NB * 4, NC_C = NB * 2 * 4;
  constexpr int I1 = NSA, I2 = I1 + NSB, I3 = I2 + ND_L, I4 = I3 + NC_L, I5 = I4 + ND_C, I6 = I5 + NC_C;
  const float scC = 0.125f * LOG2E, scD = 0.07216878364870322f * LOG2E;
  while (true) {
    __syncthreads();
    if (otid() == 0) *s_item = atomicAdd(cnt, 1);
    __syncthreads();
    const int it = *s_item;
    if (it >= (a_only ? I1 : (scans_only ? I2 : (l == DEPTH - 1 ? I4 : I6)))) break;
    if (it < I1) scanA_unit(p, l, it, lds);
    else if (it < I2) scanB_unit(p, l, it - I1, lds);
    else {
      bool isD, isLat; int q;
      if (it < I3) { isD = true; isLat = true; q = it - I2; }
      else if (it < I4) { isD = false; isLat = true; q = it - I3; }
      else if (it < I5) { isD = true; isLat = false; q = it - I4; }
      else { isD = false; isLat = false; q = it - I5; }
      const int tid = otid(), lane = tid & 63, wid = tid >> 6, r = lane & 31;
      const int nkeys = isLat ? TPB : CTXL;
      if (isD) {
        const int nqt = isLat ? 8 : 1;
        const int qt = q % nqt, hd = (q / nqt) % 4, bl = q / (nqt * 4);
        const int tokk = bl * TPB, ql = qt * 256 + wid * 32 + r;
        const int tokq = tokk + (isLat ? CTXL : 0) + ql;
        attn_item<192, 128, true>(Qd + (size_t)tokq * 768 + hd * 192, Kd + (size_t)tokk * 768 + hd * 192, 768,
                                  Vd + (size_t)tokk * 512 + hd * 128, 512, Y + (size_t)tokq * 2048 + 1536 + hd * 128,
                                  nkeys, scD, isLat ? ql : -1, rc, lds);
      } else {
        const int nqt = isLat ? 32 : 4;
        const int qt = q % nqt, kvh = (q / nqt) % 2, bl = q / (nqt * 2);
        const int hq = kvh * 4 + (wid >> 1);
        const int tokk = bl * TPB, ql = qt * 64 + (wid & 1) * 32 + r;
        const int tokq = tokk + (isLat ? CTXL : 0) + ql;
        attn_item<64, 64, false>(P + (size_t)tokq * PS + C_Q + hq * 64, P + (size_t)tokk * PS + C_K + kvh * 64, PS,
                                 P + (size_t)tokk * PS + C_V + kvh * 64, PS, Y + (size_t)tokq * 2048 + 1024 + hq * 64,
                                 nkeys, scC, -1, rc, lds);
      }
    }
  }
}

__device__ void phase_readout(const Params& p, int l) {
  const int tid = otid(), lane = tid & 63, wid = tid >> 6;
  const u16* P = (const u16*)(p.ws + OFF_P);
  const u16* Oa = (const u16*)(p.ws + OFF_OA);
  const u16* Ob = (const u16*)(p.ws + OFF_OB);
  u16* Y = (u16*)((char*)p.out);
  const int col = lane * 8;
  float gnv[2][8];
#pragma unroll
  for (int mix = 0; mix < 2; ++mix)
#pragma unroll
    for (int e = 0; e < 8; ++e) gnv[mix][e] = ((mix == 0 ? p.hnorm : p.mnorm) + l * 128 + (col & 127))[e];
  const int stride = gridDim.x * 8;
  const bool skipc = l == DEPTH - 1;
  for (int tok0 = blockIdx.x * 8 + wid; tok0 < NTOK; tok0 += 2 * stride) {
    int tk[2]; bool doit[2];
    tk[0] = tok0; tk[1] = tok0 + stride;
    doit[0] = !(skipc && (tk[0] % TPB) < CTXL);
    doit[1] = tk[1] < NTOK && !(skipc && (tk[1] % TPB) < CTXL);
    if (!doit[1]) tk[1] = tk[0];
    uint4 ra[2][2], rb[2][2], rg[2][2];
#pragma unroll
    for (int u = 0; u < 2; ++u)
#pragma unroll
      for (int mix = 0; mix < 2; ++mix) {
        const u16* O = mix == 0 ? Oa : Ob;
        ra[u][mix] = *(const uint4*)(O + (size_t)tk[u] * 512 + col);
        rb[u][mix] = *(const uint4*)(O + ((size_t)NTOK + tk[u]) * 512 + col);
        rg[u][mix] = *(const uint4*)(P + (size_t)tk[u] * PS + (mix == 0 ? A_G : B_O) + col);
      }
#pragma unroll
    for (int u = 0; u < 2; ++u) {
      uint4 outv[2];
#pragma unroll
      for (int mix = 0; mix < 2; ++mix) {
        float a[8], b[8], gt[8], o[8];
        unpack8(ra[u][mix], a); unpack8(rb[u][mix], b); unpack8(rg[u][mix], gt);
        float ss = 0.f;
#pragma unroll
        for (int e = 0; e < 8; ++e) { a[e] += b[e]; ss += a[e] * a[e]; }
        ss += __shfl_xor(ss, 1); ss += __shfl_xor(ss, 2); ss += __shfl_xor(ss, 4); ss += __shfl_xor(ss, 8);
        const float rstd = rsqrtf(ss * (1.f / 128.f) + EPS);
#pragma unroll
        for (int e = 0; e < 8; ++e) {
          float y = a[e] * rstd * gnv[mix][e];
          o[e] = y * (mix == 0 ? siluf_(gt[e]) : sigmoidf_(gt[e]));
        }
        outv[mix] = pack8f(o);
      }
      if (doit[u]) {
        *(uint4*)(Y + (size_t)tk[u] * 2048 + col) = outv[0];
        *(uint4*)(Y + (size_t)tk[u] * 2048 + 512 + col) = outv[1];
      }
    }
  }
}

struct EpiInproj {
  u16* P; float* Gb;
  DI bool operator()(f32x4 (&acc)[2][2][4][2], const pg8::UDesc& u, int wr, int wc, int fr, int fq) const {
    const int row0 = u.pm * 256 + wr * 64 + fr, col0 = u.pn * 256 + wc * 32 + 8 * fq;
    const bool gate = (u.pn == 9) && (wc == 0) && (fq < 2);
#pragma unroll
    for (int ai = 0; ai < 2; ++ai)
#pragma unroll
      for (int m = 0; m < 4; ++m) {
        const size_t row = (size_t)(row0 + ai * 128 + m * 16);
#pragma unroll
        for (int bj = 0; bj < 2; ++bj) *(uint4*)(P + row * PS + col0 + bj * 128) = pk8(acc[ai][bj][m][0], acc[ai][bj][m][1]);
        if (gate) { *(f32x4*)(Gb + row * 16 + 8 * fq) = acc[ai][0][m][0]; *(f32x4*)(Gb + row * 16 + 8 * fq + 4) = acc[ai][0][m][1]; }
      }
    return false;
  }
};
__device__ void phase_inproj(const Params& p, int l, char* lds) {
  pg8::PlainSched S{p.ws + OFF_H, wsel(p, l) + OFF_WINT, 2048u, 2048u, 16, NTOK / 256, PS / 256, (int)gridDim.x, (int)blockIdx.x};
  EpiInproj E{(u16*)(p.ws + OFF_P), (float*)(p.ws + OFF_GB)};
  pg8::gemm_stream(( LAS unsigned char*)lds, S, E);
}

struct MlaSched {
  const char* P; const char* Wq; const char* Wk; const char* Wv; int G, c;
  DI bool next(int i, pg8::UDesc& u) const {
    const long L = (long)i * G + c; if (L >= (NTOK / 256) * 7) return false;
    const int pm = (int)(L / 7), j = (int)(L % 7);
    u.pm = pm; u.lda2 = PS * 2;
    if (j < 3) { u.tag = 0; u.pn = j; u.A = P + (size_t)pm * 256 * PS * 2 + D_CQ * 2; u.B = Wq + (size_t)j * 256 * 512; u.ldb2 = 512; u.nt = 4; }
    else if (j < 5) { u.tag = 1; u.pn = j - 3; u.A = P + (size_t)pm * 256 * PS * 2 + D_CKV * 2; u.B = Wk + (size_t)(j - 3) * 256 * 256; u.ldb2 = 256; u.nt = 2; }
    else { u.tag = 2; u.pn = j - 5; u.A = P + (size_t)pm * 256 * PS * 2 + D_CKV * 2; u.B = Wv + (size_t)(j - 5) * 256 * 256; u.ldb2 = 256; u.nt = 2; }
    return true;
  }
};
struct EpiMla {
  u16 *Qd, *Kd, *Vd;
  DI bool operator()(f32x4 (&acc)[2][2][4][2], const pg8::UDesc& u, int wr, int wc, int fr, int fq) const {
    const int row0 = u.pm * 256 + wr * 64 + fr, col0 = u.pn * 256 + wc * 32 + 8 * fq;
#pragma unroll
    for (int ai = 0; ai < 2; ++ai)
#pragma unroll
      for (int m = 0; m < 4; ++m) {
        const size_t row = (size_t)(row0 + ai * 128 + m * 16);
#pragma unroll
        for (int bj = 0; bj < 2; ++bj) {
          const int col = col0 + bj * 128;
          u16* dst = u.tag == 0 ? Qd + row * 768 + col : (u.tag == 1 ? Kd + row * 768 + (col >> 7) * 192 + (col & 127) : Vd + row * 512 + col);
          *(uint4*)dst = pk8(acc[ai][bj][m][0], acc[ai][bj][m][1]);
        }
      }
    return false;
  }
};
__device__ void phase_mlaup(const Params& p, int l, char* lds) {
  MlaSched S{p.ws + OFF_P, wsel(p, l) + OFF_WUQ, wsel(p, l) + OFF_WUK, wsel(p, l) + OFF_WUV, (int)gridDim.x, (int)blockIdx.x};
  EpiMla E{(u16*)(p.ws + OFF_QD), (u16*)(p.ws + OFF_KD), (u16*)(p.ws + OFF_VD)};
  pg8::gemm_stream((LAS unsigned char*)lds, S, E);
}

struct EpiGate {
  u16* Gt;
  DI bool operator()(f32x4 (&acc)[2][2][4][2], const pg8::UDesc& u, int wr, int wc, int fr, int fq) const {
    const int row0 = u.pm * 256 + wr * 64 + fr, col0 = u.pn * 256 + wc * 32 + 8 * fq;
#pragma unroll
    for (int ai = 0; ai < 2; ++ai)
#pragma unroll
      for (int m = 0; m < 4; ++m) {
        const size_t row = (size_t)(row0 + ai * 128 + m * 16);
#pragma unroll
        for (int bj = 0; bj < 2; ++bj) {
          f32x4 a = acc[ai][bj][m][0], b = acc[ai][bj][m][1];
#pragma unroll
          for (int e = 0; e < 4; ++e) { a[e] = fmaxf(sigmoidf_(a[e]), 1e-30f); b[e] = fmaxf(sigmoidf_(b[e]), 1e-30f); }
          *(uint4*)(Gt + row * 4096 + col0 + bj * 128) = pk8(a, b);
        }
      }
    return false;
  }
};
__device__ void phase_gate(const Params& p, int l, char* lds, int lat_only) {
  pg8::PlainSched S{p.ws + OFF_H, wsel(p, l) + OFF_WGT, 2048u, 2048u, 16, NTOK / 256, 16, (int)gridDim.x, (int)blockIdx.x, lat_only};
  EpiGate E{(u16*)(p.ws + OFF_P)};
  pg8::gemm_stream((LAS unsigned char*)lds, S, E);
}

struct BranchSched {
  const char* Y; const char* Wb; int G, c, lat_only;
  DI bool next(int i, pg8::UDesc& u) const {
    int pm, pn; if (!pg8::tile_order((long)(i >> 2) * G + c, lat_only ? NTOK / 256 - NB : NTOK / 256, 4, pm, pn)) return false;
    if (lat_only) pm = pm + (pm >> 3) + 1;
    const int r = i & 3;
    u.pm = pm; u.pn = pn; u.tag = r; u.lda2 = 4096; u.ldb2 = 1024; u.nt = 8;
    u.A = Y + (size_t)pm * 256 * 4096 + r * 1024; u.B = Wb + ((size_t)r * 1024 + pn * 256) * 1024;
    return true;
  }
};
struct EpiBranch {
  const u16* Gt; u16* Mg;
  DI bool operator()(f32x4 (&acc)[2][2][4][2], const pg8::UDesc& u, int wr, int wc, int fr, int fq) const {
    const int row0 = u.pm * 256 + wr * 64 + fr, col0 = u.pn * 256 + wc * 32 + 8 * fq, r = u.tag;
    const int rn = r < 3 ? r + 1 : r;
    uint4 gin[2][2][2], gnn[2][2][2];
#define EPB_LOAD(slot, k_) do { const int ai_ = (k_) >> 1, mh_ = (k_) & 1; \
    _Pragma("unroll") for (int mm = 0; mm < 2; ++mm) _Pragma("unroll") for (int bj = 0; bj < 2; ++bj) { \
      const u16* gp = Gt + (size_t)(row0 + ai_ * 128 + (mh_ * 2 + mm) * 16) * 4096 + col0 + bj * 128; \
      gin[slot][mm][bj] = *(const uint4*)(gp + r * 1024); gnn[slot][mm][bj] = *(const uint4*)(gp + rn * 1024); } } while (0)
    EPB_LOAD(0, 0);
#pragma unroll
    for (int k = 0; k < 4; ++k) {
      const int ai = k >> 1, mh = k & 1, slot = k & 1;
      if (k + 1 < 4) EPB_LOAD(slot ^ 1, k + 1);
#pragma unroll
      for (int mm = 0; mm < 2; ++mm) {
        const int m = mh * 2 + mm;
        const size_t row = (size_t)(row0 + ai * 128 + m * 16);
#pragma unroll
        for (int bj = 0; bj < 2; ++bj) {
          const int col = col0 + bj * 128;
          float gv[8];
          unpack8(gin[slot][mm][bj], gv);
          if (r < 3) {
            float gn[8];
            unpack8(gnn[slot][mm][bj], gn);
#pragma unroll
            for (int e = 0; e < 4; ++e) {
              acc[ai][bj][m][0][e] *= gv[e] * __builtin_amdgcn_rcpf(gn[e]);
              acc[ai][bj][m][1][e] *= gv[4 + e] * __builtin_amdgcn_rcpf(gn[4 + e]);
            }
          } else {
            f32x4 a = acc[ai][bj][m][0], b = acc[ai][bj][m][1];
#pragma unroll
            for (int e = 0; e < 4; ++e) { a[e] *= gv[e]; b[e] *= gv[4 + e]; }
            *(uint4*)(Mg + row * 1024 + col) = pk8(a, b);
          }
        }
      }
    }
#undef EPB_LOAD
    return r < 3;
  }
};
__device__ void phase_branch(const Params& p, int l, char* lds, int lat_only) {
  BranchSched S{(const char*)p.out, wsel(p, l) + OFF_WBT, (int)gridDim.x, (int)blockIdx.x, lat_only};
  EpiBranch E{(const u16*)(p.ws + OFF_P), (u16*)(p.ws + OFF_OA)};
  pg8::gemm_stream((LAS unsigned char*)lds, S, E);
}

struct EpiResid {
  const Params* pp; const float* mod; int g, gidx; float* dummy;
  DI bool operator()(f32x4 (&acc)[2][2][4][2], const pg8::UDesc& u, int wr, int wc, int fr, int fq) const {
    int mr; u16* xb = xrow_ptr(*pp, g, u.pm * 256, mr);
    if (dummy) xb = (u16*)dummy + (size_t)u.pm * 256 * DM;
    const float* gate = mod + (size_t)mr * 6144 + gidx * DM;
    const int row0 = wr * 64 + fr, col0 = u.pn * 256 + wc * 32 + 8 * fq;
    f32x4 gv[2][2];
#pragma unroll
    for (int bj = 0; bj < 2; ++bj) { gv[bj][0] = *(const f32x4*)(gate + col0 + bj * 128); gv[bj][1] = *(const f32x4*)(gate + col0 + bj * 128 + 4); }
#pragma unroll
    for (int ai = 0; ai < 2; ++ai) {
      uint4 xin[4][2];
#pragma unroll
      for (int m = 0; m < 4; ++m)
#pragma unroll
        for (int bj = 0; bj < 2; ++bj) xin[m][bj] = *(const uint4*)(xb + (size_t)(row0 + ai * 128 + m * 16) * DM + col0 + bj * 128);
#pragma unroll
      for (int m = 0; m < 4; ++m) {
        u16* xr = xb + (size_t)(row0 + ai * 128 + m * 16) * DM + col0;
#pragma unroll
        for (int bj = 0; bj < 2; ++bj) {
          float xv[8];
          unpack8(xin[m][bj], xv);
          f32x4 x0 = {xv[0], xv[1], xv[2], xv[3]}, x1 = {xv[4], xv[5], xv[6], xv[7]};
          x0 += gv[bj][0] * acc[ai][bj][m][0]; x1 += gv[bj][1] * acc[ai][bj][m][1];
          *(uint4*)(xr + bj * 128) = pk8(x0, x1);
        }
      }
    }
    return false;
  }
};
__device__ void phase_resid_gemm(const Params& p, int l, int g, const char* A, const char* W, int K, int gidx, char* lds, float* dummy = nullptr) {
  pg8::PlainSched S{A, W, (unsigned)K * 2u, (unsigned)K * 2u, K / 64, NTOK / 256, 4, (int)gridDim.x, (int)blockIdx.x, (l == DEPTH - 1) ? 1 : 0};
  EpiResid E{&p, (const float*)(p.ws + OFF_MOD) + (size_t)l * 33 * 6144, g, gidx, dummy};
  pg8::gemm_stream((LAS unsigned char*)lds, S, E);
}

struct EpiFF1 {
  u16* Hid;
  DI bool operator()(f32x4 (&acc)[2][2][4][2], const pg8::UDesc& u, int wr, int wc, int fr, int fq) const {
    const int row0 = u.pm * 256 + wr * 64 + fr, col0 = u.pn * 256 + wc * 32 + 8 * fq;
#pragma unroll
    for (int ai = 0; ai < 2; ++ai)
#pragma unroll
      for (int m = 0; m < 4; ++m) {
        const size_t row = (size_t)(row0 + ai * 128 + m * 16);
#pragma unroll
        for (int bj = 0; bj < 2; ++bj) {
          f32x4 a = acc[ai][bj][m][0], b = acc[ai][bj][m][1];
#pragma unroll
          for (int e = 0; e < 4; ++e) { float t = fmaxf(a[e], 0.f); a[e] = t * t; t = fmaxf(b[e], 0.f); b[e] = t * t; }
          *(uint4*)(Hid + row * DFF + col0 + bj * 128) = pk8(a, b);
        }
      }
    return false;
  }
};
__device__ void phase_ff1(const Params& p, int l, char* lds, int lat_only) {
  pg8::PlainSched S{p.ws + OFF_H, wsel(p, l) + OFF_W1T, 2048u, 2048u, 16, NTOK / 256, 16, (int)gridDim.x, (int)blockIdx.x, lat_only};
  EpiFF1 E{(u16*)(p.ws + OFF_P)};
  pg8::gemm_stream((LAS unsigned char*)lds, S, E);
}

DI void final_finish(const uint2 (&q)[4], int lane, const float4 (&gfv)[4], float* orow) {
  float4 v[4]; float ss = 0.f;
#pragma unroll
  for (int j = 0; j < 4; ++j) {
    v[j].x = __uint_as_float(q[j].x << 16); v[j].y = __uint_as_float(q[j].x & 0xffff0000u); v[j].z = __uint_as_float(q[j].y << 16); v[j].w = __uint_as_float(q[j].y & 0xffff0000u);
    ss += v[j].x * v[j].x + v[j].y * v[j].y + v[j].z * v[j].z + v[j].w * v[j].w;
  }
  ss = wave_sum(ss);
  const float rstd = rsqrtf(ss * (1.f / DM) + EPS);
#pragma unroll
  for (int j = 0; j < 4; ++j) {
    const int c = j * 256 + lane * 4;
    const float4 gg = gfv[j];
    float4 o = {v[j].x * rstd * gg.x, v[j].y * rstd * gg.y, v[j].z * rstd * gg.z, v[j].w * rstd * gg.w};
    *(float4*)(orow + c) = o;
  }
}
__device__ void phase_final(const Params& p) {
  const int tid = otid(), lane = tid & 63, wid = tid >> 6;
  const int stride = gridDim.x * 8;
  const u16* X = (const u16*)(p.ws + OFF_XL);
  float4 gfv[4];
#pragma unroll
  for (int j = 0; j < 4; ++j) gfv[j] = *(const float4*)(p.gfin + j * 256 + lane * 4);
  for (int tok = blockIdx.x * 8 + wid; tok < NBATCH * SEQ; tok += 2 * stride) {
    const int tokB = tok + stride;
    const bool doB = tokB < NBATCH * SEQ;
    uint2 qa[4], qb[4];
    norm_load(X + (size_t)tok * DM, lane, qa);
    norm_load(X + (size_t)(doB ? tokB : tok) * DM, lane, qb);
    final_finish(qa, lane, gfv, p.out + (size_t)tok * DM);
    if (doB) final_finish(qb, lane, gfv, p.out + (size_t)tokB * DM);
  }
}

#define XB_TMO      128
#define XB_XCNT(j)  (256  + 64 * (j))
#define XB_XSUB(j)  (1280 + 64 * (j))
#define XB_XGEN(j)  (2304 + 64 * (j))
#define XB_TOP      3328
#define XB_TOPGEN   3392
#define XCD_BAR_WORDS 3456
#define XB_SPIN_CAP (1u << 18)
DI unsigned xb_ld(unsigned* p) { return __hip_atomic_load(p, __ATOMIC_RELAXED, __HIP_MEMORY_SCOPE_AGENT); }
DI unsigned xb_add(unsigned* p, unsigned v) { return __hip_atomic_fetch_add(p, v, __ATOMIC_RELAXED, __HIP_MEMORY_SCOPE_AGENT); }
DI unsigned xb_xcc_id() { return (unsigned)__builtin_amdgcn_s_getreg((3 << 11) | 20) & 0xFu; }
#define XB_SPIN(cond, bar) do { unsigned _sp = 0; while (cond) { __builtin_amdgcn_s_sleep(1); \
    if ((++_sp & 255u) == 0u) { if (xb_ld(&(bar)[XB_TMO])) break; if (_sp > XB_SPIN_CAP) { atomicAdd(&(bar)[XB_TMO], 1u); break; } } } } while (0)
struct XcdBarrier { unsigned* bar; unsigned x; volatile __attribute__((address_space(3))) unsigned* st; };
DI XcdBarrier xcd_barrier_post(unsigned* bar, volatile __attribute__((address_space(3))) unsigned* st) {
  XcdBarrier b; b.bar = bar; b.x = xb_xcc_id(); b.st = st;
  if (threadIdx.x == 0) (void)xb_add(&bar[XB_XCNT(b.x)], 1u);
  return b;
}
DI void xcd_barrier_complete(unsigned* bar, unsigned x, unsigned& nloc, unsigned& nx) {
  const unsigned G = gridDim.x * gridDim.y * gridDim.z;
  unsigned sum, cnt, mine, sp = 0u;
  for (;;) {
    sum = 0u; cnt = 0u; mine = 0u;
#pragma unroll
    for (unsigned j = 0; j < 16; ++j) { const unsigned c = xb_ld(&bar[XB_XCNT(j)]); sum += c; cnt += (c > 0u) ? 1u : 0u; mine = (j == x) ? c : mine; }
    if (sum == G) break;
    __builtin_amdgcn_s_sleep(1);
    if ((++sp & 255u) == 0u) { if (xb_ld(&bar[XB_TMO])) break; if (sp > XB_SPIN_CAP) { atomicAdd(&bar[XB_TMO], 1u); break; } }
  }
  nloc = mine > 0u ? mine : 1u; nx = cnt > 0u ? cnt : 1u;
}
DI void xcd_barrier(const XcdBarrier& b) {
  asm volatile("s_waitcnt vmcnt(0)" ::: "memory");
  __syncthreads();
  if (threadIdx.x == 0) {
    unsigned* bar = b.bar;
    __builtin_amdgcn_s_waitcnt(0);
    unsigned nloc = b.st[0], nx = b.st[1];
    if (nloc == 0u) { xcd_barrier_complete(bar, b.x, nloc, nx); b.st[0] = nloc; b.st[1] = nx; }
    const unsigned old = xb_add(&bar[XB_XSUB(b.x)], 1u);
    const unsigned gen = old / nloc;
    if (old + 1u == (gen + 1u) * nloc) {
      __builtin_amdgcn_fence(__ATOMIC_RELEASE, "agent");
      asm volatile("s_waitcnt vmcnt(0)" ::: "memory");
      const unsigned og = xb_add(&bar[XB_TOP], 1u);
      const unsigned tg = og / nx;
      if (og + 1u == (tg + 1u) * nx) xb_add(&bar[XB_TOPGEN], 1u);
      else XB_SPIN(xb_ld(&bar[XB_TOPGEN]) == tg, bar);
      __builtin_amdgcn_fence(__ATOMIC_ACQUIRE, "agent");
      xb_add(&bar[XB_XGEN(b.x)], 1u);
      asm volatile("s_waitcnt vmcnt(0)" ::: "memory");
    } else {
      XB_SPIN(xb_ld(&bar[XB_XGEN(b.x)]) == gen, bar);
      __builtin_amdgcn_fence(__ATOMIC_ACQUIRE, "agent");
      asm volatile("s_waitcnt vmcnt(0)" ::: "memory");
    }
  }
  __syncthreads();
}

constexpr int NSUB = 12;
constexpr int NPHASE = 1 + DEPTH * NG * NSUB + 1;

__global__ void __launch_bounds__(512) mega(Params p, int ph_lo, int ph_hi) {
  extern __shared__ __attribute__((aligned(16))) char lds[];
  volatile __attribute__((address_space(3))) unsigned* st = (volatile __attribute__((address_space(3))) unsigned*)(lds + LDS_BYTES - 32);
  if (threadIdx.x < 2) st[threadIdx.x] = 0u;
  __syncthreads();
  XcdBarrier xb{};
  if (ph_hi - ph_lo > 1) xb = xcd_barrier_post((unsigned*)(p.ws + OFF_BAR), st);
#define GSYNC() xcd_barrier(xb)
  for (int ph = ph_lo; ph < ph_hi; ++ph) {
    if (ph > 0 && ph < NPHASE - 1 && ((ph - 1) % NSUB) == 0 && ((ph - 1) / NSUB) != 0) continue;
    if (ph == 0) { phase_prep(p, lds); phase_wconv(p, 0, lds); }
    else if (ph == NPHASE - 1) phase_final(p);
    else {
      const int q = ph - 1, lg = q / NSUB, sub = q % NSUB, l = lg / NG, g = lg % NG;
      switch (sub) {
        case 0: if (lg == 0) phase_norm(p, l, g, 0); break;
        case 1: for (int rep = 0; rep < ((PROBE & 2) ? 2 : 1); ++rep) { if (rep) GSYNC(); phase_inproj(p, l, lds); } break;
        case 2: phase_tokprep(p, l); break;
        case 3: phase_mlaup(p, l, lds); break;
        case 4: phase_mixers(p, l, g, lds); if (PROBE & 1) { GSYNC(); phase_mixers(p, l, g, lds, 8); } if (PROBE & 4) { GSYNC(); phase_mixers(p, l, g, lds, 8, true); } if (PROBE & 16) { GSYNC(); phase_mixers(p, l, g, lds, 8, true, true); } break;
        case 5: for (int rep = 0; rep < ((PROBE & 8) ? 2 : 1); ++rep) { if (rep) GSYNC(); phase_readout(p, l); } break;
        case 6: for (int rep = 0; rep < ((PROBE & 2) ? 2 : 1); ++rep) { if (rep) GSYNC(); phase_gate(p, l, lds, l == DEPTH - 1); } break;
        case 7: for (int rep = 0; rep < ((PROBE & 32) ? 2 : 1); ++rep) { if (rep) GSYNC(); phase_branch(p, l, lds, l == DEPTH - 1); } if (g == 0 && l + 1 < DEPTH) phase_wconv(p, l + 1, lds, (int*)(p.ws + OFF_CNT) + 24 + l); break;
        case 8: for (int rep = 0; rep < ((PROBE & 64) ? 2 : 1); ++rep) { if (rep) GSYNC(); phase_resid_gemm(p, l, g, p.ws + OFF_OA, wsel(p, l) + OFF_WOT, DM, 2, lds, rep ? (float*)((char*)p.out) : nullptr); } break;
        case 9: for (int rep = 0; rep < ((PROBE & 8) ? 2 : 1); ++rep) { if (rep) GSYNC(); phase_norm(p, l, g, 1); } break;
        case 10: for (int rep = 0; rep < ((PROBE & 2) ? 2 : 1); ++rep) { if (rep) GSYNC(); phase_ff1(p, l, lds, l == DEPTH - 1); } break;
        default: for (int rep = 0; rep < ((PROBE & 64) ? 2 : 1); ++rep) { if (rep) GSYNC(); phase_resid_gemm(p, l, g, p.ws + OFF_P, wsel(p, l) + OFF_W2T, DFF, 5, lds, rep ? (float*)((char*)p.out) : nullptr); } if (lg + 1 < DEPTH * NG) phase_norm_dyn(p, (lg + 1) / NG, (lg + 1) % NG, (int*)(p.ws + OFF_CNT) + 16 + lg); break;
      }
    }
    if (ph + 1 < ph_hi) { if (ph == ph_lo) cg::this_grid().sync(); else GSYNC(); }
  }
}

extern "C" void kernel_launch(void* const* d_in, const int* in_sizes, int n_in, void* d_out, int out_size, void* d_ws,
                              size_t ws_size, hipStream_t stream) {
  static int grid_blocks = 0;
  if (!grid_blocks) {
    int dev = 0, cus = 0, per_cu = 0;
    (void)hipGetDevice(&dev);
    (void)hipDeviceGetAttribute(&cus, hipDeviceAttributeMultiprocessorCount, dev);
    (void)hipFuncSetAttribute((const void*)mega, hipFuncAttributeMaxDynamicSharedMemorySize, LDS_BYTES);
    (void)hipOccupancyMaxActiveBlocksPerMultiprocessor(&per_cu, mega, NTHR, LDS_BYTES);
    if (per_cu < 1) per_cu = 1;
    if (per_cu > 1) per_cu = 1;
    grid_blocks = cus * per_cu;
  }
  if (ws_size < WS_NEED) { fprintf(stderr, "workspace too small: %zu < %zu\n", ws_size, (size_t)WS_NEED); }
  Params p{};
  const float** pf = (const float**)&p;
  for (int i = 0; i < 26; ++i) pf[i] = (const float*)d_in[i];
  p.out = (float*)d_out;
  p.ws = (char*)d_ws;
  (void)hipMemsetAsync((char*)d_ws + OFF_CNT, 0, 256 + 3456 * 4, stream);
#if ONE_LAUNCH
  int lo = 0, hi = NPHASE;
  void* args[] = {&p, &lo, &hi};
  hipError_t e = hipLaunchCooperativeKernel((void*)mega, dim3(grid_blocks), dim3(NTHR), args, LDS_BYTES, stream);
  if (e != hipSuccess) fprintf(stderr, "cooperative launch failed: %s (grid %d)\n", hipGetErrorString(e), grid_blocks);
#else
  for (int ph = 0; ph < NPHASE; ++ph) mega<<<grid_blocks, NTHR, LDS_BYTES, stream>>>(p, ph, ph + 1);
#endif
}
```

```cpp
#include <hip/hip_runtime.h>
#include <hip/hip_cooperative_groups.h>
#include <cstdio>
#include <cstdint>
namespace cg = cooperative_groups;

#ifndef PROBE
#define PROBE 0
#endif
#ifndef ONE_LAUNCH
#define ONE_LAUNCH 1
#endif

typedef unsigned short u16;
typedef short bf16x8 __attribute__((ext_vector_type(8)));
typedef short s16x4 __attribute__((ext_vector_type(4)));
typedef float f32x16 __attribute__((ext_vector_type(16)));
typedef float f32x2v __attribute__((ext_vector_type(2)));
typedef __bf16 bf16x2v __attribute__((ext_vector_type(2)));
#define DI __device__ __forceinline__
#define MFMA(a, b, c) __builtin_amdgcn_mfma_f32_32x32x16_bf16((a), (b), (c), 0, 0, 0)

constexpr int DM = 1024, NBATCH = 32, SEQ = 2048, CTXL = 256, DEPTH = 4, DFF = 4096;
constexpr int NG = 2, NB = 16, TPB = 2304, NTOK = NB * TPB;
constexpr int PS = 5376, NPC = 5328, INW = 9424;
constexpr int A_I = 0, A_FF = 512, A_FB = 1024, B_K = 1536, B_V = 1792, B_G = 2304, C_K = 2320, C_V = 2448,
              D_CKV = 2576, D_KR = 2704, A_Q = 2768, A_G = 3280, B_Q = 3792, B_O = 4048, C_Q = 4560, D_CQ = 5072;
constexpr float EPS = 1e-6f;
constexpr float LOG2E = 1.4426950408889634f;

constexpr size_t al256(size_t x) { return (x + 255) & ~(size_t)255; }
constexpr size_t OFF_WINT = 0;
constexpr size_t OFF_WGT = OFF_WINT + al256((size_t)PS * 1024 * 2);
constexpr size_t OFF_WBT = OFF_WGT + al256((size_t)4096 * 1024 * 2);
constexpr size_t OFF_WOT = OFF_WBT + al256((size_t)4 * 1024 * 512 * 2);
constexpr size_t OFF_W1T = OFF_WOT + al256((size_t)1024 * 1024 * 2);
constexpr size_t OFF_W2T = OFF_W1T + al256((size_t)4096 * 1024 * 2);
constexpr size_t OFF_WUQ = OFF_W2T + al256((size_t)1024 * 4096 * 2);
constexpr size_t OFF_WUK = OFF_WUQ + al256((size_t)768 * 256 * 2);
constexpr size_t OFF_WUV = OFF_WUK + al256((size_t)512 * 128 * 2);
constexpr size_t OFF_MOD = OFF_WUV + al256((size_t)512 * 128 * 2);
constexpr size_t OFF_LB = OFF_MOD + al256((size_t)4 * 33 * 6144 * 4);
constexpr size_t OFF_ROPE = OFF_LB + al256((size_t)4 * 2 * 512 * 4);
constexpr size_t OFF_CNT = OFF_ROPE + al256((size_t)2 * 64 * 16 * 4);
constexpr size_t OFF_BAR = OFF_CNT + 256;
constexpr size_t OFF_XC = OFF_BAR + al256(3456 * 4);
constexpr size_t OFF_XL = OFF_XC + al256((size_t)NBATCH * CTXL * DM * 2);
constexpr size_t OFF_P = OFF_XL + al256((size_t)NBATCH * SEQ * DM * 2);
constexpr size_t OFF_GB = OFF_P + al256((size_t)NTOK * PS * 2);
constexpr size_t OFF_KQ = OFF_GB + al256((size_t)NTOK * 16 * 4);
constexpr size_t OFF_H = OFF_KQ + al256((size_t)NTOK * 512 * 2);
constexpr size_t OFF_QD = OFF_H + al256((size_t)NTOK * 1024 * 2);
constexpr size_t OFF_KD = OFF_QD + al256((size_t)NTOK * 768 * 2);
constexpr size_t OFF_VD = OFF_KD + al256((size_t)NTOK * 768 * 2);
constexpr size_t OFF_OA = OFF_VD + al256((size_t)NTOK * 512 * 2);
constexpr size_t OFF_OB = OFF_OA + al256((size_t)2 * NTOK * 512 * 2);
constexpr size_t OFF_W2ND = OFF_OB + al256((size_t)2 * NTOK * 512 * 2);
constexpr size_t WS_NEED = OFF_W2ND + (OFF_MOD - OFF_WINT);
constexpr int LDS_BYTES = 143360;
constexpr int LDSV = 69632;
constexpr int NTHR = 512;
constexpr size_t OFF_MF = OFF_QD;

struct Params {
  const float *x, *c, *ctx, *c_ctx, *w_ada, *b_ada, *g1, *g2, *w_in, *bgate, *lblog, *hnorm, *convw, *mnorm,
      *gqn, *gkn, *mqn, *mkvn, *wuq, *wuk, *wuv, *wbr, *wout, *wff1, *wff2, *gfin;
  float* out;
  char* ws;
};

DI int otid() { int t = threadIdx.x; asm volatile("" : "+v"(t)); return t; }
DI char* wsel(const Params& p, int l) { return p.ws + ((l & 1) ? OFF_W2ND : (size_t)0); }
DI float bf2f(u16 v) { return __uint_as_float(((unsigned)v) << 16); }
DI unsigned pack2(float a, float b) {
  f32x2v v = {a, b};
  bf16x2v r = __builtin_convertvector(v, bf16x2v);
  return __builtin_bit_cast(unsigned, r);
}
DI u16 f2bf(float a) { return (u16)(pack2(a, 0.f) & 0xffffu); }
DI int crow(int reg, int h) { return (reg & 3) + 8 * (reg >> 2) + 4 * h; }
DI float sigmoidf_(float x) { return __builtin_amdgcn_rcpf(1.f + __expf(-x)); }
DI float siluf_(float x) { return x * __builtin_amdgcn_rcpf(1.f + __expf(-x)); }
DI float ex2(float x) { return __builtin_amdgcn_exp2f(x); }
DI bf16x8 pack8(const f32x16& x, int s) {
  union { unsigned u[4]; bf16x8 v; } t;
  t.u[0] = pack2(x[8 * s + 0], x[8 * s + 1]);
  t.u[1] = pack2(x[8 * s + 2], x[8 * s + 3]);
  t.u[2] = pack2(x[8 * s + 4], x[8 * s + 5]);
  t.u[3] = pack2(x[8 * s + 6], x[8 * s + 7]);
  return t.v;
}
DI bf16x8 cat4(s16x4 lo, s16x4 hi) { return __builtin_shufflevector(lo, hi, 0, 1, 2, 3, 4, 5, 6, 7); }
DI float wave_sum(float v) {
#pragma unroll
  for (int d = 32; d >= 1; d >>= 1) v += __shfl_xor(v, d);
  return v;
}
DI void unpack8(const uint4& q, float* f) {
  f[0] = __uint_as_float(q.x << 16); f[1] = __uint_as_float(q.x & 0xffff0000u);
  f[2] = __uint_as_float(q.y << 16); f[3] = __uint_as_float(q.y & 0xffff0000u);
  f[4] = __uint_as_float(q.z << 16); f[5] = __uint_as_float(q.z & 0xffff0000u);
  f[6] = __uint_as_float(q.w << 16); f[7] = __uint_as_float(q.w & 0xffff0000u);
}
DI uint4 pack8f(const float* f) {
  uint4 q;
  q.x = pack2(f[0], f[1]); q.y = pack2(f[2], f[3]); q.z = pack2(f[4], f[5]); q.w = pack2(f[6], f[7]);
  return q;
}

DI u16* xrow_ptr(const Params& p, int g, int tok, int& modrow) {
  int bl = tok / TPB, pp = tok - bl * TPB, b = g * NB + bl;
  if (pp < CTXL) { modrow = 32; return (u16*)(p.ws + OFF_XC) + ((size_t)b * CTXL + pp) * DM; }
  modrow = b;
  return (u16*)(p.ws + OFF_XL) + ((size_t)b * SEQ + (pp - CTXL)) * DM;
}

#define LAS __attribute__((address_space(3)))
typedef float f32x4 __attribute__((ext_vector_type(4)));
namespace pg8 {
constexpr int BM = 256, BK = 64, HALF = 128, HTB = HALF * BK * 2, STAGE_BYTES = 8 * HTB, NXCD = 8, WGM = 8;
DI int lds_byte(int r, int c) { const int st = (r >> 4) * 2 + (c >> 5), rr = r & 15, cc = c & 31, ob = rr * 64 + cc * 2; return st * 1024 + (ob ^ (((ob >> 9) & 1) << 5)); }
DI void stage_rc(int b, int& R, int& C) { const int st = b / 1024, sb = b % 1024, swz = sb ^ (((sb >> 9) & 1) << 5); R = (st >> 1) * 16 + swz / 64; C = (st & 1) * 32 + (swz % 64) / 2; }
DI int perm32(int rho) { const int n = rho >> 4, i = rho & 15; return 8 * (i >> 2) + 4 * n + (i & 3); }
struct UDesc { const char* A; const char* B; unsigned lda2, ldb2; int nt, pm, pn, tag; };
DI bool tile_order(long L, int nM, int nN, int& pm, int& pn) {
  const int nwg = nM * nN; if (L >= nwg) return false;
  int wgid = (int)L; { const int q = nwg / NXCD, r = nwg % NXCD, xcd = wgid % NXCD, off = wgid / NXCD; wgid = (xcd < r ? xcd * (q + 1) : r * (q + 1) + (xcd - r) * q) + off; }
  const int nig = WGM * nN, gid = wgid / nig, fm = gid * WGM, gsz = (nM - fm) < WGM ? (nM - fm) : WGM;
  pm = fm + ((wgid % nig) % gsz); pn = (wgid % nig) / gsz; return true;
}
template <class Epi, class Sched>
DI void gemm_stream(LAS unsigned char* lds, const Sched& S, const Epi& E) {
  const int tid = otid(), wid = __builtin_amdgcn_readfirstlane(tid >> 6), lane = tid & 63, wr = wid >> 2, wc = wid & 3, fr = lane & 15, fq = lane >> 4;
  int RA[2], RB[2], CC[2];
#pragma unroll
  for (int i = 0; i < 2; ++i) { int R, C; stage_rc(tid * 16 + i * 8192, R, C); RA[i] = R; RB[i] = (R & ~31) + perm32(R & 31); CC[i] = C * 2; }
  const size_t kstep = (size_t)(BK * 2);
  const unsigned ldsw = (unsigned)wid * 1024u;
  const int aoff = lds_byte(wr * 64 + fr, fq * 8), boff = lds_byte(wc * 32 + fr, fq * 8);
#define PG8_SA(b, h) (((b) * 2 + (h)) * HTB)
#define PG8_SB(b, h) ((4 + (b) * 2 + (h)) * HTB)
#define PG8_STAGE(bufoff, gbase, voff) do { _Pragma("unroll") for (int _i = 0; _i < 2; ++_i) \
    __builtin_amdgcn_global_load_lds((const unsigned*)((const char*)(gbase) + (voff)[_i]), (LAS unsigned*)(lds + (bufoff) + ldsw + _i * 8192), 16, 0, 0); } while (0)
#define PG8_LDA(dst, b, h) do { _Pragma("unroll") for (int m = 0; m < 4; ++m) _Pragma("unroll") for (int k = 0; k < 2; ++k) dst[m][k] = *(const LAS bf16x8*)(lds + PG8_SA(b, h) + aoff + m * 2048 + k * 1024); } while (0)
#define PG8_LDB(dst, b, h) do { _Pragma("unroll") for (int n = 0; n < 2; ++n) _Pragma("unroll") for (int k = 0; k < 2; ++k) dst[n][k] = *(const LAS bf16x8*)(lds + PG8_SB(b, h) + boff + n * 2048 + k * 1024); } while (0)
#define PG8_MMA(ai, bj, At, Bt) do { __builtin_amdgcn_s_setprio(1); _Pragma("unroll") for (int m = 0; m < 4; ++m) _Pragma("unroll") for (int n = 0; n < 2; ++n) _Pragma("unroll") for (int k = 0; k < 2; ++k) \
    acc[ai][bj][m][n] = __builtin_amdgcn_mfma_f32_16x16x32_bf16(Bt[n][k], At[m][k], acc[ai][bj][m][n], 0, 0, 0); __builtin_amdgcn_s_setprio(0); } while (0)
#define PG8_WAIT_V(n) asm volatile("s_waitcnt vmcnt(" #n ")" ::: "memory")
#define PG8_WAIT_L(n) asm volatile("s_waitcnt lgkmcnt(" #n ")" ::: "memory")
#define PG8_BAR __builtin_amdgcn_s_barrier()
#define PG8_SCHED __builtin_amdgcn_sched_barrier(0)
  UDesc cur, nxt; int ui = 0;
  if (!S.next(0, cur)) return;
  f32x4 acc[2][2][4][2];
#pragma unroll
  for (int a = 0; a < 2; ++a)
#pragma unroll
    for (int b = 0; b < 2; ++b)
#pragma unroll
      for (int m = 0; m < 4; ++m)
#pragma unroll
        for (int n = 0; n < 2; ++n) acc[a][b][m][n] = (f32x4){0.f, 0.f, 0.f, 0.f};
  bf16x8 At[4][2], B0[2][2], B1[2][2];
  const char* cA = cur.A; const char* cB = cur.B;
  unsigned vA[2], vB[2];
#pragma unroll
  for (int i = 0; i < 2; ++i) { vA[i] = (unsigned)RA[i] * cur.lda2 + CC[i]; vB[i] = (unsigned)RB[i] * cur.ldb2 + CC[i]; }
  size_t hA = (size_t)HALF * cur.lda2, hB = (size_t)HALF * cur.ldb2;
  PG8_STAGE(PG8_SB(0, 0), cB, vB); PG8_STAGE(PG8_SA(0, 0), cA, vA); PG8_STAGE(PG8_SB(0, 1), cB + hB, vB); PG8_STAGE(PG8_SA(0, 1), cA + hA, vA);
  if (wr == 1) PG8_BAR;
  PG8_WAIT_V(4); PG8_BAR;
  PG8_STAGE(PG8_SB(1, 0), cB + kstep, vB); PG8_STAGE(PG8_SA(1, 0), cA + kstep, vA); PG8_STAGE(PG8_SB(1, 1), cB + hB + kstep, vB);
  PG8_WAIT_V(6); PG8_BAR;
  for (;;) {
    const bool has_next = S.next(ui + 1, nxt);
    const char* nA = has_next ? nxt.A : cA; const char* nB = has_next ? nxt.B : cB;
    const unsigned nlda = has_next ? nxt.lda2 : cur.lda2, nldb = has_next ? nxt.ldb2 : cur.ldb2;
    unsigned nvA[2], nvB[2];
#pragma unroll
    for (int i = 0; i < 2; ++i) { nvA[i] = (unsigned)RA[i] * nlda + CC[i]; nvB[i] = (unsigned)RB[i] * nldb + CC[i]; }
    const size_t nhA = (size_t)HALF * nlda, nhB = (size_t)HALF * nldb;
    const int nt = cur.nt;
    for (int t = 0; t < nt; t += 2) {
      const bool last = (t == nt - 2);
      const char* a1 = cA + (size_t)(t + 1) * kstep;
      const char* a2 = last ? nA : cA + (size_t)(t + 2) * kstep; const char* b2 = last ? nB : cB + (size_t)(t + 2) * kstep;
      const char* a3 = a2 + kstep; const char* b3 = b2 + kstep;
      unsigned v2A[2], v2B[2];
#pragma unroll
      for (int i = 0; i < 2; ++i) { v2A[i] = last ? nvA[i] : vA[i]; v2B[i] = last ? nvB[i] : vB[i]; }
      const size_t h2A = last ? nhA : hA, h2B = last ? nhB : hB;
      PG8_LDB(B0, 0, 0); PG8_SCHED; PG8_LDA(At, 0, 0); PG8_STAGE(PG8_SA(1, 1), a1 + hA, vA);
      PG8_WAIT_L(8); PG8_BAR; PG8_WAIT_L(0); PG8_MMA(0, 0, At, B0); PG8_BAR; PG8_SCHED;
      PG8_LDB(B1, 0, 1); PG8_STAGE(PG8_SB(0, 0), b2, v2B);
      PG8_BAR; PG8_WAIT_L(0); PG8_MMA(0, 1, At, B1); PG8_BAR;
      PG8_LDA(At, 0, 1); PG8_STAGE(PG8_SA(0, 0), a2, v2A);
      PG8_BAR; PG8_WAIT_L(0); PG8_MMA(1, 0, At, B0); PG8_BAR; PG8_SCHED;
      PG8_STAGE(PG8_SB(0, 1), b2 + h2B, v2B);
      PG8_WAIT_V(6); PG8_BAR; PG8_MMA(1, 1, At, B1); PG8_BAR;
      PG8_LDB(B0, 1, 0); PG8_SCHED; PG8_LDA(At, 1, 0); PG8_STAGE(PG8_SA(0, 1), a2 + h2A, v2A);
      PG8_WAIT_L(8); PG8_BAR; PG8_WAIT_L(0); PG8_MMA(0, 0, At, B0); PG8_BAR; PG8_SCHED;
      PG8_LDB(B1, 1, 1); PG8_STAGE(PG8_SB(1, 0), b3, v2B);
      PG8_BAR; PG8_WAIT_L(0); PG8_MMA(0, 1, At, B1); PG8_BAR;
      PG8_LDA(At, 1, 1); PG8_STAGE(PG8_SA(1, 0), a3, v2A);
      PG8_BAR; PG8_WAIT_L(0); PG8_MMA(1, 0, At, B0); PG8_BAR; PG8_SCHED;
      PG8_STAGE(PG8_SB(1, 1), b3 + h2B, v2B);
      PG8_WAIT_V(6); PG8_BAR; PG8_MMA(1, 1, At, B1); PG8_BAR;
    }
    const bool keep = E(acc, cur, wr, wc, fr, fq);
    if (!has_next) break;
    if (!keep) {
#pragma unroll
      for (int a = 0; a < 2; ++a)
#pragma unroll
        for (int b = 0; b < 2; ++b)
#pragma unroll
          for (int m = 0; m < 4; ++m)
#pragma unroll
            for (int n = 0; n < 2; ++n) acc[a][b][m][n] = (f32x4){0.f, 0.f, 0.f, 0.f};
    }
    cur = nxt; cA = nA; cB = nB; hA = nhA; hB = nhB;
#pragma unroll
    for (int i = 0; i < 2; ++i) { vA[i] = nvA[i]; vB[i] = nvB[i]; }
    ++ui;
  }
  PG8_WAIT_V(0);
  if (wr == 0) PG8_BAR;
  PG8_BAR;
#undef PG8_SA
#undef PG8_SB
#undef PG8_STAGE
#undef PG8_LDA
#undef PG8_LDB
#undef PG8_MMA
#undef PG8_WAIT_V
#undef PG8_WAIT_L
#undef PG8_BAR
#undef PG8_SCHED
}
struct PlainSched {
  const char* A; const char* B; unsigned lda2, ldb2; int nt, nM, nN, G, c; int lat_only = 0;
  DI bool next(int i, UDesc& u) const {
    int pm, pn; if (!tile_order((long)i * G + c, lat_only ? nM - NB : nM, nN, pm, pn)) return false;
    if (lat_only) pm = pm + (pm >> 3) + 1;
    u.A = A + (size_t)pm * 256 * lda2; u.B = B + (size_t)pn * 256 * ldb2; u.lda2 = lda2; u.ldb2 = ldb2; u.nt = nt; u.pm = pm; u.pn = pn; u.tag = 0; return true;
  }
};
}

DI uint4 pk8(const f32x4& a, const f32x4& b) {
  uint4 q; q.x = pack2(a[0], a[1]); q.y = pack2(a[2], a[3]); q.z = pack2(b[0], b[1]); q.w = pack2(b[2], b[3]); return q;
}

__device__ void phase_prep(const Params& p, char* lds) {
  const int tid = otid(), nthr = gridDim.x * NTHR, gt = blockIdx.x * NTHR + tid;
  {
    const float4* s = (const float4*)p.x; uint2* d = (uint2*)(p.ws + OFF_XL);
    const size_t n = (size_t)NBATCH * SEQ * DM / 4;
    for (size_t i = gt; i < n; i += nthr) { const float4 v = s[i]; uint2 o; o.x = pack2(v.x, v.y); o.y = pack2(v.z, v.w); d[i] = o; }
    const float4* s2 = (const float4*)p.ctx; uint2* d2 = (uint2*)(p.ws + OFF_XC);
    const size_t n2 = (size_t)NBATCH * CTXL * DM / 4;
    for (size_t i = gt; i < n2; i += nthr) { const float4 v = s2[i]; uint2 o; o.x = pack2(v.x, v.y); o.y = pack2(v.z, v.w); d2[i] = o; }
  }
  if (gt < 1024) {
    float v[DEPTH], mx = -1e30f;
    for (int l = 0; l < DEPTH; ++l) { v[l] = p.lblog[l * 1024 + gt]; mx = fmaxf(mx, v[l]); }
    float sum = 0.f;
    for (int l = 0; l < DEPTH; ++l) { v[l] = expf(v[l] - mx); sum += v[l]; }
    float* lb = (float*)(p.ws + OFF_LB);
    float run = 0.f;
    for (int l = 0; l < DEPTH; ++l) { lb[l * 1024 + gt] = run; if (l + 1 < DEPTH) run += v[l + 1] / sum; }
  }
  if (gt >= 1024 && gt < 2048) {
    int i = gt - 1024, pos = i >> 4, fi = i & 15;
    float inv = powf(10000.f, -(float)fi / 16.f);
    float ang = (float)pos * inv;
    float* rc = (float*)(p.ws + OFF_ROPE);
    rc[i] = cosf(ang); rc[1024 + i] = sinf(ang);
  }
  float* ssm = (float*)lds;
  float* red = (float*)lds + 2 * 33 * 32;
  for (int item = blockIdx.x; item < DEPTH * 24; item += gridDim.x) {
    const int l = item / 24, kh = tid >> 8, tl = tid & 255, j = (item % 24) * 256 + tl;
    float acc[33];
#pragma unroll
    for (int r = 0; r < 33; ++r) acc[r] = 0.f;
    const float* W = p.w_ada + (size_t)l * DM * 6144;
    for (int k0 = kh * 512; k0 < kh * 512 + 512; k0 += 32) {
      __syncthreads();
      for (int idx = tl; idx < 33 * 32; idx += 256) {
        int rr = idx >> 5, kk = idx & 31;
        float cv = rr < 32 ? p.c[rr * DM + k0 + kk] : p.c_ctx[k0 + kk];
        ssm[kh * 33 * 32 + idx] = cv / (1.f + expf(-cv));
      }
      __syncthreads();
#pragma unroll 16
      for (int kk = 0; kk < 32; ++kk) {
        float w = W[(size_t)(k0 + kk) * 6144 + j];
#pragma unroll
        for (int r = 0; r < 33; ++r) acc[r] += ssm[kh * 33 * 32 + r * 32 + kk] * w;
      }
    }
    __syncthreads();
    if (kh == 1) {
#pragma unroll
      for (int r = 0; r < 33; ++r) red[r * 256 + tl] = acc[r];
    }
    __syncthreads();
    if (kh == 0) {
      float bb = p.b_ada[l * 6144 + j];
      float* mod = (float*)(p.ws + OFF_MOD) + (size_t)l * 33 * 6144;
#pragma unroll
      for (int r = 0; r < 33; ++r) mod[r * 6144 + j] = acc[r] + red[r * 256 + tl] + bb;
    }
  }
  __syncthreads();
}

DI u16* wdst(char* wb, int type, int sub, int n) {
  switch (type) {
    case 0: return n < NPC ? (u16*)(wb + OFF_WINT) + (size_t)n * 1024 : (u16*)(wb + OFF_WGT) + (size_t)(n - NPC) * 1024;
    case 1: return (u16*)(wb + OFF_WBT) + ((size_t)sub * 1024 + n) * 512;
    case 2: return (u16*)(wb + OFF_WOT) + (size_t)n * 1024;
    case 3: return (u16*)(wb + OFF_W1T) + (size_t)n * 1024;
    case 4: return (u16*)(wb + OFF_W2T) + (size_t)n * 4096;
    case 5: return (u16*)(wb + OFF_WUQ) + (size_t)n * 256;
    case 6: return (u16*)(wb + OFF_WUK) + (size_t)n * 128;
    default: return (u16*)(wb + OFF_WUV) + (size_t)n * 128;
  }
}
__device__ void phase_wconv(const Params& p, int l, char* lds, int* cnt = nullptr) {
  char* wb = wsel(p, l);
  int* s_item = (int*)(lds + LDS_BYTES - 16);
  float* tile = (float*)lds;
  const int tid = otid();
  {
    unsigned* z = (unsigned*)((u16*)(wb + OFF_WINT) + (size_t)NPC * 1024);
    for (int i = blockIdx.x * NTHR + tid; i < (PS - NPC) * 1024 / 2; i += gridDim.x * NTHR) z[i] = 0u;
  }
  constexpr int T0 = 16 * 148, T1 = T0 + 4 * 128, T2 = T1 + 256, T3 = T2 + 1024, T4 = T3 + 1024, T5 = T4 + 48, T6 = T5 + 16, T7 = T6 + 16;
  for (int itk = 0;; ++itk) {
    int it;
    if (cnt) { __syncthreads(); if (tid == 0) *s_item = atomicAdd(cnt, 1); __syncthreads(); it = *s_item; }
    else it = blockIdx.x + itk * gridDim.x;
    if (it >= T7) break;
    int type, sub = 0, K, N, kt, nt;
    const float* src;
    if (it < T0) { type = 0; K = 1024; N = INW; int q = it; kt = q / 148; nt = q % 148; src = p.w_in + (size_t)l * 1024 * INW; }
    else if (it < T1) { type = 1; K = 512; N = 1024; int q = it - T0; sub = q / 128; q %= 128; kt = q / 16; nt = q % 16; src = p.wbr + ((size_t)l * 4 + sub) * 512 * 1024; }
    else if (it < T2) { type = 2; K = 1024; N = 1024; int q = it - T1; kt = q / 16; nt = q % 16; src = p.wout + (size_t)l * 1024 * 1024; }
    else if (it < T3) { type = 3; K = 1024; N = 4096; int q = it - T2; kt = q / 64; nt = q % 64; src = p.wff1 + (size_t)l * 1024 * 4096; }
    else if (it < T4) { type = 4; K = 4096; N = 1024; int q = it - T3; kt = q / 16; nt = q % 16; src = p.wff2 + (size_t)l * 4096 * 1024; }
    else if (it < T5) { type = 5; K = 256; N = 768; int q = it - T4; kt = q / 12; nt = q % 12; src = p.wuq + (size_t)l * 256 * 768; }
    else if (it < T6) { type = 6; K = 128; N = 512; int q = it - T5; kt = q / 8; nt = q % 8; src = p.wuk + (size_t)l * 128 * 512; }
    else { type = 7; K = 128; N = 512; int q = it - T6; kt = q / 8; nt = q % 8; src = p.wuv + (size_t)l * 128 * 512; }
    (void)K;
    const int k0 = kt * 64, n0 = nt * 64;
    __syncthreads();
    {
      const int nn = tid & 63, ks = tid >> 6;
#pragma unroll 4
      for (int j = 0; j < 8; ++j) {
        int k = ks + 8 * j;
        tile[k * 65 + nn] = (n0 + nn < N) ? src[(size_t)(k0 + k) * N + n0 + nn] : 0.f;
      }
    }
    __syncthreads();
    {
      const int kp = tid & 31, nn = tid >> 5;
#pragma unroll 4
      for (int j = 0; j < 4; ++j) {
        int n = nn + 16 * j;
        if (n0 + n < N) {
          unsigned v = pack2(tile[(2 * kp) * 65 + n], tile[(2 * kp + 1) * 65 + n]);
          *(unsigned*)(wdst(wb, type, sub, n0 + n) + k0 + 2 * kp) = v;
        }
      }
    }
  }
  __syncthreads();
}

DI void norm_token(const Params& p, int l, int g, int which, int tok, int lane, const float* gn, const float* mod, u16* H) {
  int mr; const u16* xr = xrow_ptr(p, g, tok, mr);
  const float* shift = mod + (size_t)mr * 6144 + (which == 0 ? 0 : 3) * DM;
  const float* scale = shift + DM;
  float4 v[4]; float ss = 0.f;
#pragma unroll
  for (int j = 0; j < 4; ++j) {
    const uint2 q = *(const uint2*)(xr + j * 256 + lane * 4);
    v[j].x = __uint_as_float(q.x << 16); v[j].y = __uint_as_float(q.x & 0xffff0000u); v[j].z = __uint_as_float(q.y << 16); v[j].w = __uint_as_float(q.y & 0xffff0000u);
    ss += v[j].x * v[j].x + v[j].y * v[j].y + v[j].z * v[j].z + v[j].w * v[j].w;
  }
  ss = wave_sum(ss);
  const float rstd = rsqrtf(ss * (1.f / DM) + EPS);
#pragma unroll
  for (int j = 0; j < 4; ++j) {
    int c = j * 256 + lane * 4;
    float4 gg = *(const float4*)(gn + c), sh = *(const float4*)(shift + c), sc = *(const float4*)(scale + c);
    float o0 = v[j].x * rstd * gg.x * (1.f + sc.x) + sh.x;
    float o1 = v[j].y * rstd * gg.y * (1.f + sc.y) + sh.y;
    float o2 = v[j].z * rstd * gg.z * (1.f + sc.z) + sh.z;
    float o3 = v[j].w * rstd * gg.w * (1.f + sc.w) + sh.w;
    uint2 o; o.x = pack2(o0, o1); o.y = pack2(o2, o3);
    *(uint2*)(H + (size_t)tok * DM + c) = o;
  }
}
DI void norm_load(const u16* xr, int lane, uint2 (&q)[4]) {
#pragma unroll
  for (int j = 0; j < 4; ++j) q[j] = *(const uint2*)(xr + j * 256 + lane * 4);
}
DI void norm_mod_load(const float* shift, int lane, float4 (&shv)[4], float4 (&scv)[4]) {
#pragma unroll
  for (int j = 0; j < 4; ++j) { const int c = j * 256 + lane * 4; shv[j] = *(const float4*)(shift + c); scv[j] = *(const float4*)(shift + DM + c); }
}
DI void norm_finish2(const uint2 (&q)[4], int lane, const float4 (&ggv)[4], const float4 (&shv)[4], const float4 (&scv)[4], u16* hrow) {
  float4 v[4]; float ss = 0.f;
#pragma unroll
  for (int j = 0; j < 4; ++j) {
    v[j].x = __uint_as_float(q[j].x << 16); v[j].y = __uint_as_float(q[j].x & 0xffff0000u); v[j].z = __uint_as_float(q[j].y << 16); v[j].w = __uint_as_float(q[j].y & 0xffff0000u);
    ss += v[j].x * v[j].x + v[j].y * v[j].y + v[j].z * v[j].z + v[j].w * v[j].w;
  }
  ss = wave_sum(ss);
  const float rstd = rsqrtf(ss * (1.f / DM) + EPS);
#pragma unroll
  for (int j = 0; j < 4; ++j) {
    const int c = j * 256 + lane * 4;
    const float4 gg = ggv[j], sh = shv[j], sc = scv[j];
    float o0 = v[j].x * rstd * gg.x * (1.f + sc.x) + sh.x;
    float o1 = v[j].y * rstd * gg.y * (1.f + sc.y) + sh.y;
    float o2 = v[j].z * rstd * gg.z * (1.f + sc.z) + sh.z;
    float o3 = v[j].w * rstd * gg.w * (1.f + sc.w) + sh.w;
    uint2 o; o.x = pack2(o0, o1); o.y = pack2(o2, o3);
    *(uint2*)(hrow + c) = o;
  }
}
DI void norm_finish(const uint2 (&q)[4], int lane, const float* gn, const float* shift, u16* hrow) {
  float4 ggv[4], shv[4], scv[4];
#pragma unroll
  for (int j = 0; j < 4; ++j) ggv[j] = *(const float4*)(gn + j * 256 + lane * 4);
  norm_mod_load(shift, lane, shv, scv);
  norm_finish2(q, lane, ggv, shv, scv, hrow);
}
__device__ void phase_norm(const Params& p, int l, int g, int which) {
  const int tid = otid(), lane = tid & 63, wid = tid >> 6;
  const float* gn = (which == 0 ? p.g1 : p.g2) + l * DM;
  const float* mod = (const float*)(p.ws + OFF_MOD) + (size_t)l * 33 * 6144;
  u16* H = (u16*)(p.ws + OFF_H);
  const int stride = gridDim.x * 8;
  float4 ggh[4];
#pragma unroll
  for (int j = 0; j < 4; ++j) ggh[j] = *(const float4*)(gn + j * 256 + lane * 4);
  const bool skipc = which == 1 && l == DEPTH - 1;
  for (int tok = blockIdx.x * 8 + wid; tok < NTOK; tok += 2 * stride) {
    const int tokB = tok + stride;
    const bool doA = !(skipc && (tok % TPB) < CTXL), doB = tokB < NTOK && !(skipc && (tokB % TPB) < CTXL);
    int mrA = 0, mrB = 0;
    const u16* xa = xrow_ptr(p, g, tok, mrA);
    const u16* xb = xrow_ptr(p, g, doB ? tokB : tok, mrB);
    uint2 qa[4], qb[4];
    float4 shA[4], scA[4], shB[4], scB[4];
    norm_load(xa, lane, qa);
    norm_load(xb, lane, qb);
    norm_mod_load(mod + (size_t)mrA * 6144 + (which == 0 ? 0 : 3) * DM, lane, shA, scA);
    norm_mod_load(mod + (size_t)mrB * 6144 + (which == 0 ? 0 : 3) * DM, lane, shB, scB);
    if (doA) norm_finish2(qa, lane, ggh, shA, scA, H + (size_t)tok * DM);
    if (doB) norm_finish2(qb, lane, ggh, shB, scB, H + (size_t)tokB * DM);
  }
}
__device__ void phase_norm_dyn(const Params& p, int l, int g, int* cnt) {
  const int tid = otid(), lane = tid & 63;
  const float* gn = p.g1 + l * DM;
  const float* mod = (const float*)(p.ws + OFF_MOD) + (size_t)l * 33 * 6144;
  u16* H = (u16*)(p.ws + OFF_H);
  for (;;) {
    int c = 0;
    if (lane == 0) c = atomicAdd(cnt, 1);
    c = __shfl(c, 0);
    if (c >= NTOK / 8) break;
#pragma unroll 1
    for (int t = 0; t < 8; t += 2) {
      const int tokA = c * 8 + t, tokB = tokA + 1;
      int mrA = 0, mrB = 0;
      const u16* xa = xrow_ptr(p, g, tokA, mrA);
      const u16* xb = xrow_ptr(p, g, tokB, mrB);
      uint2 qa[4], qb[4];
      norm_load(xa, lane, qa);
      norm_load(xb, lane, qb);
      norm_finish(qa, lane, gn, mod + (size_t)mrA * 6144, H + (size_t)tokA * DM);
      norm_finish(qb, lane, gn, mod + (size_t)mrB * 6144, H + (size_t)tokB * DM);
    }
  }
}

__device__ void phase_tokprep(const Params& p, int l) {
  const int tid = otid(), lane = tid & 63, wid = tid >> 6;
  u16* P = (u16*)(p.ws + OFF_P);
  u16* KQ = (u16*)(p.ws + OFF_KQ);
  u16* Kd = (u16*)(p.ws + OFF_KD);
  const float* rc = (const float*)(p.ws + OFF_ROPE);
  const float* rs = rc + 1024;
  const int c8 = lane & 7;
  const bool isk_ = lane < 32;
  float cwv[24], gqv[8], gkv[8], gmv[8];
  {
    const float* cw = p.convw + ((size_t)l * 2 + (isk_ ? 1 : 0)) * 3 * 256 + (isk_ ? lane : lane - 32) * 8;
#pragma unroll
    for (int e = 0; e < 8; ++e) { cwv[e] = cw[e]; cwv[8 + e] = cw[256 + e]; cwv[16 + e] = cw[512 + e]; }
    const float* gq = p.gqn + l * 64 + c8 * 8; const float* gk = p.gkn + l * 64 + c8 * 8;
    const float* gm = lane < 16 ? p.mkvn + l * 128 + lane * 8 : p.mqn + l * 256 + ((lane >= 32 ? lane - 32 : 0)) * 8;
#pragma unroll
    for (int e = 0; e < 8; ++e) { gqv[e] = gq[e]; gkv[e] = gk[e]; gmv[e] = gm[e]; }
  }
  const uint4 zz = {0u, 0u, 0u, 0u};
  const int convcol = (isk_ ? B_K : B_Q) + (isk_ ? lane : lane - 32) * 8;
  const int mcol = lane < 16 ? D_CKV + lane * 8 : (lane >= 32 ? D_CQ + (lane - 32) * 8 : D_KR + ((lane - 16) & 7) * 8);
  uint4 n_q = zz, n_k = zz, n_m = zz, n_c0 = zz, n_c1 = zz, n_c2 = zz;
#define TOKPREP_LOAD(tok_) do { const int pp_ = (tok_) % TPB; const u16* row_ = P + (size_t)(tok_) * PS; \
    n_q = *(const uint4*)(row_ + C_Q + lane * 8); n_k = lane < 16 ? *(const uint4*)(row_ + C_K + lane * 8) : zz; n_m = *(const uint4*)(row_ + mcol); \
    n_c1 = *(const uint4*)(row_ + convcol); \
    n_c0 = !(pp_ == 0 || pp_ == CTXL) ? *(const uint4*)(row_ - PS + convcol) : zz; \
    n_c2 = !(pp_ == CTXL - 1 || pp_ == TPB - 1) ? *(const uint4*)(row_ + PS + convcol) : zz; } while (0)
  const int tstride = gridDim.x * 8;
  if (blockIdx.x * 8 + wid < NTOK) TOKPREP_LOAD(blockIdx.x * 8 + wid);
  for (int tok = blockIdx.x * 8 + wid; tok < NTOK; tok += tstride) {
    const int pp = tok % TPB;
    const bool lat = pp >= CTXL;
    const int pos = pp - CTXL, prow = pos >> 6, pcol = pos & 63;
    u16* row = P + (size_t)tok * PS;
    const uint4 pl_q = n_q, pl_k = n_k, pl_m = n_m, pl_c0 = n_c0, pl_c1 = n_c1, pl_c2 = n_c2;
    if (tok + tstride < NTOK) TOKPREP_LOAD(tok + tstride);
    float csv[8], snv[8];
    {
      const int ppos0 = (c8 & 4) ? pcol : prow;
      if (lat) {
        const float4 c0 = *(const float4*)(rc + ppos0 * 16 + (c8 & 1) * 8), c1 = *(const float4*)(rc + ppos0 * 16 + (c8 & 1) * 8 + 4);
        const float4 s0 = *(const float4*)(rs + ppos0 * 16 + (c8 & 1) * 8), s1 = *(const float4*)(rs + ppos0 * 16 + (c8 & 1) * 8 + 4);
        csv[0] = c0.x; csv[1] = c0.y; csv[2] = c0.z; csv[3] = c0.w; csv[4] = c1.x; csv[5] = c1.y; csv[6] = c1.z; csv[7] = c1.w;
        snv[0] = s0.x; snv[1] = s0.y; snv[2] = s0.z; snv[3] = s0.w; snv[4] = s1.x; snv[5] = s1.y; snv[6] = s1.z; snv[7] = s1.w;
      } else {
#pragma unroll
        for (int e = 0; e < 8; ++e) { csv[e] = 1.f; snv[e] = 0.f; }
      }
    }
    {
      const bool isk = lane < 32;
      const int cc = (isk ? lane : lane - 32) * 8;
      float x0[8], x1[8], x2[8];
      unpack8(pl_c1, x1); unpack8(pl_c0, x0); unpack8(pl_c2, x2);
      float o[8];
#pragma unroll
      for (int e = 0; e < 8; ++e) {
        float a = cwv[e] * x0[e] + cwv[8 + e] * x1[e] + cwv[16 + e] * x2[e];
        a = siluf_(a);
        o[e] = isk ? a * 0.125f : a;
      }
      *(uint4*)(KQ + (size_t)tok * 512 + (isk ? 0 : 256) + cc) = pack8f(o);
    }
#pragma unroll
    for (int pass = 0; pass < 2; ++pass) {
      const bool act = pass == 0 || lane < 16;
      const int colb = (pass == 0 ? C_Q : C_K) + lane * 8;
      float x[8];
      unpack8(pass == 0 ? pl_q : pl_k, x);
      float ss = 0.f;
#pragma unroll
      for (int e = 0; e < 8; ++e) ss += x[e] * x[e];
      ss += __shfl_xor(ss, 1); ss += __shfl_xor(ss, 2); ss += __shfl_xor(ss, 4);
      const float rstd = rsqrtf(ss * (1.f / 64.f) + EPS);
#pragma unroll
      for (int e = 0; e < 8; ++e) x[e] = x[e] * rstd * (pass == 0 ? gqv[e] : gkv[e]);
      float o[8];
#pragma unroll
      for (int e = 0; e < 8; ++e) {
        float other = __shfl_xor(x[e], 2);
        const float cs = csv[e], sn = snv[e];
        o[e] = (c8 & 2) ? (x[e] * cs + other * sn) : (x[e] * cs - other * sn);
      }
      if (act) *(uint4*)(row + colb) = pack8f(o);
    }
    {
      const bool isckv = lane < 16, iscq = lane >= 32, iskr = lane >= 16 && lane < 24;
      int colb = isckv ? D_CKV + lane * 8 : (iscq ? D_CQ + (lane - 32) * 8 : D_KR + ((lane - 16) & 7) * 8);
      float x[8];
      unpack8(pl_m, x);
      float ss = 0.f;
#pragma unroll
      for (int e = 0; e < 8; ++e) ss += x[e] * x[e];
      ss += __shfl_xor(ss, 1); ss += __shfl_xor(ss, 2); ss += __shfl_xor(ss, 4); ss += __shfl_xor(ss, 8);
      float ss32 = ss + __shfl_xor(ss, 16);
      float o[8];
      if (isckv) {
        const float rstd = rsqrtf(ss * (1.f / 128.f) + EPS);
        for (int e = 0; e < 8; ++e) o[e] = x[e] * rstd * gmv[e];
      } else if (iscq) {
        const float rstd = rsqrtf(ss32 * (1.f / 256.f) + EPS);
        for (int e = 0; e < 8; ++e) o[e] = x[e] * rstd * gmv[e];
      } else {
        for (int e = 0; e < 8; ++e) o[e] = x[e];
      }
      float orot[8];
#pragma unroll
      for (int e = 0; e < 8; ++e) {
        float other = __shfl_xor(x[e], 2);
        const int ck = lane & 7;
        const float cs = csv[e], sn = snv[e];
        orot[e] = (ck & 2) ? (x[e] * cs + other * sn) : (x[e] * cs - other * sn);
      }
      if (isckv || iscq) *(uint4*)(row + colb) = pack8f(o);
      if (iskr) {
        uint4 q = pack8f(orot);
        const int ck = lane & 7;
#pragma unroll
        for (int hd = 0; hd < 4; ++hd) *(uint4*)(Kd + (size_t)tok * 768 + hd * 192 + 128 + ck * 8) = q;
      }
    }
  }
#undef TOKPREP_LOAD
}

template <int DK, int DV, bool ROPEQ>
__device__ void attn_item(const u16* __restrict__ qrow, const u16* __restrict__ Kp, int kst, const u16* __restrict__ Vp, int vst,
                          u16* __restrict__ orow, int nkeys, float sc, int pos, const float* __restrict__ rc, char* lds) {
  constexpr int KLD = DK + 8, VLD = DV + 32;
  constexpr int KB = 64 * KLD, VB = 64 * VLD;
  u16* KS = (u16*)lds;
  u16* VS = KS + 2 * KB;
  const int tid = otid(), lane = tid & 63, r = lane & 31, h = lane >> 5;
  bf16x8 qf[DK / 16];
  {
#pragma unroll
    for (int s = 0; s < DK / 16; ++s) qf[s] = *(const bf16x8*)(qrow + h * 8 + s * 16);
    if (ROPEQ && pos >= 0) {
      const int prow = pos >> 6, pcol = pos & 63;
      const float* rs = rc + 1024;
      constexpr int s0 = (DK - 64) / 16;
#pragma unroll
      for (int part = 0; part < 2; ++part) {
        const int ppos = part ? pcol : prow;
#pragma unroll
        for (int j = 0; j < 8; ++j) {
          const int fi = 8 * h + j;
          float cs = rc[ppos * 16 + fi], sn = rs[ppos * 16 + fi];
          float x1 = bf2f((u16)qf[s0 + 2 * part][j]), x2 = bf2f((u16)qf[s0 + 2 * part + 1][j]);
          qf[s0 + 2 * part][j] = (short)f2bf(x1 * cs - x2 * sn);
          qf[s0 + 2 * part + 1][j] = (short)f2bf(x2 * cs + x1 * sn);
        }
      }
    }
  }
  f32x16 oT[DV / 32];
#pragma unroll
  for (int d = 0; d < DV / 32; ++d)
#pragma unroll
    for (int e = 0; e < 16; ++e) oT[d][e] = 0.f;
  float m = -1e30f, lsum = 0.f;
  const int ntile = nkeys >> 6;
  constexpr int NKP = KB * 2 / 1024, NVP = VB * 2 / 1024, NKJ = (NKP + 7) / 8, NVJ = (NVP + 7) / 8;
  const int wu = __builtin_amdgcn_readfirstlane(tid >> 6);
  unsigned ksrc[NKJ], vsrc[NVJ];
#pragma unroll
  for (int j = 0; j < NKJ; ++j) { const int o = (wu + 8 * j) * 1024 + lane * 16, row = o / (KLD * 2), col = (o % (KLD * 2)) / 2; ksrc[j] = (unsigned)(row * kst + (col < DK ? col : 0)) * 2u; }
#pragma unroll
  for (int j = 0; j < NVJ; ++j) { const int o = (wu + 8 * j) * 1024 + lane * 16, row = o / (VLD * 2), col = (o % (VLD * 2)) / 2; vsrc[j] = (unsigned)(row * vst + (col < DV ? col : 0)) * 2u; }
#define ATT_DMA(kt_, buf_) do { \
    const char* kg_ = (const char*)Kp + (size_t)(kt_) * 64 * kst * 2; const char* vg_ = (const char*)Vp + (size_t)(kt_) * 64 * vst * 2; \
    _Pragma("unroll") for (int j = 0; j < NKJ; ++j) if (wu + 8 * j < NKP) \
      __builtin_amdgcn_global_load_lds((const unsigned*)(kg_ + ksrc[j]), (LAS unsigned*)((char*)KS + (buf_) * KB * 2 + (wu + 8 * j) * 1024), 16, 0, 0); \
    _Pragma("unroll") for (int j = 0; j < NVJ; ++j) if (wu + 8 * j < NVP) \
      __builtin_amdgcn_global_load_lds((const unsigned*)(vg_ + vsrc[j]), (LAS unsigned*)((char*)VS + (buf_) * VB * 2 + (wu + 8 * j) * 1024), 16, 0, 0); \
  } while (0)
  __syncthreads();
  ATT_DMA(0, 0);
  asm volatile("s_waitcnt vmcnt(0)" ::: "memory");
  __syncthreads();
  const int troff = ((lane & 15) >> 2) * VLD + 16 * ((lane >> 4) & 1) + 4 * (lane & 3) + 4 * h * VLD;
#pragma unroll 1
  for (int kt = 0; kt < ntile; ++kt) {
    const int buf = kt & 1;
    if (kt + 1 < ntile) ATT_DMA(kt + 1, buf ^ 1);
    const u16* KSb = KS + buf * KB;
    const u16* VSb = VS + buf * VB;
    f32x16 sT[2];
#pragma unroll
    for (int kk = 0; kk < 2; ++kk) {
#pragma unroll
      for (int e = 0; e < 16; ++e) sT[kk][e] = 0.f;
#pragma unroll
      for (int s = 0; s < DK / 16; ++s) {
        bf16x8 a = *(const bf16x8*)(KSb + (kk * 32 + r) * KLD + s * 16 + h * 8);
        sT[kk] = MFMA(a, qf[s], sT[kk]);
      }
    }
    float mx = -1e30f;
#pragma unroll
    for (int kk = 0; kk < 2; ++kk)
#pragma unroll
      for (int e = 0; e < 16; ++e) mx = fmaxf(mx, sT[kk][e]);
    mx = fmaxf(mx, __shfl_xor(mx, 32));
    const float mn = fmaxf(m, mx * sc);
    const float alpha = ex2(m - mn);
    m = mn;
    lsum *= alpha;
#pragma unroll
    for (int kk = 0; kk < 2; ++kk) {
      sT[kk] = sT[kk] * sc - mn;
#pragma unroll
      for (int e = 0; e < 16; ++e) sT[kk][e] = ex2(sT[kk][e]);
    }
    {
      f32x16 t16 = sT[0] + sT[1];
      typedef float f32x8v __attribute__((ext_vector_type(8)));
      typedef float f32x4v __attribute__((ext_vector_type(4)));
      f32x8v t8 = __builtin_shufflevector(t16, t16, 0, 1, 2, 3, 4, 5, 6, 7) + __builtin_shufflevector(t16, t16, 8, 9, 10, 11, 12, 13, 14, 15);
      f32x4v t4 = __builtin_shufflevector(t8, t8, 0, 1, 2, 3) + __builtin_shufflevector(t8, t8, 4, 5, 6, 7);
      lsum += (t4[0] + t4[1]) + (t4[2] + t4[3]);
    }
#pragma unroll
    for (int d = 0; d < DV / 32; ++d) oT[d] = oT[d] * alpha;
#pragma unroll
    for (int kk = 0; kk < 2; ++kk)
#pragma unroll
      for (int s2 = 0; s2 < 2; ++s2) {
        bf16x8 pb = pack8(sT[kk], s2);
#pragma unroll
        for (int d = 0; d < DV / 32; ++d) {
          const u16* vb = VSb + (kk * 32 + s2 * 16) * VLD + d * 32 + troff;
          s16x4 lo = __builtin_amdgcn_ds_read_tr16_b64_v4i16((LAS s16x4*)vb);
          s16x4 hi = __builtin_amdgcn_ds_read_tr16_b64_v4i16((LAS s16x4*)(vb + 8 * VLD));
          oT[d] = MFMA(cat4(lo, hi), pb, oT[d]);
        }
      }
    asm volatile("s_waitcnt vmcnt(0)" ::: "memory");
    __syncthreads();
  }
#undef ATT_DMA
  lsum += __shfl_xor(lsum, 32);
  const float inv = 1.f / lsum;
#pragma unroll
  for (int d = 0; d < DV / 32; ++d)
#pragma unroll
    for (int gq = 0; gq < 4; ++gq) {
      uint2 o;
      o.x = pack2(oT[d][4 * gq] * inv, oT[d][4 * gq + 1] * inv);
      o.y = pack2(oT[d][4 * gq + 2] * inv, oT[d][4 * gq + 3] * inv);
      *(uint2*)(orow + d * 32 + 8 * gq + 4 * h) = o;
    }
}

DI void lds_ld8(const float* p, float* o) {
  const float4 a = *(const float4*)p, b = *(const float4*)(p + 4);
  o[0] = a.x; o[1] = a.y; o[2] = a.z; o[3] = a.w; o[4] = b.x; o[5] = b.y; o[6] = b.z; o[7] = b.w;
}
__device__ void scanA_unit(const Params& p, int l, int unit, char* lds) {
  const int tid = otid(), lane = tid & 63, wid = tid >> 6, r = lane & 31, h = lane >> 5;
  const int bl = unit >> 3, hd = (unit >> 1) & 3, dir = unit & 1;
  const u16* P = (const u16*)(p.ws + OFF_P);
  u16* Oa = (u16*)(p.ws + OFF_OA) + (size_t)dir * NTOK * 512;
  float* BC = (float*)lds;
  u16* Qs = (u16*)(lds + 33792);
  u16* KKs = (u16*)(lds + 51200);
  u16* AM = (u16*)(lds + 51200);
  u16* KT = (u16*)(lds + 68608);
  u16* VT = (u16*)(lds + 87040);
  u16* ST = (u16*)(lds + 105472);
  float* EL = (float*)(lds + 140288);
  float* QTOT = (float*)(lds + 140800);
  const int ch = tid & 15;
  float lbv[8];
  {
    const float* lb = (const float*)(p.ws + OFF_LB) + (size_t)l * 1024 + dir * 512 + hd * 128 + ch * 8;
#pragma unroll
    for (int e = 0; e < 8; ++e) lbv[e] = lb[e];
  }
  const int vt = wid & 3, th = wid >> 2;
  f32x16 S[2];
#pragma unroll
  for (int j = 0; j < 2; ++j)
#pragma unroll
    for (int e = 0; e < 16; ++e) S[j][e] = 0.f;
  __syncthreads();
  for (int i = tid; i < 128 * 136 / 2; i += NTHR) ((unsigned*)ST)[i] = 0u;
  uint4 pqr[2], pfr[2], pvr[2];
#define SCANA_TOK0(st_) (bl * TPB + ((st_) >= 4 ? CTXL : 0) + (dir ? ((st_) >= 4 ? 31 - ((st_) - 4) : 3 - (st_)) : ((st_) >= 4 ? (st_) - 4 : (st_))) * 64)
#define SCANA_PREFETCH(st_) do { const int t0_ = SCANA_TOK0(st_); \
    _Pragma("unroll") for (int j = 0; j < 2; ++j) { const int i = (tid >> 4) + 32 * j; \
      const u16* row = P + (size_t)(t0_ + (dir ? 63 - i : i)) * PS + hd * 128 + ch * 8; \
      pqr[j] = *(const uint4*)(row + A_Q); pfr[j] = *(const uint4*)(row + (dir ? A_FB : A_FF)); pvr[j] = *(const uint4*)(row + A_I); } } while (0)
  SCANA_PREFETCH(0);
#pragma unroll 1
  for (int step = 0; step < 36; ++step) {
    const int tok0 = SCANA_TOK0(step);
    __syncthreads();
#pragma unroll
    for (int j = 0; j < 2; ++j) {
      const int i = (tid >> 4) + 32 * j;
      uint4 qraw = pqr[j];
      uint4 fraw = pfr[j];
      uint4 vq = pvr[j];
      float qv[8], fv[8], kkv[8], lfv[8];
      unpack8(qraw, qv); unpack8(fraw, fv);
#pragma unroll
      for (int e = 0; e < 8; ++e) {
        qv[e] = siluf_(qv[e]);
        const float ex = __expf(-fv[e]);
        const float rcp1 = __builtin_amdgcn_rcpf(1.f + ex);
        const float sg = rcp1;
        const float sgn = ex * rcp1;
        const float f = lbv[e] + (1.f - lbv[e]) * sg;
        kkv[e] = (1.f - lbv[e]) * (fv[e] > 30.f ? 0.f : (fv[e] < -30.f ? 1.f : sgn));
        lfv[e] = __log2f(fmaxf(f, 1e-37f));
      }
      *(float4*)(BC + i * 132 + ch * 8) = (float4){lfv[0], lfv[1], lfv[2], lfv[3]};
      *(float4*)(BC + i * 132 + ch * 8 + 4) = (float4){lfv[4], lfv[5], lfv[6], lfv[7]};
      *(uint4*)(Qs + i * 136 + ch * 8) = pack8f(qv);
      *(uint4*)(KKs + i * 136 + ch * 8) = pack8f(kkv);
      u16* dv = VT + (ch * 8) * 72 + ((((i >> 3) ^ (ch & 7)) << 3) | (i & 7));
      dv[0 * 72] = (u16)(vq.x & 0xffff); dv[1 * 72] = (u16)(vq.x >> 16); dv[2 * 72] = (u16)(vq.y & 0xffff); dv[3 * 72] = (u16)(vq.y >> 16);
      dv[4 * 72] = (u16)(vq.z & 0xffff); dv[5 * 72] = (u16)(vq.z >> 16); dv[6 * 72] = (u16)(vq.w & 0xffff); dv[7 * 72] = (u16)(vq.w >> 16);
    }
    __syncthreads();
    {
      const int k = tid & 127, qd = tid >> 7;
      float cv[16];
#pragma unroll
      for (int i = 0; i < 16; ++i) cv[i] = BC[(qd * 16 + i) * 132 + k];
      float run = 0.f;
#pragma unroll
      for (int i = 0; i < 16; ++i) { run += cv[i]; BC[(qd * 16 + i) * 132 + k] = run; }
      QTOT[qd * 128 + k] = run;
    }
    __syncthreads();
    {
      const int k = tid & 127, qd = tid >> 7;
      float off = 0.f;
      for (int q2 = 0; q2 < qd; ++q2) off += QTOT[q2 * 128 + k];
      if (qd > 0) {
        float cv[16];
#pragma unroll
        for (int i = 0; i < 16; ++i) cv[i] = BC[(qd * 16 + i) * 132 + k];
#pragma unroll
        for (int i = 0; i < 16; ++i) BC[(qd * 16 + i) * 132 + k] = cv[i] + off;
      }
    }
    __syncthreads();
    f32x4 cod[2];
#pragma unroll
    for (int jj = 0; jj < 2; ++jj) {
      cod[jj] = (f32x4){0.f, 0.f, 0.f, 0.f};
      const int job = wid + 8 * jj;
      if (job < 10) {
        const int bI = job < 1 ? 0 : (job < 3 ? 1 : (job < 6 ? 2 : 3));
        const int bJ = job - (bI * (bI + 1)) / 2;
        const int l16 = lane & 15, kg = lane >> 4;
        const int t = 16 * bI + l16, s = 16 * bJ + l16, rr = 16 * bI;
#pragma unroll
        for (int ks = 0; ks < 4; ++ks) {
          const int k0 = ks * 32 + kg * 8;
          float qv[8], kv[8];
          unpack8(*(const uint4*)(Qs + t * 136 + k0), qv);
          unpack8(*(const uint4*)(KKs + s * 136 + k0), kv);
          float brv[8], btv[8], bsv8[8];
          lds_ld8(BC + rr * 132 + k0, brv); lds_ld8(BC + t * 132 + k0, btv); lds_ld8(BC + s * 132 + k0, bsv8);
#pragma unroll
          for (int e = 0; e < 8; ++e) {
            qv[e] *= ex2(btv[e] - brv[e]);
            kv[e] *= ex2(fminf(brv[e] - bsv8[e], 120.f));
          }
          union { uint4 u; bf16x8 v; } ua, ub;
          ua.u = pack8f(qv); ub.u = pack8f(kv);
          cod[jj] = __builtin_amdgcn_mfma_f32_16x16x32_bf16(ua.v, ub.v, cod[jj], 0, 0, 0);
        }
      }
    }
    if (tid < 128) EL[tid] = ex2(BC[63 * 132 + tid]);
#pragma unroll
    for (int j = 0; j < 2; ++j) {
      const int i = (tid >> 4) + 32 * j;
      float kv[8];
      unpack8(*(const uint4*)(KKs + i * 136 + ch * 8), kv);
      u16* dk = KT + (ch * 8) * 72 + ((((i >> 3) ^ (ch & 7)) << 3) | (i & 7));
      float dv8[8];
      { float bl8[8], bi8[8]; lds_ld8(BC + 63 * 132 + ch * 8, bl8); lds_ld8(BC + i * 132 + ch * 8, bi8);
#pragma unroll
        for (int e = 0; e < 8; ++e) dv8[e] = bl8[e] - bi8[e]; }
#pragma unroll
      for (int e = 0; e < 8; ++e) dk[e * 72] = f2bf(kv[e] * ex2(dv8[e]));
    }
    __syncthreads();
#pragma unroll
    for (int j = 0; j < 2; ++j) {
      const int i = (tid >> 4) + 32 * j;
      float qv[8];
      unpack8(*(const uint4*)(Qs + i * 136 + ch * 8), qv);
      { float bi8[8]; lds_ld8(BC + i * 132 + ch * 8, bi8);
#pragma unroll
        for (int e = 0; e < 8; ++e) qv[e] *= ex2(bi8[e]); }
      *(uint4*)(Qs + i * 136 + ch * 8) = pack8f(qv);
    }
    for (int i = tid; i < 64 * 72 / 2; i += NTHR) ((unsigned*)AM)[i] = 0u;
    __syncthreads();
#pragma unroll
    for (int jj = 0; jj < 2; ++jj) {
      const int job = wid + 8 * jj;
      if (job < 10) {
        const int bI = job < 1 ? 0 : (job < 3 ? 1 : (job < 6 ? 2 : 3));
        const int bJ = job - (bI * (bI + 1)) / 2;
        const int l16 = lane & 15, kg = lane >> 4;
#pragma unroll
        for (int e = 0; e < 4; ++e) {
          const int tp = 4 * kg + e;
          const float v = (bJ < bI || l16 <= tp) ? cod[jj][e] : 0.f;
          AM[(16 * bI + tp) * 72 + 16 * bJ + l16] = f2bf(v);
        }
      }
    }
    __syncthreads();
    if (step + 1 < 36) SCANA_PREFETCH(step + 1);
    f32x16 o;
#pragma unroll
    for (int e = 0; e < 16; ++e) o[e] = 0.f;
#pragma unroll
    for (int ks = 0; ks < 8; ++ks) {
      bf16x8 a = *(const bf16x8*)(Qs + (th * 32 + r) * 136 + ks * 16 + h * 8);
      bf16x8 b = *(const bf16x8*)(ST + (vt * 32 + r) * 136 + ks * 16 + h * 8);
      o = MFMA(a, b, o);
    }
    bf16x8 bv[4];
#pragma unroll
    for (int ks = 0; ks < 4; ++ks) bv[ks] = *(const bf16x8*)(VT + (vt * 32 + r) * 72 + (((ks * 2 + h) ^ (((vt * 32 + r) >> 3) & 7)) << 3));
#pragma unroll
    for (int ks = 0; ks < 4; ++ks) {
      bf16x8 a = *(const bf16x8*)(AM + (th * 32 + r) * 72 + ks * 16 + h * 8);
      o = MFMA(a, bv[ks], o);
    }
    {
      u16* ob = Oa + (size_t)tok0 * 512 + hd * 128 + vt * 32 + r;
#pragma unroll
      for (int e = 0; e < 16; ++e) {
        const int i = th * 32 + crow(e, h);
        ob[(dir ? 63 - i : i) * 512] = f2bf(o[e]);
      }
    }
    __syncthreads();
#pragma unroll
    for (int j = 0; j < 2; ++j) {
      const int kt = 2 * th + j;
#pragma unroll
      for (int e = 0; e < 16; ++e) S[j][e] *= EL[kt * 32 + crow(e, h)];
#pragma unroll
      for (int ks = 0; ks < 4; ++ks) {
        bf16x8 a = *(const bf16x8*)(KT + (kt * 32 + r) * 72 + (((ks * 2 + h) ^ (((kt * 32 + r) >> 3) & 7)) << 3));
        S[j] = MFMA(a, bv[ks], S[j]);
      }
#pragma unroll
      for (int gq = 0; gq < 4; ++gq) {
        uint2 w;
        w.x = pack2(S[j][4 * gq], S[j][4 * gq + 1]); w.y = pack2(S[j][4 * gq + 2], S[j][4 * gq + 3]);
        *(uint2*)(ST + (vt * 32 + r) * 136 + kt * 32 + 8 * gq + 4 * h) = w;
      }
    }
  }
#undef SCANA_PREFETCH
#undef SCANA_TOK0
}

__device__ void scanB_unit(const Params& p, int l, int unit2, char* lds) {
  const int tid0 = otid(), vb = tid0 >> 8, tid = tid0 & 255, lane = tid & 63, wid = tid >> 6, r = lane & 31, h = lane >> 5;
  const int unit = unit2 * 2 + vb;
  lds += vb * LDSV;
  const int bl = unit >> 3, hd = (unit >> 1) & 3, dir = unit & 1;
  const u16* P = (const u16*)(p.ws + OFF_P);
  const u16* KQ = (const u16*)(p.ws + OFF_KQ);
  const float* Gb = (const float*)(p.ws + OFF_GB);
  u16* Ob = (u16*)(p.ws + OFF_OB) + (size_t)dir * NTOK * 512;
  u16* QB = (u16*)lds;
  u16* KB = (u16*)(lds + 9216);
  u16* SM = (u16*)(lds + 18432);
  u16* KWT = (u16*)(lds + 27648);
  u16* VT = (u16*)(lds + 36864);
  float* vec = (float*)(lds + 55296);
  float *IG = vec, *LF = vec + 64, *BV = vec + 128, *UV = vec + 192, *MT = vec + 256, *WI = vec + 320, *WK = vec + 384,
        *DEN = vec + 448, *NV = vec + 512  , *SC = vec + 640, *BL2 = vec + 704, *UL2 = vec + 768, *EMT = vec + 832;
  const float bI = p.bgate[l * 16 + (2 * dir) * 4 + hd], bF = p.bgate[l * 16 + (2 * dir + 1) * 4 + hd];
  f32x16 C[2];
#pragma unroll
  for (int ft = 0; ft < 2; ++ft)
#pragma unroll
    for (int e = 0; e < 16; ++e) C[ft][e] = 0.f;
  float m = -1e30f;
  __syncthreads();
  if (tid < 128) NV[tid] = 0.f;
  int cur = 0;
  uint4 pk0, pk1, pq0, pq1, pv0, pv1, pv2, pv3; float pgI = 0.f, pgF = 0.f;
#define SCANB_TOK0(st_) (bl * TPB + ((st_) >= 4 ? CTXL : 0) + (dir ? ((st_) >= 4 ? 31 - ((st_) - 4) : 3 - (st_)) : ((st_) >= 4 ? (st_) - 4 : (st_))) * 64)
#define SCANB_LDKQ(j, K_, Q_) do { const int id = tid + 256 * (j), i = id >> 3, c8 = id & 7; \
      const u16* row = KQ + (size_t)(t0_ + (dir ? 63 - i : i)) * 512 + hd * 64 + c8 * 8; K_ = *(const uint4*)(row); Q_ = *(const uint4*)(row + 256); } while (0)
#define SCANB_LDV(j, V_) do { const int id = tid + 256 * (j), i = id >> 4, c16 = id & 15; \
      V_ = *(const uint4*)(P + (size_t)(t0_ + (dir ? 63 - i : i)) * PS + B_V + hd * 128 + c16 * 8); } while (0)
#define SCANB_PREFETCH(st_) do { const int t0_ = SCANB_TOK0(st_); \
    SCANB_LDKQ(0, pk0, pq0); SCANB_LDKQ(1, pk1, pq1); SCANB_LDV(0, pv0); SCANB_LDV(1, pv1); SCANB_LDV(2, pv2); SCANB_LDV(3, pv3); \
    if (tid < 64) { const int tok = t0_ + (dir ? 63 - tid : tid); pgI = Gb[(size_t)tok * 16 + (2 * dir) * 4 + hd]; pgF = Gb[(size_t)tok * 16 + (2 * dir + 1) * 4 + hd]; } } while (0)
#define SCANB_STKQ(j, K_, Q_) do { const int id = tid + 256 * (j), i = id >> 3, c8 = id & 7; \
      *(uint4*)(KB + i * 72 + c8 * 8) = K_; *(uint4*)(QB + i * 72 + c8 * 8) = Q_; } while (0)
#define SCANB_STV(j, V_) do { const int id = tid + 256 * (j), i = id >> 4, c16 = id & 15; const uint4 vq = V_; u16* dv = VT + (c16 * 8) * 72 + ((((i >> 3) ^ (c16 & 7)) << 3) | (i & 7)); \
      dv[0 * 72] = (u16)(vq.x & 0xffff); dv[1 * 72] = (u16)(vq.x >> 16); dv[2 * 72] = (u16)(vq.y & 0xffff); dv[3 * 72] = (u16)(vq.y >> 16); \
      dv[4 * 72] = (u16)(vq.z & 0xffff); dv[5 * 72] = (u16)(vq.z >> 16); dv[6 * 72] = (u16)(vq.w & 0xffff); dv[7 * 72] = (u16)(vq.w >> 16); } while (0)
  SCANB_PREFETCH(0);
#pragma unroll 1
  for (int step = 0; step < 36; ++step) {
    const int tok0 = SCANB_TOK0(step);
    __syncthreads();
    SCANB_STKQ(0, pk0, pq0); SCANB_STKQ(1, pk1, pq1);
    SCANB_STV(0, pv0); SCANB_STV(1, pv1); SCANB_STV(2, pv2); SCANB_STV(3, pv3);
    if (tid < 64) {
      const int i = tid;
      const float gI = pgI + bI;
      const float gF = pgF + bF;
      const float lf = fminf(gF, 0.f) - log1pf(expf(-fabsf(gF)));
      float b = lf;
#pragma unroll
      for (int d = 1; d < 64; d <<= 1) { float t = __shfl_up(b, d); if (lane >= d) b += t; }
      const float u = gI - b;
      float pm = u;
#pragma unroll
      for (int d = 1; d < 64; d <<= 1) { float t = __shfl_up(pm, d); if (lane >= d) pm = fmaxf(pm, t); }
      const float mt = b + fmaxf(m, pm);
      const float wi = expf(b + m - mt);
      const float mnew = __shfl(mt, 63), b63 = __shfl(b, 63);
      const float dec = expf(b63 + m - mnew);
      const float wk = expf(b63 - b + gI - mnew);
      IG[i] = gI; LF[i] = lf; BV[i] = b; UV[i] = u; MT[i] = mt; WI[i] = wi; WK[i] = wk;
      BL2[i] = (b - mt) * LOG2E; UL2[i] = u * LOG2E; EMT[i] = expf(-mt);
      if (i == 0) { SC[0] = mnew; SC[1] = dec; }
    }
    __syncthreads();
    {
      const int tt = wid >> 1, st = wid & 1;
      f32x16 a16;
#pragma unroll
      for (int e = 0; e < 16; ++e) a16[e] = 0.f;
#pragma unroll
      for (int ks = 0; ks < 4; ++ks) {
        bf16x8 a = *(const bf16x8*)(QB + (tt * 32 + r) * 72 + ks * 16 + h * 8);
        bf16x8 b = *(const bf16x8*)(KB + (st * 32 + r) * 72 + ks * 16 + h * 8);
        a16 = MFMA(a, b, a16);
      }
      const int s = st * 32 + r;
      const float us = UL2[s];
      float blv[16];
#pragma unroll
      for (int e = 0; e < 16; ++e) blv[e] = BL2[tt * 32 + crow(e, h)];
#pragma unroll
      for (int e = 0; e < 16; ++e) {
        const int t = tt * 32 + crow(e, h);
        float v = 0.f;
        if (s <= t) v = a16[e] * ex2(blv[e] + us);
        SM[t * 72 + s] = f2bf(v);
      }
    }
#pragma unroll
    for (int j = 0; j < 2; ++j) {
      const int id = tid + 256 * j, i = id >> 3, c8 = id & 7;
      float kv[8];
      unpack8(*(const uint4*)(KB + i * 72 + c8 * 8), kv);
      const float wk = WK[i];
#pragma unroll
      for (int e = 0; e < 8; ++e) KWT[(c8 * 8 + e) * 72 + ((((i >> 3) ^ c8) << 3) | (i & 7))] = f2bf(kv[e] * wk);
    }
    __syncthreads();
    const float mnew = SC[0], dec = SC[1];
    {
      const int t = tid >> 2, part = tid & 3;
      float rsum = 0.f, qn = 0.f, ns = 0.f;
#pragma unroll
      for (int cc = 0; cc < 2; ++cc) {
        const int c8 = part * 2 + cc;
        float sv[8], qv[8], kv[8];
        unpack8(*(const uint4*)(SM + t * 72 + c8 * 8), sv);
        unpack8(*(const uint4*)(QB + t * 72 + c8 * 8), qv);
        unpack8(*(const uint4*)(KWT + t * 72 + c8 * 8), kv);
#pragma unroll
        for (int e = 0; e < 8; ++e) { rsum += sv[e]; qn += qv[e] * NV[cur * 64 + c8 * 8 + e]; ns += kv[e]; }
      }
      rsum += __shfl_xor(rsum, 1); qn += __shfl_xor(qn, 1); ns += __shfl_xor(ns, 1);
      rsum += __shfl_xor(rsum, 2); qn += __shfl_xor(qn, 2); ns += __shfl_xor(ns, 2);
      if (part == 0) {
        DEN[t] = 1.f / fmaxf(fabsf(WI[t] * qn + rsum), EMT[t]);
        NV[(cur ^ 1) * 64 + t] = dec * NV[cur * 64 + t] + ns;
      }
    }
    __syncthreads();
    if (step + 1 < 36) SCANB_PREFETCH(step + 1);
    f32x16 num[2];
#pragma unroll
    for (int tt = 0; tt < 2; ++tt)
#pragma unroll
      for (int e = 0; e < 16; ++e) num[tt][e] = 0.f;
#pragma unroll
    for (int ft = 0; ft < 2; ++ft)
#pragma unroll
      for (int s = 0; s < 2; ++s) {
        bf16x8 pb = pack8(C[ft], s);
#pragma unroll
        for (int tt = 0; tt < 2; ++tt) {
          const u16* qb = QB + (tt * 32 + r) * 72 + ft * 32 + s * 16 + 4 * h;
          bf16x8 a = cat4(*(const s16x4*)qb, *(const s16x4*)(qb + 8));
          num[tt] = MFMA(a, pb, num[tt]);
        }
      }
#pragma unroll
    for (int tt = 0; tt < 2; ++tt)
#pragma unroll
      for (int e = 0; e < 16; ++e) num[tt][e] *= WI[tt * 32 + crow(e, h)];
    bf16x8 bv[4];
#pragma unroll
    for (int ks = 0; ks < 4; ++ks) bv[ks] = *(const bf16x8*)(VT + (wid * 32 + r) * 72 + (((ks * 2 + h) ^ (((wid * 32 + r) >> 3) & 7)) << 3));
#pragma unroll
    for (int ks = 0; ks < 4; ++ks)
#pragma unroll
      for (int tt = 0; tt < 2; ++tt) {
        bf16x8 a = *(const bf16x8*)(SM + (tt * 32 + r) * 72 + ks * 16 + h * 8);
        num[tt] = MFMA(a, bv[ks], num[tt]);
      }
#pragma unroll
    for (int tt = 0; tt < 2; ++tt)
#pragma unroll
      for (int e = 0; e < 16; ++e) {
        const int i = tt * 32 + crow(e, h);
        const int tok = tok0 + (dir ? 63 - i : i);
        Ob[(size_t)tok * 512 + hd * 128 + wid * 32 + r] = f2bf(num[tt][e] * DEN[i]);
      }
#pragma unroll
    for (int ft = 0; ft < 2; ++ft) {
#pragma unroll
      for (int e = 0; e < 16; ++e) C[ft][e] *= dec;
#pragma unroll
      for (int ks = 0; ks < 4; ++ks) {
        bf16x8 a = *(const bf16x8*)(KWT + (ft * 32 + r) * 72 + (((ks * 2 + h) ^ (((ft * 32 + r) >> 3) & 7)) << 3));
        C[ft] = MFMA(a, bv[ks], C[ft]);
      }
    }
    m = mnew;
    cur ^= 1;
  }
#undef SCANB_PREFETCH
#undef SCANB_LDKQ
#undef SCANB_LDV
#undef SCANB_STKQ
#undef SCANB_STV
#undef SCANB_TOK0
}

__device__ void phase_mixers(const Params& p, int l, int g, char* lds, int cbase = 0, bool scans_only = false, bool a_only = false) {
  int* s_item = (int*)(lds + LDS_BYTES - 16);
  int* cnt = (int*)(p.ws + OFF_CNT) + cbase + (l * NG + g);
  const u16* P = (const u16*)(p.ws + OFF_P);
  const u16* Qd = (const u16*)(p.ws + OFF_QD);
  const u16* Kd = (const u16*)(p.ws + OFF_KD);
  const u16* Vd = (const u16*)(p.ws + OFF_VD);
  u16* Y = (u16*)((char*)p.out);
  const float* rc = (const float*)(p.ws + OFF_ROPE);
  constexpr int NSA = NB * 8, NSB = NB * 4;
  constexpr int ND_L = NB * 4 * 8, NC_L = NB * 2 * 32, ND_C = NB * 4, NC_C = NB * 2 * 4;
  constexpr int I1 = NSA, I2 = I1 + NSB, I3 = I2 + ND_L, I4 = I3 + NC_L, I5 = I4 + ND_C, I6 = I5 + NC_C;
  const float scC = 0.125f * LOG2E, scD = 0.07216878364870322f * LOG2E;
  while (true) {
    __syncthreads();
    if (otid() == 0) *s_item = atomicAdd(cnt, 1);
    __syncthreads();
    const int it = *s_item;
    if (it >= (a_only ? I1 : (scans_only ? I2 : (l == DEPTH - 1 ? I4 : I6)))) break;
    if (it < I1) scanA_unit(p, l, it, lds);
    else if (it < I2) scanB_unit(p, l, it - I1, lds);
    else {
      bool isD, isLat; int q;
      if (it < I3) { isD = true; isLat = true; q = it - I2; }
      else if (it < I4) { isD = false; isLat = true; q = it - I3; }
      else if (it < I5) { isD = true; isLat = false; q = it - I4; }
      else { isD = false; isLat = false; q = it - I5; }
      const int tid = otid(), lane = tid & 63, wid = tid >> 6, r = lane & 31;
      const int nkeys = isLat ? TPB : CTXL;
      if (isD) {
        const int nqt = isLat ? 8 : 1;
        const int qt = q % nqt, hd = (q / nqt) % 4, bl = q / (nqt * 4);
        const int tokk = bl * TPB, ql = qt * 256 + wid * 32 + r;
        const int tokq = tokk + (isLat ? CTXL : 0) + ql;
        attn_item<192, 128, true>(Qd + (size_t)tokq * 768 + hd * 192, Kd + (size_t)tokk * 768 + hd * 192, 768,
                                  Vd + (size_t)tokk * 512 + hd * 128, 512, Y + (size_t)tokq * 2048 + 1536 + hd * 128,
                                  nkeys, scD, isLat ? ql : -1, rc, lds);
      } else {
        const int nqt = isLat ? 32 : 4;
        const int qt = q % nqt, kvh = (q / nqt) % 2, bl = q / (nqt * 2);
        const int hq = kvh * 4 + (wid >> 1);
        const int tokk = bl * TPB, ql = qt * 64 + (wid & 1) * 32 + r;
        const int tokq = tokk + (isLat ? CTXL : 0) + ql;
        attn_item<64, 64, false>(P + (size_t)tokq * PS + C_Q + hq * 64, P + (size_t)tokk * PS + C_K + kvh * 64, PS,
                                 P + (size_t)tokk * PS + C_V + kvh * 64, PS, Y + (size_t)tokq * 2048 + 1024 + hq * 64,
                                 nkeys, scC, -1, rc, lds);
      }
    }
  }
}

__device__ void phase_readout(const Params& p, int l) {
  const int tid = otid(), lane = tid & 63, wid = tid >> 6;
  const u16* P = (const u16*)(p.ws + OFF_P);
  const u16* Oa = (const u16*)(p.ws + OFF_OA);
  const u16* Ob = (const u16*)(p.ws + OFF_OB);
  u16* Y = (u16*)((char*)p.out);
  const int col = lane * 8;
  float gnv[2][8];
#pragma unroll
  for (int mix = 0; mix < 2; ++mix)
#pragma unroll
    for (int e = 0; e < 8; ++e) gnv[mix][e] = ((mix == 0 ? p.hnorm : p.mnorm) + l * 128 + (col & 127))[e];
  const int stride = gridDim.x * 8;
  const bool skipc = l == DEPTH - 1;
  for (int tok0 = blockIdx.x * 8 + wid; tok0 < NTOK; tok0 += 2 * stride) {
    int tk[2]; bool doit[2];
    tk[0] = tok0; tk[1] = tok0 + stride;
    doit[0] = !(skipc && (tk[0] % TPB) < CTXL);
    doit[1] = tk[1] < NTOK && !(skipc && (tk[1] % TPB) < CTXL);
    if (!doit[1]) tk[1] = tk[0];
    uint4 ra[2][2], rb[2][2], rg[2][2];
#pragma unroll
    for (int u = 0; u < 2; ++u)
#pragma unroll
      for (int mix = 0; mix < 2; ++mix) {
        const u16* O = mix == 0 ? Oa : Ob;
        ra[u][mix] = *(const uint4*)(O + (size_t)tk[u] * 512 + col);
        rb[u][mix] = *(const uint4*)(O + ((size_t)NTOK + tk[u]) * 512 + col);
        rg[u][mix] = *(const uint4*)(P + (size_t)tk[u] * PS + (mix == 0 ? A_G : B_O) + col);
      }
#pragma unroll
    for (int u = 0; u < 2; ++u) {
      uint4 outv[2];
#pragma unroll
      for (int mix = 0; mix < 2; ++mix) {
        float a[8], b[8], gt[8], o[8];
        unpack8(ra[u][mix], a); unpack8(rb[u][mix], b); unpack8(rg[u][mix], gt);
        float ss = 0.f;
#pragma unroll
        for (int e = 0; e < 8; ++e) { a[e] += b[e]; ss += a[e] * a[e]; }
        ss += __shfl_xor(ss, 1); ss += __shfl_xor(ss, 2); ss += __shfl_xor(ss, 4); ss += __shfl_xor(ss, 8);
        const float rstd = rsqrtf(ss * (1.f / 128.f) + EPS);
#pragma unroll
        for (int e = 0; e < 8; ++e) {
          float y = a[e] * rstd * gnv[mix][e];
          o[e] = y * (mix == 0 ? siluf_(gt[e]) : sigmoidf_(gt[e]));
        }
        outv[mix] = pack8f(o);
      }
      if (doit[u]) {
        *(uint4*)(Y + (size_t)tk[u] * 2048 + col) = outv[0];
        *(uint4*)(Y + (size_t)tk[u] * 2048 + 512 + col) = outv[1];
      }
    }
  }
}

struct EpiInproj {
  u16* P; float* Gb;
  DI bool operator()(f32x4 (&acc)[2][2][4][2], const pg8::UDesc& u, int wr, int wc, int fr, int fq) const {
    const int row0 = u.pm * 256 + wr * 64 + fr, col0 = u.pn * 256 + wc * 32 + 8 * fq;
    const bool gate = (u.pn == 9) && (wc == 0) && (fq < 2);
#pragma unroll
    for (int ai = 0; ai < 2; ++ai)
#pragma unroll
      for (int m = 0; m < 4; ++m) {
        const size_t row = (size_t)(row0 + ai * 128 + m * 16);
#pragma unroll
        for (int bj = 0; bj < 2; ++bj) *(uint4*)(P + row * PS + col0 + bj * 128) = pk8(acc[ai][bj][m][0], acc[ai][bj][m][1]);
        if (gate) { *(f32x4*)(Gb + row * 16 + 8 * fq) = acc[ai][0][m][0]; *(f32x4*)(Gb + row * 16 + 8 * fq + 4) = acc[ai][0][m][1]; }
      }
    return false;
  }
};
__device__ void phase_inproj(const Params& p, int l, char* lds) {
  pg8::PlainSched S{p.ws + OFF_H, wsel(p, l) + OFF_WINT, 2048u, 2048u, 16, NTOK / 256, PS / 256, (int)gridDim.x, (int)blockIdx.x};
  EpiInproj E{(u16*)(p.ws + OFF_P), (float*)(p.ws + OFF_GB)};
  pg8::gemm_stream(( LAS unsigned char*)lds, S, E);
}

struct MlaSched {
  const char* P; const char* Wq; const char* Wk; const char* Wv; int G, c;
  DI bool next(int i, pg8::UDesc& u) const {
    const long L = (long)i * G + c; if (L >= (NTOK / 256) * 7) return false;
    const int pm = (int)(L / 7), j = (int)(L % 7);
    u.pm = pm; u.lda2 = PS * 2;
    if (j < 3) { u.tag = 0; u.pn = j; u.A = P + (size_t)pm * 256 * PS * 2 + D_CQ * 2; u.B = Wq + (size_t)j * 256 * 512; u.ldb2 = 512; u.nt = 4; }
    else if (j < 5) { u.tag = 1; u.pn = j - 3; u.A = P + (size_t)pm * 256 * PS * 2 + D_CKV * 2; u.B = Wk + (size_t)(j - 3) * 256 * 256; u.ldb2 = 256; u.nt = 2; }
    else { u.tag = 2; u.pn = j - 5; u.A = P + (size_t)pm * 256 * PS * 2 + D_CKV * 2; u.B = Wv + (size_t)(j - 5) * 256 * 256; u.ldb2 = 256; u.nt = 2; }
    return true;
  }
};
struct EpiMla {
  u16 *Qd, *Kd, *Vd;
  DI bool operator()(f32x4 (&acc)[2][2][4][2], const pg8::UDesc& u, int wr, int wc, int fr, int fq) const {
    const int row0 = u.pm * 256 + wr * 64 + fr, col0 = u.pn * 256 + wc * 32 + 8 * fq;
#pragma unroll
    for (int ai = 0; ai < 2; ++ai)
#pragma unroll
      for (int m = 0; m < 4; ++m) {
        const size_t row = (size_t)(row0 + ai * 128 + m * 16);
#pragma unroll
        for (int bj = 0; bj < 2; ++bj) {
          const int col = col0 + bj * 128;
          u16* dst = u.tag == 0 ? Qd + row * 768 + col : (u.tag == 1 ? Kd + row * 768 + (col >> 7) * 192 + (col & 127) : Vd + row * 512 + col);
          *(uint4*)dst = pk8(acc[ai][bj][m][0], acc[ai][bj][m][1]);
        }
      }
    return false;
  }
};
__device__ void phase_mlaup(const Params& p, int l, char* lds) {
  MlaSched S{p.ws + OFF_P, wsel(p, l) + OFF_WUQ, wsel(p, l) + OFF_WUK, wsel(p, l) + OFF_WUV, (int)gridDim.x, (int)blockIdx.x};
  EpiMla E{(u16*)(p.ws + OFF_QD), (u16*)(p.ws + OFF_KD), (u16*)(p.ws + OFF_VD)};
  pg8::gemm_stream((LAS unsigned char*)lds, S, E);
}

struct EpiGate {
  u16* Gt;
  DI bool operator()(f32x4 (&acc)[2][2][4][2], const pg8::UDesc& u, int wr, int wc, int fr, int fq) const {
    const int row0 = u.pm * 256 + wr * 64 + fr, col0 = u.pn * 256 + wc * 32 + 8 * fq;
#pragma unroll
    for (int ai = 0; ai < 2; ++ai)
#pragma unroll
      for (int m = 0; m < 4; ++m) {
        const size_t row = (size_t)(row0 + ai * 128 + m * 16);
#pragma unroll
        for (int bj = 0; bj < 2; ++bj) {
          f32x4 a = acc[ai][bj][m][0], b = acc[ai][bj][m][1];
#pragma unroll
          for (int e = 0; e < 4; ++e) { a[e] = fmaxf(sigmoidf_(a[e]), 1e-30f); b[e] = fmaxf(sigmoidf_(b[e]), 1e-30f); }
          *(uint4*)(Gt + row * 4096 + col0 + bj * 128) = pk8(a, b);
        }
      }
    return false;
  }
};
__device__ void phase_gate(const Params& p, int l, char* lds, int lat_only) {
  pg8::PlainSched S{p.ws + OFF_H, wsel(p, l) + OFF_WGT, 2048u, 2048u, 16, NTOK / 256, 16, (int)gridDim.x, (int)blockIdx.x, lat_only};
  EpiGate E{(u16*)(p.ws + OFF_P)};
  pg8::gemm_stream((LAS unsigned char*)lds, S, E);
}

struct BranchSched {
  const char* Y; const char* Wb; int G, c, lat_only;
  DI bool next(int i, pg8::UDesc& u) const {
    int pm, pn; if (!pg8::tile_order((long)(i >> 2) * G + c, lat_only ? NTOK / 256 - NB : NTOK / 256, 4, pm, pn)) return false;
    if (lat_only) pm = pm + (pm >> 3) + 1;
    const int r = i & 3;
    u.pm = pm; u.pn = pn; u.tag = r; u.lda2 = 4096; u.ldb2 = 1024; u.nt = 8;
    u.A = Y + (size_t)pm * 256 * 4096 + r * 1024; u.B = Wb + ((size_t)r * 1024 + pn * 256) * 1024;
    return true;
  }
};
struct EpiBranch {
  const u16* Gt; u16* Mg;
  DI bool operator()(f32x4 (&acc)[2][2][4][2], const pg8::UDesc& u, int wr, int wc, int fr, int fq) const {
    const int row0 = u.pm * 256 + wr * 64 + fr, col0 = u.pn * 256 + wc * 32 + 8 * fq, r = u.tag;
    const int rn = r < 3 ? r + 1 : r;
    uint4 gin[2][2][2], gnn[2][2][2];
#define EPB_LOAD(slot, k_) do { const int ai_ = (k_) >> 1, mh_ = (k_) & 1; \
    _Pragma("unroll") for (int mm = 0; mm < 2; ++mm) _Pragma("unroll") for (int bj = 0; bj < 2; ++bj) { \
      const u16* gp = Gt + (size_t)(row0 + ai_ * 128 + (mh_ * 2 + mm) * 16) * 4096 + col0 + bj * 128; \
      gin[slot][mm][bj] = *(const uint4*)(gp + r * 1024); gnn[slot][mm][bj] = *(const uint4*)(gp + rn * 1024); } } while (0)
    EPB_LOAD(0, 0);
#pragma unroll
    for (int k = 0; k < 4; ++k) {
      const int ai = k >> 1, mh = k & 1, slot = k & 1;
      if (k + 1 < 4) EPB_LOAD(slot ^ 1, k + 1);
#pragma unroll
      for (int mm = 0; mm < 2; ++mm) {
        const int m = mh * 2 + mm;
        const size_t row = (size_t)(row0 + ai * 128 + m * 16);
#pragma unroll
        for (int bj = 0; bj < 2; ++bj) {
          const int col = col0 + bj * 128;
          float gv[8];
          unpack8(gin[slot][mm][bj], gv);
          if (r < 3) {
            float gn[8];
            unpack8(gnn[slot][mm][bj], gn);
#pragma unroll
            for (int e = 0; e < 4; ++e) {
              acc[ai][bj][m][0][e] *= gv[e] * __builtin_amdgcn_rcpf(gn[e]);
              acc[ai][bj][m][1][e] *= gv[4 + e] * __builtin_amdgcn_rcpf(gn[4 + e]);
            }
          } else {
            f32x4 a = acc[ai][bj][m][0], b = acc[ai][bj][m][1];
#pragma unroll
            for (int e = 0; e < 4; ++e) { a[e] *= gv[e]; b[e] *= gv[4 + e]; }
            *(uint4*)(Mg + row * 1024 + col) = pk8(a, b);
          }
        }
      }
    }
#undef EPB_LOAD
    return r < 3;
  }
};
__device__ void phase_branch(const Params& p, int l, char* lds, int lat_only) {
  BranchSched S{(const char*)p.out, wsel(p, l) + OFF_WBT, (int)gridDim.x, (int)blockIdx.x, lat_only};
  EpiBranch E{(const u16*)(p.ws + OFF_P), (u16*)(p.ws + OFF_OA)};
  pg8::gemm_stream((LAS unsigned char*)lds, S, E);
}

struct EpiResid {
  const Params* pp; const float* mod; int g, gidx; float* dummy;
  DI bool operator()(f32x4 (&acc)[2][2][4][2], const pg8::UDesc& u, int wr, int wc, int fr, int fq) const {
    int mr; u16* xb = xrow_ptr(*pp, g, u.pm * 256, mr);
    if (dummy) xb = (u16*)dummy + (size_t)u.pm * 256 * DM;
    const float* gate = mod + (size_t)mr * 6144 + gidx * DM;
    const int row0 = wr * 64 + fr, col0 = u.pn * 256 + wc * 32 + 8 * fq;
    f32x4 gv[2][2];
#pragma unroll
    for (int bj = 0; bj < 2; ++bj) { gv[bj][0] = *(const f32x4*)(gate + col0 + bj * 128); gv[bj][1] = *(const f32x4*)(gate + col0 + bj * 128 + 4); }
#pragma unroll
    for (int ai = 0; ai < 2; ++ai) {
      uint4 xin[4][2];
#pragma unroll
      for (int m = 0; m < 4; ++m)
#pragma unroll
        for (int bj = 0; bj < 2; ++bj) xin[m][bj] = *(const uint4*)(xb + (size_t)(row0 + ai * 128 + m * 16) * DM + col0 + bj * 128);
#pragma unroll
      for (int m = 0; m < 4; ++m) {
        u16* xr = xb + (size_t)(row0 + ai * 128 + m * 16) * DM + col0;
#pragma unroll
        for (int bj = 0; bj < 2; ++bj) {
          float xv[8];
          unpack8(xin[m][bj], xv);
          f32x4 x0 = {xv[0], xv[1], xv[2], xv[3]}, x1 = {xv[4], xv[5], xv[6], xv[7]};
          x0 += gv[bj][0] * acc[ai][bj][m][0]; x1 += gv[bj][1] * acc[ai][bj][m][1];
          *(uint4*)(xr + bj * 128) = pk8(x0, x1);
        }
      }
    }
    return false;
  }
};
__device__ void phase_resid_gemm(const Params& p, int l, int g, const char* A, const char* W, int K, int gidx, char* lds, float* dummy = nullptr) {
  pg8::PlainSched S{A, W, (unsigned)K * 2u, (unsigned)K * 2u, K / 64, NTOK / 256, 4, (int)gridDim.x, (int)blockIdx.x, (l == DEPTH - 1) ? 1 : 0};
  EpiResid E{&p, (const float*)(p.ws + OFF_MOD) + (size_t)l * 33 * 6144, g, gidx, dummy};
  pg8::gemm_stream((LAS unsigned char*)lds, S, E);
}

struct EpiFF1 {
  u16* Hid;
  DI bool operator()(f32x4 (&acc)[2][2][4][2], const pg8::UDesc& u, int wr, int wc, int fr, int fq) const {
    const int row0 = u.pm * 256 + wr * 64 + fr, col0 = u.pn * 256 + wc * 32 + 8 * fq;
#pragma unroll
    for (int ai = 0; ai < 2; ++ai)
#pragma unroll
      for (int m = 0; m < 4; ++m) {
        const size_t row = (size_t)(row0 + ai * 128 + m * 16);
#pragma unroll
        for (int bj = 0; bj < 2; ++bj) {
          f32x4 a = acc[ai][bj][m][0], b = acc[ai][bj][m][1];
#pragma unroll
          for (int e = 0; e < 4; ++e) { float t = fmaxf(a[e], 0.f); a[e] = t * t; t = fmaxf(b[e], 0.f); b[e] = t * t; }
          *(uint4*)(Hid + row * DFF + col0 + bj * 128) = pk8(a, b);
        }
      }
    return false;
  }
};
__device__ void phase_ff1(const Params& p, int l, char* lds, int lat_only) {
  pg8::PlainSched S{p.ws + OFF_H, wsel(p, l) + OFF_W1T, 2048u, 2048u, 16, NTOK / 256, 16, (int)gridDim.x, (int)blockIdx.x, lat_only};
  EpiFF1 E{(u16*)(p.ws + OFF_P)};
  pg8::gemm_stream((LAS unsigned char*)lds, S, E);
}

DI void final_finish(const uint2 (&q)[4], int lane, const float4 (&gfv)[4], float* orow) {
  float4 v[4]; float ss = 0.f;
#pragma unroll
  for (int j = 0; j < 4; ++j) {
    v[j].x = __uint_as_float(q[j].x << 16); v[j].y = __uint_as_float(q[j].x & 0xffff0000u); v[j].z = __uint_as_float(q[j].y << 16); v[j].w = __uint_as_float(q[j].y & 0xffff0000u);
    ss += v[j].x * v[j].x + v[j].y * v[j].y + v[j].z * v[j].z + v[j].w * v[j].w;
  }
  ss = wave_sum(ss);
  const float rstd = rsqrtf(ss * (1.f / DM) + EPS);
#pragma unroll
  for (int j = 0; j < 4; ++j) {
    const int c = j * 256 + lane * 4;
    const float4 gg = gfv[j];
    float4 o = {v[j].x * rstd * gg.x, v[j].y * rstd * gg.y, v[j].z * rstd * gg.z, v[j].w * rstd * gg.w};
    *(float4*)(orow + c) = o;
  }
}
__device__ void phase_final(const Params& p) {
  const int tid = otid(), lane = tid & 63, wid = tid >> 6;
  const int stride = gridDim.x * 8;
  const u16* X = (const u16*)(p.ws + OFF_XL);
  float4 gfv[4];
#pragma unroll
  for (int j = 0; j < 4; ++j) gfv[j] = *(const float4*)(p.gfin + j * 256 + lane * 4);
  for (int tok = blockIdx.x * 8 + wid; tok < NBATCH * SEQ; tok += 2 * stride) {
    const int tokB = tok + stride;
    const bool doB = tokB < NBATCH * SEQ;
    uint2 qa[4], qb[4];
    norm_load(X + (size_t)tok * DM, lane, qa);
    norm_load(X + (size_t)(doB ? tokB : tok) * DM, lane, qb);
    final_finish(qa, lane, gfv, p.out + (size_t)tok * DM);
    if (doB) final_finish(qb, lane, gfv, p.out + (size_t)tokB * DM);
  }
}

#define XB_TMO      128
#define XB_XCNT(j)  (256  + 64 * (j))
#define XB_XSUB(j)  (1280 + 64 * (j))
#define XB_XGEN(j)  (2304 + 64 * (j))
#define XB_TOP      3328
#define XB_TOPGEN   3392
#define XCD_BAR_WORDS 3456
#define XB_SPIN_CAP (1u << 18)
DI unsigned xb_ld(unsigned* p) { return __hip_atomic_load(p, __ATOMIC_RELAXED, __HIP_MEMORY_SCOPE_AGENT); }
DI unsigned xb_add(unsigned* p, unsigned v) { return __hip_atomic_fetch_add(p, v, __ATOMIC_RELAXED, __HIP_MEMORY_SCOPE_AGENT); }
DI unsigned xb_xcc_id() { return (unsigned)__builtin_amdgcn_s_getreg((3 << 11) | 20) & 0xFu; }
#define XB_SPIN(cond, bar) do { unsigned _sp = 0; while (cond) { __builtin_amdgcn_s_sleep(1); \
    if ((++_sp & 255u) == 0u) { if (xb_ld(&(bar)[XB_TMO])) break; if (_sp > XB_SPIN_CAP) { atomicAdd(&(bar)[XB_TMO], 1u); break; } } } } while (0)
struct XcdBarrier { unsigned* bar; unsigned x; volatile __attribute__((address_space(3))) unsigned* st; };
DI XcdBarrier xcd_barrier_post(unsigned* bar, volatile __attribute__((address_space(3))) unsigned* st) {
  XcdBarrier b; b.bar = bar; b.x = xb_xcc_id(); b.st = st;
  if (threadIdx.x == 0) (void)xb_add(&bar[XB_XCNT(b.x)], 1u);
  return b;
}
DI void xcd_barrier_complete(unsigned* bar, unsigned x, unsigned& nloc, unsigned& nx) {
  const unsigned G = gridDim.x * gridDim.y * gridDim.z;
  unsigned sum, cnt, mine, sp = 0u;
  for (;;) {
    sum = 0u; cnt = 0u; mine = 0u;
#pragma unroll
    for (unsigned j = 0; j < 16; ++j) { const unsigned c = xb_ld(&bar[XB_XCNT(j)]); sum += c; cnt += (c > 0u) ? 1u : 0u; mine = (j == x) ? c : mine; }
    if (sum == G) break;
    __builtin_amdgcn_s_sleep(1);
    if ((++sp & 255u) == 0u) { if (xb_ld(&bar[XB_TMO])) break; if (sp > XB_SPIN_CAP) { atomicAdd(&bar[XB_TMO], 1u); break; } }
  }
  nloc = mine > 0u ? mine : 1u; nx = cnt > 0u ? cnt : 1u;
}
DI void xcd_barrier(const XcdBarrier& b) {
  asm volatile("s_waitcnt vmcnt(0)" ::: "memory");
  __syncthreads();
  if (threadIdx.x == 0) {
    unsigned* bar = b.bar;
    __builtin_amdgcn_s_waitcnt(0);
    unsigned nloc = b.st[0], nx = b.st[1];
    if (nloc == 0u) { xcd_barrier_complete(bar, b.x, nloc, nx); b.st[0] = nloc; b.st[1] = nx; }
    const unsigned old = xb_add(&bar[XB_XSUB(b.x)], 1u);
    const unsigned gen = old / nloc;
    if (old + 1u == (gen + 1u) * nloc) {
      __builtin_amdgcn_fence(__ATOMIC_RELEASE, "agent");
      asm volatile("s_waitcnt vmcnt(0)" ::: "memory");
      const unsigned og = xb_add(&bar[XB_TOP], 1u);
      const unsigned tg = og / nx;
      if (og + 1u == (tg + 1u) * nx) xb_add(&bar[XB_TOPGEN], 1u);
      else XB_SPIN(xb_ld(&bar[XB_TOPGEN]) == tg, bar);
      __builtin_amdgcn_fence(__ATOMIC_ACQUIRE, "agent");
      xb_add(&bar[XB_XGEN(b.x)], 1u);
      asm volatile("s_waitcnt vmcnt(0)" ::: "memory");
    } else {
      XB_SPIN(xb_ld(&bar[XB_XGEN(b.x)]) == gen, bar);
      __builtin_amdgcn_fence(__ATOMIC_ACQUIRE, "agent");
      asm volatile("s_waitcnt vmcnt(0)" ::: "memory");
    }
  }
  __syncthreads();
}

constexpr int NSUB = 12;
constexpr int NPHASE = 1 + DEPTH * NG * NSUB + 1;

__global__ void __launch_bounds__(512) mega(Params p, int ph_lo, int ph_hi) {
  extern __shared__ __attribute__((aligned(16))) char lds[];
  volatile __attribute__((address_space(3))) unsigned* st = (volatile __attribute__((address_space(3))) unsigned*)(lds + LDS_BYTES - 32);
  if (threadIdx.x < 2) st[threadIdx.x] = 0u;
  __syncthreads();
  XcdBarrier xb{};
  if (ph_hi - ph_lo > 1) xb = xcd_barrier_post((unsigned*)(p.ws + OFF_BAR), st);
#define GSYNC() xcd_barrier(xb)
  for (int ph = ph_lo; ph < ph_hi; ++ph) {
    if (ph > 0 && ph < NPHASE - 1 && ((ph - 1) % NSUB) == 0 && ((ph - 1) / NSUB) != 0) continue;
    if (ph == 0) { phase_prep(p, lds); phase_wconv(p, 0, lds); }
    else if (ph == NPHASE - 1) phase_final(p);
    else {
      const int q = ph - 1, lg = q / NSUB, sub = q % NSUB, l = lg / NG, g = lg % NG;
      switch (sub) {
        case 0: if (lg == 0) phase_norm(p, l, g, 0); break;
        case 1: for (int rep = 0; rep < ((PROBE & 2) ? 2 : 1); ++rep) { if (rep) GSYNC(); phase_inproj(p, l, lds); } break;
        case 2: phase_tokprep(p, l); break;
        case 3: phase_mlaup(p, l, lds); break;
        case 4: phase_mixers(p, l, g, lds); if (PROBE & 1) { GSYNC(); phase_mixers(p, l, g, lds, 8); } if (PROBE & 4) { GSYNC(); phase_mixers(p, l, g, lds, 8, true); } if (PROBE & 16) { GSYNC(); phase_mixers(p, l, g, lds, 8, true, true); } break;
        case 5: for (int rep = 0; rep < ((PROBE & 8) ? 2 : 1); ++rep) { if (rep) GSYNC(); phase_readout(p, l); } break;
        case 6: for (int rep = 0; rep < ((PROBE & 2) ? 2 : 1); ++rep) { if (rep) GSYNC(); phase_gate(p, l, lds, l == DEPTH - 1); } break;
        case 7: for (int rep = 0; rep < ((PROBE & 32) ? 2 : 1); ++rep) { if (rep) GSYNC(); phase_branch(p, l, lds, l == DEPTH - 1); } if (g == 0 && l + 1 < DEPTH) phase_wconv(p, l + 1, lds, (int*)(p.ws + OFF_CNT) + 24 + l); break;
        case 8: for (int rep = 0; rep < ((PROBE & 64) ? 2 : 1); ++rep) { if (rep) GSYNC(); phase_resid_gemm(p, l, g, p.ws + OFF_OA, wsel(p, l) + OFF_WOT, DM, 2, lds, rep ? (float*)((char*)p.out) : nullptr); } break;
        case 9: for (int rep = 0; rep < ((PROBE & 8) ? 2 : 1); ++rep) { if (rep) GSYNC(); phase_norm(p, l, g, 1); } break;
        case 10: for (int rep = 0; rep < ((PROBE & 2) ? 2 : 1); ++rep) { if (rep) GSYNC(); phase_ff1(p, l, lds, l == DEPTH - 1); } break;
        default: for (int rep = 0; rep < ((PROBE & 64) ? 2 : 1); ++rep) { if (rep) GSYNC(); phase_resid_gemm(p, l, g, p.ws + OFF_P, wsel(p, l) + OFF_W2T, DFF, 5, lds, rep ? (float*)((char*)p.out) : nullptr); } if (lg + 1 < DEPTH * NG) phase_norm_dyn(p, (lg + 1) / NG, (lg + 1) % NG, (int*)(p.ws + OFF_CNT) + 16 + lg); break;
      }
    }
    if (ph + 1 < ph_hi) { if (ph == ph_lo) cg::this_grid().sync(); else GSYNC(); }
  }
}

extern "C" void kernel_launch(void* const* d_in, const int* in_sizes, int n_in, void* d_out, int out_size, void* d_ws,
                              size_t ws_size, hipStream_t stream) {
  static int grid_blocks = 0;
  if (!grid_blocks) {
    int dev = 0, cus = 0, per_cu = 0;
    (void)hipGetDevice(&dev);
    (void)hipDeviceGetAttribute(&cus, hipDeviceAttributeMultiprocessorCount, dev);
    (void)hipFuncSetAttribute((const void*)mega, hipFuncAttributeMaxDynamicSharedMemorySize, LDS_BYTES);
    (void)hipOccupancyMaxActiveBlocksPerMultiprocessor(&per_cu, mega, NTHR, LDS_BYTES);
    if (per_cu < 1) per_cu = 1;
    if (per_cu > 1) per_cu = 1;
    grid_blocks = cus * per_cu;
  }
  if (ws_size < WS_NEED) { fprintf(stderr, "workspace too small: %zu < %zu\n", ws_size, (size_t)WS_NEED); }
  Params p{};
  const float** pf = (const float**)&p;
  for (int i = 0; i < 26; ++i) pf[i] = (const float*)d_in[i];
  p.out = (float*)d_out;
  p.ws = (char*)d_ws;
  (void)hipMemsetAsync((char*)d_ws + OFF_CNT, 0, 256 + 3456 * 4, stream);
#if ONE_LAUNCH
  int lo = 0, hi = NPHASE;
  void* args[] = {&p, &lo, &hi};
  hipError_t e = hipLaunchCooperativeKernel((void*)mega, dim3(grid_blocks), dim3(NTHR), args, LDS_BYTES, stream);
  if (e != hipSuccess) fprintf(stderr, "cooperative launch failed: %s (grid %d)\n", hipGetErrorString(e), grid_blocks);
#else
  for (int ph = 0; ph < NPHASE; ++ph) mega<<<grid_blocks, NTHR, LDS_BYTES, stream>>>(p, ph, ph + 1);
#endif
}
```
